# Optimizing an MI355X kernel written in HIP

```python
import jax, jax.numpy as jnp
from jax import lax
import numpy as np

D_MODEL = 1024
BATCH = 32
SEQ = 2048
DEPTH = 4

GRID_W = 64
CTX_LEN = 256
D_MIX = D_MODEL
MLA_HEADS = 8
Q_RANK = 256
KV_RANK = 128
QK_NOPE = 64
QK_ROPE = 32
V_HEAD = 64
MLA_SCALE = (QK_NOPE + QK_ROPE) ** -0.5
ROPE_BASE = 10000.0
Q_BLOCK = 128
RWKV_HEADS = 8
RWKV_HEAD = 64
RWKV_DIM = RWKV_HEADS * RWKV_HEAD
DECAY_LORA = 64
AAA_LORA = 64
MV_LORA = 32
GATE_LORA = 128
N_DIRS = 2
LNX_EPS = 64e-5
D_FF = 4 * D_MODEL
NORM_EPS = 1e-6

MLA_IN = Q_RANK + KV_RANK + QK_ROPE
RWKV_IN = 3 * RWKV_DIM + N_DIRS * DECAY_LORA + N_DIRS * AAA_LORA + GATE_LORA
C_IN = MLA_IN + RWKV_IN
RWKV_SPLITS = (RWKV_DIM, 2 * RWKV_DIM, 3 * RWKV_DIM,
               3 * RWKV_DIM + N_DIRS * DECAY_LORA,
               3 * RWKV_DIM + N_DIRS * DECAY_LORA + N_DIRS * AAA_LORA)

kernel_name = 'hybrid_mla_rwkv7_diffusion_trunk'


def rmsnorm(x, g):
    xf = x.astype(jnp.float32)
    y = xf * lax.rsqrt(jnp.mean(xf * xf, axis=-1, keepdims=True) + NORM_EPS)
    return (y * g.astype(jnp.float32)).astype(x.dtype)


def modulate(h, shift, scale):
    return h * (1 + scale[:, None]) + shift[:, None]


def sq_relu_mlp(h, w1, w2):
    return jnp.square(jax.nn.relu(h @ w1)) @ w2


def axial_angles(n_tokens):
    rows = n_tokens // GRID_W
    row = jnp.repeat(jnp.arange(rows, dtype=jnp.float32), GRID_W)
    col = jnp.tile(jnp.arange(GRID_W, dtype=jnp.float32), rows)
    n_freq = QK_ROPE // 4
    inv_freq = ROPE_BASE ** (-jnp.arange(n_freq, dtype=jnp.float32) / n_freq)
    ar = row[:, None] * inv_freq
    ac = col[:, None] * inv_freq
    return jnp.concatenate([ar, ar, ac, ac], axis=-1)


def apply_axial_rope(x, angles):
    shape = (angles.shape[0],) + (1,) * (x.ndim - 3) + (QK_ROPE,)
    cos = jnp.cos(angles).reshape(shape).astype(x.dtype)
    sin = jnp.sin(angles).reshape(shape).astype(x.dtype)
    xr1, xr2, xc1, xc2 = jnp.split(x, 4, axis=-1)
    rot = jnp.concatenate([-xr2, xr1, -xc2, xc1], axis=-1)
    return x * cos + rot * sin


def mla_q(cq, g, w_uq, angles):
    B, T, _ = cq.shape
    q = (rmsnorm(cq, g) @ w_uq).reshape(B, T, MLA_HEADS, QK_NOPE + QK_ROPE)
    if angles is None:
        return q
    return jnp.concatenate([q[..., :QK_NOPE], apply_axial_rope(q[..., QK_NOPE:], angles)], axis=-1)


def mla_kv(f, g, w_ukv, angles):
    B, T, _ = f.shape
    ckv, kr = f[..., :KV_RANK], f[..., KV_RANK:]
    kv = (rmsnorm(ckv, g) @ w_ukv).reshape(B, T, MLA_HEADS, QK_NOPE + V_HEAD)
    k_nope, v = kv[..., :QK_NOPE], kv[..., QK_NOPE:]
    if angles is not None:
        kr = apply_axial_rope(kr, angles)
    k = jnp.concatenate([k_nope, jnp.broadcast_to(kr[:, :, None], (B, T, MLA_HEADS, QK_ROPE))], axis=-1)
    return k, v


def attend(q, k, v):
    s = jnp.einsum('bqhd,bkhd->bhqk', q, k).astype(jnp.float32) * MLA_SCALE
    p = jax.nn.softmax(s, axis=-1).astype(v.dtype)
    return jnp.einsum('bhqk,bkhd->bqhd', p, v)


def blocked_attention(q, k, v):
    B, S, H, dk = q.shape
    qb = jnp.moveaxis(q.reshape(B, S // Q_BLOCK, Q_BLOCK, H, dk), 1, 0)
    ob = lax.map(lambda qi: attend(qi, k, v), qb)
    return jnp.moveaxis(ob, 0, 1).reshape(B, S, H * v.shape[-1])


def centred_shift(f, mu):
    pad = jnp.pad(f, ((0, 0), (1, 1), (0, 0)))
    nb = 0.5 * (pad[:, :-2] + pad[:, 2:])
    return f + mu * (nb - f)


def heads(z):
    return z.reshape(z.shape[:-1] + (RWKV_HEADS, RWKV_HEAD))


def rwkv_token_terms(f, h, mu, w0, w2, a0, a2, g2, k_k, k_a, v_first, vres):
    B, T, _ = f.shape
    f = centred_shift(f, mu)
    r, k, v, w_lo, a_lo, g_lo = jnp.split(f, RWKV_SPLITS, axis=-1)
    w_lo = jnp.tanh(w_lo).reshape(B, T, N_DIRS, DECAY_LORA)
    w = -jax.nn.softplus(-(w0 + jnp.einsum('btdl,dlc->btdc', w_lo, w2))) - 0.5
    decay = jnp.exp(-jnp.exp(w.astype(jnp.float32)))
    a = jax.nn.sigmoid(a0 + jnp.einsum('btdl,dlc->btdc', a_lo.reshape(B, T, N_DIRS, AAA_LORA), a2))
    g = jax.nn.sigmoid(g_lo) @ g2
    if vres is not None:
        v0, v1, v2 = vres
        v = v + (v_first - v) * jax.nn.sigmoid(v0 + (h @ v1) @ v2)
    k_dir = k[:, :, None] * (1 + (a - 1) * k_a)
    kkf = heads(k * k_k).astype(jnp.float32)
    kk = (kkf / jnp.maximum(jnp.sqrt(jnp.sum(kkf * kkf, axis=-1, keepdims=True)), 1e-12)).astype(k.dtype)
    return (heads(r), heads(decay), heads(k_dir), heads(v), -kk, kk[:, :, None] * heads(a), g)


def two_way(c_arr, x_arr, per_dir):
    if per_dir:
        cf, cb, xf, xb = c_arr[:, :, 0], c_arr[:, ::-1, 1], x_arr[:, :, 0], x_arr[:, ::-1, 1]
    else:
        cf, cb, xf, xb = c_arr, c_arr[:, ::-1], x_arr, x_arr[:, ::-1]
    s = jnp.stack([jnp.concatenate([cf, xf], axis=1), jnp.concatenate([cb, xb], axis=1)], axis=0)
    return jnp.moveaxis(s, 2, 0).astype(jnp.float32)


def rwkv7_step(state, inp):
    r, w, k, v, a, b = inp
    sa = jnp.einsum('dbhij,dbhj->dbhi', state, a)
    state = state * w[..., None, :] + sa[..., :, None] * b[..., None, :] + v[..., :, None] * k[..., None, :]
    return state, jnp.einsum('dbhij,dbhj->dbhi', state, r)


def bidirectional_rwkv7(tok_c, tok_x):
    r_c, w_c, k_c, v_c, a_c, b_c, _ = tok_c
    r_x, w_x, k_x, v_x, a_x, b_x, _ = tok_x
    xs = (two_way(r_c, r_x, False), two_way(w_c, w_x, True), two_way(k_c, k_x, True),
          two_way(v_c, v_x, False), two_way(a_c, a_x, False), two_way(b_c, b_x, True))
    B, Tc = r_c.shape[:2]
    s0 = jnp.zeros((N_DIRS, B, RWKV_HEADS, RWKV_HEAD, RWKV_HEAD), jnp.float32)
    _, ys = lax.scan(rwkv7_step, s0, xs)
    ys = jnp.moveaxis(ys, 0, 2)
    y_c = ys[0, :, :Tc] + ys[1, :, :Tc][:, ::-1]
    y_x = ys[0, :, Tc:] + ys[1, :, Tc:][:, ::-1]
    return y_c, y_x


def rwkv_output(y, tok, r_k, lnx_w, lnx_b):
    r, _, k_dir, v, _, _, g = tok
    B, T = r.shape[:2]
    mean = jnp.mean(y, axis=-1, keepdims=True)
    var = jnp.mean(jnp.square(y - mean), axis=-1, keepdims=True)
    yn = ((y - mean) * lax.rsqrt(var + LNX_EPS)).reshape(B, T, RWKV_DIM).astype(r.dtype) * lnx_w + lnx_b
    bonus = jnp.sum(r[:, :, None] * k_dir * r_k, axis=(2, 4))[..., None] * v
    return (yn + bonus.reshape(B, T, RWKV_DIM)) * g


def setup_inputs(seed: int = 0) -> dict:
    key = jax.random.key(seed)
    ks = iter(jax.random.split(key, 40))
    nrm = lambda shape, s: jax.random.normal(next(ks), shape, jnp.float32) * s
    uni = lambda shape: jax.random.uniform(next(ks), shape, jnp.float32)
    L, D, R = DEPTH, D_MODEL, RWKV_DIM
    return {
        'x': nrm((BATCH, SEQ, D), 1.0),
        'c': nrm((BATCH, D), 1.0),
        'ctx': nrm((BATCH, CTX_LEN, D), 1.0),
        'c_ctx': nrm((D,), 1.0),
        'ada_w': nrm((L, D, 6 * D), 0.5 * D ** -0.5),
        'ada_b': nrm((L, 6 * D), 0.02),
        'norm1_g': 1.0 + nrm((L, D), 0.02),
        'norm2_g': 1.0 + nrm((L, D), 0.02),
        'w_in': nrm((L, D, C_IN), D ** -0.5),
        'q_norm_g': 1.0 + nrm((L, Q_RANK), 0.02),
        'w_uq': nrm((L, Q_RANK, MLA_HEADS * (QK_NOPE + QK_ROPE)), Q_RANK ** -0.5),
        'kv_norm_g': 1.0 + nrm((L, KV_RANK), 0.02),
        'w_ukv': nrm((L, KV_RANK, MLA_HEADS * (QK_NOPE + V_HEAD)), KV_RANK ** -0.5),
        'shift_mu': uni((L, RWKV_IN)),
        'decay_w0': -6.0 + 5.0 * uni((L, N_DIRS, R)),
        'decay_w2': nrm((L, N_DIRS, DECAY_LORA, R), 0.1 * DECAY_LORA ** -0.5),
        'iclr_a0': nrm((L, N_DIRS, R), 0.1),
        'iclr_a2': nrm((L, N_DIRS, AAA_LORA, R), 0.5 * AAA_LORA ** -0.5),
        'gate_g2': nrm((L, GATE_LORA, R), GATE_LORA ** -0.5),
        'k_k': 0.85 + nrm((L, R), 0.05),
        'k_a': 1.0 + nrm((L, R), 0.05),
        'r_k': nrm((L, RWKV_HEADS, RWKV_HEAD), 0.1),
        'lnx_w': 1.0 + nrm((L, R), 0.02),
        'lnx_b': nrm((L, R), 0.02),
        'vres_v1': nrm((L - 1, D, MV_LORA), 0.5 * D ** -0.5),
        'vres_v2': nrm((L - 1, MV_LORA, R), 0.5 * MV_LORA ** -0.5),
        'vres_v0': nrm((L - 1, R), 0.1),
        'w_out': nrm((L, D_MIX, D), D_MIX ** -0.5),
        'w_mlp1': nrm((L, D, D_FF), D ** -0.5),
        'w_mlp2': nrm((L, D_FF, D), D_FF ** -0.5),
        'final_g': 1.0 + nrm((D,), 0.02),
    }


def reference(x, c, ctx, c_ctx, ada_w, ada_b, norm1_g, norm2_g, w_in, q_norm_g, w_uq, kv_norm_g, w_ukv,
              shift_mu, decay_w0, decay_w2, iclr_a0, iclr_a2, gate_g2, k_k, k_a, r_k, lnx_w, lnx_b,
              vres_v1, vres_v2, vres_v0, w_out, w_mlp1, w_mlp2, final_g):
    B, S, _ = x.shape
    Tc = ctx.shape[1]
    angles = axial_angles(S)
    silu_c = jax.nn.silu(c)
    silu_cc = jax.nn.silu(c_ctx)[None]
    v_first_x = None
    v_first_c = None
    for i in range(DEPTH):
        last = i == DEPTH - 1
        mx = jnp.split(silu_c @ ada_w[i] + ada_b[i], 6, axis=-1)
        mc = jnp.split(silu_cc @ ada_w[i] + ada_b[i], 6, axis=-1)
        hx = modulate(rmsnorm(x, norm1_g[i]), mx[0], mx[1])
        hc = modulate(rmsnorm(ctx, norm1_g[i]), mc[0], mc[1])
        fx = hx @ w_in[i]
        fc = hc @ w_in[i]

        kx, vx = mla_kv(fx[..., Q_RANK:MLA_IN], kv_norm_g[i], w_ukv[i], angles)
        kc, vc = mla_kv(fc[..., Q_RANK:MLA_IN], kv_norm_g[i], w_ukv[i], None)
        qx = mla_q(fx[..., :Q_RANK], q_norm_g[i], w_uq[i], angles)
        att_x = blocked_attention(qx, jnp.concatenate([kc, kx], axis=1), jnp.concatenate([vc, vx], axis=1))

        vres = None if i == 0 else (vres_v0[i - 1], vres_v1[i - 1], vres_v2[i - 1])
        tok_x = rwkv_token_terms(fx[..., MLA_IN:], hx, shift_mu[i], decay_w0[i], decay_w2[i], iclr_a0[i],
                                 iclr_a2[i], gate_g2[i], k_k[i], k_a[i], v_first_x, vres)
        tok_c = rwkv_token_terms(fc[..., MLA_IN:], hc, shift_mu[i], decay_w0[i], decay_w2[i], iclr_a0[i],
                                 iclr_a2[i], gate_g2[i], k_k[i], k_a[i], v_first_c, vres)
        if i == 0:
            v_first_x = tok_x[3].reshape(B, S, RWKV_DIM)
            v_first_c = tok_c[3].reshape(B, Tc, RWKV_DIM)
        y_c, y_x = bidirectional_rwkv7(tok_c, tok_x)
        rw_x = rwkv_output(y_x, tok_x, r_k[i], lnx_w[i], lnx_b[i])

        x = x + mx[2][:, None] * (jnp.concatenate([att_x, rw_x], axis=-1) @ w_out[i])
        x = x + mx[5][:, None] * sq_relu_mlp(modulate(rmsnorm(x, norm2_g[i]), mx[3], mx[4]), w_mlp1[i], w_mlp2[i])

        if not last:
            qc = mla_q(fc[..., :Q_RANK], q_norm_g[i], w_uq[i], None)
            att_c = attend(qc, kc, vc).reshape(B, Tc, MLA_HEADS * V_HEAD)
            rw_c = rwkv_output(y_c, tok_c, r_k[i], lnx_w[i], lnx_b[i])
            ctx = ctx + mc[2][:, None] * (jnp.concatenate([att_c, rw_c], axis=-1) @ w_out[i])
            ctx = ctx + mc[5][:, None] * sq_relu_mlp(modulate(rmsnorm(ctx, norm2_g[i]), mc[3], mc[4]), w_mlp1[i], w_mlp2[i])
    return rmsnorm(x, final_g)
```

```cpp
#include <hip/hip_runtime.h>
#include <hip/hip_cooperative_groups.h>
#include <hip/hip_fp16.h>
#include <cstdio>
#include <cstdint>
namespace cg = cooperative_groups;
#define DI __device__ __forceinline__
DI int ltid() { int t = threadIdx.x; asm volatile("" : "+v"(t)); return t; }
namespace pg8 {
#define PG8_LAS __attribute__((address_space(3)))
typedef unsigned short bf16_t;
typedef short bf16x8 __attribute__((ext_vector_type(8)));
typedef float f32x4 __attribute__((ext_vector_type(4)));
typedef unsigned u32x4 __attribute__((ext_vector_type(4)));
constexpr int BM = 256, BK = 64, HALF = 128, HTB = HALF * BK * 2  , STAGE_BYTES = 8 * HTB, NXCD = 8, WGM = 8;

__host__ __device__ __forceinline__ int lds_byte(int r, int c) { const int st = (r >> 4) * 2 + (c >> 5), rr = r & 15, cc = c & 31, ob = rr * 64 + cc * 2; return st * 1024 + (ob ^ (((ob >> 9) & 1) << 5)); }
__host__ __device__ __forceinline__ void stage_rc(int b, int& R, int& C) { const int st = b / 1024, sb = b % 1024, swz = sb ^ (((sb >> 9) & 1) << 5); R = (st >> 1) * 16 + swz / 64; C = (st & 1) * 32 + (swz % 64) / 2; }
__host__ __device__ __forceinline__ int perm32(int rho) { const int n = rho >> 4, i = rho & 15; return 8 * (i >> 2) + 4 * n + (i & 3); }

struct Unit { int pm, pn; };
struct Gemm { const bf16_t* A; const bf16_t* Bt; int M, N, K; };

struct StaticOrder {
    int nM, nN, nwg, G, c;
    __host__ __device__ void init(int M, int N, int G_, int c_) { nM = M / BM; nN = N / BM; nwg = nM * nN; G = G_; c = c_; }
    __host__ __device__ bool next(int i, Unit& u) const {
        const long L = (long)i * G + c; if (L >= nwg) return false;
        int wgid = (int)L; { const int q = nwg / NXCD, r = nwg % NXCD, xcd = wgid % NXCD, off = wgid / NXCD; wgid = (xcd < r ? xcd * (q + 1) : r * (q + 1) + (xcd - r) * q) + off; }
        const int nig = WGM * nN, gid = wgid / nig, fm = gid * WGM, gsz = (nM - fm) < WGM ? (nM - fm) : WGM;
        u.pm = fm + ((wgid % nig) % gsz); u.pn = (wgid % nig) / gsz; return true;
    }
    __device__ __forceinline__ void a_ready(const Unit&) const {}
    __device__ __forceinline__ void done(const Unit&) const {}
};

__device__ __forceinline__ unsigned cvt_pk_bf16(float lo, float hi) { unsigned r; asm volatile("v_cvt_pk_bf16_f32 %0, %1, %2" : "=v"(r) : "v"(lo), "v"(hi)); return r; }

template <class Epi, class Sched, bool ALIGN_EPI = false, bool SP2 = false>
__device__ __forceinline__ void gemm_phase(PG8_LAS unsigned char* lds, const Gemm g, const Sched& S, const Epi& E) {
    const int tid = ltid(), wid = __builtin_amdgcn_readfirstlane(tid >> 6), lane = tid & 63, wr = wid >> 2, wc = wid & 3, fr = lane & 15, fq = lane >> 4;
    const int K = g.K, nt = K / BK;
    unsigned voffA[2], voffB[2];
#pragma unroll
    for (int i = 0; i < 2; ++i) { int R, C; stage_rc(tid * 16 + i * 8192, R, C); const int Rb = Epi::PERM ? ((R & ~31) + perm32(R & 31)) : R;
        voffA[i] = (unsigned)(R * K + C) * 2u; voffB[i] = (unsigned)(Rb * K + C) * 2u; }
    const size_t kstep = (size_t)(BK * 2);
    const size_t hstep = (size_t)HALF * K * 2;
    const size_t tstep = 2 * hstep;
    const unsigned ldsw = (unsigned)wid * 1024u;
    const int aoff = lds_byte(wr * 64 + fr, fq * 8), boff = lds_byte(wc * 32 + fr, fq * 8);
#define PG8_SA(b, h) (((b) * 2 + (h)) * HTB)
#define PG8_SB(b, h) ((4 + (b) * 2 + (h)) * HTB)
#define PG8_STAGE(bufoff, gbase, voff) do { _Pragma("unroll") for (int _i = 0; _i < 2; ++_i) \
        __builtin_amdgcn_global_load_lds((const unsigned*)((const char*)(gbase) + (voff)[_i]), (PG8_LAS unsigned*)(lds + (bufoff) + ldsw + _i * 8192), 16, 0, 0); } while (0)
#define PG8_LDA(dst, b, h) do { _Pragma("unroll") for (int m = 0; m < 4; ++m) _Pragma("unroll") for (int k = 0; k < 2; ++k) dst[m][k] = *(const PG8_LAS bf16x8*)(lds + PG8_SA(b, h) + aoff + m * 2048 + k * 1024); } while (0)
#define PG8_LDB(dst, b, h) do { _Pragma("unroll") for (int n = 0; n < 2; ++n) _Pragma("unroll") for (int k = 0; k < 2; ++k) dst[n][k] = *(const PG8_LAS bf16x8*)(lds + PG8_SB(b, h) + boff + n * 2048 + k * 1024); } while (0)
#define PG8_MMA(ai, bj, At, Bt) do { __builtin_amdgcn_s_setprio(1); _Pragma("unroll") for (int m = 0; m < 4; ++m) _Pragma("unroll") for (int n = 0; n < 2; ++n) _Pragma("unroll") for (int k = 0; k < 2; ++k) \
        acc[ai][bj][m][n] = __builtin_amdgcn_mfma_f32_16x16x32_bf16(Bt[n][k], At[m][k], acc[ai][bj][m][n], 0, 0, 0); __builtin_amdgcn_s_setprio(0); } while (0)
#define PG8_WAIT_V(n) asm volatile("s_waitcnt vmcnt(" #n ")" ::: "memory")
#define PG8_WAIT_L(n) asm volatile("s_waitcnt lgkmcnt(" #n ")" ::: "memory")
#define PG8_BAR __builtin_amdgcn_s_barrier()
#define PG8_SCHED __builtin_amdgcn_sched_barrier(0)
    Unit cur, nxt; int ui = 0;
    if (!S.next(0, cur)) return;
    f32x4 acc[2][2][4][2];
#pragma unroll
    for (int a = 0; a < 2; ++a)
#pragma unroll
        for (int b = 0; b < 2; ++b)
#pragma unroll
            for (int m = 0; m < 4; ++m)
#pragma unroll
                for (int n = 0; n < 2; ++n) acc[a][b][m][n] = (f32x4){0.f, 0.f, 0.f, 0.f};
    bf16x8 At[4][2], B0[2][2], B1[2][2];
    const char* cA = (const char*)g.A + (size_t)cur.pm * tstep; const char* cB = (const char*)g.Bt + (size_t)cur.pn * tstep;
    S.a_ready(cur);
    if constexpr (SP2) {
        PG8_STAGE(PG8_SB(0, 0), cB, voffB); PG8_STAGE(PG8_SB(0, 1), cB + hstep, voffB); PG8_STAGE(PG8_SA(0, 0), cA, voffA); PG8_STAGE(PG8_SA(0, 1), cA + hstep, voffA);
        if (wr == 1) PG8_BAR;
        PG8_WAIT_V(2); PG8_BAR;
        PG8_STAGE(PG8_SB(1, 0), cB + kstep, voffB); PG8_STAGE(PG8_SA(1, 0), cA + kstep, voffA); PG8_STAGE(PG8_SB(1, 1), cB + hstep + kstep, voffB);
        PG8_WAIT_V(6); PG8_BAR;
    } else {
        PG8_STAGE(PG8_SB(0, 0), cB, voffB); PG8_STAGE(PG8_SA(0, 0), cA, voffA); PG8_STAGE(PG8_SB(0, 1), cB + hstep, voffB); PG8_STAGE(PG8_SA(0, 1), cA + hstep, voffA);
        if (wr == 1) PG8_BAR;
        PG8_WAIT_V(4); PG8_BAR;
        PG8_STAGE(PG8_SB(1, 0), cB + kstep, voffB); PG8_STAGE(PG8_SA(1, 0), cA + kstep, voffA); PG8_STAGE(PG8_SB(1, 1), cB + hstep + kstep, voffB);
        PG8_WAIT_V(6); PG8_BAR;
    }
    for (;;) {
        const bool has_next = S.next(ui + 1, nxt);
        const char* nA = has_next ? (const char*)g.A + (size_t)nxt.pm * tstep : cA; const char* nB = has_next ? (const char*)g.Bt + (size_t)nxt.pn * tstep : cB;
#pragma nounroll
        for (int t = 0; t < nt; t += 2) {
            const bool last = (t == nt - 2);
            const char* a1 = cA + (size_t)(t + 1) * kstep;
            const char* a2 = last ? nA : cA + (size_t)(t + 2) * kstep; const char* b2 = last ? nB : cB + (size_t)(t + 2) * kstep;
            const char* a3 = a2 + kstep; const char* b3 = b2 + kstep;
            if (last && has_next) S.a_ready(nxt);
            if constexpr (SP2) {
            PG8_LDB(B0, 0, 0); PG8_LDB(B1, 0, 1); PG8_SCHED; PG8_LDA(At, 0, 0); PG8_STAGE(PG8_SA(1, 1), a1 + hstep, voffA);
            PG8_WAIT_V(8); PG8_WAIT_L(0); PG8_BAR; PG8_MMA(0, 0, At, B0); PG8_MMA(0, 1, At, B1); PG8_BAR; PG8_SCHED;
            PG8_LDA(At, 0, 1); PG8_STAGE(PG8_SB(0, 0), b2, voffB); PG8_STAGE(PG8_SB(0, 1), b2 + hstep, voffB); PG8_STAGE(PG8_SA(0, 0), a2, voffA);
            PG8_WAIT_V(8); PG8_WAIT_L(0); PG8_BAR; PG8_MMA(1, 0, At, B0); PG8_MMA(1, 1, At, B1); PG8_BAR; PG8_SCHED;
            PG8_LDB(B0, 1, 0); PG8_LDB(B1, 1, 1); PG8_SCHED; PG8_LDA(At, 1, 0); PG8_STAGE(PG8_SA(0, 1), a2 + hstep, voffA);
            PG8_WAIT_V(8); PG8_WAIT_L(0); PG8_BAR; PG8_MMA(0, 0, At, B0); PG8_MMA(0, 1, At, B1); PG8_BAR; PG8_SCHED;
            PG8_LDA(At, 1, 1); PG8_STAGE(PG8_SB(1, 0), b3, voffB); PG8_STAGE(PG8_SB(1, 1), b3 + hstep, voffB); PG8_STAGE(PG8_SA(1, 0), a3, voffA);
            PG8_WAIT_V(8); PG8_WAIT_L(0); PG8_BAR; PG8_MMA(1, 0, At, B0); PG8_MMA(1, 1, At, B1); PG8_BAR; PG8_SCHED;
            } else {
            PG8_LDB(B0, 0, 0); PG8_SCHED; PG8_LDA(At, 0, 0); PG8_STAGE(PG8_SA(1, 1), a1 + hstep, voffA);
            PG8_WAIT_L(8); PG8_BAR; PG8_WAIT_L(0); PG8_MMA(0, 0, At, B0); PG8_BAR; PG8_SCHED;
            PG8_LDB(B1, 0, 1); PG8_STAGE(PG8_SB(0, 0), b2, voffB);
            PG8_BAR; PG8_WAIT_L(0); PG8_MMA(0, 1, At, B1); PG8_BAR;
            PG8_LDA(At, 0, 1); PG8_STAGE(PG8_SA(0, 0), a2, voffA);
            PG8_BAR; PG8_WAIT_L(0); PG8_MMA(1, 0, At, B0); PG8_BAR; PG8_SCHED;
            PG8_STAGE(PG8_SB(0, 1), b2 + hstep, voffB);
            PG8_WAIT_V(6); PG8_BAR; PG8_MMA(1, 1, At, B1); PG8_BAR;
            PG8_LDB(B0, 1, 0); PG8_SCHED; PG8_LDA(At, 1, 0); PG8_STAGE(PG8_SA(0, 1), a2 + hstep, voffA);
            PG8_WAIT_L(8); PG8_BAR; PG8_WAIT_L(0); PG8_MMA(0, 0, At, B0); PG8_BAR; PG8_SCHED;
            PG8_LDB(B1, 1, 1); PG8_STAGE(PG8_SB(1, 0), b3, voffB);
            PG8_BAR; PG8_WAIT_L(0); PG8_MMA(0, 1, At, B1); PG8_BAR;
            PG8_LDA(At, 1, 1); PG8_STAGE(PG8_SA(1, 0), a3, voffA);
            PG8_BAR; PG8_WAIT_L(0); PG8_MMA(1, 0, At, B0); PG8_BAR; PG8_SCHED;
            PG8_STAGE(PG8_SB(1, 1), b3 + hstep, voffB);
            PG8_WAIT_V(6); PG8_BAR; PG8_MMA(1, 1, At, B1); PG8_BAR;
            }
        }
        if constexpr (ALIGN_EPI) { if (wr == 0) PG8_BAR; }
        if constexpr (!Epi::AFTER_DRAIN) { E(acc, cur, wr, wc, fr, fq); S.done(cur); }
        if (!has_next) break;
#pragma unroll
        for (int a = 0; a < 2; ++a)
#pragma unroll
            for (int b = 0; b < 2; ++b)
#pragma unroll
                for (int m = 0; m < 4; ++m)
#pragma unroll
                    for (int n = 0; n < 2; ++n) acc[a][b][m][n] = (f32x4){0.f, 0.f, 0.f, 0.f};
        cur = nxt; cA = nA; cB = nB; ++ui;
        if constexpr (ALIGN_EPI) { if (wr == 1) PG8_BAR; }
    }
    PG8_WAIT_V(0);
    if constexpr (!ALIGN_EPI) { if (wr == 0) PG8_BAR; }
    PG8_BAR;
    if constexpr (Epi::AFTER_DRAIN) { E.fused(acc, cur, wr, wc, fr, fq, lds, wid, lane); S.done(cur); }
#undef PG8_SA
#undef PG8_SB
#undef PG8_STAGE
#undef PG8_LDA
#undef PG8_LDB
#undef PG8_MMA
#undef PG8_WAIT_V
#undef PG8_WAIT_L
#undef PG8_BAR
#undef PG8_SCHED
}
}
typedef unsigned short bf16_t;
using bf16x8 = __attribute__((ext_vector_type(8))) short;
using s16x4  = __attribute__((ext_vector_type(4))) short;
using f32x16 = __attribute__((ext_vector_type(16))) float;
using f32x4  = __attribute__((ext_vector_type(4))) float;
using u32x4  = __attribute__((ext_vector_type(4))) unsigned;
using u32x2  = __attribute__((ext_vector_type(2))) unsigned;

constexpr int DM = 1024, NB = 32, SEQ = 2048, TC = 256, TT = 2304, TALL = NB * TT, NL = 4;
constexpr int CIN = 2336, CINX = 2368, NIN = 2560, DFF = 4096;
constexpr int OFF_R = 416, OFF_K = 928, OFF_V = 1440, OFF_WLO = 1952, OFF_HV = 2336;
constexpr int NPH = 50, LDS_BYTES = 147456;
constexpr size_t MiB = 1u << 20;
constexpr size_t WS_MODS = 0, WS_ROPE = 3 * MiB + 512 * 1024, WS_XC = 4 * MiB, WS_VF = 36 * MiB, WS_WT = 108 * MiB, WS_INV = 134 * MiB, TR = 137 * MiB;
constexpr size_t WT_IN = WS_WT, WT_UQ = WS_WT + 5 * MiB, WT_UKV = WS_WT + 5 * MiB + 512 * 1024, WT_L1 = WS_WT + 6 * MiB, WT_L2 = WS_WT + 7 * MiB,
                 WT_OUT = WS_WT + 8 * MiB, WT_M1 = WS_WT + 10 * MiB, WT_M2 = WS_WT + 18 * MiB;
constexpr size_t WS_R = TR, WS_K = TR + 72 * MiB, WS_H = TR, WS_F = TR + 144 * MiB, WS_Q = TR + 144 * MiB, WS_VATT = TR + 252 * MiB, WS_MIX = TR + 324 * MiB,
                 WS_DEC = TR + 144 * MiB, WS_HID = TR + 144 * MiB, WS_A1 = TR + 477 * MiB, WS_A2 = TR + 513 * MiB, WS_YB = TR + 477 * MiB,
                 WS_CQN = TR + 549 * MiB, WS_CKVN = TR + 585 * MiB, WS_KATT = TR + 621 * MiB, WS_AA = TR + 585 * MiB, WS_G = TR + 729 * MiB,
                 WS_V = TR + 801 * MiB, WS_END = TR + 873 * MiB;

struct Args { const float* in[31]; float* out; unsigned char* ws; int lo, hi; };
enum { I_X = 0, I_C, I_CTX, I_CCTX, I_ADAW, I_ADAB, I_N1G, I_N2G, I_WIN, I_QNG, I_WUQ, I_KVNG, I_WUKV, I_MU, I_W0, I_W2, I_A0, I_A2, I_G2, I_KK, I_KA, I_RK,
       I_LNW, I_LNB, I_V1, I_V2, I_V0, I_WOUT, I_M1, I_M2, I_FG };

DI float bflo(unsigned w) { return __uint_as_float(w << 16); }
DI float bfhi(unsigned w) { return __uint_as_float(w & 0xffff0000u); }
DI unsigned cvtpk(float lo, float hi) { return pg8::cvt_pk_bf16(lo, hi); }
DI bf16_t f2bf(float f) { return (bf16_t)(cvtpk(f, 0.f) & 0xffffu); }
DI void load8(const bf16_t* p, float (&f)[8]) { const u32x4 w = *(const u32x4*)p; f[0] = bflo(w.x); f[1] = bfhi(w.x); f[2] = bflo(w.y); f[3] = bfhi(w.y); f[4] = bflo(w.z); f[5] = bfhi(w.z); f[6] = bflo(w.w); f[7] = bfhi(w.w); }
DI void store8(bf16_t* p, const float (&f)[8]) { u32x4 w; w.x = cvtpk(f[0], f[1]); w.y = cvtpk(f[2], f[3]); w.z = cvtpk(f[4], f[5]); w.w = cvtpk(f[6], f[7]); *(u32x4*)p = w; }
DI void loadf8(const float* p, float (&f)[8]) { const f32x4 a = *(const f32x4*)p, b = *(const f32x4*)(p + 4); f[0] = a[0]; f[1] = a[1]; f[2] = a[2]; f[3] = a[3]; f[4] = b[0]; f[5] = b[1]; f[6] = b[2]; f[7] = b[3]; }
DI float h2f(unsigned b) { return __half2float(__ushort_as_half((unsigned short)b)); }
DI float sigmoidf_(float x) { return 1.f / (1.f + __expf(-x)); }
DI float xorsum(float v, int mask) { return v + __shfl_xor(v, mask, 64); }
DI float* xrow(float* out, float* xc, int m) { const int b = m / TT, tt = m - b * TT; return tt < TC ? xc + (size_t)(b * TC + tt) * DM : out + (size_t)(b * SEQ + tt - TC) * DM; }

template <class Fn> struct Epi8 {
    static constexpr bool PERM = true, AFTER_DRAIN = false; Fn f;
    DI void operator()(const pg8::f32x4 (&acc)[2][2][4][2], const pg8::Unit& u, int wr, int wc, int fr, int fq) const {
#pragma unroll
        for (int ai = 0; ai < 2; ++ai)
#pragma unroll
            for (int m = 0; m < 4; ++m) { const int rit = ai * 128 + wr * 64 + m * 16 + fr;
#pragma unroll
                for (int bj = 0; bj < 2; ++bj) { f(rit, u.pn * 256 + bj * 128 + wc * 32 + 8 * fq, acc[ai][bj][m][0], acc[ai][bj][m][1], u, fq); __builtin_amdgcn_sched_barrier(0); } }
    }
};
DI void st8(bf16_t* p, const pg8::f32x4& v0, const pg8::f32x4& v1) { u32x4 w; w.x = cvtpk(v0[0], v0[1]); w.y = cvtpk(v0[2], v0[3]); w.z = cvtpk(v1[0], v1[1]); w.w = cvtpk(v1[2], v1[3]); *(u32x4*)p = w; }

struct FnF { bf16_t* F;
    DI void operator()(int rit, int col0, const pg8::f32x4& v0, const pg8::f32x4& v1, const pg8::Unit& u, int) const {
        if (col0 < CINX) st8(F + (size_t)(u.pm * 256 + rit) * CINX + col0, v0, v1); } };
struct FnQ { bf16_t* Q; const float* rope;
    DI void operator()(int rit, int col0, const pg8::f32x4& v0, const pg8::f32x4& v1, const pg8::Unit& u, int fq) const {
        const int seg = u.pm % 9; const bool isrope = (seg != 0) && (((col0 >> 5) % 3) == 2);
        float x[8] = {v0[0], v0[1], v0[2], v0[3], v1[0], v1[1], v1[2], v1[3]};
        if (isrope) { const int s = (seg - 1) * 256 + rit, pos = (fq < 2) ? (s >> 6) : (s & 63); float cs[8], sn[8]; loadf8(rope + pos * 8, cs); loadf8(rope + 512 + pos * 8, sn);
            const float sg = (fq & 1) ? 1.f : -1.f;
#pragma unroll
            for (int j = 0; j < 8; ++j) { const float p = __shfl_xor(x[j], 16, 64); x[j] = x[j] * cs[j] + sg * p * sn[j]; } }
        store8(Q + (size_t)(u.pm * 256 + rit) * 768 + col0, x); } };
struct FnKV { bf16_t* KA; bf16_t* VA;
    DI void operator()(int rit, int col0, const pg8::f32x4& v0, const pg8::f32x4& v1, const pg8::Unit& u, int) const {
        const size_t row = (size_t)(u.pm * 256 + rit); const int h = col0 >> 7, c = col0 & 127;
        if (c < 64) st8(KA + row * 768 + h * 96 + c, v0, v1); else st8(VA + row * 512 + h * 64 + (c - 64), v0, v1); } };
struct FnL1 { __half* DEC; bf16_t* AA; const float* w0; const float* a0;
    DI void operator()(int rit, int col0, const pg8::f32x4& v0, const pg8::f32x4& v1, const pg8::Unit& u, int) const {
        const size_t row = (size_t)(u.pm * 256 + rit); float x[8] = {v0[0], v0[1], v0[2], v0[3], v1[0], v1[1], v1[2], v1[3]};
        if (col0 < 1024) { float b[8]; loadf8(w0 + col0, b); u32x4 w; unsigned hh[8];
#pragma unroll
            for (int j = 0; j < 8; ++j) { const float uu = 0.6065306597f * sigmoidf_(x[j] + b[j]); hh[j] = (unsigned)__half_as_ushort(__float2half(-uu * 1.4426950409f)); }
            w.x = hh[0] | (hh[1] << 16); w.y = hh[2] | (hh[3] << 16); w.z = hh[4] | (hh[5] << 16); w.w = hh[6] | (hh[7] << 16);
            *(u32x4*)(DEC + row * 1024 + col0) = w;
        } else { const int c = col0 - 1024; float b[8]; loadf8(a0 + c, b);
#pragma unroll
            for (int j = 0; j < 8; ++j) x[j] = sigmoidf_(x[j] + b[j]);
            store8(AA + row * 1024 + c, x); } } };
struct FnL2 { bf16_t* G; bf16_t* V; const bf16_t* VF; const float* v0p; int dovres;
    DI void operator()(int rit, int col0, const pg8::f32x4& v0, const pg8::f32x4& v1, const pg8::Unit& u, int) const {
        const size_t row = (size_t)(u.pm * 256 + rit);
        if (col0 < 512) st8(G + row * 512 + col0, v0, v1);
        else if (dovres) { const int c = col0 - 512; float x[8] = {v0[0], v0[1], v0[2], v0[3], v1[0], v1[1], v1[2], v1[3]}, b[8], v[8], vf[8]; loadf8(v0p + c, b); load8(V + row * 512 + c, v); load8(VF + row * 512 + c, vf);
#pragma unroll
            for (int j = 0; j < 8; ++j) v[j] = v[j] + (vf[j] - v[j]) * sigmoidf_(b[j] + x[j]);
            store8(V + row * 512 + c, v); } } };
struct FnRes { float* out; float* xc; const float* mods; int gidx;
    DI void operator()(int rit, int col0, const pg8::f32x4& v0, const pg8::f32x4& v1, const pg8::Unit& u, int) const {
        const int b = u.pm / 9, seg = u.pm - b * 9; const float* g = mods + (size_t)(seg == 0 ? 32 : b) * 6144 + gidx * 1024 + col0;
        float* p = (seg == 0 ? xc + (size_t)(b * TC + rit) * DM : out + (size_t)(b * SEQ + (seg - 1) * 256 + rit) * DM) + col0;
        const pg8::f32x4 g0 = *(const pg8::f32x4*)g, g1 = *(const pg8::f32x4*)(g + 4); pg8::f32x4 x0 = *(pg8::f32x4*)p, x1 = *(pg8::f32x4*)(p + 4);
        x0 += g0 * v0; x1 += g1 * v1; *(pg8::f32x4*)p = x0; *(pg8::f32x4*)(p + 4) = x1; } };
struct FnM1 { bf16_t* HID;
    DI void operator()(int rit, int col0, const pg8::f32x4& v0, const pg8::f32x4& v1, const pg8::Unit& u, int) const {
        float x[8] = {v0[0], v0[1], v0[2], v0[3], v1[0], v1[1], v1[2], v1[3]};
#pragma unroll
        for (int j = 0; j < 8; ++j) { const float r = fmaxf(x[j], 0.f); x[j] = r * r; }
        store8(HID + (size_t)(u.pm * 256 + rit) * DFF + col0, x); } };

struct Order { pg8::StaticOrder s; int lat;
    DI void init(int lat_, int N) { lat = lat_; s.init(lat_ ? NB * SEQ : TALL, N, (int)gridDim.x, (int)blockIdx.x); }
    DI bool next(int i, pg8::Unit& u) const { if (!s.next(i, u)) return false; if (lat) u.pm = (u.pm >> 3) * 9 + 1 + (u.pm & 7); return true; }
    DI void a_ready(const pg8::Unit&) const {}
    DI void done(const pg8::Unit&) const {}
};
template <int N, int K, class Fn> DI void run_gemm(unsigned char* lds, const bf16_t* A, const bf16_t* Bt, int lat, const Fn& fn) {
    pg8::Gemm g{A, Bt, lat ? NB * SEQ : TALL, N, K}; Order S; S.init(lat, N); Epi8<Fn> E{fn};
    pg8::gemm_phase<Epi8<Fn>, Order, true, true>((PG8_LAS unsigned char*)lds, g, S, E);
    __syncthreads();
}
namespace att {
constexpr int NW = 8, QBLK = 32, KVBLK = 64;
constexpr float SCALE = 0.10206207261596577f, THR = 8.f;
constexpr int LDQ = 768, LDKK = 768, LDV = 512, LDO = 1024;
constexpr int SHM_V = KVBLK * 64 * 2, SHM_K = KVBLK * 256, SHM_ATTN = 2 * SHM_V + 2 * SHM_K + NW * 64 * 4;
#define KSWZ(row, colB) ((row) * 256 + ((colB) ^ (((row) & 7) << 4)))
#define SBAR() __builtin_amdgcn_sched_barrier(0)
DI int crow(int r, int hi) { return (r & 3) + 8 * (r >> 2) + 4 * hi; }
DI unsigned cvtpk_(float lo, float hi) { unsigned r; asm volatile("v_cvt_pk_bf16_f32 %0, %1, %2" : "=v"(r) : "v"(lo), "v"(hi)); return r; }
DI void partialSM(f32x16& p0, f32x16& p1, float& m_reg, float& mn, float& alpha) {
  constexpr float C = SCALE * 1.4426950408889634f;
  float pmax = p0[0];
#pragma unroll
  for (int r = 1; r < 16; ++r) pmax = fmaxf(pmax, p0[r]);
#pragma unroll
  for (int r = 0; r < 16; ++r) pmax = fmaxf(pmax, p1[r]);
  { auto rr = __builtin_amdgcn_permlane32_swap(__float_as_uint(pmax), __float_as_uint(pmax), false, false);
    pmax = fmaxf(__uint_as_float(rr[0]), __uint_as_float(rr[1])); }
  if (__builtin_expect(__all(pmax - m_reg <= THR / SCALE), 1)) { mn = m_reg; alpha = 1.f; }
  else { mn = fmaxf(m_reg, pmax); alpha = __builtin_amdgcn_exp2f((m_reg - mn) * C); m_reg = mn; }
  const float mnC = -mn * C;
#pragma unroll
  for (int r = 0; r < 16; ++r) p0[r] = fmaf(p0[r], C, mnC);
#pragma unroll
  for (int r = 0; r < 16; ++r) p1[r] = fmaf(p1[r], C, mnC);
#pragma unroll
  for (int r = 0; r < 16; ++r) p0[r] = __builtin_amdgcn_exp2f(p0[r]);
}
DI void finishSM(f32x16& p0, f32x16& p1, float alpha, float& l_reg, bf16x8& pa0, bf16x8& pa1, bf16x8& pa2, bf16x8& pa3) {
#pragma unroll
  for (int r = 0; r < 16; ++r) p1[r] = __builtin_amdgcn_exp2f(p1[r]);
  float ps = 0;
#pragma unroll
  for (int r = 0; r < 16; ++r) ps += p0[r];
#pragma unroll
  for (int r = 0; r < 16; ++r) ps += p1[r];
  { auto rr = __builtin_amdgcn_permlane32_swap(__float_as_uint(ps), __float_as_uint(ps), false, false);
    ps = __uint_as_float(rr[0]) + __uint_as_float(rr[1]); }
  l_reg = l_reg * alpha + ps;
#define PK4(P, BASE, OUT) do { unsigned a0 = cvtpk_(P[BASE + 0], P[BASE + 1]), a1 = cvtpk_(P[BASE + 2], P[BASE + 3]);   \
    unsigned b0 = cvtpk_(P[BASE + 4], P[BASE + 5]), b1 = cvtpk_(P[BASE + 6], P[BASE + 7]);                              \
    auto r0 = __builtin_amdgcn_permlane32_swap(a0, b0, false, false); auto r1 = __builtin_amdgcn_permlane32_swap(a1, b1, false, false); \
    u32x4 w = {r0[0], r1[0], r0[1], r1[1]}; OUT = *reinterpret_cast<bf16x8*>(&w); } while (0)
  PK4(p0, 0, pa0); PK4(p0, 8, pa1); PK4(p1, 0, pa2); PK4(p1, 8, pa3);
#undef PK4
}
DI void qkt(f32x16& p0, f32x16& p1, const char* Ks, const bf16x8* qr, int r32, int hi) {
  p0 = f32x16{}; p1 = f32x16{};
#pragma unroll
  for (int d0 = 0; d0 < 6; ++d0) { const int cb = (d0 * 16 + hi * 8) * 2;
    bf16x8 b0 = *reinterpret_cast<const bf16x8*>(Ks + KSWZ(r32, cb));
    bf16x8 b1 = *reinterpret_cast<const bf16x8*>(Ks + KSWZ(32 + r32, cb));
    p0 = __builtin_amdgcn_mfma_f32_32x32x16_bf16(b0, qr[d0], p0, 0, 0, 0);
    p1 = __builtin_amdgcn_mfma_f32_32x32x16_bf16(b1, qr[d0], p1, 0, 0, 0); }
}
DI int v_st(int k, int c) { const int kk = (k & ~0xC) | ((k & 4) << 1) | ((k & 8) >> 1); return ((kk >> 3) * 2 + (c >> 5)) * 512 + ((kk & 7) * 32 + (c & 31)) * 2; }
DI int v_rd_base(int lane) { return ((lane & 3) << 3) | (((lane >> 2) & 3) << 6) | (((lane >> 4) & 1) << 5) | (((lane >> 5) & 1) << 8); }
constexpr int v_rd_off(int d0, int ks, int half) { return d0 * 512 + ks * 2048 + half * 1024; }
template <int OFF> DI s16x4 tr_read(int vb) {
  s16x4 r; asm volatile("ds_read_b64_tr_b16 %0, %1 offset:%2" : "=&v"(r) : "v"(vb), "i"(OFF) : "memory"); return r;
}
template <int D0> DI void pv_one(f32x16& od, int vb, bf16x8 pa0, bf16x8 pa1, bf16x8 pa2, bf16x8 pa3) {
  const s16x4 l0 = tr_read<v_rd_off(D0, 0, 0)>(vb), h0 = tr_read<v_rd_off(D0, 0, 1)>(vb), l1 = tr_read<v_rd_off(D0, 1, 0)>(vb), h1 = tr_read<v_rd_off(D0, 1, 1)>(vb);
  const s16x4 l2 = tr_read<v_rd_off(D0, 2, 0)>(vb), h2 = tr_read<v_rd_off(D0, 2, 1)>(vb), l3 = tr_read<v_rd_off(D0, 3, 0)>(vb), h3 = tr_read<v_rd_off(D0, 3, 1)>(vb);
  asm volatile("s_waitcnt lgkmcnt(0)" ::: "memory"); SBAR();
#define PK(L, H) (bf16x8){L[0], L[1], L[2], L[3], H[0], H[1], H[2], H[3]}
  od = __builtin_amdgcn_mfma_f32_32x32x16_bf16(pa0, PK(l0, h0), od, 0, 0, 0);
  od = __builtin_amdgcn_mfma_f32_32x32x16_bf16(pa1, PK(l1, h1), od, 0, 0, 0);
  od = __builtin_amdgcn_mfma_f32_32x32x16_bf16(pa2, PK(l2, h2), od, 0, 0, 0);
  od = __builtin_amdgcn_mfma_f32_32x32x16_bf16(pa3, PK(l3, h3), od, 0, 0, 0);
#undef PK
}
DI void pv_d0(f32x16* o, int vb, bf16x8 pa0, bf16x8 pa1, bf16x8 pa2, bf16x8 pa3) {
  pv_one<0>(o[0], vb, pa0, pa1, pa2, pa3); pv_one<1>(o[1], vb, pa0, pa1, pa2, pa3);
}
DI void attn_body(const bf16_t* __restrict__ Qb, const bf16_t* __restrict__ Kh, const bf16_t* __restrict__ Vh, bf16_t* __restrict__ Ob, int seq, char* lds) {
  const int tid = ltid(), wid = tid >> 6, lane = tid & 63, r32 = lane & 31, hi = lane >> 5;
  char* V_lds = lds; char* K_lds = lds + 2 * SHM_V;
  float* ws = (float*)(lds + 2 * SHM_V + 2 * SHM_K) + wid * 64; float* li_l = ws; float* al_l = ws + 32;
  float m_reg = -1e30f, l_reg = 0; f32x16 o[2] = {}; bf16x8 qr[6];
  const bf16_t* Qw = Qb + (long)(wid * QBLK + r32) * LDQ + hi * 8;
#pragma unroll
  for (int d0 = 0; d0 < 6; ++d0) qr[d0] = *reinterpret_cast<const bf16x8*>(Qw + d0 * 16);
  const int kc2 = 512 + (tid & 255);
  const int kr1 = tid / 12, kch1 = tid - kr1 * 12, kr2 = kc2 / 12, kch2 = kc2 - kr2 * 12, vr = tid >> 3, vch = tid & 7;
  const int vst = v_st(vr, vch * 8), kst1 = KSWZ(kr1, kch1 * 16), kst2 = KSWZ(kr2, kch2 * 16);
  const int vb0 = (int)(uintptr_t)V_lds + v_rd_base(lane);
  struct { bf16x8 v, k1, k2; } sr_[2];
#define SLOAD(i, k0) do { sr_[i].v = *reinterpret_cast<const bf16x8*>(&Vh[(long)((k0) + vr) * LDV + vch * 8]); \
    sr_[i].k1 = *reinterpret_cast<const bf16x8*>(&Kh[(long)((k0) + kr1) * LDKK + kch1 * 8]); sr_[i].k2 = *reinterpret_cast<const bf16x8*>(&Kh[(long)((k0) + kr2) * LDKK + kch2 * 8]); } while (0)
#define SWRITE(b, i) do { *(bf16x8*)(V_lds + (b) * SHM_V + vst) = sr_[i].v; *(bf16x8*)(K_lds + (b) * SHM_K + kst1) = sr_[i].k1; *(bf16x8*)(K_lds + (b) * SHM_K + kst2) = sr_[i].k2; } while (0)
#define RESC(a) do { if (__any((a) < 1.f)) { if (hi == 0) al_l[r32] = (a); asm volatile("s_waitcnt lgkmcnt(0)" ::: "memory"); \
    _Pragma("unroll") for (int d = 0; d < 2; ++d) _Pragma("unroll") for (int r = 0; r < 16; ++r) o[d][r] *= al_l[crow(r, hi)]; } } while (0)
  f32x16 pA0, pA1, pB0, pB1; float mnA, mnB, alA, alB; bf16x8 pa0, pa1, pa2, pa3; const int NT = seq / KVBLK;
  constexpr int SE = 0, SO = 1;
  SLOAD(SE, 0); asm volatile("s_waitcnt vmcnt(0)" ::: "memory"); SWRITE(0, SE); __syncthreads();
  qkt(pA0, pA1, K_lds, qr, r32, hi); partialSM(pA0, pA1, m_reg, mnA, alA);
  SLOAD(SO, KVBLK); if (2 < NT) SLOAD(SE, 2 * KVBLK);
  SWRITE(1, SO); __syncthreads();
  for (int j = 1; j + 1 < NT; j += 2) {
    SBAR(); qkt(pB0, pB1, K_lds + SHM_K, qr, r32, hi);
    finishSM(pA0, pA1, alA, l_reg, pa0, pa1, pa2, pa3); SBAR();
    SLOAD(SO, (j + 2) * KVBLK); SBAR();
    pv_d0(o, vb0, pa0, pa1, pa2, pa3); partialSM(pB0, pB1, m_reg, mnB, alB);
    __syncthreads(); SWRITE(0, SE);
    RESC(alB); __syncthreads();
    SBAR(); qkt(pA0, pA1, K_lds, qr, r32, hi);
    finishSM(pB0, pB1, alB, l_reg, pa0, pa1, pa2, pa3); SBAR();
    if (j + 3 < NT) SLOAD(SE, (j + 3) * KVBLK); SBAR();
    pv_d0(o, vb0 + SHM_V, pa0, pa1, pa2, pa3); partialSM(pA0, pA1, m_reg, mnA, alA);
    __syncthreads(); SWRITE(1, SO);
    RESC(alA); __syncthreads();
  }
  SBAR(); qkt(pB0, pB1, K_lds + SHM_K, qr, r32, hi);
  finishSM(pA0, pA1, alA, l_reg, pa0, pa1, pa2, pa3); SBAR();
  pv_d0(o, vb0, pa0, pa1, pa2, pa3); partialSM(pB0, pB1, m_reg, mnB, alB);
  __syncthreads(); RESC(alB);
  finishSM(pB0, pB1, alB, l_reg, pa0, pa1, pa2, pa3); SBAR();
  pv_d0(o, vb0 + SHM_V, pa0, pa1, pa2, pa3);
  if (hi == 0) li_l[r32] = l_reg; asm volatile("s_waitcnt lgkmcnt(0)" ::: "memory");
  float rli[16];
#pragma unroll
  for (int r = 0; r < 16; ++r) rli[r] = __builtin_amdgcn_rcpf(li_l[crow(r, hi)]);
  bf16_t* Ow = Ob + (long)(wid * QBLK) * LDO;
#pragma unroll
  for (int r = 0; r < 16; ++r) { const int orow = crow(r, hi);
#pragma unroll
    for (int d0 = 0; d0 < 2; ++d0) Ow[(long)orow * LDO + d0 * 32 + r32] = f2bf(o[d0][r] * rli[r]); }
#undef SLOAD
#undef SWRITE
#undef RESC
}
}

DI void phase_attn(const bf16_t* Q, const bf16_t* KA, const bf16_t* VA, bf16_t* MIX, bool last, char* lds) {
    const int c = blockIdx.x, G = gridDim.x, NU = 2048 + (last ? 0 : 256);
    for (int L = c; L < NU; L += G) {
        int bh, seq; long qrow0;
        if (L < 2048) { int qb;
            if (G == 256) { const int i = L >> 8, cc = L & 255, xcd = cc & 7, slot = cc >> 3; bh = i * 32 + xcd * 4 + (slot >> 3); qb = slot & 7; }
            else { bh = L >> 3; qb = L & 7; }
            qrow0 = (long)(bh >> 3) * TT + TC + qb * 256; seq = TT; }
        else { bh = L - 2048; qrow0 = (long)(bh >> 3) * TT; seq = TC; }
        const int b = bh >> 3, h = bh & 7;
        att::attn_body(Q + qrow0 * 768 + h * 96, KA + (long)b * TT * 768 + h * 96, VA + (long)b * TT * 512 + h * 64, MIX + qrow0 * 1024 + h * 64, seq, lds);
        __syncthreads();
    }
}

DI float rowsum16(float x) {
    x += __int_as_float(__builtin_amdgcn_update_dpp(0, __float_as_int(x), 0x128, 0xf, 0xf, false));
    x += __int_as_float(__builtin_amdgcn_update_dpp(0, __float_as_int(x), 0x124, 0xf, 0xf, false));
    x += __int_as_float(__builtin_amdgcn_update_dpp(0, __float_as_int(x), 0x122, 0xf, 0xf, false));
    x += __int_as_float(__builtin_amdgcn_update_dpp(0, __float_as_int(x), 0x121, 0xf, 0xf, false));
    return x;
}
DI int scan_row(int d, int b, int n) { const int tt = d == 0 ? n : (n < TC ? TC - 1 - n : TT + TC - 1 - n); return b * TT + tt; }
DI void phase_scan(const bf16_t* R, const bf16_t* Kk, const bf16_t* V, const __half* DEC, const bf16_t* AA, const float* INV, const float* kkp, const float* kap,
                   bf16_t* MIX, bf16_t* YB, char* lds) {
    const int tid = ltid(), grp = tid >> 8, g = tid & 255, rg = g >> 4, cgp = g & 15, pst = g >> 4, pj0 = (g & 15) * 4;
    float* buf = (float*)lds + grp * 12288; float* ybuf = (float*)(lds + 98304) + grp * 2048;
    for (int s0 = blockIdx.x * 2; s0 < 512; s0 += gridDim.x * 2) {
        const int sid = s0 + grp, d = sid >> 8, b = (sid >> 3) & 31, h = sid & 7, hc = h * 64 + pj0;
        const f32x4 kk4 = *(const f32x4*)(kkp + hc), ka4 = *(const f32x4*)(kap + hc);
        float S[4][4];
#pragma unroll
        for (int i = 0; i < 4; ++i)
#pragma unroll
            for (int j = 0; j < 4; ++j) S[i][j] = 0.f;
        u32x2 lr, lk, lv, ld_, la; float linv;
#define PREP_LOAD(c) do { const size_t m_ = (size_t)scan_row(d, b, (c) * 16 + pst); lr = *(const u32x2*)(R + m_ * 512 + hc); lk = *(const u32x2*)(Kk + m_ * 512 + hc); lv = *(const u32x2*)(V + m_ * 512 + hc); \
        ld_ = *(const u32x2*)(DEC + m_ * 1024 + d * 512 + hc); la = *(const u32x2*)(AA + m_ * 1024 + d * 512 + hc); linv = INV[m_ * 8 + h]; } while (0)
#define PREP_WRITE(dst) do { float* q_ = (dst) + pst * 384 + pj0; \
        const float k0 = bflo(lk.x), k1 = bfhi(lk.x), k2 = bflo(lk.y), k3 = bfhi(lk.y), a0 = bflo(la.x), a1 = bfhi(la.x), a2 = bflo(la.y), a3 = bfhi(la.y); \
        const float q0 = k0 * kk4[0] * linv, q1 = k1 * kk4[1] * linv, q2 = k2 * kk4[2] * linv, q3 = k3 * kk4[3] * linv; \
        const float2 w01 = make_float2(h2f(ld_.x & 0xffffu), h2f(ld_.x >> 16)), w23 = make_float2(h2f(ld_.y & 0xffffu), h2f(ld_.y >> 16)); \
        *(f32x4*)(q_) = (f32x4){-q0, -q1, -q2, -q3}; \
        *(f32x4*)(q_ + 64) = (f32x4){__builtin_amdgcn_exp2f(w01.x), __builtin_amdgcn_exp2f(w01.y), __builtin_amdgcn_exp2f(w23.x), __builtin_amdgcn_exp2f(w23.y)}; \
        *(f32x4*)(q_ + 128) = (f32x4){q0 * a0, q1 * a1, q2 * a2, q3 * a3}; \
        *(f32x4*)(q_ + 192) = (f32x4){k0 * (1.f + (a0 - 1.f) * ka4[0]), k1 * (1.f + (a1 - 1.f) * ka4[1]), k2 * (1.f + (a2 - 1.f) * ka4[2]), k3 * (1.f + (a3 - 1.f) * ka4[3])}; \
        *(f32x4*)(q_ + 256) = (f32x4){bflo(lr.x), bfhi(lr.x), bflo(lr.y), bfhi(lr.y)}; \
        *(f32x4*)(q_ + 320) = (f32x4){bflo(lv.x), bfhi(lv.x), bflo(lv.y), bfhi(lv.y)}; } while (0)
        PREP_LOAD(0); PREP_WRITE(buf); __syncthreads();
        for (int c = 0; c < TT / 16; ++c) {
            const float* cur = buf + (c & 1) * 6144; float* yb = ybuf + (c & 1) * 1024;
            if (c + 1 < TT / 16) PREP_LOAD(c + 1);
#pragma unroll 2
            for (int st = 0; st < 16; ++st) {
                const float* p = cur + st * 384;
                const f32x4 a4 = *(const f32x4*)(p + 4 * cgp), w4 = *(const f32x4*)(p + 64 + 4 * cgp), b4 = *(const f32x4*)(p + 128 + 4 * cgp),
                            k4 = *(const f32x4*)(p + 192 + 4 * cgp), r4 = *(const f32x4*)(p + 256 + 4 * cgp), v4 = *(const f32x4*)(p + 320 + 4 * rg);
                float sa[4], y[4];
#pragma unroll
                for (int i = 0; i < 4; ++i) sa[i] = rowsum16(S[i][0] * a4[0] + S[i][1] * a4[1] + S[i][2] * a4[2] + S[i][3] * a4[3]);
#pragma unroll
                for (int i = 0; i < 4; ++i)
#pragma unroll
                    for (int j = 0; j < 4; ++j) S[i][j] = S[i][j] * w4[j] + sa[i] * b4[j] + v4[i] * k4[j];
#pragma unroll
                for (int i = 0; i < 4; ++i) y[i] = rowsum16(S[i][0] * r4[0] + S[i][1] * r4[1] + S[i][2] * r4[2] + S[i][3] * r4[3]);
                if (cgp == 0) *(f32x4*)(yb + st * 64 + 4 * rg) = (f32x4){y[0], y[1], y[2], y[3]};
            }
            if (c + 1 < TT / 16) PREP_WRITE(buf + ((c + 1) & 1) * 6144);
            __syncthreads();
            { const f32x4 yv = *(const f32x4*)(yb + pst * 64 + pj0); const size_t m_ = (size_t)scan_row(d, b, c * 16 + pst);
              u32x2 w; w.x = cvtpk(yv[0], yv[1]); w.y = cvtpk(yv[2], yv[3]);
              if (d == 0) *(u32x2*)(MIX + m_ * 1024 + 512 + hc) = w; else *(u32x2*)(YB + m_ * 512 + hc) = w; }
        }
        __syncthreads();
#undef PREP_LOAD
#undef PREP_WRITE
    }
}
DI void phase_prologue(const Args& a, unsigned char* lds) {
    const int tid = ltid(), G = gridDim.x;
    float* out = a.out; float* xc = (float*)(a.ws + WS_XC);
    {
        const size_t n4x = (size_t)NB * SEQ * DM / 4, n4c = (size_t)NB * TC * DM / 4;
        const f32x4* sx = (const f32x4*)a.in[I_X]; const f32x4* sc = (const f32x4*)a.in[I_CTX];
        for (size_t i = (size_t)blockIdx.x * 512 + tid; i < n4x + n4c; i += (size_t)G * 512) { if (i < n4x) ((f32x4*)out)[i] = sx[i]; else ((f32x4*)xc)[i - n4x] = sc[i - n4x]; }
    }
    if (blockIdx.x == 0) {
        float* rope = (float*)(a.ws + WS_ROPE); const int pos = tid >> 3, j = tid & 7;
        const float inv_freq = powf(10000.f, -(float)j / 8.f), ang = (float)pos * inv_freq;
        rope[tid] = cosf(ang); rope[512 + tid] = sinf(ang);
    }
    float* sv = (float*)lds; float* red = sv + 33 * 1024;
    for (int i = tid; i < 33 * 1024; i += 512) { const float v = i < 32 * 1024 ? a.in[I_C][i] : a.in[I_CCTX][i - 32 * 1024]; sv[i] = v / (1.f + __expf(-v)); }
    __syncthreads();
    const int wave = tid >> 6, lane = tid & 63;
    float* mods = (float*)(a.ws + WS_MODS);
    for (int it = blockIdx.x; it < NL * 96; it += G) {
        const int l = it / 96, n0 = (it - l * 96) * 64;
        const float* w = a.in[I_ADAW] + (size_t)l * 1024 * 6144 + n0 + lane;
        float acc[33];
#pragma unroll
        for (int r = 0; r < 33; ++r) acc[r] = 0.f;
        for (int k = wave * 128; k < wave * 128 + 128; ++k) { const float wv = w[(size_t)k * 6144];
#pragma unroll
            for (int r = 0; r < 33; ++r) acc[r] += sv[r * 1024 + k] * wv; }
        for (int i = tid; i < 33 * 64; i += 512) red[i] = 0.f;
        __syncthreads();
        for (int ww = 0; ww < 8; ++ww) { if (wave == ww) {
#pragma unroll
                for (int r = 0; r < 33; ++r) red[r * 64 + lane] += acc[r]; }
            __syncthreads(); }
        for (int i = tid; i < 33 * 64; i += 512) { const int r = i >> 6, n = n0 + (i & 63); mods[((size_t)l * 33 + r) * 6144 + n] = red[i] + a.in[I_ADAB][l * 6144 + n]; }
        __syncthreads();
    }
}

template <class Gt> DI void cvt_tile(bf16_t* dst, int ldk, int n0, int k0, const Gt& get, float* tl) {
    const int tid = ltid(), a_ = tid & 63, b_ = tid >> 6;
#pragma unroll
    for (int i = 0; i < 8; ++i) { const int kk = b_ + 8 * i; tl[kk * 65 + a_] = get(n0 + a_, k0 + kk); }
    __syncthreads();
#pragma unroll
    for (int i = 0; i < 8; ++i) { const int nn = b_ + 8 * i; dst[(size_t)(n0 + nn) * ldk + k0 + a_] = f2bf(tl[a_ * 65 + nn]); }
    __syncthreads();
}
DI void convert_weights(const Args& a, int l, unsigned char* lds) {
    float* tl = (float*)lds; unsigned char* ws = a.ws;
    const float* w_in = a.in[I_WIN] + (size_t)l * 1024 * CIN; const float* v1 = a.in[I_V1] + (size_t)(l > 0 ? l - 1 : 0) * 1024 * 32;
    const float* w_uq = a.in[I_WUQ] + (size_t)l * 256 * 768; const float* w_ukv = a.in[I_WUKV] + (size_t)l * 128 * 1024;
    const float* w2 = a.in[I_W2] + (size_t)l * 2 * 64 * 512; const float* a2 = a.in[I_A2] + (size_t)l * 2 * 64 * 512;
    const float* g2 = a.in[I_G2] + (size_t)l * 128 * 512; const float* v2 = a.in[I_V2] + (size_t)(l > 0 ? l - 1 : 0) * 32 * 512;
    const float* w_out = a.in[I_WOUT] + (size_t)l * 1024 * 1024; const float* m1 = a.in[I_M1] + (size_t)l * 1024 * 4096; const float* m2 = a.in[I_M2] + (size_t)l * 4096 * 1024;
    constexpr int T0 = 640, T1 = T0 + 48, T2 = T1 + 64, T3 = T2 + 128, T4 = T3 + 64, T5 = T4 + 256, T6 = T5 + 1024, T7 = T6 + 1024;
    for (int t = blockIdx.x; t < T7; t += gridDim.x) {
        if (t < T0) { const int nt = t >> 4, kt = t & 15;
            cvt_tile((bf16_t*)(ws + WT_IN), 1024, nt * 64, kt * 64, [&](int n, int k) -> float { return n < CIN ? w_in[(size_t)k * CIN + n] : ((n < CINX && l > 0) ? v1[k * 32 + (n - CIN)] : 0.f); }, tl); }
        else if (t < T1) { const int u = t - T0, nt = u >> 2, kt = u & 3;
            cvt_tile((bf16_t*)(ws + WT_UQ), 256, nt * 64, kt * 64, [&](int n, int k) -> float { return w_uq[k * 768 + n]; }, tl); }
        else if (t < T2) { const int u = t - T1, nt = u >> 2, kt = u & 3;
            cvt_tile((bf16_t*)(ws + WT_UKV), 256, nt * 64, kt * 64, [&](int n, int k) -> float { return k < 128 ? w_ukv[k * 1024 + n] : 0.f; }, tl); }
        else if (t < T3) { const int u = t - T2, nt = u >> 2, kt = u & 3;
            cvt_tile((bf16_t*)(ws + WT_L1), 256, nt * 64, kt * 64, [&](int n, int k) -> float {
                if (n < 1024) { const int d = n >> 9, c = n & 511; return (k < 128 && (k >> 6) == d) ? w2[(d * 64 + (k & 63)) * 512 + c] : 0.f; }
                const int n2 = n - 1024, d = n2 >> 9, c = n2 & 511; return (k >= 128 && ((k - 128) >> 6) == d) ? a2[(d * 64 + ((k - 128) & 63)) * 512 + c] : 0.f; }, tl); }
        else if (t < T4) { const int u = t - T3, nt = u >> 2, kt = u & 3;
            cvt_tile((bf16_t*)(ws + WT_L2), 256, nt * 64, kt * 64, [&](int n, int k) -> float {
                if (n < 512) return k < 128 ? g2[k * 512 + n] : 0.f;
                return (l > 0 && k >= 128 && k < 160) ? v2[(k - 128) * 512 + (n - 512)] : 0.f; }, tl); }
        else if (t < T5) { const int u = t - T4, nt = u >> 4, kt = u & 15;
            cvt_tile((bf16_t*)(ws + WT_OUT), 1024, nt * 64, kt * 64, [&](int n, int k) -> float { return w_out[(size_t)k * 1024 + n]; }, tl); }
        else if (t < T6) { const int u = t - T5, nt = u >> 4, kt = u & 15;
            cvt_tile((bf16_t*)(ws + WT_M1), 1024, nt * 64, kt * 64, [&](int n, int k) -> float { return m1[(size_t)k * 4096 + n]; }, tl); }
        else { const int u = t - T6, nt = u >> 6, kt = u & 63;
            cvt_tile((bf16_t*)(ws + WT_M2), 4096, nt * 64, kt * 64, [&](int n, int k) -> float { return m2[(size_t)k * 1024 + n]; }, tl); }
    }
}

DI void phase_norm(const Args& a, int l, const float* gamma, int shift_idx, int scale_idx, bool latent_only) {
    const int lane = ltid() & 63, gw = blockIdx.x * 8 + (ltid() >> 6), nw = gridDim.x * 8;
    float* xc = (float*)(a.ws + WS_XC); bf16_t* H = (bf16_t*)(a.ws + WS_H); const float* mods = (const float*)(a.ws + WS_MODS) + (size_t)l * 33 * 6144;
    for (int m = gw; m < TALL; m += nw) {
        const int b = m / TT, tt = m - b * TT; const bool ctx = tt < TC; if (latent_only && ctx) continue;
        const float* xr = xrow(a.out, xc, m); const float* md = mods + (size_t)(ctx ? 32 : b) * 6144;
        f32x4 v[4]; float ss = 0.f;
#pragma unroll
        for (int i = 0; i < 4; ++i) { v[i] = *(const f32x4*)(xr + i * 256 + lane * 4); ss += v[i][0] * v[i][0] + v[i][1] * v[i][1] + v[i][2] * v[i][2] + v[i][3] * v[i][3]; }
#pragma unroll
        for (int k = 1; k < 64; k <<= 1) ss = xorsum(ss, k);
        const float rstd = rsqrtf(ss * (1.f / 1024.f) + 1e-6f);
#pragma unroll
        for (int i = 0; i < 4; ++i) { const int col = i * 256 + lane * 4; const f32x4 g = *(const f32x4*)(gamma + col), sc = *(const f32x4*)(md + scale_idx * 1024 + col), sh = *(const f32x4*)(md + shift_idx * 1024 + col);
            float o[4];
#pragma unroll
            for (int j = 0; j < 4; ++j) o[j] = v[i][j] * rstd * g[j] * (1.f + sc[j]) + sh[j];
            u32x2 w; w.x = cvtpk(o[0], o[1]); w.y = cvtpk(o[2], o[3]); *(u32x2*)(H + (size_t)m * 1024 + col) = w; }
    }
}

DI void shift8(const bf16_t* Frow, bool pok, bool nok, int col, const float* mu, float (&o)[8]) {
    float c[8], p[8], n[8], u[8]; load8(Frow + col, c); loadf8(mu + (col - OFF_R), u);
    if (pok) load8(Frow - CINX + col, p); else {
#pragma unroll
        for (int j = 0; j < 8; ++j) p[j] = 0.f; }
    if (nok) load8(Frow + CINX + col, n); else {
#pragma unroll
        for (int j = 0; j < 8; ++j) n[j] = 0.f; }
#pragma unroll
    for (int j = 0; j < 8; ++j) o[j] = c[j] + u[j] * (0.5f * (p[j] + n[j]) - c[j]);
}
DI void phase_split(const Args& a, int l) {
    const int lane = ltid() & 63, gw = blockIdx.x * 8 + (ltid() >> 6), nw = gridDim.x * 8;
    unsigned char* ws = a.ws;
    const bf16_t* F = (const bf16_t*)(ws + WS_F); bf16_t* R = (bf16_t*)(ws + WS_R); bf16_t* Kb = (bf16_t*)(ws + WS_K); bf16_t* Vb = (bf16_t*)(ws + (l == 0 ? WS_VF : WS_V));
    bf16_t* A1 = (bf16_t*)(ws + WS_A1); bf16_t* A2 = (bf16_t*)(ws + WS_A2); bf16_t* CQN = (bf16_t*)(ws + WS_CQN); bf16_t* CKVN = (bf16_t*)(ws + WS_CKVN); bf16_t* KA = (bf16_t*)(ws + WS_KATT);
    float* INV = (float*)(ws + WS_INV); const float* rope = (const float*)(ws + WS_ROPE);
    const float* mu = a.in[I_MU] + (size_t)l * 1920; const float* kkp = a.in[I_KK] + l * 512; const float* qg = a.in[I_QNG] + l * 256; const float* kvg = a.in[I_KVNG] + l * 128;
    for (int m = gw; m < TALL; m += nw) {
        const int b = m / TT, tt = m - b * TT; const bool ctx = tt < TC;
        const bool pok = !(tt == 0 || tt == TC), nok = !(tt == TC - 1 || tt == TT - 1);
        const bf16_t* Fr = F + (size_t)m * CINX; float x[8];
        shift8(Fr, pok, nok, OFF_R + lane * 8, mu, x); store8(R + (size_t)m * 512 + lane * 8, x);
        shift8(Fr, pok, nok, OFF_K + lane * 8, mu, x); store8(Kb + (size_t)m * 512 + lane * 8, x);
        { float kq[8], ss = 0.f; loadf8(kkp + lane * 8, kq);
#pragma unroll
          for (int j = 0; j < 8; ++j) { const float t = x[j] * kq[j]; ss += t * t; }
          ss = xorsum(ss, 1); ss = xorsum(ss, 2); ss = xorsum(ss, 4);
          if ((lane & 7) == 0) INV[(size_t)m * 8 + (lane >> 3)] = 1.f / fmaxf(sqrtf(ss), 1e-12f); }
        shift8(Fr, pok, nok, OFF_V + lane * 8, mu, x); store8(Vb + (size_t)m * 512 + lane * 8, x);
        if (lane < 48) { shift8(Fr, pok, nok, OFF_WLO + lane * 8, mu, x);
            if (lane < 16) {
#pragma unroll
                for (int j = 0; j < 8; ++j) x[j] = tanhf(x[j]); }
            else if (lane >= 32) {
#pragma unroll
                for (int j = 0; j < 8; ++j) x[j] = sigmoidf_(x[j]); }
            if (lane < 32) store8(A1 + (size_t)m * 256 + lane * 8, x); else store8(A2 + (size_t)m * 256 + (lane - 32) * 8, x); }
        else { if (lane < 52) load8(Fr + OFF_HV + (lane - 48) * 8, x); else {
#pragma unroll
                for (int j = 0; j < 8; ++j) x[j] = 0.f; }
            store8(A2 + (size_t)m * 256 + 128 + (lane - 48) * 8, x); }
        { const int col = lane < 32 ? lane * 8 : (lane < 48 ? 256 + (lane - 32) * 8 : 384 + ((lane - 48) & 3) * 8);
          load8(Fr + col, x); float ss = 0.f;
#pragma unroll
          for (int j = 0; j < 8; ++j) ss += x[j] * x[j];
          ss = xorsum(ss, 1); ss = xorsum(ss, 2); ss = xorsum(ss, 4); ss = xorsum(ss, 8); const float ss32 = xorsum(ss, 16);
          float px[8]; const int q = (lane - 48) & 3;
#pragma unroll
          for (int j = 0; j < 8; ++j) px[j] = __shfl_xor(x[j], 1, 64);
          if (lane < 32) { const float rstd = rsqrtf(ss32 * (1.f / 256.f) + 1e-6f); float g[8]; loadf8(qg + lane * 8, g);
#pragma unroll
              for (int j = 0; j < 8; ++j) x[j] = x[j] * rstd * g[j];
              store8(CQN + (size_t)m * 256 + lane * 8, x); }
          else if (lane < 48) { const float rstd = rsqrtf(ss * (1.f / 128.f) + 1e-6f); float g[8]; loadf8(kvg + (lane - 32) * 8, g);
#pragma unroll
              for (int j = 0; j < 8; ++j) x[j] = x[j] * rstd * g[j];
              store8(CKVN + (size_t)m * 256 + (lane - 32) * 8, x); }
          else { if (lane < 52) {
                  if (!ctx) { const int s = tt - TC, pos = (q < 2) ? (s >> 6) : (s & 63); float cs[8], sn[8]; loadf8(rope + pos * 8, cs); loadf8(rope + 512 + pos * 8, sn); const float sg = (q & 1) ? 1.f : -1.f;
#pragma unroll
                      for (int j = 0; j < 8; ++j) x[j] = x[j] * cs[j] + sg * px[j] * sn[j]; }
#pragma unroll
                  for (int hh = 0; hh < 8; ++hh) store8(KA + (size_t)m * 768 + hh * 96 + 64 + q * 8, x); }
              float z[8];
#pragma unroll
              for (int j = 0; j < 8; ++j) z[j] = 0.f;
              store8(CKVN + (size_t)m * 256 + 128 + (lane - 48) * 8, z); } }
    }
}

DI void phase_rwkv_out(const Args& a, int l, bool latent_only) {
    const int lane = ltid() & 63, gw = blockIdx.x * 8 + (ltid() >> 6), nw = gridDim.x * 8;
    unsigned char* ws = a.ws;
    const bf16_t* R = (const bf16_t*)(ws + WS_R); const bf16_t* Kb = (const bf16_t*)(ws + WS_K); const bf16_t* Vb = (const bf16_t*)(ws + (l == 0 ? WS_VF : WS_V));
    const bf16_t* AA = (const bf16_t*)(ws + WS_AA); const bf16_t* Gb = (const bf16_t*)(ws + WS_G); const bf16_t* YB = (const bf16_t*)(ws + WS_YB); bf16_t* MIX = (bf16_t*)(ws + WS_MIX);
    const int c = lane * 8; float ka[8], rk[8], lw[8], lb[8];
    loadf8(a.in[I_KA] + l * 512 + c, ka); loadf8(a.in[I_RK] + l * 512 + c, rk); loadf8(a.in[I_LNW] + l * 512 + c, lw); loadf8(a.in[I_LNB] + l * 512 + c, lb);
    for (int m = gw; m < TALL; m += nw) {
        const int tt = m % TT; if (latent_only && tt < TC) continue;
        float yf[8], yb[8], r[8], k[8], v[8], a0[8], a1[8], g[8];
        load8(MIX + (size_t)m * 1024 + 512 + c, yf); load8(YB + (size_t)m * 512 + c, yb); load8(R + (size_t)m * 512 + c, r); load8(Kb + (size_t)m * 512 + c, k); load8(Vb + (size_t)m * 512 + c, v);
        load8(AA + (size_t)m * 1024 + c, a0); load8(AA + (size_t)m * 1024 + 512 + c, a1); load8(Gb + (size_t)m * 512 + c, g);
        float s = 0.f, bon = 0.f;
#pragma unroll
        for (int j = 0; j < 8; ++j) { yf[j] += yb[j]; s += yf[j]; bon += r[j] * k[j] * (2.f + (a0[j] + a1[j] - 2.f) * ka[j]) * rk[j]; }
        s = xorsum(s, 1); s = xorsum(s, 2); s = xorsum(s, 4); bon = xorsum(bon, 1); bon = xorsum(bon, 2); bon = xorsum(bon, 4);
        const float mean = s * (1.f / 64.f); float vs = 0.f;
#pragma unroll
        for (int j = 0; j < 8; ++j) { yf[j] -= mean; vs += yf[j] * yf[j]; }
        vs = xorsum(vs, 1); vs = xorsum(vs, 2); vs = xorsum(vs, 4);
        const float rstd = rsqrtf(vs * (1.f / 64.f) + 64e-5f);
#pragma unroll
        for (int j = 0; j < 8; ++j) yf[j] = (yf[j] * rstd * lw[j] + lb[j] + bon * v[j]) * g[j];
        store8(MIX + (size_t)m * 1024 + 512 + c, yf);
    }
}

DI void phase_final(const Args& a) {
    const int lane = ltid() & 63, gw = blockIdx.x * 8 + (ltid() >> 6), nw = gridDim.x * 8; const float* gamma = a.in[I_FG];
    for (int m = gw; m < NB * SEQ; m += nw) {
        float* xr = a.out + (size_t)m * DM; f32x4 v[4]; float ss = 0.f;
#pragma unroll
        for (int i = 0; i < 4; ++i) { v[i] = *(const f32x4*)(xr + i * 256 + lane * 4); ss += v[i][0] * v[i][0] + v[i][1] * v[i][1] + v[i][2] * v[i][2] + v[i][3] * v[i][3]; }
#pragma unroll
        for (int k = 1; k < 64; k <<= 1) ss = xorsum(ss, k);
        const float rstd = rsqrtf(ss * (1.f / 1024.f) + 1e-6f);
#pragma unroll
        for (int i = 0; i < 4; ++i) { const int col = i * 256 + lane * 4; const f32x4 g = *(const f32x4*)(gamma + col); *(f32x4*)(xr + col) = v[i] * rstd * g; }
    }
}

#ifndef SUBM
#define SUBM 3
#endif
#ifndef PHMASK
#define PHMASK 0xfff
#endif
__global__ void __launch_bounds__(512, 2) trunk_fwd(Args ka) {
    extern __shared__ __attribute__((aligned(16))) unsigned char lds[];
    cg::grid_group grid = cg::this_grid();
    const int ph_lo = ka.lo, ph_hi = ka.hi;
    for (int ph = ph_lo; ph < ph_hi; ++ph) {
        Args a = ka; asm volatile("" : "+s"(a.ws)); asm volatile("" : "+s"(a.out));
        unsigned char* ws = a.ws;
        if (ph == 0) phase_prologue(a, lds);
        else if (ph == NPH - 1) phase_final(a);
        else {
            const int l = (ph - 1) / 12, s = (ph - 1) % 12; const bool last = (l == NL - 1);
            const float* mods = (const float*)(ws + WS_MODS) + (size_t)l * 33 * 6144;
            if (s == 0 && ((PHMASK >> 0) & 1)) { convert_weights(a, l, lds); phase_norm(a, l, a.in[I_N1G] + l * 1024, 0, 1, false); }
            if (s == 1 && ((PHMASK >> 1) & 1)) { run_gemm<NIN, 1024>(lds, (const bf16_t*)(ws + WS_H), (const bf16_t*)(ws + WT_IN), 0, FnF{(bf16_t*)(ws + WS_F)}); }
            if (s == 2 && ((PHMASK >> 2) & 1)) { phase_split(a, l); }
            if (s == 3 && ((PHMASK >> 3) & 1)) { if (SUBM & 1) run_gemm<768, 256>(lds, (const bf16_t*)(ws + WS_CQN), (const bf16_t*)(ws + WT_UQ), 0, FnQ{(bf16_t*)(ws + WS_Q), (const float*)(ws + WS_ROPE)});
                    if (SUBM & 2) run_gemm<1024, 256>(lds, (const bf16_t*)(ws + WS_CKVN), (const bf16_t*)(ws + WT_UKV), 0, FnKV{(bf16_t*)(ws + WS_KATT), (bf16_t*)(ws + WS_VATT)}); }
            if (s == 4 && ((PHMASK >> 4) & 1)) { phase_attn((const bf16_t*)(ws + WS_Q), (const bf16_t*)(ws + WS_KATT), (const bf16_t*)(ws + WS_VATT), (bf16_t*)(ws + WS_MIX), last, (char*)lds); }
            if (s == 5 && ((PHMASK >> 5) & 1)) { if (SUBM & 1) run_gemm<2048, 256>(lds, (const bf16_t*)(ws + WS_A1), (const bf16_t*)(ws + WT_L1), 0, FnL1{(__half*)(ws + WS_DEC), (bf16_t*)(ws + WS_AA), a.in[I_W0] + l * 1024, a.in[I_A0] + l * 1024});
                    if (SUBM & 2) run_gemm<1024, 256>(lds, (const bf16_t*)(ws + WS_A2), (const bf16_t*)(ws + WT_L2), 0,
                             FnL2{(bf16_t*)(ws + WS_G), (bf16_t*)(ws + WS_V), (const bf16_t*)(ws + WS_VF), a.in[I_V0] + (l > 0 ? l - 1 : 0) * 512, l > 0 ? 1 : 0}); }
            if (s == 6 && ((PHMASK >> 6) & 1)) { phase_scan((const bf16_t*)(ws + WS_R), (const bf16_t*)(ws + WS_K), (const bf16_t*)(ws + (l == 0 ? WS_VF : WS_V)), (const __half*)(ws + WS_DEC), (const bf16_t*)(ws + WS_AA),
                               (const float*)(ws + WS_INV), a.in[I_KK] + l * 512, a.in[I_KA] + l * 512, (bf16_t*)(ws + WS_MIX), (bf16_t*)(ws + WS_YB), (char*)lds); }
            if (s == 7 && ((PHMASK >> 7) & 1)) { phase_rwkv_out(a, l, last); }
            if (s == 8 && ((PHMASK >> 8) & 1)) { run_gemm<1024, 1024>(lds, (const bf16_t*)(ws + WS_MIX), (const bf16_t*)(ws + WT_OUT), last ? 1 : 0, FnRes{a.out, (float*)(ws + WS_XC), mods, 2}); }
            if (s == 9 && ((PHMASK >> 9) & 1)) { phase_norm(a, l, a.in[I_N2G] + l * 1024, 3, 4, last); }
            if (s == 10 && ((PHMASK >> 10) & 1)) { run_gemm<DFF, 1024>(lds, (const bf16_t*)(ws + WS_H), (const bf16_t*)(ws + WT_M1), last ? 1 : 0, FnM1{(bf16_t*)(ws + WS_HID)}); }
            if (s == 11 && ((PHMASK >> 11) & 1)) { run_gemm<1024, DFF>(lds, (const bf16_t*)(ws + WS_HID), (const bf16_t*)(ws + WT_M2), last ? 1 : 0, FnRes{a.out, (float*)(ws + WS_XC), mods, 5}); }
        }
        if (ph + 1 < ph_hi) grid.sync();
    }
}

extern "C" void kernel_launch(void* const* d_in, const int* in_sizes, int n_in, void* d_out, int out_size, void* d_ws, size_t ws_size, hipStream_t stream) {
    static int grid = 0;
    if (grid == 0) {
        if (n_in != 31 || out_size != NB * SEQ * DM || ws_size < WS_END) { fprintf(stderr, "kernel_launch: unexpected shapes: n_in %d out %d ws %zu (need %zu)\n", n_in, out_size, ws_size, (size_t)WS_END); grid = -1; return; }
        int dev = 0, cus = 0, per_cu = 0;
        (void)hipGetDevice(&dev); (void)hipDeviceGetAttribute(&cus, hipDeviceAttributeMultiprocessorCount, dev);
        if (hipFuncSetAttribute((const void*)trunk_fwd, hipFuncAttributeMaxDynamicSharedMemorySize, LDS_BYTES) != hipSuccess) { fprintf(stderr, "kernel_launch: hipFuncSetAttribute failed\n"); grid = -1; return; }
        if (hipOccupancyMaxActiveBlocksPerMultiprocessor(&per_cu, (const void*)trunk_fwd, 512, LDS_BYTES) != hipSuccess || per_cu < 1) { fprintf(stderr, "kernel_launch: occupancy query gave %d\n", per_cu); per_cu = 1; }
        (void)hipGetLastError();
        grid = cus * 1;
    }
    if (grid < 0) return;
    Args a{};
    for (int i = 0; i < 31; ++i) a.in[i] = (const float*)d_in[i];
    a.out = (float*)d_out; a.ws = (unsigned char*)d_ws; a.lo = 0; a.hi = NPH;
    void* args[] = {&a};
    hipError_t e = hipLaunchCooperativeKernel((const void*)trunk_fwd, dim3(grid), dim3(512), args, LDS_BYTES, stream);
    if (e != hipSuccess) fprintf(stderr, "kernel_launch: cooperative launch failed: %s (grid %d)\n", hipGetErrorString(e), grid);
}
```

```cpp
#include <hip/hip_runtime.h>
#include <hip/hip_cooperative_groups.h>
#include <hip/hip_fp16.h>
#include <cstdio>
#include <cstdint>
namespace cg = cooperative_groups;
#define DI __device__ __forceinline__
DI int ltid() { int t = threadIdx.x; asm volatile("" : "+v"(t)); return t; }
namespace pg8 {
#define PG8_LAS __attribute__((address_space(3)))
typedef unsigned short bf16_t;
typedef short bf16x8 __attribute__((ext_vector_type(8)));
typedef float f32x4 __attribute__((ext_vector_type(4)));
typedef unsigned u32x4 __attribute__((ext_vector_type(4)));
constexpr int BM = 256, BK = 64, HALF = 128, HTB = HALF * BK * 2  , STAGE_BYTES = 8 * HTB, NXCD = 8, WGM = 8;

__host__ __device__ __forceinline__ int lds_byte(int r, int c) { const int st = (r >> 4) * 2 + (c >> 5), rr = r & 15, cc = c & 31, ob = rr * 64 + cc * 2; return st * 1024 + (ob ^ (((ob >> 9) & 1) << 5)); }
__host__ __device__ __forceinline__ void stage_rc(int b, int& R, int& C) { const int st = b / 1024, sb = b % 1024, swz = sb ^ (((sb >> 9) & 1) << 5); R = (st >> 1) * 16 + swz / 64; C = (st & 1) * 32 + (swz % 64) / 2; }
__host__ __device__ __forceinline__ int perm32(int rho) { const int n = rho >> 4, i = rho & 15; return 8 * (i >> 2) + 4 * n + (i & 3); }

struct Unit { int pm, pn; };
struct Gemm { const bf16_t* A; const bf16_t* Bt; int M, N, K; };

struct StaticOrder {
    int nM, nN, nwg, G, c;
    __host__ __device__ void init(int M, int N, int G_, int c_) { nM = M / BM; nN = N / BM; nwg = nM * nN; G = G_; c = c_; }
    __host__ __device__ bool next(int i, Unit& u) const {
        const long L = (long)i * G + c; if (L >= nwg) return false;
        int wgid = (int)L; { const int q = nwg / NXCD, r = nwg % NXCD, xcd = wgid % NXCD, off = wgid / NXCD; wgid = (xcd < r ? xcd * (q + 1) : r * (q + 1) + (xcd - r) * q) + off; }
        const int nig = WGM * nN, gid = wgid / nig, fm = gid * WGM, gsz = (nM - fm) < WGM ? (nM - fm) : WGM;
        u.pm = fm + ((wgid % nig) % gsz); u.pn = (wgid % nig) / gsz; return true;
    }
    __device__ __forceinline__ void a_ready(const Unit&) const {}
    __device__ __forceinline__ void done(const Unit&) const {}
};

__device__ __forceinline__ unsigned cvt_pk_bf16(float lo, float hi) { unsigned r; asm volatile("v_cvt_pk_bf16_f32 %0, %1, %2" : "=v"(r) : "v"(lo), "v"(hi)); return r; }

template <class Epi, class Sched, bool ALIGN_EPI = false, bool SP2 = false>
__device__ __forceinline__ void gemm_phase(PG8_LAS unsigned char* lds, const Gemm g, const Sched& S, const Epi& E) {
    const int tid = ltid(), wid = __builtin_amdgcn_readfirstlane(tid >> 6), lane = tid & 63, wr = wid >> 2, wc = wid & 3, fr = lane & 15, fq = lane >> 4;
    const int K = g.K, nt = K / BK;
    unsigned voffA[2], voffB[2];
#pragma unroll
    for (int i = 0; i < 2; ++i) { int R, C; stage_rc(tid * 16 + i * 8192, R, C); const int Rb = Epi::PERM ? ((R & ~31) + perm32(R & 31)) : R;
        voffA[i] = (unsigned)(R * K + C) * 2u; voffB[i] = (unsigned)(Rb * K + C) * 2u; }
    const size_t kstep = (size_t)(BK * 2);
    const size_t hstep = (size_t)HALF * K * 2;
    const size_t tstep = 2 * hstep;
    const unsigned ldsw = (unsigned)wid * 1024u;
    const int aoff = lds_byte(wr * 64 + fr, fq * 8), boff = lds_byte(wc * 32 + fr, fq * 8);
#define PG8_SA(b, h) (((b) * 2 + (h)) * HTB)
#define PG8_SB(b, h) ((4 + (b) * 2 + (h)) * HTB)
#define PG8_STAGE(bufoff, gbase, voff) do { _Pragma("unroll") for (int _i = 0; _i < 2; ++_i) \
        __builtin_amdgcn_global_load_lds((const unsigned*)((const char*)(gbase) + (voff)[_i]), (PG8_LAS unsigned*)(lds + (bufoff) + ldsw + _i * 8192), 16, 0, 0); } while (0)
#define PG8_LDA(dst, b, h) do { _Pragma("unroll") for (int m = 0; m < 4; ++m) _Pragma("unroll") for (int k = 0; k < 2; ++k) dst[m][k] = *(const PG8_LAS bf16x8*)(lds + PG8_SA(b, h) + aoff + m * 2048 + k * 1024); } while (0)
#define PG8_LDB(dst, b, h) do { _Pragma("unroll") for (int n = 0; n < 2; ++n) _Pragma("unroll") for (int k = 0; k < 2; ++k) dst[n][k] = *(const PG8_LAS bf16x8*)(lds + PG8_SB(b, h) + boff + n * 2048 + k * 1024); } while (0)
#define PG8_MMA(ai, bj, At, Bt) do { __builtin_amdgcn_s_setprio(1); _Pragma("unroll") for (int m = 0; m < 4; ++m) _Pragma("unroll") for (int n = 0; n < 2; ++n) _Pragma("unroll") for (int k = 0; k < 2; ++k) \
        acc[ai][bj][m][n] = __builtin_amdgcn_mfma_f32_16x16x32_bf16(Bt[n][k], At[m][k], acc[ai][bj][m][n], 0, 0, 0); __builtin_amdgcn_s_setprio(0); } while (0)
#define PG8_WAIT_V(n) asm volatile("s_waitcnt vmcnt(" #n ")" ::: "memory")
#define PG8_WAIT_L(n) asm volatile("s_waitcnt lgkmcnt(" #n ")" ::: "memory")
#define PG8_BAR __builtin_amdgcn_s_barrier()
#define PG8_SCHED __builtin_amdgcn_sched_barrier(0)
    Unit cur, nxt; int ui = 0;
    if (!S.next(0, cur)) return;
    f32x4 acc[2][2][4][2];
#pragma unroll
    for (int a = 0; a < 2; ++a)
#pragma unroll
        for (int b = 0; b < 2; ++b)
#pragma unroll
            for (int m = 0; m < 4; ++m)
#pragma unroll
                for (int n = 0; n < 2; ++n) acc[a][b][m][n] = (f32x4){0.f, 0.f, 0.f, 0.f};
    bf16x8 At[4][2], B0[2][2], B1[2][2];
    const char* cA = (const char*)g.A + (size_t)cur.pm * tstep; const char* cB = (const char*)g.Bt + (size_t)cur.pn * tstep;
    S.a_ready(cur);
    if constexpr (SP2) {
        PG8_STAGE(PG8_SB(0, 0), cB, voffB); PG8_STAGE(PG8_SB(0, 1), cB + hstep, voffB); PG8_STAGE(PG8_SA(0, 0), cA, voffA); PG8_STAGE(PG8_SA(0, 1), cA + hstep, voffA);
        if (wr == 1) PG8_BAR;
        PG8_WAIT_V(2); PG8_BAR;
        PG8_STAGE(PG8_SB(1, 0), cB + kstep, voffB); PG8_STAGE(PG8_SA(1, 0), cA + kstep, voffA); PG8_STAGE(PG8_SB(1, 1), cB + hstep + kstep, voffB);
        PG8_WAIT_V(6); PG8_BAR;
    } else {
        PG8_STAGE(PG8_SB(0, 0), cB, voffB); PG8_STAGE(PG8_SA(0, 0), cA, voffA); PG8_STAGE(PG8_SB(0, 1), cB + hstep, voffB); PG8_STAGE(PG8_SA(0, 1), cA + hstep, voffA);
        if (wr == 1) PG8_BAR;
        PG8_WAIT_V(4); PG8_BAR;
        PG8_STAGE(PG8_SB(1, 0), cB + kstep, voffB); PG8_STAGE(PG8_SA(1, 0), cA + kstep, voffA); PG8_STAGE(PG8_SB(1, 1), cB + hstep + kstep, voffB);
        PG8_WAIT_V(6); PG8_BAR;
    }
    for (;;) {
        const bool has_next = S.next(ui + 1, nxt);
        const char* nA = has_next ? (const char*)g.A + (size_t)nxt.pm * tstep : cA; const char* nB = has_next ? (const char*)g.Bt + (size_t)nxt.pn * tstep : cB;
#pragma nounroll
        for (int t = 0; t < nt; t += 2) {
            const bool last = (t == nt - 2);
            const char* a1 = cA + (size_t)(t + 1) * kstep;
            const char* a2 = last ? nA : cA + (size_t)(t + 2) * kstep; const char* b2 = last ? nB : cB + (size_t)(t + 2) * kstep;
            const char* a3 = a2 + kstep; const char* b3 = b2 + kstep;
            if (last && has_next) S.a_ready(nxt);
            if constexpr (SP2) {
            PG8_LDB(B0, 0, 0); PG8_LDB(B1, 0, 1); PG8_SCHED; PG8_LDA(At, 0, 0); PG8_STAGE(PG8_SA(1, 1), a1 + hstep, voffA);
            PG8_WAIT_V(8); PG8_WAIT_L(0); PG8_BAR; PG8_MMA(0, 0, At, B0); PG8_MMA(0, 1, At, B1); PG8_BAR; PG8_SCHED;
            PG8_LDA(At, 0, 1); PG8_STAGE(PG8_SB(0, 0), b2, voffB); PG8_STAGE(PG8_SB(0, 1), b2 + hstep, voffB); PG8_STAGE(PG8_SA(0, 0), a2, voffA);
            PG8_WAIT_V(8); PG8_WAIT_L(0); PG8_BAR; PG8_MMA(1, 0, At, B0); PG8_MMA(1, 1, At, B1); PG8_BAR; PG8_SCHED;
            PG8_LDB(B0, 1, 0); PG8_LDB(B1, 1, 1); PG8_SCHED; PG8_LDA(At, 1, 0); PG8_STAGE(PG8_SA(0, 1), a2 + hstep, voffA);
            PG8_WAIT_V(8); PG8_WAIT_L(0); PG8_BAR; PG8_MMA(0, 0, At, B0); PG8_MMA(0, 1, At, B1); PG8_BAR; PG8_SCHED;
            PG8_LDA(At, 1, 1); PG8_STAGE(PG8_SB(1, 0), b3, voffB); PG8_STAGE(PG8_SB(1, 1), b3 + hstep, voffB); PG8_STAGE(PG8_SA(1, 0), a3, voffA);
            PG8_WAIT_V(8); PG8_WAIT_L(0); PG8_BAR; PG8_MMA(1, 0, At, B0); PG8_MMA(1, 1, At, B1); PG8_BAR; PG8_SCHED;
            } else {
            PG8_LDB(B0, 0, 0); PG8_SCHED; PG8_LDA(At, 0, 0); PG8_STAGE(PG8_SA(1, 1), a1 + hstep, voffA);
            PG8_WAIT_L(8); PG8_BAR; PG8_WAIT_L(0); PG8_MMA(0, 0, At, B0); PG8_BAR; PG8_SCHED;
            PG8_LDB(B1, 0, 1); PG8_STAGE(PG8_SB(0, 0), b2, voffB);
            PG8_BAR; PG8_WAIT_L(0); PG8_MMA(0, 1, At, B1); PG8_BAR;
            PG8_LDA(At, 0, 1); PG8_STAGE(PG8_SA(0, 0), a2, voffA);
            PG8_BAR; PG8_WAIT_L(0); PG8_MMA(1, 0, At, B0); PG8_BAR; PG8_SCHED;
            PG8_STAGE(PG8_SB(0, 1), b2 + hstep, voffB);
            PG8_WAIT_V(6); PG8_BAR; PG8_MMA(1, 1, At, B1); PG8_BAR;
            PG8_LDB(B0, 1, 0); PG8_SCHED; PG8_LDA(At, 1, 0); PG8_STAGE(PG8_SA(0, 1), a2 + hstep, voffA);
            PG8_WAIT_L(8); PG8_BAR; PG8_WAIT_L(0); PG8_MMA(0, 0, At, B0); PG8_BAR; PG8_SCHED;
            PG8_LDB(B1, 1, 1); PG8_STAGE(PG8_SB(1, 0), b3, voffB);
            PG8_BAR; PG8_WAIT_L(0); PG8_MMA(0, 1, At, B1); PG8_BAR;
            PG8_LDA(At, 1, 1); PG8_STAGE(PG8_SA(1, 0), a3, voffA);
            PG8_BAR; PG8_WAIT_L(0); PG8_MMA(1, 0, At, B0); PG8_BAR; PG8_SCHED;
            PG8_STAGE(PG8_SB(1, 1), b3 + hstep, voffB);
            PG8_WAIT_V(6); PG8_BAR; PG8_MMA(1, 1, At, B1); PG8_BAR;
            }
        }
        if constexpr (ALIGN_EPI) { if (wr == 0) PG8_BAR; }
        if constexpr (!Epi::AFTER_DRAIN) { E(acc, cur, wr, wc, fr, fq); S.done(cur); }
        if (!has_next) break;
#pragma unroll
        for (int a = 0; a < 2; ++a)
#pragma unroll
            for (int b = 0; b < 2; ++b)
#pragma unroll
                for (int m = 0; m < 4; ++m)
#pragma unroll
                    for (int n = 0; n < 2; ++n) acc[a][b][m][n] = (f32x4){0.f, 0.f, 0.f, 0.f};
        cur = nxt; cA = nA; cB = nB; ++ui;
        if constexpr (ALIGN_EPI) { if (wr == 1) PG8_BAR; }
    }
    PG8_WAIT_V(0);
    if constexpr (!ALIGN_EPI) { if (wr == 0) PG8_BAR; }
    PG8_BAR;
    if constexpr (Epi::AFTER_DRAIN) { E.fused(acc, cur, wr, wc, fr, fq, lds, wid, lane); S.done(cur); }
#undef PG8_SA
#undef PG8_SB
#undef PG8_STAGE
#undef PG8_LDA
#undef PG8_LDB
#undef PG8_MMA
#undef PG8_WAIT_V
#undef PG8_WAIT_L
#undef PG8_BAR
#undef PG8_SCHED
}
}
typedef unsigned short bf16_t;
using bf16x8 = __attribute__((ext_vector_type(8))) short;
using s16x4  = __attribute__((ext_vector_type(4))) short;
using f32x16 = __attribute__((ext_vector_type(16))) float;
using f32x4  = __attribute__((ext_vector_type(4))) float;
using u32x4  = __attribute__((ext_vector_type(4))) unsigned;
using u32x2  = __attribute__((ext_vector_type(2))) unsigned;

constexpr int DM = 1024, NB = 32, SEQ = 2048, TC = 256, TT = 2304, TALL = NB * TT, NL = 4;
constexpr int CIN = 2336, CINX = 2368, NIN = 2560, DFF = 4096;
constexpr int OFF_R = 416, OFF_K = 928, OFF_V = 1440, OFF_WLO = 1952, OFF_HV = 2336;
constexpr int NPH = 50, LDS_BYTES = 147456;
constexpr size_t MiB = 1u << 20;
constexpr size_t WS_MODS = 0, WS_ROPE = 3 * MiB + 512 * 1024, WS_XC = 4 * MiB, WS_VF = 36 * MiB, WS_WT = 108 * MiB, WS_INV = 134 * MiB, TR = 137 * MiB;
constexpr size_t WT_IN = WS_WT, WT_UQ = WS_WT + 5 * MiB, WT_UKV = WS_WT + 5 * MiB + 512 * 1024, WT_L1 = WS_WT + 6 * MiB, WT_L2 = WS_WT + 7 * MiB,
                 WT_OUT = WS_WT + 8 * MiB, WT_M1 = WS_WT + 10 * MiB, WT_M2 = WS_WT + 18 * MiB;
constexpr size_t WS_R = TR, WS_K = TR + 72 * MiB, WS_H = TR, WS_F = TR + 144 * MiB, WS_Q = TR + 144 * MiB, WS_VATT = TR + 252 * MiB, WS_MIX = TR + 324 * MiB,
                 WS_DEC = TR + 144 * MiB, WS_HID = TR + 144 * MiB, WS_A1 = TR + 477 * MiB, WS_A2 = TR + 513 * MiB, WS_YB = TR + 477 * MiB,
                 WS_CQN = TR + 549 * MiB, WS_CKVN = TR + 585 * MiB, WS_KATT = TR + 621 * MiB, WS_AA = TR + 585 * MiB, WS_G = TR + 729 * MiB,
                 WS_V = TR + 801 * MiB, WS_END = TR + 873 * MiB;

struct Args { const float* in[31]; float* out; unsigned char* ws; int lo, hi; };
enum { I_X = 0, I_C, I_CTX, I_CCTX, I_ADAW, I_ADAB, I_N1G, I_N2G, I_WIN, I_QNG, I_WUQ, I_KVNG, I_WUKV, I_MU, I_W0, I_W2, I_A0, I_A2, I_G2, I_KK, I_KA, I_RK,
       I_LNW, I_LNB, I_V1, I_V2, I_V0, I_WOUT, I_M1, I_M2, I_FG };

DI float bflo(unsigned w) { return __uint_as_float(w << 16); }
DI float bfhi(unsigned w) { return __uint_as_float(w & 0xffff0000u); }
DI unsigned cvtpk(float lo, float hi) { return pg8::cvt_pk_bf16(lo, hi); }
DI bf16_t f2bf(float f) { return (bf16_t)(cvtpk(f, 0.f) & 0xffffu); }
DI void load8(const bf16_t* p, float (&f)[8]) { const u32x4 w = *(const u32x4*)p; f[0] = bflo(w.x); f[1] = bfhi(w.x); f[2] = bflo(w.y); f[3] = bfhi(w.y); f[4] = bflo(w.z); f[5] = bfhi(w.z); f[6] = bflo(w.w); f[7] = bfhi(w.w); }
DI void store8(bf16_t* p, const float (&f)[8]) { u32x4 w; w.x = cvtpk(f[0], f[1]); w.y = cvtpk(f[2], f[3]); w.z = cvtpk(f[4], f[5]); w.w = cvtpk(f[6], f[7]); *(u32x4*)p = w; }
DI void loadf8(const float* p, float (&f)[8]) { const f32x4 a = *(const f32x4*)p, b = *(const f32x4*)(p + 4); f[0] = a[0]; f[1] = a[1]; f[2] = a[2]; f[3] = a[3]; f[4] = b[0]; f[5] = b[1]; f[6] = b[2]; f[7] = b[3]; }
DI float h2f(unsigned b) { return __half2float(__ushort_as_half((unsigned short)b)); }
DI float sigmoidf_(float x) { return 1.f / (1.f + __expf(-x)); }
DI float xorsum(float v, int mask) { return v + __shfl_xor(v, mask, 64); }
DI float* xrow(float* out, float* xc, int m) { const int b = m / TT, tt = m - b * TT; return tt < TC ? xc + (size_t)(b * TC + tt) * DM : out + (size_t)(b * SEQ + tt - TC) * DM; }

template <class Fn> struct Epi8 {
    static constexpr bool PERM = true, AFTER_DRAIN = false; Fn f;
    DI void operator()(const pg8::f32x4 (&acc)[2][2][4][2], const pg8::Unit& u, int wr, int wc, int fr, int fq) const {
#pragma unroll
        for (int ai = 0; ai < 2; ++ai)
#pragma unroll
            for (int m = 0; m < 4; ++m) { const int rit = ai * 128 + wr * 64 + m * 16 + fr;
#pragma unroll
                for (int bj = 0; bj < 2; ++bj) { f(rit, u.pn * 256 + bj * 128 + wc * 32 + 8 * fq, acc[ai][bj][m][0], acc[ai][bj][m][1], u, fq); __builtin_amdgcn_sched_barrier(0); } }
    }
};
DI void st8(bf16_t* p, const pg8::f32x4& v0, const pg8::f32x4& v1) { u32x4 w; w.x = cvtpk(v0[0], v0[1]); w.y = cvtpk(v0[2], v0[3]); w.z = cvtpk(v1[0], v1[1]); w.w = cvtpk(v1[2], v1[3]); *(u32x4*)p = w; }

struct FnF { bf16_t* F;
    DI void operator()(int rit, int col0, const pg8::f32x4& v0, const pg8::f32x4& v1, const pg8::Unit& u, int) const {
        if (col0 < CINX) st8(F + (size_t)(u.pm * 256 + rit) * CINX + col0, v0, v1); } };
struct FnQ { bf16_t* Q; const float* rope;
    DI void operator()(int rit, int col0, const pg8::f32x4& v0, const pg8::f32x4& v1, const pg8::Unit& u, int fq) const {
        const int seg = u.pm % 9; const bool isrope = (seg != 0) && (((col0 >> 5) % 3) == 2);
        float x[8] = {v0[0], v0[1], v0[2], v0[3], v1[0], v1[1], v1[2], v1[3]};
        if (isrope) { const int s = (seg - 1) * 256 + rit, pos = (fq < 2) ? (s >> 6) : (s & 63); float cs[8], sn[8]; loadf8(rope + pos * 8, cs); loadf8(rope + 512 + pos * 8, sn);
            const float sg = (fq & 1) ? 1.f : -1.f;
#pragma unroll
            for (int j = 0; j < 8; ++j) { const float p = __shfl_xor(x[j], 16, 64); x[j] = x[j] * cs[j] + sg * p * sn[j]; } }
        store8(Q + (size_t)(u.pm * 256 + rit) * 768 + col0, x); } };
struct FnKV { bf16_t* KA; bf16_t* VA;
    DI void operator()(int rit, int col0, const pg8::f32x4& v0, const pg8::f32x4& v1, const pg8::Unit& u, int) const {
        const size_t row = (size_t)(u.pm * 256 + rit); const int h = col0 >> 7, c = col0 & 127;
        if (c < 64) st8(KA + row * 768 + h * 96 + c, v0, v1); else st8(VA + row * 512 + h * 64 + (c - 64), v0, v1); } };
struct FnL1 { __half* DEC; bf16_t* AA; const float* w0; const float* a0;
    DI void operator()(int rit, int col0, const pg8::f32x4& v0, const pg8::f32x4& v1, const pg8::Unit& u, int) const {
        const size_t row = (size_t)(u.pm * 256 + rit); float x[8] = {v0[0], v0[1], v0[2], v0[3], v1[0], v1[1], v1[2], v1[3]};
        if (col0 < 1024) { float b[8]; loadf8(w0 + col0, b); u32x4 w; unsigned hh[8];
#pragma unroll
            for (int j = 0; j < 8; ++j) { const float uu = 0.6065306597f * sigmoidf_(x[j] + b[j]); hh[j] = (unsigned)__half_as_ushort(__float2half(-uu * 1.4426950409f)); }
            w.x = hh[0] | (hh[1] << 16); w.y = hh[2] | (hh[3] << 16); w.z = hh[4] | (hh[5] << 16); w.w = hh[6] | (hh[7] << 16);
            *(u32x4*)(DEC + row * 1024 + col0) = w;
        } else { const int c = col0 - 1024; float b[8]; loadf8(a0 + c, b);
#pragma unroll
            for (int j = 0; j < 8; ++j) x[j] = sigmoidf_(x[j] + b[j]);
            store8(AA + row * 1024 + c, x); } } };
struct FnL2 { bf16_t* G; bf16_t* V; const bf16_t* VF; const float* v0p; int dovres;
    DI void operator()(int rit, int col0, const pg8::f32x4& v0, const pg8::f32x4& v1, const pg8::Unit& u, int) const {
        const size_t row = (size_t)(u.pm * 256 + rit);
        if (col0 < 512) st8(G + row * 512 + col0, v0, v1);
        else if (dovres) { const int c = col0 - 512; float x[8] = {v0[0], v0[1], v0[2], v0[3], v1[0], v1[1], v1[2], v1[3]}, b[8], v[8], vf[8]; loadf8(v0p + c, b); load8(V + row * 512 + c, v); load8(VF + row * 512 + c, vf);
#pragma unroll
            for (int j = 0; j < 8; ++j) v[j] = v[j] + (vf[j] - v[j]) * sigmoidf_(b[j] + x[j]);
            store8(V + row * 512 + c, v); } } };
struct FnRes { float* out; float* xc; const float* mods; int gidx;
    DI void operator()(int rit, int col0, const pg8::f32x4& v0, const pg8::f32x4& v1, const pg8::Unit& u, int) const {
        const int b = u.pm / 9, seg = u.pm - b * 9; const float* g = mods + (size_t)(seg == 0 ? 32 : b) * 6144 + gidx * 1024 + col0;
        float* p = (seg == 0 ? xc + (size_t)(b * TC + rit) * DM : out + (size_t)(b * SEQ + (seg - 1) * 256 + rit) * DM) + col0;
        const pg8::f32x4 g0 = *(const pg8::f32x4*)g, g1 = *(const pg8::f32x4*)(g + 4); pg8::f32x4 x0 = *(pg8::f32x4*)p, x1 = *(pg8::f32x4*)(p + 4);
        x0 += g0 * v0; x1 += g1 * v1; *(pg8::f32x4*)p = x0; *(pg8::f32x4*)(p + 4) = x1; } };
struct FnM1 { bf16_t* HID;
    DI void operator()(int rit, int col0, const pg8::f32x4& v0, const pg8::f32x4& v1, const pg8::Unit& u, int) const {
        float x[8] = {v0[0], v0[1], v0[2], v0[3], v1[0], v1[1], v1[2], v1[3]};
#pragma unroll
        for (int j = 0; j < 8; ++j) { const float r = fmaxf(x[j], 0.f); x[j] = r * r; }
        store8(HID + (size_t)(u.pm * 256 + rit) * DFF + col0, x); } };

struct Order { pg8::StaticOrder s; int lat;
    DI void init(int lat_, int N) { lat = lat_; s.init(lat_ ? NB * SEQ : TALL, N, (int)gridDim.x, (int)blockIdx.x); }
    DI bool next(int i, pg8::Unit& u) const { if (!s.next(i, u)) return false; if (lat) u.pm = (u.pm >> 3) * 9 + 1 + (u.pm & 7); return true; }
    DI void a_ready(const pg8::Unit&) const {}
    DI void done(const pg8::Unit&) const {}
};
template <int N, int K, class Fn> DI void run_gemm(unsigned char* lds, const bf16_t* A, const bf16_t* Bt, int lat, const Fn& fn) {
    pg8::Gemm g{A, Bt, lat ? NB * SEQ : TALL, N, K}; Order S; S.init(lat, N); Epi8<Fn> E{fn};
    pg8::gemm_phase<Epi8<Fn>, Order, true, true>((PG8_LAS unsigned char*)lds, g, S, E);
    __syncthreads();
}
namespace att {
constexpr int NW = 8, QBLK = 32, KVBLK = 64;
constexpr float SCALE = 0.10206207261596577f, THR = 8.f;
constexpr int LDQ = 768, LDKK = 768, LDV = 512, LDO = 1024;
constexpr int SHM_V = KVBLK * 64 * 2, SHM_K = KVBLK * 256, SHM_ATTN = 2 * SHM_V + 2 * SHM_K + NW * 64 * 4;
#define KSWZ(row, colB) ((row) * 256 + ((colB) ^ (((row) & 7) << 4)))
#define SBAR() __builtin_amdgcn_sched_barrier(0)
DI int crow(int r, int hi) { return (r & 3) + 8 * (r >> 2) + 4 * hi; }
DI unsigned cvtpk_(float lo, float hi) { unsigned r; asm volatile("v_cvt_pk_bf16_f32 %0, %1, %2" : "=v"(r) : "v"(lo), "v"(hi)); return r; }
DI void partialSM(f32x16& p0, f32x16& p1, float& m_reg, float& mn, float& alpha) {
  constexpr float C = SCALE * 1.4426950408889634f;
  float pmax = p0[0];
#pragma unroll
  for (int r = 1; r < 16; ++r) pmax = fmaxf(pmax, p0[r]);
#pragma unroll
  for (int r = 0; r < 16; ++r) pmax = fmaxf(pmax, p1[r]);
  { auto rr = __builtin_amdgcn_permlane32_swap(__float_as_uint(pmax), __float_as_uint(pmax), false, false);
    pmax = fmaxf(__uint_as_float(rr[0]), __uint_as_float(rr[1])); }
  if (__builtin_expect(__all(pmax - m_reg <= THR / SCALE), 1)) { mn = m_reg; alpha = 1.f; }
  else { mn = fmaxf(m_reg, pmax); alpha = __builtin_amdgcn_exp2f((m_reg - mn) * C); m_reg = mn; }
  const float mnC = -mn * C;
#pragma unroll
  for (int r = 0; r < 16; ++r) p0[r] = fmaf(p0[r], C, mnC);
#pragma unroll
  for (int r = 0; r < 16; ++r) p1[r] = fmaf(p1[r], C, mnC);
#pragma unroll
  for (int r = 0; r < 16; ++r) p0[r] = __builtin_amdgcn_exp2f(p0[r]);
}
DI void finishSM(f32x16& p0, f32x16& p1, float alpha, float& l_reg, bf16x8& pa0, bf16x8& pa1, bf16x8& pa2, bf16x8& pa3) {
#pragma unroll
  for (int r = 0; r < 16; ++r) p1[r] = __builtin_amdgcn_exp2f(p1[r]);
  float ps = 0;
#pragma unroll
  for (int r = 0; r < 16; ++r) ps += p0[r];
#pragma unroll
  for (int r = 0; r < 16; ++r) ps += p1[r];
  { auto rr = __builtin_amdgcn_permlane32_swap(__float_as_uint(ps), __float_as_uint(ps), false, false);
    ps = __uint_as_float(rr[0]) + __uint_as_float(rr[1]); }
  l_reg = l_reg * alpha + ps;
#define PK4(P, BASE, OUT) do { unsigned a0 = cvtpk_(P[BASE + 0], P[BASE + 1]), a1 = cvtpk_(P[BASE + 2], P[BASE + 3]);   \
    unsigned b0 = cvtpk_(P[BASE + 4], P[BASE + 5]), b1 = cvtpk_(P[BASE + 6], P[BASE + 7]);                              \
    auto r0 = __builtin_amdgcn_permlane32_swap(a0, b0, false, false); auto r1 = __builtin_amdgcn_permlane32_swap(a1, b1, false, false); \
    u32x4 w = {r0[0], r1[0], r0[1], r1[1]}; OUT = *reinterpret_cast<bf16x8*>(&w); } while (0)
  PK4(p0, 0, pa0); PK4(p0, 8, pa1); PK4(p1, 0, pa2); PK4(p1, 8, pa3);
#undef PK4
}
DI void qkt(f32x16& p0, f32x16& p1, const char* Ks, const bf16x8* qr, int r32, int hi) {
  p0 = f32x16{}; p1 = f32x16{};
#pragma unroll
  for (int d0 = 0; d0 < 6; ++d0) { const int cb = (d0 * 16 + hi * 8) * 2;
    bf16x8 b0 = *reinterpret_cast<const bf16x8*>(Ks + KSWZ(r32, cb));
    bf16x8 b1 = *reinterpret_cast<const bf16x8*>(Ks + KSWZ(32 + r32, cb));
    p0 = __builtin_amdgcn_mfma_f32_32x32x16_bf16(b0, qr[d0], p0, 0, 0, 0);
    p1 = __builtin_amdgcn_mfma_f32_32x32x16_bf16(b1, qr[d0], p1, 0, 0, 0); }
}
DI int v_st(int k, int c) { const int kk = (k & ~0xC) | ((k & 4) << 1) | ((k & 8) >> 1); return ((kk >> 3) * 2 + (c >> 5)) * 512 + ((kk & 7) * 32 + (c & 31)) * 2; }
DI int v_rd_base(int lane) { return ((lane & 3) << 3) | (((lane >> 2) & 3) << 6) | (((lane >> 4) & 1) << 5) | (((lane >> 5) & 1) << 8); }
constexpr int v_rd_off(int d0, int ks, int half) { return d0 * 512 + ks * 2048 + half * 1024; }
template <int OFF> DI s16x4 tr_read(int vb) {
  s16x4 r; asm volatile("ds_read_b64_tr_b16 %0, %1 offset:%2" : "=&v"(r) : "v"(vb), "i"(OFF) : "memory"); return r;
}
template <int D0> DI void pv_one(f32x16& od, int vb, bf16x8 pa0, bf16x8 pa1, bf16x8 pa2, bf16x8 pa3) {
  const s16x4 l0 = tr_read<v_rd_off(D0, 0, 0)>(vb), h0 = tr_read<v_rd_off(D0, 0, 1)>(vb), l1 = tr_read<v_rd_off(D0, 1, 0)>(vb), h1 = tr_read<v_rd_off(D0, 1, 1)>(vb);
  const s16x4 l2 = tr_read<v_rd_off(D0, 2, 0)>(vb), h2 = tr_read<v_rd_off(D0, 2, 1)>(vb), l3 = tr_read<v_rd_off(D0, 3, 0)>(vb), h3 = tr_read<v_rd_off(D0, 3, 1)>(vb);
  asm volatile("s_waitcnt lgkmcnt(0)" ::: "memory"); SBAR();
#define PK(L, H) (bf16x8){L[0], L[1], L[2], L[3], H[0], H[1], H[2], H[3]}
  od = __builtin_amdgcn_mfma_f32_32x32x16_bf16(pa0, PK(l0, h0), od, 0, 0, 0);
  od = __builtin_amdgcn_mfma_f32_32x32x16_bf16(pa1, PK(l1, h1), od, 0, 0, 0);
  od = __builtin_amdgcn_mfma_f32_32x32x16_bf16(pa2, PK(l2, h2), od, 0, 0, 0);
  od = __builtin_amdgcn_mfma_f32_32x32x16_bf16(pa3, PK(l3, h3), od, 0, 0, 0);
#undef PK
}
DI void pv_d0(f32x16* o, int vb, bf16x8 pa0, bf16x8 pa1, bf16x8 pa2, bf16x8 pa3) {
  pv_one<0>(o[0], vb, pa0, pa1, pa2, pa3); pv_one<1>(o[1], vb, pa0, pa1, pa2, pa3);
}
DI void attn_body(const bf16_t* __restrict__ Qb, const bf16_t* __restrict__ Kh, const bf16_t* __restrict__ Vh, bf16_t* __restrict__ Ob, int seq, char* lds) {
  const int tid = ltid(), wid = tid >> 6, lane = tid & 63, r32 = lane & 31, hi = lane >> 5;
  char* V_lds = lds; char* K_lds = lds + 2 * SHM_V;
  float* ws = (float*)(lds + 2 * SHM_V + 2 * SHM_K) + wid * 64; float* li_l = ws; float* al_l = ws + 32;
  float m_reg = -1e30f, l_reg = 0; f32x16 o[2] = {}; bf16x8 qr[6];
  const bf16_t* Qw = Qb + (long)(wid * QBLK + r32) * LDQ + hi * 8;
#pragma unroll
  for (int d0 = 0; d0 < 6; ++d0) qr[d0] = *reinterpret_cast<const bf16x8*>(Qw + d0 * 16);
  const int kc2 = 512 + (tid & 255);
  const int kr1 = tid / 12, kch1 = tid - kr1 * 12, kr2 = kc2 / 12, kch2 = kc2 - kr2 * 12, vr = tid >> 3, vch = tid & 7;
  const int vst = v_st(vr, vch * 8), kst1 = KSWZ(kr1, kch1 * 16), kst2 = KSWZ(kr2, kch2 * 16);
  const int vb0 = (int)(uintptr_t)V_lds + v_rd_base(lane);
  struct { bf16x8 v, k1, k2; } sr_[2];
#define SLOAD(i, k0) do { sr_[i].v = *reinterpret_cast<const bf16x8*>(&Vh[(long)((k0) + vr) * LDV + vch * 8]); \
    sr_[i].k1 = *reinterpret_cast<const bf16x8*>(&Kh[(long)((k0) + kr1) * LDKK + kch1 * 8]); sr_[i].k2 = *reinterpret_cast<const bf16x8*>(&Kh[(long)((k0) + kr2) * LDKK + kch2 * 8]); } while (0)
#define SWRITE(b, i) do { *(bf16x8*)(V_lds + (b) * SHM_V + vst) = sr_[i].v; *(bf16x8*)(K_lds + (b) * SHM_K + kst1) = sr_[i].k1; *(bf16x8*)(K_lds + (b) * SHM_K + kst2) = sr_[i].k2; } while (0)
#define RESC(a) do { if (__any((a) < 1.f)) { if (hi == 0) al_l[r32] = (a); asm volatile("s_waitcnt lgkmcnt(0)" ::: "memory"); \
    _Pragma("unroll") for (int d = 0; d < 2; ++d) _Pragma("unroll") for (int r = 0; r < 16; ++r) o[d][r] *= al_l[crow(r, hi)]; } } while (0)
  f32x16 pA0, pA1, pB0, pB1; float mnA, mnB, alA, alB; bf16x8 pa0, pa1, pa2, pa3; const int NT = seq / KVBLK;
  constexpr int SE = 0, SO = 1;
  SLOAD(SE, 0); asm volatile("s_waitcnt vmcnt(0)" ::: "memory"); SWRITE(0, SE); __syncthreads();
  qkt(pA0, pA1, K_lds, qr, r32, hi); partialSM(pA0, pA1, m_reg, mnA, alA);
  SLOAD(SO, KVBLK); if (2 < NT) SLOAD(SE, 2 * KVBLK);
  SWRITE(1, SO); __syncthreads();
  for (int j = 1; j + 1 < NT; j += 2) {
    SBAR(); qkt(pB0, pB1, K_lds + SHM_K, qr, r32, hi);
    finishSM(pA0, pA1, alA, l_reg, pa0, pa1, pa2, pa3); SBAR();
    SLOAD(SO, (j + 2) * KVBLK); SBAR();
    pv_d0(o, vb0, pa0, pa1, pa2, pa3); partialSM(pB0, pB1, m_reg, mnB, alB);
    __syncthreads(); SWRITE(0, SE);
    RESC(alB); __syncthreads();
    SBAR(); qkt(pA0, pA1, K_lds, qr, r32, hi);
    finishSM(pB0, pB1, alB, l_reg, pa0, pa1, pa2, pa3); SBAR();
    if (j + 3 < NT) SLOAD(SE, (j + 3) * KVBLK); SBAR();
    pv_d0(o, vb0 + SHM_V, pa0, pa1, pa2, pa3); partialSM(pA0, pA1, m_reg, mnA, alA);
    __syncthreads(); SWRITE(1, SO);
    RESC(alA); __syncthreads();
  }
  SBAR(); qkt(pB0, pB1, K_lds + SHM_K, qr, r32, hi);
  finishSM(pA0, pA1, alA, l_reg, pa0, pa1, pa2, pa3); SBAR();
  pv_d0(o, vb0, pa0, pa1, pa2, pa3); partialSM(pB0, pB1, m_reg, mnB, alB);
  __syncthreads(); RESC(alB);
  finishSM(pB0, pB1, alB, l_reg, pa0, pa1, pa2, pa3); SBAR();
  pv_d0(o, vb0 + SHM_V, pa0, pa1, pa2, pa3);
  if (hi == 0) li_l[r32] = l_reg; asm volatile("s_waitcnt lgkmcnt(0)" ::: "memory");
  float rli[16];
#pragma unroll
  for (int r = 0; r < 16; ++r) rli[r] = __builtin_amdgcn_rcpf(li_l[crow(r, hi)]);
  bf16_t* Ow = Ob + (long)(wid * QBLK) * LDO;
#pragma unroll
  for (int r = 0; r < 16; ++r) { const int orow = crow(r, hi);
#pragma unroll
    for (int d0 = 0; d0 < 2; ++d0) Ow[(long)orow * LDO + d0 * 32 + r32] = f2bf(o[d0][r] * rli[r]); }
#undef SLOAD
#undef SWRITE
#undef RESC
}
}

DI void phase_attn(const bf16_t* Q, const bf16_t* KA, const bf16_t* VA, bf16_t* MIX, bool last, char* lds) {
    const int c = blockIdx.x, G = gridDim.x, NU = 2048 + (last ? 0 : 256);
    for (int L = c; L < NU; L += G) {
        int bh, seq; long qrow0;
        if (L < 2048) { int qb;
            if (G == 256) { const int i = L >> 8, cc = L & 255, xcd = cc & 7, slot = cc >> 3; bh = i * 32 + xcd * 4 + (slot >> 3); qb = slot & 7; }
            else { bh = L >> 3; qb = L & 7; }
            qrow0 = (long)(bh >> 3) * TT + TC + qb * 256; seq = TT; }
        else { bh = L - 2048; qrow0 = (long)(bh >> 3) * TT; seq = TC; }
        const int b = bh >> 3, h = bh & 7;
        att::attn_body(Q + qrow0 * 768 + h * 96, KA + (long)b * TT * 768 + h * 96, VA + (long)b * TT * 512 + h * 64, MIX + qrow0 * 1024 + h * 64, seq, lds);
        __syncthreads();
    }
}

DI float rowsum16(float x) {
    x += __int_as_float(__builtin_amdgcn_update_dpp(0, __float_as_int(x), 0x128, 0xf, 0xf, false));
    x += __int_as_float(__builtin_amdgcn_update_dpp(0, __float_as_int(x), 0x124, 0xf, 0xf, false));
    x += __int_as_float(__builtin_amdgcn_update_dpp(0, __float_as_int(x), 0x122, 0xf, 0xf, false));
    x += __int_as_float(__builtin_amdgcn_update_dpp(0, __float_as_int(x), 0x121, 0xf, 0xf, false));
    return x;
}
#define RS8_STEP(R) "v_add_f32_dpp %0, %0, %0 " R " row_mask:0xf bank_mask:0xf\n\tv_add_f32_dpp %1, %1, %1 " R " row_mask:0xf bank_mask:0xf\n\t" \
                    "v_add_f32_dpp %2, %2, %2 " R " row_mask:0xf bank_mask:0xf\n\tv_add_f32_dpp %3, %3, %3 " R " row_mask:0xf bank_mask:0xf\n\t" \
                    "v_add_f32_dpp %4, %4, %4 " R " row_mask:0xf bank_mask:0xf\n\tv_add_f32_dpp %5, %5, %5 " R " row_mask:0xf bank_mask:0xf\n\t" \
                    "v_add_f32_dpp %6, %6, %6 " R " row_mask:0xf bank_mask:0xf\n\tv_add_f32_dpp %7, %7, %7 " R " row_mask:0xf bank_mask:0xf\n\t"
DI void sum8x8(float& x0, float& x1, float& x2, float& x3, float& x4, float& x5, float& x6, float& x7) {
    asm volatile("s_nop 1\n\t" RS8_STEP("quad_perm:[1,0,3,2]") RS8_STEP("quad_perm:[2,3,0,1]") RS8_STEP("row_half_mirror")
                 : "+v"(x0), "+v"(x1), "+v"(x2), "+v"(x3), "+v"(x4), "+v"(x5), "+v"(x6), "+v"(x7));
}
typedef float f32x2 __attribute__((ext_vector_type(2)));
DI float dot8(const f32x2 (&s)[4], const f32x4& x0, const f32x4& x1) {
    f32x2 t = s[0] * (f32x2){x0[0], x0[1]};
    t = __builtin_elementwise_fma(s[1], (f32x2){x0[2], x0[3]}, t);
    t = __builtin_elementwise_fma(s[2], (f32x2){x1[0], x1[1]}, t);
    t = __builtin_elementwise_fma(s[3], (f32x2){x1[2], x1[3]}, t);
    return t.x + t.y;
}
DI int scan_row(int d, int b, int n) { const int tt = d == 0 ? n : (n < TC ? TC - 1 - n : TT + TC - 1 - n); return b * TT + tt; }
struct ScanStep { f32x4 a0, a1, w0, w1, b0, b1, k0, k1, q0, q1, v; float br, kr; };
DI void scan_ld(ScanStep& t, const float* p, const float* sc, int cgp, int vrow) {
    t.a0 = *(const f32x4*)(p + 8 * cgp); t.a1 = *(const f32x4*)(p + 8 * cgp + 4); t.w0 = *(const f32x4*)(p + 64 + 8 * cgp); t.w1 = *(const f32x4*)(p + 64 + 8 * cgp + 4);
    t.b0 = *(const f32x4*)(p + 128 + 8 * cgp); t.b1 = *(const f32x4*)(p + 128 + 8 * cgp + 4); t.k0 = *(const f32x4*)(p + 192 + 8 * cgp); t.k1 = *(const f32x4*)(p + 192 + 8 * cgp + 4);
    t.q0 = *(const f32x4*)(p + 256 + 8 * cgp); t.q1 = *(const f32x4*)(p + 256 + 8 * cgp + 4); t.v = *(const f32x4*)(p + 320 + vrow); t.br = sc[0]; t.kr = sc[1];
}
DI void phase_scan(const bf16_t* R, const bf16_t* Kk, const bf16_t* V, const __half* DEC, const bf16_t* AA, const float* INV, const float* kkp, const float* kap,
                   bf16_t* MIX, bf16_t* YB, char* lds) {
    const int tid = ltid(); const bool consumer = tid < 256;
    float* bufA = (float*)lds; float* ybufA = (float*)(lds + 98304); float* sbufA = (float*)(lds + 114688);
    constexpr int NCH = TT / 16;
    for (int s0 = blockIdx.x * 2; s0 < 512; s0 += gridDim.x * 2) {
        const int p_ = tid & 255, pst = p_ >> 4, pj0 = (p_ & 15) * 4;
        const int cw = tid >> 6, cgrp = (cw >> 1) & 1, ws_ = cw & 1, lane = tid & 63, rgl = lane >> 3, cgp = lane & 7, vrow = ws_ * 32 + rgl * 4;
        f32x2 S[4][4];
#pragma unroll
        for (int i = 0; i < 4; ++i)
#pragma unroll
            for (int j = 0; j < 4; ++j) S[i][j] = (f32x2){0.f, 0.f};
#define PRODUCE(c, bsel) do { _Pragma("unroll") for (int gq = 0; gq < 2; ++gq) { \
            const int sid = s0 + gq, d = sid >> 8, b = (sid >> 3) & 31, h = sid & 7, hc = h * 64 + pj0; \
            const size_t m_ = (size_t)scan_row(d, b, (c) * 16 + pst); \
            const u32x2 lr = *(const u32x2*)(R + m_ * 512 + hc), lk = *(const u32x2*)(Kk + m_ * 512 + hc), lv = *(const u32x2*)(V + m_ * 512 + hc), \
                        ld_ = *(const u32x2*)(DEC + m_ * 1024 + d * 512 + hc), la = *(const u32x2*)(AA + m_ * 1024 + d * 512 + hc); const float linv = INV[m_ * 8 + h]; \
            const f32x4 kk4 = *(const f32x4*)(kkp + hc), ka4 = *(const f32x4*)(kap + hc); \
            float* q_ = bufA + gq * 12288 + (bsel) * 6144 + pst * 384 + pj0; float* sd_ = sbufA + gq * 64 + (bsel) * 32; \
            const float k0 = bflo(lk.x), k1 = bfhi(lk.x), k2 = bflo(lk.y), k3 = bfhi(lk.y), a0 = bflo(la.x), a1 = bfhi(la.x), a2 = bflo(la.y), a3 = bfhi(la.y); \
            const float q0 = k0 * kk4[0] * linv, q1 = k1 * kk4[1] * linv, q2 = k2 * kk4[2] * linv, q3 = k3 * kk4[3] * linv; \
            const float w0 = __builtin_amdgcn_exp2f(h2f(ld_.x & 0xffffu)), w1 = __builtin_amdgcn_exp2f(h2f(ld_.x >> 16)), w2 = __builtin_amdgcn_exp2f(h2f(ld_.y & 0xffffu)), w3 = __builtin_amdgcn_exp2f(h2f(ld_.y >> 16)); \
            const float r0 = bflo(lr.x), r1 = bfhi(lr.x), r2 = bflo(lr.y), r3 = bfhi(lr.y); \
            const float b0 = q0 * a0, b1 = q1 * a1, b2 = q2 * a2, b3 = q3 * a3; \
            const float d0 = k0 * (1.f + (a0 - 1.f) * ka4[0]), d1 = k1 * (1.f + (a1 - 1.f) * ka4[1]), d2 = k2 * (1.f + (a2 - 1.f) * ka4[2]), d3 = k3 * (1.f + (a3 - 1.f) * ka4[3]); \
            *(f32x4*)(q_) = (f32x4){-q0, -q1, -q2, -q3}; \
            *(f32x4*)(q_ + 64) = (f32x4){w0, w1, w2, w3}; \
            *(f32x4*)(q_ + 128) = (f32x4){b0, b1, b2, b3}; \
            *(f32x4*)(q_ + 192) = (f32x4){d0, d1, d2, d3}; \
            *(f32x4*)(q_ + 256) = (f32x4){w0 * r0, w1 * r1, w2 * r2, w3 * r3}; \
            *(f32x4*)(q_ + 320) = (f32x4){bflo(lv.x), bfhi(lv.x), bflo(lv.y), bfhi(lv.y)}; \
            const float br_ = rowsum16(b0 * r0 + b1 * r1 + b2 * r2 + b3 * r3), kr_ = rowsum16(d0 * r0 + d1 * r1 + d2 * r2 + d3 * r3); \
            if ((p_ & 15) == 0) { sd_[pst * 2] = br_; sd_[pst * 2 + 1] = kr_; } } } while (0)
#define OUTPUT(c, bsel) do { _Pragma("unroll") for (int gq = 0; gq < 2; ++gq) { \
            const int sid = s0 + gq, d = sid >> 8, b = (sid >> 3) & 31, h = sid & 7, hc = h * 64 + pj0; \
            const f32x4 yv = *(const f32x4*)(ybufA + gq * 2048 + (bsel) * 1024 + pst * 64 + pj0); const size_t m_ = (size_t)scan_row(d, b, (c) * 16 + pst); \
            u32x2 w; w.x = cvtpk(yv[0], yv[1]); w.y = cvtpk(yv[2], yv[3]); \
            if (d == 0) *(u32x2*)(MIX + m_ * 1024 + 512 + hc) = w; else *(u32x2*)(YB + m_ * 512 + hc) = w; } } while (0)
        if (!consumer) PRODUCE(0, 0);
        __syncthreads();
        for (int c = 0; c < NCH; ++c) {
            if (consumer) {
                const float* cur = bufA + cgrp * 12288 + (c & 1) * 6144; float* yb = ybufA + cgrp * 2048 + (c & 1) * 1024; const float* sc = sbufA + cgrp * 64 + (c & 1) * 32;
                ScanStep t; scan_ld(t, cur, sc, cgp, vrow);
#pragma unroll 2
                for (int st = 0; st < 16; ++st) {
                    ScanStep n; scan_ld(n, cur + (st + 1) * 384, sc + (st + 1) * 2, cgp, vrow);
                    float sa0 = dot8(S[0], t.a0, t.a1), sa1 = dot8(S[1], t.a0, t.a1), sa2 = dot8(S[2], t.a0, t.a1), sa3 = dot8(S[3], t.a0, t.a1);
                    float z0 = dot8(S[0], t.q0, t.q1), z1 = dot8(S[1], t.q0, t.q1), z2 = dot8(S[2], t.q0, t.q1), z3 = dot8(S[3], t.q0, t.q1);
                    sum8x8(sa0, sa1, sa2, sa3, z0, z1, z2, z3);
                    const f32x2 w01 = {t.w0[0], t.w0[1]}, w23 = {t.w0[2], t.w0[3]}, w45 = {t.w1[0], t.w1[1]}, w67 = {t.w1[2], t.w1[3]};
                    const f32x2 b01 = {t.b0[0], t.b0[1]}, b23 = {t.b0[2], t.b0[3]}, b45 = {t.b1[0], t.b1[1]}, b67 = {t.b1[2], t.b1[3]};
                    const f32x2 k01 = {t.k0[0], t.k0[1]}, k23 = {t.k0[2], t.k0[3]}, k45 = {t.k1[0], t.k1[1]}, k67 = {t.k1[2], t.k1[3]};
                    const float sa[4] = {sa0, sa1, sa2, sa3};
#pragma unroll
                    for (int i = 0; i < 4; ++i) { const f32x2 s2 = {sa[i], sa[i]}, v2 = {t.v[i], t.v[i]};
                        S[i][0] = __builtin_elementwise_fma(v2, k01, __builtin_elementwise_fma(s2, b01, S[i][0] * w01));
                        S[i][1] = __builtin_elementwise_fma(v2, k23, __builtin_elementwise_fma(s2, b23, S[i][1] * w23));
                        S[i][2] = __builtin_elementwise_fma(v2, k45, __builtin_elementwise_fma(s2, b45, S[i][2] * w45));
                        S[i][3] = __builtin_elementwise_fma(v2, k67, __builtin_elementwise_fma(s2, b67, S[i][3] * w67)); }
                    if (cgp == 0) *(f32x4*)(yb + st * 64 + vrow) = (f32x4){z0 + sa0 * t.br + t.v[0] * t.kr, z1 + sa1 * t.br + t.v[1] * t.kr, z2 + sa2 * t.br + t.v[2] * t.kr, z3 + sa3 * t.br + t.v[3] * t.kr};
                    t = n;
                }
            } else {
                if (c + 1 < NCH) PRODUCE(c + 1, (c + 1) & 1);
                if (c > 0) OUTPUT(c - 1, (c - 1) & 1);
            }
            __syncthreads();
        }
        if (!consumer) OUTPUT(NCH - 1, (NCH - 1) & 1);
        __syncthreads();
#undef PRODUCE
#undef OUTPUT
    }
}

DI void phase_prologue(const Args& a, unsigned char* lds) {
    const int tid = ltid(), G = gridDim.x;
    float* out = a.out; float* xc = (float*)(a.ws + WS_XC);
    {
        const size_t n4x = (size_t)NB * SEQ * DM / 4, n4c = (size_t)NB * TC * DM / 4;
        const f32x4* sx = (const f32x4*)a.in[I_X]; const f32x4* sc = (const f32x4*)a.in[I_CTX];
        for (size_t i = (size_t)blockIdx.x * 512 + tid; i < n4x + n4c; i += (size_t)G * 512) { if (i < n4x) ((f32x4*)out)[i] = sx[i]; else ((f32x4*)xc)[i - n4x] = sc[i - n4x]; }
    }
    if (blockIdx.x == 0) {
        float* rope = (float*)(a.ws + WS_ROPE); const int pos = tid >> 3, j = tid & 7;
        const float inv_freq = powf(10000.f, -(float)j / 8.f), ang = (float)pos * inv_freq;
        rope[tid] = cosf(ang); rope[512 + tid] = sinf(ang);
    }
    float* sv = (float*)lds; float* red = sv + 33 * 1024;
    for (int i = tid; i < 33 * 1024; i += 512) { const float v = i < 32 * 1024 ? a.in[I_C][i] : a.in[I_CCTX][i - 32 * 1024]; sv[i] = v / (1.f + __expf(-v)); }
    __syncthreads();
    const int wave = tid >> 6, lane = tid & 63;
    float* mods = (float*)(a.ws + WS_MODS);
    for (int it = blockIdx.x; it < NL * 96; it += G) {
        const int l = it / 96, n0 = (it - l * 96) * 64;
        const float* w = a.in[I_ADAW] + (size_t)l * 1024 * 6144 + n0 + lane;
        float acc[33];
#pragma unroll
        for (int r = 0; r < 33; ++r) acc[r] = 0.f;
        for (int k = wave * 128; k < wave * 128 + 128; ++k) { const float wv = w[(size_t)k * 6144];
#pragma unroll
            for (int r = 0; r < 33; ++r) acc[r] += sv[r * 1024 + k] * wv; }
        for (int i = tid; i < 33 * 64; i += 512) red[i] = 0.f;
        __syncthreads();
        for (int ww = 0; ww < 8; ++ww) { if (wave == ww) {
#pragma unroll
                for (int r = 0; r < 33; ++r) red[r * 64 + lane] += acc[r]; }
            __syncthreads(); }
        for (int i = tid; i < 33 * 64; i += 512) { const int r = i >> 6, n = n0 + (i & 63); mods[((size_t)l * 33 + r) * 6144 + n] = red[i] + a.in[I_ADAB][l * 6144 + n]; }
        __syncthreads();
    }
}

template <class Gt> DI void cvt_tile(bf16_t* dst, int ldk, int n0, int k0, const Gt& get, float* tl) {
    const int tid = ltid(), a_ = tid & 63, b_ = tid >> 6;
#pragma unroll
    for (int i = 0; i < 8; ++i) { const int kk = b_ + 8 * i; tl[kk * 65 + a_] = get(n0 + a_, k0 + kk); }
    __syncthreads();
#pragma unroll
    for (int i = 0; i < 8; ++i) { const int nn = b_ + 8 * i; dst[(size_t)(n0 + nn) * ldk + k0 + a_] = f2bf(tl[a_ * 65 + nn]); }
    __syncthreads();
}
DI void convert_weights(const Args& a, int l, unsigned char* lds) {
    float* tl = (float*)lds; unsigned char* ws = a.ws;
    const float* w_in = a.in[I_WIN] + (size_t)l * 1024 * CIN; const float* v1 = a.in[I_V1] + (size_t)(l > 0 ? l - 1 : 0) * 1024 * 32;
    const float* w_uq = a.in[I_WUQ] + (size_t)l * 256 * 768; const float* w_ukv = a.in[I_WUKV] + (size_t)l * 128 * 1024;
    const float* w2 = a.in[I_W2] + (size_t)l * 2 * 64 * 512; const float* a2 = a.in[I_A2] + (size_t)l * 2 * 64 * 512;
    const float* g2 = a.in[I_G2] + (size_t)l * 128 * 512; const float* v2 = a.in[I_V2] + (size_t)(l > 0 ? l - 1 : 0) * 32 * 512;
    const float* w_out = a.in[I_WOUT] + (size_t)l * 1024 * 1024; const float* m1 = a.in[I_M1] + (size_t)l * 1024 * 4096; const float* m2 = a.in[I_M2] + (size_t)l * 4096 * 1024;
    constexpr int T0 = 640, T1 = T0 + 48, T2 = T1 + 64, T3 = T2 + 128, T4 = T3 + 64, T5 = T4 + 256, T6 = T5 + 1024, T7 = T6 + 1024;
    for (int t = blockIdx.x; t < T7; t += gridDim.x) {
        if (t < T0) { const int nt = t >> 4, kt = t & 15;
            cvt_tile((bf16_t*)(ws + WT_IN), 1024, nt * 64, kt * 64, [&](int n, int k) -> float { return n < CIN ? w_in[(size_t)k * CIN + n] : ((n < CINX && l > 0) ? v1[k * 32 + (n - CIN)] : 0.f); }, tl); }
        else if (t < T1) { const int u = t - T0, nt = u >> 2, kt = u & 3;
            cvt_tile((bf16_t*)(ws + WT_UQ), 256, nt * 64, kt * 64, [&](int n, int k) -> float { return w_uq[k * 768 + n]; }, tl); }
        else if (t < T2) { const int u = t - T1, nt = u >> 2, kt = u & 3;
            cvt_tile((bf16_t*)(ws + WT_UKV), 256, nt * 64, kt * 64, [&](int n, int k) -> float { return k < 128 ? w_ukv[k * 1024 + n] : 0.f; }, tl); }
        else if (t < T3) { const int u = t - T2, nt = u >> 2, kt = u & 3;
            cvt_tile((bf16_t*)(ws + WT_L1), 256, nt * 64, kt * 64, [&](int n, int k) -> float {
                if (n < 1024) { const int d = n >> 9, c = n & 511; return (k < 128 && (k >> 6) == d) ? w2[(d * 64 + (k & 63)) * 512 + c] : 0.f; }
                const int n2 = n - 1024, d = n2 >> 9, c = n2 & 511; return (k >= 128 && ((k - 128) >> 6) == d) ? a2[(d * 64 + ((k - 128) & 63)) * 512 + c] : 0.f; }, tl); }
        else if (t < T4) { const int u = t - T3, nt = u >> 2, kt = u & 3;
            cvt_tile((bf16_t*)(ws + WT_L2), 256, nt * 64, kt * 64, [&](int n, int k) -> float {
                if (n < 512) return k < 128 ? g2[k * 512 + n] : 0.f;
                return (l > 0 && k >= 128 && k < 160) ? v2[(k - 128) * 512 + (n - 512)] : 0.f; }, tl); }
        else if (t < T5) { const int u = t - T4, nt = u >> 4, kt = u & 15;
            cvt_tile((bf16_t*)(ws + WT_OUT), 1024, nt * 64, kt * 64, [&](int n, int k) -> float { return w_out[(size_t)k * 1024 + n]; }, tl); }
        else if (t < T6) { const int u = t - T5, nt = u >> 4, kt = u & 15;
            cvt_tile((bf16_t*)(ws + WT_M1), 1024, nt * 64, kt * 64, [&](int n, int k) -> float { return m1[(size_t)k * 4096 + n]; }, tl); }
        else { const int u = t - T6, nt = u >> 6, kt = u & 63;
            cvt_tile((bf16_t*)(ws + WT_M2), 4096, nt * 64, kt * 64, [&](int n, int k) -> float { return m2[(size_t)k * 1024 + n]; }, tl); }
    }
}

DI void phase_norm(const Args& a, int l, const float* gamma, int shift_idx, int scale_idx, bool latent_only) {
    const int lane = ltid() & 63, gw = blockIdx.x * 8 + (ltid() >> 6), nw = gridDim.x * 8;
    float* xc = (float*)(a.ws + WS_XC); bf16_t* H = (bf16_t*)(a.ws + WS_H); const float* mods = (const float*)(a.ws + WS_MODS) + (size_t)l * 33 * 6144;
    for (int m = gw; m < TALL; m += nw) {
        const int b = m / TT, tt = m - b * TT; const bool ctx = tt < TC; if (latent_only && ctx) continue;
        const float* xr = xrow(a.out, xc, m); const float* md = mods + (size_t)(ctx ? 32 : b) * 6144;
        f32x4 v[4]; float ss = 0.f;
#pragma unroll
        for (int i = 0; i < 4; ++i) { v[i] = *(const f32x4*)(xr + i * 256 + lane * 4); ss += v[i][0] * v[i][0] + v[i][1] * v[i][1] + v[i][2] * v[i][2] + v[i][3] * v[i][3]; }
#pragma unroll
        for (int k = 1; k < 64; k <<= 1) ss = xorsum(ss, k);
        const float rstd = rsqrtf(ss * (1.f / 1024.f) + 1e-6f);
#pragma unroll
        for (int i = 0; i < 4; ++i) { const int col = i * 256 + lane * 4; const f32x4 g = *(const f32x4*)(gamma + col), sc = *(const f32x4*)(md + scale_idx * 1024 + col), sh = *(const f32x4*)(md + shift_idx * 1024 + col);
            float o[4];
#pragma unroll
            for (int j = 0; j < 4; ++j) o[j] = v[i][j] * rstd * g[j] * (1.f + sc[j]) + sh[j];
            u32x2 w; w.x = cvtpk(o[0], o[1]); w.y = cvtpk(o[2], o[3]); *(u32x2*)(H + (size_t)m * 1024 + col) = w; }
    }
}

DI void shift8(const bf16_t* Frow, bool pok, bool nok, int col, const float* mu, float (&o)[8]) {
    float c[8], p[8], n[8], u[8]; load8(Frow + col, c); loadf8(mu + (col - OFF_R), u);
    if (pok) load8(Frow - CINX + col, p); else {
#pragma unroll
        for (int j = 0; j < 8; ++j) p[j] = 0.f; }
    if (nok) load8(Frow + CINX + col, n); else {
#pragma unroll
        for (int j = 0; j < 8; ++j) n[j] = 0.f; }
#pragma unroll
    for (int j = 0; j < 8; ++j) o[j] = c[j] + u[j] * (0.5f * (p[j] + n[j]) - c[j]);
}
DI void phase_split(const Args& a, int l) {
    const int lane = ltid() & 63, gw = blockIdx.x * 8 + (ltid() >> 6), nw = gridDim.x * 8;
    unsigned char* ws = a.ws;
    const bf16_t* F = (const bf16_t*)(ws + WS_F); bf16_t* R = (bf16_t*)(ws + WS_R); bf16_t* Kb = (bf16_t*)(ws + WS_K); bf16_t* Vb = (bf16_t*)(ws + (l == 0 ? WS_VF : WS_V));
    bf16_t* A1 = (bf16_t*)(ws + WS_A1); bf16_t* A2 = (bf16_t*)(ws + WS_A2); bf16_t* CQN = (bf16_t*)(ws + WS_CQN); bf16_t* CKVN = (bf16_t*)(ws + WS_CKVN); bf16_t* KA = (bf16_t*)(ws + WS_KATT);
    float* INV = (float*)(ws + WS_INV); const float* rope = (const float*)(ws + WS_ROPE);
    const float* mu = a.in[I_MU] + (size_t)l * 1920; const float* kkp = a.in[I_KK] + l * 512; const float* qg = a.in[I_QNG] + l * 256; const float* kvg = a.in[I_KVNG] + l * 128;
    for (int m = gw; m < TALL; m += nw) {
        const int b = m / TT, tt = m - b * TT; const bool ctx = tt < TC;
        const bool pok = !(tt == 0 || tt == TC), nok = !(tt == TC - 1 || tt == TT - 1);
        const bf16_t* Fr = F + (size_t)m * CINX; float x[8];
        shift8(Fr, pok, nok, OFF_R + lane * 8, mu, x); store8(R + (size_t)m * 512 + lane * 8, x);
        shift8(Fr, pok, nok, OFF_K + lane * 8, mu, x); store8(Kb + (size_t)m * 512 + lane * 8, x);
        { float kq[8], ss = 0.f; loadf8(kkp + lane * 8, kq);
#pragma unroll
          for (int j = 0; j < 8; ++j) { const float t = x[j] * kq[j]; ss += t * t; }
          ss = xorsum(ss, 1); ss = xorsum(ss, 2); ss = xorsum(ss, 4);
          if ((lane & 7) == 0) INV[(size_t)m * 8 + (lane >> 3)] = 1.f / fmaxf(sqrtf(ss), 1e-12f); }
        shift8(Fr, pok, nok, OFF_V + lane * 8, mu, x); store8(Vb + (size_t)m * 512 + lane * 8, x);
        if (lane < 48) { shift8(Fr, pok, nok, OFF_WLO + lane * 8, mu, x);
            if (lane < 16) {
#pragma unroll
                for (int j = 0; j < 8; ++j) x[j] = tanhf(x[j]); }
            else if (lane >= 32) {
#pragma unroll
                for (int j = 0; j < 8; ++j) x[j] = sigmoidf_(x[j]); }
            if (lane < 32) store8(A1 + (size_t)m * 256 + lane * 8, x); else store8(A2 + (size_t)m * 256 + (lane - 32) * 8, x); }
        else { if (lane < 52) load8(Fr + OFF_HV + (lane - 48) * 8, x); else {
#pragma unroll
                for (int j = 0; j < 8; ++j) x[j] = 0.f; }
            store8(A2 + (size_t)m * 256 + 128 + (lane - 48) * 8, x); }
        { const int col = lane < 32 ? lane * 8 : (lane < 48 ? 256 + (lane - 32) * 8 : 384 + ((lane - 48) & 3) * 8);
          load8(Fr + col, x); float ss = 0.f;
#pragma unroll
          for (int j = 0; j < 8; ++j) ss += x[j] * x[j];
          ss = xorsum(ss, 1); ss = xorsum(ss, 2); ss = xorsum(ss, 4); ss = xorsum(ss, 8); const float ss32 = xorsum(ss, 16);
          float px[8]; const int q = (lane - 48) & 3;
#pragma unroll
          for (int j = 0; j < 8; ++j) px[j] = __shfl_xor(x[j], 1, 64);
          if (lane < 32) { const float rstd = rsqrtf(ss32 * (1.f / 256.f) + 1e-6f); float g[8]; loadf8(qg + lane * 8, g);
#pragma unroll
              for (int j = 0; j < 8; ++j) x[j] = x[j] * rstd * g[j];
              store8(CQN + (size_t)m * 256 + lane * 8, x); }
          else if (lane < 48) { const float rstd = rsqrtf(ss * (1.f / 128.f) + 1e-6f); float g[8]; loadf8(kvg + (lane - 32) * 8, g);
#pragma unroll
              for (int j = 0; j < 8; ++j) x[j] = x[j] * rstd * g[j];
              store8(CKVN + (size_t)m * 256 + (lane - 32) * 8, x); }
          else { if (lane < 52) {
                  if (!ctx) { const int s = tt - TC, pos = (q < 2) ? (s >> 6) : (s & 63); float cs[8], sn[8]; loadf8(rope + pos * 8, cs); loadf8(rope + 512 + pos * 8, sn); const float sg = (q & 1) ? 1.f : -1.f;
#pragma unroll
                      for (int j = 0; j < 8; ++j) x[j] = x[j] * cs[j] + sg * px[j] * sn[j]; }
#pragma unroll
                  for (int hh = 0; hh < 8; ++hh) store8(KA + (size_t)m * 768 + hh * 96 + 64 + q * 8, x); }
              float z[8];
#pragma unroll
              for (int j = 0; j < 8; ++j) z[j] = 0.f;
              store8(CKVN + (size_t)m * 256 + 128 + (lane - 48) * 8, z); } }
    }
}

DI void phase_rwkv_out(const Args& a, int l, bool latent_only) {
    const int lane = ltid() & 63, gw = blockIdx.x * 8 + (ltid() >> 6), nw = gridDim.x * 8;
    unsigned char* ws = a.ws;
    const bf16_t* R = (const bf16_t*)(ws + WS_R); const bf16_t* Kb = (const bf16_t*)(ws + WS_K); const bf16_t* Vb = (const bf16_t*)(ws + (l == 0 ? WS_VF : WS_V));
    const bf16_t* AA = (const bf16_t*)(ws + WS_AA); const bf16_t* Gb = (const bf16_t*)(ws + WS_G); const bf16_t* YB = (const bf16_t*)(ws + WS_YB); bf16_t* MIX = (bf16_t*)(ws + WS_MIX);
    const int c = lane * 8; float ka[8], rk[8], lw[8], lb[8];
    loadf8(a.in[I_KA] + l * 512 + c, ka); loadf8(a.in[I_RK] + l * 512 + c, rk); loadf8(a.in[I_LNW] + l * 512 + c, lw); loadf8(a.in[I_LNB] + l * 512 + c, lb);
    for (int m = gw; m < TALL; m += nw) {
        const int tt = m % TT; if (latent_only && tt < TC) continue;
        float yf[8], yb[8], r[8], k[8], v[8], a0[8], a1[8], g[8];
        load8(MIX + (size_t)m * 1024 + 512 + c, yf); load8(YB + (size_t)m * 512 + c, yb); load8(R + (size_t)m * 512 + c, r); load8(Kb + (size_t)m * 512 + c, k); load8(Vb + (size_t)m * 512 + c, v);
        load8(AA + (size_t)m * 1024 + c, a0); load8(AA + (size_t)m * 1024 + 512 + c, a1); load8(Gb + (size_t)m * 512 + c, g);
        float s = 0.f, bon = 0.f;
#pragma unroll
        for (int j = 0; j < 8; ++j) { yf[j] += yb[j]; s += yf[j]; bon += r[j] * k[j] * (2.f + (a0[j] + a1[j] - 2.f) * ka[j]) * rk[j]; }
        s = xorsum(s, 1); s = xorsum(s, 2); s = xorsum(s, 4); bon = xorsum(bon, 1); bon = xorsum(bon, 2); bon = xorsum(bon, 4);
        const float mean = s * (1.f / 64.f); float vs = 0.f;
#pragma unroll
        for (int j = 0; j < 8; ++j) { yf[j] -= mean; vs += yf[j] * yf[j]; }
        vs = xorsum(vs, 1); vs = xorsum(vs, 2); vs = xorsum(vs, 4);
        const float rstd = rsqrtf(vs * (1.f / 64.f) + 64e-5f);
#pragma unroll
        for (int j = 0; j < 8; ++j) yf[j] = (yf[j] * rstd * lw[j] + lb[j] + bon * v[j]) * g[j];
        store8(MIX + (size_t)m * 1024 + 512 + c, yf);
    }
}

DI void phase_final(const Args& a) {
    const int lane = ltid() & 63, gw = blockIdx.x * 8 + (ltid() >> 6), nw = gridDim.x * 8; const float* gamma = a.in[I_FG];
    for (int m = gw; m < NB * SEQ; m += nw) {
        float* xr = a.out + (size_t)m * DM; f32x4 v[4]; float ss = 0.f;
#pragma unroll
        for (int i = 0; i < 4; ++i) { v[i] = *(const f32x4*)(xr + i * 256 + lane * 4); ss += v[i][0] * v[i][0] + v[i][1] * v[i][1] + v[i][2] * v[i][2] + v[i][3] * v[i][3]; }
#pragma unroll
        for (int k = 1; k < 64; k <<= 1) ss = xorsum(ss, k);
        const float rstd = rsqrtf(ss * (1.f / 1024.f) + 1e-6f);
#pragma unroll
        for (int i = 0; i < 4; ++i) { const int col = i * 256 + lane * 4; const f32x4 g = *(const f32x4*)(gamma + col); *(f32x4*)(xr + col) = v[i] * rstd * g; }
    }
}

#ifndef DUPMASK
#define DUPMASK 0
#endif
#ifndef SUBM
#define SUBM 3
#endif
#ifndef PHMASK
#define PHMASK 0xfff
#endif
__global__ void __launch_bounds__(512, 2) trunk_fwd(Args ka) {
    extern __shared__ __attribute__((aligned(16))) unsigned char lds[];
    cg::grid_group grid = cg::this_grid();
    const int ph_lo = ka.lo, ph_hi = ka.hi;
    for (int ph = ph_lo; ph < ph_hi; ++ph) {
        Args a = ka; asm volatile("" : "+s"(a.ws)); asm volatile("" : "+s"(a.out));
        unsigned char* ws = a.ws;
        if (ph == 0) phase_prologue(a, lds);
        else if (ph == NPH - 1) phase_final(a);
        else {
            const int l = (ph - 1) / 12, s = (ph - 1) % 12; const bool last = (l == NL - 1);
            const float* mods = (const float*)(ws + WS_MODS) + (size_t)l * 33 * 6144;
            if (s == 0 && ((PHMASK >> 0) & 1)) for (int rep_ = 0; rep_ < (((DUPMASK >> 0) & 1) ? 2 : 1); ++rep_) { convert_weights(a, l, lds); phase_norm(a, l, a.in[I_N1G] + l * 1024, 0, 1, false); }
            if (s == 1 && ((PHMASK >> 1) & 1)) for (int rep_ = 0; rep_ < (((DUPMASK >> 1) & 1) ? 2 : 1); ++rep_) { run_gemm<NIN, 1024>(lds, (const bf16_t*)(ws + WS_H), (const bf16_t*)(ws + WT_IN), 0, FnF{(bf16_t*)(ws + WS_F)}); }
            if (s == 2 && ((PHMASK >> 2) & 1)) for (int rep_ = 0; rep_ < (((DUPMASK >> 2) & 1) ? 2 : 1); ++rep_) { phase_split(a, l); }
            if (s == 3 && ((PHMASK >> 3) & 1)) for (int rep_ = 0; rep_ < (((DUPMASK >> 3) & 1) ? 2 : 1); ++rep_) { if (SUBM & 1) run_gemm<768, 256>(lds, (const bf16_t*)(ws + WS_CQN), (const bf16_t*)(ws + WT_UQ), 0, FnQ{(bf16_t*)(ws + WS_Q), (const float*)(ws + WS_ROPE)});
                    if (SUBM & 2) run_gemm<1024, 256>(lds, (const bf16_t*)(ws + WS_CKVN), (const bf16_t*)(ws + WT_UKV), 0, FnKV{(bf16_t*)(ws + WS_KATT), (bf16_t*)(ws + WS_VATT)}); }
            if (s == 4 && ((PHMASK >> 4) & 1)) for (int rep_ = 0; rep_ < (((DUPMASK >> 4) & 1) ? 2 : 1); ++rep_) { phase_attn((const bf16_t*)(ws + WS_Q), (const bf16_t*)(ws + WS_KATT), (const bf16_t*)(ws + WS_VATT), (bf16_t*)(ws + WS_MIX), last, (char*)lds); }
            if (s == 5 && ((PHMASK >> 5) & 1)) for (int rep_ = 0; rep_ < (((DUPMASK >> 5) & 1) ? 2 : 1); ++rep_) { if (SUBM & 1) run_gemm<2048, 256>(lds, (const bf16_t*)(ws + WS_A1), (const bf16_t*)(ws + WT_L1), 0, FnL1{(__half*)(ws + WS_DEC), (bf16_t*)(ws + WS_AA), a.in[I_W0] + l * 1024, a.in[I_A0] + l * 1024});
                    if (SUBM & 2) run_gemm<1024, 256>(lds, (const bf16_t*)(ws + WS_A2), (const bf16_t*)(ws + WT_L2), 0,
                             FnL2{(bf16_t*)(ws + WS_G), (bf16_t*)(ws + WS_V), (const bf16_t*)(ws + WS_VF), a.in[I_V0] + (l > 0 ? l - 1 : 0) * 512, l > 0 ? 1 : 0}); }
            if (s == 6 && ((PHMASK >> 6) & 1)) for (int rep_ = 0; rep_ < (((DUPMASK >> 6) & 1) ? 2 : 1); ++rep_) { phase_scan((const bf16_t*)(ws + WS_R), (const bf16_t*)(ws + WS_K), (const bf16_t*)(ws + (l == 0 ? WS_VF : WS_V)), (const __half*)(ws + WS_DEC), (const bf16_t*)(ws + WS_AA),
                               (const float*)(ws + WS_INV), a.in[I_KK] + l * 512, a.in[I_KA] + l * 512, (bf16_t*)(ws + WS_MIX), (bf16_t*)(ws + WS_YB), (char*)lds); }
            if (s == 7 && ((PHMASK >> 7) & 1)) for (int rep_ = 0; rep_ < (((DUPMASK >> 7) & 1) ? 2 : 1); ++rep_) { phase_rwkv_out(a, l, last); }
            if (s == 8 && ((PHMASK >> 8) & 1)) for (int rep_ = 0; rep_ < (((DUPMASK >> 8) & 1) ? 2 : 1); ++rep_) { run_gemm<1024, 1024>(lds, (const bf16_t*)(ws + WS_MIX), (const bf16_t*)(ws + WT_OUT), last ? 1 : 0, FnRes{a.out, (float*)(ws + WS_XC), mods, 2}); }
            if (s == 9 && ((PHMASK >> 9) & 1)) for (int rep_ = 0; rep_ < (((DUPMASK >> 9) & 1) ? 2 : 1); ++rep_) { phase_norm(a, l, a.in[I_N2G] + l * 1024, 3, 4, last); }
            if (s == 10 && ((PHMASK >> 10) & 1)) for (int rep_ = 0; rep_ < (((DUPMASK >> 10) & 1) ? 2 : 1); ++rep_) { run_gemm<DFF, 1024>(lds, (const bf16_t*)(ws + WS_H), (const bf16_t*)(ws + WT_M1), last ? 1 : 0, FnM1{(bf16_t*)(ws + WS_HID)}); }
            if (s == 11 && ((PHMASK >> 11) & 1)) for (int rep_ = 0; rep_ < (((DUPMASK >> 11) & 1) ? 2 : 1); ++rep_) { run_gemm<1024, DFF>(lds, (const bf16_t*)(ws + WS_HID), (const bf16_t*)(ws + WT_M2), last ? 1 : 0, FnRes{a.out, (float*)(ws + WS_XC), mods, 5}); }
        }
        if (ph + 1 < ph_hi) grid.sync();
    }
}

extern "C" void kernel_launch(void* const* d_in, const int* in_sizes, int n_in, void* d_out, int out_size, void* d_ws, size_t ws_size, hipStream_t stream) {
    static int grid = 0;
    if (grid == 0) {
        if (n_in != 31 || out_size != NB * SEQ * DM || ws_size < WS_END) { fprintf(stderr, "kernel_launch: unexpected shapes: n_in %d out %d ws %zu (need %zu)\n", n_in, out_size, ws_size, (size_t)WS_END); grid = -1; return; }
        int dev = 0, cus = 0, per_cu = 0;
        (void)hipGetDevice(&dev); (void)hipDeviceGetAttribute(&cus, hipDeviceAttributeMultiprocessorCount, dev);
        if (hipFuncSetAttribute((const void*)trunk_fwd, hipFuncAttributeMaxDynamicSharedMemorySize, LDS_BYTES) != hipSuccess) { fprintf(stderr, "kernel_launch: hipFuncSetAttribute failed\n"); grid = -1; return; }
        if (hipOccupancyMaxActiveBlocksPerMultiprocessor(&per_cu, (const void*)trunk_fwd, 512, LDS_BYTES) != hipSuccess || per_cu < 1) { fprintf(stderr, "kernel_launch: occupancy query gave %d\n", per_cu); per_cu = 1; }
        (void)hipGetLastError();
        grid = cus * 1;
    }
    if (grid < 0) return;
    Args a{};
    for (int i = 0; i < 31; ++i) a.in[i] = (const float*)d_in[i];
    a.out = (float*)d_out; a.ws = (unsigned char*)d_ws; a.lo = 0; a.hi = NPH;
    void* args[] = {&a};
    hipError_t e = hipLaunchCooperativeKernel((const void*)trunk_fwd, dim3(grid), dim3(512), args, LDS_BYTES, stream);
    if (e != hipSuccess) fprintf(stderr, "kernel_launch: cooperative launch failed: %s (grid %d)\n", hipGetErrorString(e), grid);
}
```

```cpp
#include <hip/hip_runtime.h>
#include <hip/hip_cooperative_groups.h>
#include <hip/hip_fp16.h>
#include <cstdio>
#include <cstdint>
namespace cg = cooperative_groups;
#define DI __device__ __forceinline__
DI int ltid() { int t = threadIdx.x; asm volatile("" : "+v"(t)); return t; }
namespace pg8 {
#define PG8_LAS __attribute__((address_space(3)))
typedef unsigned short bf16_t;
typedef short bf16x8 __attribute__((ext_vector_type(8)));
typedef float f32x4 __attribute__((ext_vector_type(4)));
typedef unsigned u32x4 __attribute__((ext_vector_type(4)));
constexpr int BM = 256, BK = 64, HALF = 128, HTB = HALF * BK * 2  , STAGE_BYTES = 8 * HTB, NXCD = 8, WGM = 8;

__host__ __device__ __forceinline__ int lds_byte(int r, int c) { const int st = (r >> 4) * 2 + (c >> 5), rr = r & 15, cc = c & 31, ob = rr * 64 + cc * 2; return st * 1024 + (ob ^ (((ob >> 9) & 1) << 5)); }
__host__ __device__ __forceinline__ void stage_rc(int b, int& R, int& C) { const int st = b / 1024, sb = b % 1024, swz = sb ^ (((sb >> 9) & 1) << 5); R = (st >> 1) * 16 + swz / 64; C = (st & 1) * 32 + (swz % 64) / 2; }
__host__ __device__ __forceinline__ int perm32(int rho) { const int n = rho >> 4, i = rho & 15; return 8 * (i >> 2) + 4 * n + (i & 3); }

struct Unit { int pm, pn; };
struct Gemm { const bf16_t* A; const bf16_t* Bt; int M, N, K; };

struct StaticOrder {
    int nM, nN, nwg, G, c;
    __host__ __device__ void init(int M, int N, int G_, int c_) { nM = M / BM; nN = N / BM; nwg = nM * nN; G = G_; c = c_; }
    __host__ __device__ bool next(int i, Unit& u) const {
        const long L = (long)i * G + c; if (L >= nwg) return false;
        int wgid = (int)L; { const int q = nwg / NXCD, r = nwg % NXCD, xcd = wgid % NXCD, off = wgid / NXCD; wgid = (xcd < r ? xcd * (q + 1) : r * (q + 1) + (xcd - r) * q) + off; }
        const int nig = WGM * nN, gid = wgid / nig, fm = gid * WGM, gsz = (nM - fm) < WGM ? (nM - fm) : WGM;
        u.pm = fm + ((wgid % nig) % gsz); u.pn = (wgid % nig) / gsz; return true;
    }
    __device__ __forceinline__ void a_ready(const Unit&) const {}
    __device__ __forceinline__ void done(const Unit&) const {}
};

__device__ __forceinline__ unsigned cvt_pk_bf16(float lo, float hi) { unsigned r; asm volatile("v_cvt_pk_bf16_f32 %0, %1, %2" : "=v"(r) : "v"(lo), "v"(hi)); return r; }

template <class Epi, class Sched, bool ALIGN_EPI = false, bool SP2 = false>
__device__ __forceinline__ void gemm_phase(PG8_LAS unsigned char* lds, const Gemm g, const Sched& S, const Epi& E) {
    const int tid = ltid(), wid = __builtin_amdgcn_readfirstlane(tid >> 6), lane = tid & 63, wr = wid >> 2, wc = wid & 3, fr = lane & 15, fq = lane >> 4;
    const int K = g.K, nt = K / BK;
    unsigned voffA[2], voffB[2];
#pragma unroll
    for (int i = 0; i < 2; ++i) { int R, C; stage_rc(tid * 16 + i * 8192, R, C); const int Rb = Epi::PERM ? ((R & ~31) + perm32(R & 31)) : R;
        voffA[i] = (unsigned)(R * K + C) * 2u; voffB[i] = (unsigned)(Rb * K + C) * 2u; }
    const size_t kstep = (size_t)(BK * 2);
    const size_t hstep = (size_t)HALF * K * 2;
    const size_t tstep = 2 * hstep;
    const unsigned ldsw = (unsigned)wid * 1024u;
    const int aoff = lds_byte(wr * 64 + fr, fq * 8), boff = lds_byte(wc * 32 + fr, fq * 8);
#define PG8_SA(b, h) (((b) * 2 + (h)) * HTB)
#define PG8_SB(b, h) ((4 + (b) * 2 + (h)) * HTB)
#define PG8_STAGE(bufoff, gbase, voff) do { _Pragma("unroll") for (int _i = 0; _i < 2; ++_i) \
        __builtin_amdgcn_global_load_lds((const unsigned*)((const char*)(gbase) + (voff)[_i]), (PG8_LAS unsigned*)(lds + (bufoff) + ldsw + _i * 8192), 16, 0, 0); } while (0)
#define PG8_LDA(dst, b, h) do { _Pragma("unroll") for (int m = 0; m < 4; ++m) _Pragma("unroll") for (int k = 0; k < 2; ++k) dst[m][k] = *(const PG8_LAS bf16x8*)(lds + PG8_SA(b, h) + aoff + m * 2048 + k * 1024); } while (0)
#define PG8_LDB(dst, b, h) do { _Pragma("unroll") for (int n = 0; n < 2; ++n) _Pragma("unroll") for (int k = 0; k < 2; ++k) dst[n][k] = *(const PG8_LAS bf16x8*)(lds + PG8_SB(b, h) + boff + n * 2048 + k * 1024); } while (0)
#define PG8_MMA(ai, bj, At, Bt) do { __builtin_amdgcn_s_setprio(1); _Pragma("unroll") for (int m = 0; m < 4; ++m) _Pragma("unroll") for (int n = 0; n < 2; ++n) _Pragma("unroll") for (int k = 0; k < 2; ++k) \
        acc[ai][bj][m][n] = __builtin_amdgcn_mfma_f32_16x16x32_bf16(Bt[n][k], At[m][k], acc[ai][bj][m][n], 0, 0, 0); __builtin_amdgcn_s_setprio(0); } while (0)
#define PG8_WAIT_V(n) asm volatile("s_waitcnt vmcnt(" #n ")" ::: "memory")
#define PG8_WAIT_L(n) asm volatile("s_waitcnt lgkmcnt(" #n ")" ::: "memory")
#define PG8_BAR __builtin_amdgcn_s_barrier()
#define PG8_SCHED __builtin_amdgcn_sched_barrier(0)
    Unit cur, nxt; int ui = 0;
    if (!S.next(0, cur)) return;
    f32x4 acc[2][2][4][2];
#pragma unroll
    for (int a = 0; a < 2; ++a)
#pragma unroll
        for (int b = 0; b < 2; ++b)
#pragma unroll
            for (int m = 0; m < 4; ++m)
#pragma unroll
                for (int n = 0; n < 2; ++n) acc[a][b][m][n] = (f32x4){0.f, 0.f, 0.f, 0.f};
    bf16x8 At[4][2], B0[2][2], B1[2][2];
    const char* cA = (const char*)g.A + (size_t)cur.pm * tstep; const char* cB = (const char*)g.Bt + (size_t)cur.pn * tstep;
    S.a_ready(cur);
    if constexpr (SP2) {
        PG8_STAGE(PG8_SB(0, 0), cB, voffB); PG8_STAGE(PG8_SB(0, 1), cB + hstep, voffB); PG8_STAGE(PG8_SA(0, 0), cA, voffA); PG8_STAGE(PG8_SA(0, 1), cA + hstep, voffA);
        if (wr == 1) PG8_BAR;
        PG8_WAIT_V(2); PG8_BAR;
        PG8_STAGE(PG8_SB(1, 0), cB + kstep, voffB); PG8_STAGE(PG8_SA(1, 0), cA + kstep, voffA); PG8_STAGE(PG8_SB(1, 1), cB + hstep + kstep, voffB);
        PG8_WAIT_V(6); PG8_BAR;
    } else {
        PG8_STAGE(PG8_SB(0, 0), cB, voffB); PG8_STAGE(PG8_SA(0, 0), cA, voffA); PG8_STAGE(PG8_SB(0, 1), cB + hstep, voffB); PG8_STAGE(PG8_SA(0, 1), cA + hstep, voffA);
        if (wr == 1) PG8_BAR;
        PG8_WAIT_V(4); PG8_BAR;
        PG8_STAGE(PG8_SB(1, 0), cB + kstep, voffB); PG8_STAGE(PG8_SA(1, 0), cA + kstep, voffA); PG8_STAGE(PG8_SB(1, 1), cB + hstep + kstep, voffB);
        PG8_WAIT_V(6); PG8_BAR;
    }
    for (;;) {
        const bool has_next = S.next(ui + 1, nxt);
        const char* nA = has_next ? (const char*)g.A + (size_t)nxt.pm * tstep : cA; const char* nB = has_next ? (const char*)g.Bt + (size_t)nxt.pn * tstep : cB;
#pragma nounroll
        for (int t = 0; t < nt; t += 2) {
            const bool last = (t == nt - 2);
            const char* a1 = cA + (size_t)(t + 1) * kstep;
            const char* a2 = last ? nA : cA + (size_t)(t + 2) * kstep; const char* b2 = last ? nB : cB + (size_t)(t + 2) * kstep;
            const char* a3 = a2 + kstep; const char* b3 = b2 + kstep;
            if (last && has_next) S.a_ready(nxt);
            if constexpr (SP2) {
            PG8_LDB(B0, 0, 0); PG8_LDB(B1, 0, 1); PG8_SCHED; PG8_LDA(At, 0, 0); PG8_STAGE(PG8_SA(1, 1), a1 + hstep, voffA);
            PG8_WAIT_V(8); PG8_WAIT_L(0); PG8_BAR; PG8_MMA(0, 0, At, B0); PG8_MMA(0, 1, At, B1); PG8_BAR; PG8_SCHED;
            PG8_LDA(At, 0, 1); PG8_STAGE(PG8_SB(0, 0), b2, voffB); PG8_STAGE(PG8_SB(0, 1), b2 + hstep, voffB); PG8_STAGE(PG8_SA(0, 0), a2, voffA);
            PG8_WAIT_V(8); PG8_WAIT_L(0); PG8_BAR; PG8_MMA(1, 0, At, B0); PG8_MMA(1, 1, At, B1); PG8_BAR; PG8_SCHED;
            PG8_LDB(B0, 1, 0); PG8_LDB(B1, 1, 1); PG8_SCHED; PG8_LDA(At, 1, 0); PG8_STAGE(PG8_SA(0, 1), a2 + hstep, voffA);
            PG8_WAIT_V(8); PG8_WAIT_L(0); PG8_BAR; PG8_MMA(0, 0, At, B0); PG8_MMA(0, 1, At, B1); PG8_BAR; PG8_SCHED;
            PG8_LDA(At, 1, 1); PG8_STAGE(PG8_SB(1, 0), b3, voffB); PG8_STAGE(PG8_SB(1, 1), b3 + hstep, voffB); PG8_STAGE(PG8_SA(1, 0), a3, voffA);
            PG8_WAIT_V(8); PG8_WAIT_L(0); PG8_BAR; PG8_MMA(1, 0, At, B0); PG8_MMA(1, 1, At, B1); PG8_BAR; PG8_SCHED;
            } else {
            PG8_LDB(B0, 0, 0); PG8_SCHED; PG8_LDA(At, 0, 0); PG8_STAGE(PG8_SA(1, 1), a1 + hstep, voffA);
            PG8_WAIT_L(8); PG8_BAR; PG8_WAIT_L(0); PG8_MMA(0, 0, At, B0); PG8_BAR; PG8_SCHED;
            PG8_LDB(B1, 0, 1); PG8_STAGE(PG8_SB(0, 0), b2, voffB);
            PG8_BAR; PG8_WAIT_L(0); PG8_MMA(0, 1, At, B1); PG8_BAR;
            PG8_LDA(At, 0, 1); PG8_STAGE(PG8_SA(0, 0), a2, voffA);
            PG8_BAR; PG8_WAIT_L(0); PG8_MMA(1, 0, At, B0); PG8_BAR; PG8_SCHED;
            PG8_STAGE(PG8_SB(0, 1), b2 + hstep, voffB);
            PG8_WAIT_V(6); PG8_BAR; PG8_MMA(1, 1, At, B1); PG8_BAR;
            PG8_LDB(B0, 1, 0); PG8_SCHED; PG8_LDA(At, 1, 0); PG8_STAGE(PG8_SA(0, 1), a2 + hstep, voffA);
            PG8_WAIT_L(8); PG8_BAR; PG8_WAIT_L(0); PG8_MMA(0, 0, At, B0); PG8_BAR; PG8_SCHED;
            PG8_LDB(B1, 1, 1); PG8_STAGE(PG8_SB(1, 0), b3, voffB);
            PG8_BAR; PG8_WAIT_L(0); PG8_MMA(0, 1, At, B1); PG8_BAR;
            PG8_LDA(At, 1, 1); PG8_STAGE(PG8_SA(1, 0), a3, voffA);
            PG8_BAR; PG8_WAIT_L(0); PG8_MMA(1, 0, At, B0); PG8_BAR; PG8_SCHED;
            PG8_STAGE(PG8_SB(1, 1), b3 + hstep, voffB);
            PG8_WAIT_V(6); PG8_BAR; PG8_MMA(1, 1, At, B1); PG8_BAR;
            }
        }
        if constexpr (ALIGN_EPI) { if (wr == 0) PG8_BAR; }
        if constexpr (!Epi::AFTER_DRAIN) { E(acc, cur, wr, wc, fr, fq); S.done(cur); }
        if (!has_next) break;
#pragma unroll
        for (int a = 0; a < 2; ++a)
#pragma unroll
            for (int b = 0; b < 2; ++b)
#pragma unroll
                for (int m = 0; m < 4; ++m)
#pragma unroll
                    for (int n = 0; n < 2; ++n) acc[a][b][m][n] = (f32x4){0.f, 0.f, 0.f, 0.f};
        cur = nxt; cA = nA; cB = nB; ++ui;
        if constexpr (ALIGN_EPI) { if (wr == 1) PG8_BAR; }
    }
    PG8_WAIT_V(0);
    if constexpr (!ALIGN_EPI) { if (wr == 0) PG8_BAR; }
    PG8_BAR;
    if constexpr (Epi::AFTER_DRAIN) { E.fused(acc, cur, wr, wc, fr, fq, lds, wid, lane); S.done(cur); }
#undef PG8_SA
#undef PG8_SB
#undef PG8_STAGE
#undef PG8_LDA
#undef PG8_LDB
#undef PG8_MMA
#undef PG8_WAIT_V
#undef PG8_WAIT_L
#undef PG8_BAR
#undef PG8_SCHED
}
}
typedef unsigned short bf16_t;
using bf16x8 = __attribute__((ext_vector_type(8))) short;
using s16x4  = __attribute__((ext_vector_type(4))) short;
using f32x16 = __attribute__((ext_vector_type(16))) float;
using f32x4  = __attribute__((ext_vector_type(4))) float;
using u32x4  = __attribute__((ext_vector_type(4))) unsigned;
using u32x2  = __attribute__((ext_vector_type(2))) unsigned;

constexpr int DM = 1024, NB = 32, SEQ = 2048, TC = 256, TT = 2304, TALL = NB * TT, NL = 4;
constexpr int CIN = 2336, CINX = 2368, NIN = 2560, DFF = 4096;
constexpr int OFF_R = 416, OFF_K = 928, OFF_V = 1440, OFF_WLO = 1952, OFF_HV = 2336;
constexpr int NPH = 50, LDS_BYTES = 147456;
constexpr size_t MiB = 1u << 20;
constexpr size_t WS_MODS = 0, WS_ROPE = 3 * MiB + 512 * 1024, WS_BAR = 3 * MiB + 768 * 1024, BAR_BYTES = 16384, WS_XC = 4 * MiB, WS_VF = 36 * MiB, WS_WT = 108 * MiB, WS_INV = 134 * MiB, TR = 137 * MiB;
constexpr size_t WT_IN = WS_WT, WT_UQ = WS_WT + 5 * MiB, WT_UKV = WS_WT + 5 * MiB + 512 * 1024, WT_L1 = WS_WT + 6 * MiB, WT_L2 = WS_WT + 7 * MiB,
                 WT_OUT = WS_WT + 8 * MiB, WT_M1 = WS_WT + 10 * MiB, WT_M2 = WS_WT + 18 * MiB;
constexpr size_t WS_R = TR, WS_K = TR + 72 * MiB, WS_H = TR, WS_F = TR + 144 * MiB, WS_Q = TR + 144 * MiB, WS_VATT = TR + 252 * MiB, WS_MIX = TR + 324 * MiB,
                 WS_DEC = TR + 144 * MiB, WS_HID = TR + 144 * MiB, WS_A1 = TR + 477 * MiB, WS_A2 = TR + 513 * MiB, WS_YB = TR + 477 * MiB,
                 WS_CQN = TR + 549 * MiB, WS_CKVN = TR + 585 * MiB, WS_KATT = TR + 621 * MiB, WS_AA = TR + 585 * MiB, WS_G = TR + 729 * MiB,
                 WS_V = TR + 801 * MiB, WS_END = TR + 873 * MiB;

struct Args { const float* in[31]; float* out; unsigned char* ws; int lo, hi; };
enum { I_X = 0, I_C, I_CTX, I_CCTX, I_ADAW, I_ADAB, I_N1G, I_N2G, I_WIN, I_QNG, I_WUQ, I_KVNG, I_WUKV, I_MU, I_W0, I_W2, I_A0, I_A2, I_G2, I_KK, I_KA, I_RK,
       I_LNW, I_LNB, I_V1, I_V2, I_V0, I_WOUT, I_M1, I_M2, I_FG };

DI float bflo(unsigned w) { return __uint_as_float(w << 16); }
DI float bfhi(unsigned w) { return __uint_as_float(w & 0xffff0000u); }
DI unsigned cvtpk(float lo, float hi) { return pg8::cvt_pk_bf16(lo, hi); }
DI bf16_t f2bf(float f) { return (bf16_t)(cvtpk(f, 0.f) & 0xffffu); }
DI void load8(const bf16_t* p, float (&f)[8]) { const u32x4 w = *(const u32x4*)p; f[0] = bflo(w.x); f[1] = bfhi(w.x); f[2] = bflo(w.y); f[3] = bfhi(w.y); f[4] = bflo(w.z); f[5] = bfhi(w.z); f[6] = bflo(w.w); f[7] = bfhi(w.w); }
DI void store8(bf16_t* p, const float (&f)[8]) { u32x4 w; w.x = cvtpk(f[0], f[1]); w.y = cvtpk(f[2], f[3]); w.z = cvtpk(f[4], f[5]); w.w = cvtpk(f[6], f[7]); *(u32x4*)p = w; }
DI void loadf8(const float* p, float (&f)[8]) { const f32x4 a = *(const f32x4*)p, b = *(const f32x4*)(p + 4); f[0] = a[0]; f[1] = a[1]; f[2] = a[2]; f[3] = a[3]; f[4] = b[0]; f[5] = b[1]; f[6] = b[2]; f[7] = b[3]; }
DI float h2f(unsigned b) { return __half2float(__ushort_as_half((unsigned short)b)); }
DI float sigmoidf_(float x) { return 1.f / (1.f + __expf(-x)); }
DI float xorsum(float v, int mask) { return v + __shfl_xor(v, mask, 64); }
DI float* xrow(float* out, float* xc, int m) { const int b = m / TT, tt = m - b * TT; return tt < TC ? xc + (size_t)(b * TC + tt) * DM : out + (size_t)(b * SEQ + tt - TC) * DM; }

template <class Fn> struct Epi8 {
    static constexpr bool PERM = true, AFTER_DRAIN = false; Fn f;
    DI void operator()(const pg8::f32x4 (&acc)[2][2][4][2], const pg8::Unit& u, int wr, int wc, int fr, int fq) const {
#pragma unroll
        for (int ai = 0; ai < 2; ++ai)
#pragma unroll
            for (int m = 0; m < 4; ++m) { const int rit = ai * 128 + wr * 64 + m * 16 + fr;
#pragma unroll
                for (int bj = 0; bj < 2; ++bj) { f(rit, u.pn * 256 + bj * 128 + wc * 32 + 8 * fq, acc[ai][bj][m][0], acc[ai][bj][m][1], u, fq); __builtin_amdgcn_sched_barrier(0); } }
    }
};
DI void st8(bf16_t* p, const pg8::f32x4& v0, const pg8::f32x4& v1) { u32x4 w; w.x = cvtpk(v0[0], v0[1]); w.y = cvtpk(v0[2], v0[3]); w.z = cvtpk(v1[0], v1[1]); w.w = cvtpk(v1[2], v1[3]); *(u32x4*)p = w; }

struct FnF { bf16_t* F;
    DI void operator()(int rit, int col0, const pg8::f32x4& v0, const pg8::f32x4& v1, const pg8::Unit& u, int) const {
        if (col0 < CINX) st8(F + (size_t)(u.pm * 256 + rit) * CINX + col0, v0, v1); } };
struct FnQ { bf16_t* Q; const float* rope;
    DI void operator()(int rit, int col0, const pg8::f32x4& v0, const pg8::f32x4& v1, const pg8::Unit& u, int fq) const {
        const int seg = u.pm % 9; const bool isrope = (seg != 0) && (((col0 >> 5) % 3) == 2);
        float x[8] = {v0[0], v0[1], v0[2], v0[3], v1[0], v1[1], v1[2], v1[3]};
        if (isrope) { const int s = (seg - 1) * 256 + rit, pos = (fq < 2) ? (s >> 6) : (s & 63); float cs[8], sn[8]; loadf8(rope + pos * 8, cs); loadf8(rope + 512 + pos * 8, sn);
            const float sg = (fq & 1) ? 1.f : -1.f;
#pragma unroll
            for (int j = 0; j < 8; ++j) { const float p = __shfl_xor(x[j], 16, 64); x[j] = x[j] * cs[j] + sg * p * sn[j]; } }
        store8(Q + (size_t)(u.pm * 256 + rit) * 768 + col0, x); } };
struct FnKV { bf16_t* KA; bf16_t* VA;
    DI void operator()(int rit, int col0, const pg8::f32x4& v0, const pg8::f32x4& v1, const pg8::Unit& u, int) const {
        const size_t row = (size_t)(u.pm * 256 + rit); const int h = col0 >> 7, c = col0 & 127;
        if (c < 64) st8(KA + row * 768 + h * 96 + c, v0, v1); else st8(VA + row * 512 + h * 64 + (c - 64), v0, v1); } };
struct FnL1 { __half* DEC; bf16_t* AA; const float* w0; const float* a0;
    DI void operator()(int rit, int col0, const pg8::f32x4& v0, const pg8::f32x4& v1, const pg8::Unit& u, int) const {
        const size_t row = (size_t)(u.pm * 256 + rit); float x[8] = {v0[0], v0[1], v0[2], v0[3], v1[0], v1[1], v1[2], v1[3]};
        if (col0 < 1024) { float b[8]; loadf8(w0 + col0, b); u32x4 w; unsigned hh[8];
#pragma unroll
            for (int j = 0; j < 8; ++j) { const float uu = 0.6065306597f * sigmoidf_(x[j] + b[j]); hh[j] = (unsigned)__half_as_ushort(__float2half(-uu * 1.4426950409f)); }
            w.x = hh[0] | (hh[1] << 16); w.y = hh[2] | (hh[3] << 16); w.z = hh[4] | (hh[5] << 16); w.w = hh[6] | (hh[7] << 16);
            *(u32x4*)(DEC + row * 1024 + col0) = w;
        } else { const int c = col0 - 1024; float b[8]; loadf8(a0 + c, b);
#pragma unroll
            for (int j = 0; j < 8; ++j) x[j] = sigmoidf_(x[j] + b[j]);
            store8(AA + row * 1024 + c, x); } } };
struct FnL2 { bf16_t* G; bf16_t* V; const bf16_t* VF; const float* v0p; int dovres;
    DI void operator()(int rit, int col0, const pg8::f32x4& v0, const pg8::f32x4& v1, const pg8::Unit& u, int) const {
        const size_t row = (size_t)(u.pm * 256 + rit);
        if (col0 < 512) st8(G + row * 512 + col0, v0, v1);
        else if (dovres) { const int c = col0 - 512; float x[8] = {v0[0], v0[1], v0[2], v0[3], v1[0], v1[1], v1[2], v1[3]}, b[8], v[8], vf[8]; loadf8(v0p + c, b); load8(V + row * 512 + c, v); load8(VF + row * 512 + c, vf);
#pragma unroll
            for (int j = 0; j < 8; ++j) v[j] = v[j] + (vf[j] - v[j]) * sigmoidf_(b[j] + x[j]);
            store8(V + row * 512 + c, v); } } };
struct FnRes { float* out; float* xc; const float* sx; const float* sc; const float* mods; int gidx;
    DI void operator()(int rit, int col0, const pg8::f32x4& v0, const pg8::f32x4& v1, const pg8::Unit& u, int) const {
        const int b = u.pm / 9, seg = u.pm - b * 9; const float* g = mods + (size_t)(seg == 0 ? 32 : b) * 6144 + gidx * 1024 + col0;
        const size_t off = (seg == 0 ? (size_t)(b * TC + rit) * DM : (size_t)(b * SEQ + (seg - 1) * 256 + rit) * DM) + col0;
        float* p = (seg == 0 ? xc : out) + off; const float* q = (seg == 0 ? sc : sx) + off;
        const pg8::f32x4 g0 = *(const pg8::f32x4*)g, g1 = *(const pg8::f32x4*)(g + 4); pg8::f32x4 x0 = *(const pg8::f32x4*)q, x1 = *(const pg8::f32x4*)(q + 4);
        x0 += g0 * v0; x1 += g1 * v1; *(pg8::f32x4*)p = x0; *(pg8::f32x4*)(p + 4) = x1; } };
struct FnM1 { bf16_t* HID;
    DI void operator()(int rit, int col0, const pg8::f32x4& v0, const pg8::f32x4& v1, const pg8::Unit& u, int) const {
        float x[8] = {v0[0], v0[1], v0[2], v0[3], v1[0], v1[1], v1[2], v1[3]};
#pragma unroll
        for (int j = 0; j < 8; ++j) { const float r = fmaxf(x[j], 0.f); x[j] = r * r; }
        store8(HID + (size_t)(u.pm * 256 + rit) * DFF + col0, x); } };

struct Order { pg8::StaticOrder s; int lat;
    DI void init(int lat_, int N) { lat = lat_; s.init(lat_ ? NB * SEQ : TALL, N, (int)gridDim.x, (int)blockIdx.x); }
    DI bool next(int i, pg8::Unit& u) const { if (!s.next(i, u)) return false; if (lat) u.pm = (u.pm >> 3) * 9 + 1 + (u.pm & 7); return true; }
    DI void a_ready(const pg8::Unit&) const {}
    DI void done(const pg8::Unit&) const {}
};
template <int N, int K, class Fn> DI void run_gemm(unsigned char* lds, const bf16_t* A, const bf16_t* Bt, int lat, const Fn& fn) {
    pg8::Gemm g{A, Bt, lat ? NB * SEQ : TALL, N, K}; Order S; S.init(lat, N); Epi8<Fn> E{fn};
    pg8::gemm_phase<Epi8<Fn>, Order, true, true>((PG8_LAS unsigned char*)lds, g, S, E);
    __syncthreads();
}
namespace att {
constexpr int NW = 8, QBLK = 32, KVBLK = 64;
constexpr float SCALE = 0.10206207261596577f, THR = 8.f;
constexpr int LDQ = 768, LDKK = 768, LDV = 512, LDO = 1024;
constexpr int SHM_V = KVBLK * 64 * 2, SHM_K = KVBLK * 256, SHM_ATTN = 2 * SHM_V + 2 * SHM_K + NW * 64 * 4;
#define KSWZ(row, colB) ((row) * 256 + ((colB) ^ (((row) & 7) << 4)))
#define SBAR() __builtin_amdgcn_sched_barrier(0)
DI int crow(int r, int hi) { return (r & 3) + 8 * (r >> 2) + 4 * hi; }
DI unsigned cvtpk_(float lo, float hi) { unsigned r; asm volatile("v_cvt_pk_bf16_f32 %0, %1, %2" : "=v"(r) : "v"(lo), "v"(hi)); return r; }
DI void partialSM(f32x16& p0, f32x16& p1, float& m_reg, float& mn, float& alpha) {
  constexpr float C = SCALE * 1.4426950408889634f;
  float pmax = p0[0];
#pragma unroll
  for (int r = 1; r < 16; ++r) pmax = fmaxf(pmax, p0[r]);
#pragma unroll
  for (int r = 0; r < 16; ++r) pmax = fmaxf(pmax, p1[r]);
  { auto rr = __builtin_amdgcn_permlane32_swap(__float_as_uint(pmax), __float_as_uint(pmax), false, false);
    pmax = fmaxf(__uint_as_float(rr[0]), __uint_as_float(rr[1])); }
  if (__builtin_expect(__all(pmax - m_reg <= THR / SCALE), 1)) { mn = m_reg; alpha = 1.f; }
  else { mn = fmaxf(m_reg, pmax); alpha = __builtin_amdgcn_exp2f((m_reg - mn) * C); m_reg = mn; }
  const float mnC = -mn * C;
#pragma unroll
  for (int r = 0; r < 16; ++r) p0[r] = fmaf(p0[r], C, mnC);
#pragma unroll
  for (int r = 0; r < 16; ++r) p1[r] = fmaf(p1[r], C, mnC);
#pragma unroll
  for (int r = 0; r < 16; ++r) p0[r] = __builtin_amdgcn_exp2f(p0[r]);
}
DI void finishSM(f32x16& p0, f32x16& p1, float alpha, float& l_reg, bf16x8& pa0, bf16x8& pa1, bf16x8& pa2, bf16x8& pa3) {
#pragma unroll
  for (int r = 0; r < 16; ++r) p1[r] = __builtin_amdgcn_exp2f(p1[r]);
  float ps = 0;
#pragma unroll
  for (int r = 0; r < 16; ++r) ps += p0[r];
#pragma unroll
  for (int r = 0; r < 16; ++r) ps += p1[r];
  { auto rr = __builtin_amdgcn_permlane32_swap(__float_as_uint(ps), __float_as_uint(ps), false, false);
    ps = __uint_as_float(rr[0]) + __uint_as_float(rr[1]); }
  l_reg = l_reg * alpha + ps;
#define PK4(P, BASE, OUT) do { unsigned a0 = cvtpk_(P[BASE + 0], P[BASE + 1]), a1 = cvtpk_(P[BASE + 2], P[BASE + 3]);   \
    unsigned b0 = cvtpk_(P[BASE + 4], P[BASE + 5]), b1 = cvtpk_(P[BASE + 6], P[BASE + 7]);                              \
    auto r0 = __builtin_amdgcn_permlane32_swap(a0, b0, false, false); auto r1 = __builtin_amdgcn_permlane32_swap(a1, b1, false, false); \
    u32x4 w = {r0[0], r1[0], r0[1], r1[1]}; OUT = *reinterpret_cast<bf16x8*>(&w); } while (0)
  PK4(p0, 0, pa0); PK4(p0, 8, pa1); PK4(p1, 0, pa2); PK4(p1, 8, pa3);
#undef PK4
}
DI void qkt(f32x16& p0, f32x16& p1, const char* Ks, const bf16x8* qr, int r32, int hi) {
  p0 = f32x16{}; p1 = f32x16{};
#pragma unroll
  for (int d0 = 0; d0 < 6; ++d0) { const int cb = (d0 * 16 + hi * 8) * 2;
    bf16x8 b0 = *reinterpret_cast<const bf16x8*>(Ks + KSWZ(r32, cb));
    bf16x8 b1 = *reinterpret_cast<const bf16x8*>(Ks + KSWZ(32 + r32, cb));
    p0 = __builtin_amdgcn_mfma_f32_32x32x16_bf16(b0, qr[d0], p0, 0, 0, 0);
    p1 = __builtin_amdgcn_mfma_f32_32x32x16_bf16(b1, qr[d0], p1, 0, 0, 0); }
}
DI int v_st(int k, int c) { const int kk = (k & ~0xC) | ((k & 4) << 1) | ((k & 8) >> 1); return ((kk >> 3) * 2 + (c >> 5)) * 512 + ((kk & 7) * 32 + (c & 31)) * 2; }
DI int v_rd_base(int lane) { return ((lane & 3) << 3) | (((lane >> 2) & 3) << 6) | (((lane >> 4) & 1) << 5) | (((lane >> 5) & 1) << 8); }
constexpr int v_rd_off(int d0, int ks, int half) { return d0 * 512 + ks * 2048 + half * 1024; }
template <int OFF> DI s16x4 tr_read(int vb) {
  s16x4 r; asm volatile("ds_read_b64_tr_b16 %0, %1 offset:%2" : "=&v"(r) : "v"(vb), "i"(OFF) : "memory"); return r;
}
template <int D0> DI void pv_one(f32x16& od, int vb, bf16x8 pa0, bf16x8 pa1, bf16x8 pa2, bf16x8 pa3) {
  const s16x4 l0 = tr_read<v_rd_off(D0, 0, 0)>(vb), h0 = tr_read<v_rd_off(D0, 0, 1)>(vb), l1 = tr_read<v_rd_off(D0, 1, 0)>(vb), h1 = tr_read<v_rd_off(D0, 1, 1)>(vb);
  const s16x4 l2 = tr_read<v_rd_off(D0, 2, 0)>(vb), h2 = tr_read<v_rd_off(D0, 2, 1)>(vb), l3 = tr_read<v_rd_off(D0, 3, 0)>(vb), h3 = tr_read<v_rd_off(D0, 3, 1)>(vb);
  asm volatile("s_waitcnt lgkmcnt(0)" ::: "memory"); SBAR();
#define PK(L, H) (bf16x8){L[0], L[1], L[2], L[3], H[0], H[1], H[2], H[3]}
  od = __builtin_amdgcn_mfma_f32_32x32x16_bf16(pa0, PK(l0, h0), od, 0, 0, 0);
  od = __builtin_amdgcn_mfma_f32_32x32x16_bf16(pa1, PK(l1, h1), od, 0, 0, 0);
  od = __builtin_amdgcn_mfma_f32_32x32x16_bf16(pa2, PK(l2, h2), od, 0, 0, 0);
  od = __builtin_amdgcn_mfma_f32_32x32x16_bf16(pa3, PK(l3, h3), od, 0, 0, 0);
#undef PK
}
DI void pv_d0(f32x16* o, int vb, bf16x8 pa0, bf16x8 pa1, bf16x8 pa2, bf16x8 pa3) {
  pv_one<0>(o[0], vb, pa0, pa1, pa2, pa3); pv_one<1>(o[1], vb, pa0, pa1, pa2, pa3);
}
DI void attn_body(const bf16_t* __restrict__ Qb, const bf16_t* __restrict__ Kh, const bf16_t* __restrict__ Vh, bf16_t* __restrict__ Ob, int seq, char* lds) {
  const int tid = ltid(), wid = tid >> 6, lane = tid & 63, r32 = lane & 31, hi = lane >> 5;
  char* V_lds = lds; char* K_lds = lds + 2 * SHM_V;
  float* ws = (float*)(lds + 2 * SHM_V + 2 * SHM_K) + wid * 64; float* li_l = ws; float* al_l = ws + 32;
  float m_reg = -1e30f, l_reg = 0; f32x16 o[2] = {}; bf16x8 qr[6];
  const bf16_t* Qw = Qb + (long)(wid * QBLK + r32) * LDQ + hi * 8;
#pragma unroll
  for (int d0 = 0; d0 < 6; ++d0) qr[d0] = *reinterpret_cast<const bf16x8*>(Qw + d0 * 16);
  const int kc2 = 512 + (tid & 255);
  const int kr1 = tid / 12, kch1 = tid - kr1 * 12, kr2 = kc2 / 12, kch2 = kc2 - kr2 * 12, vr = tid >> 3, vch = tid & 7;
  const int vst = v_st(vr, vch * 8), kst1 = KSWZ(kr1, kch1 * 16), kst2 = KSWZ(kr2, kch2 * 16);
  const int vb0 = (int)(uintptr_t)V_lds + v_rd_base(lane);
  struct { bf16x8 v, k1, k2; } sr_[2];
#define SLOAD(i, k0) do { sr_[i].v = *reinterpret_cast<const bf16x8*>(&Vh[(long)((k0) + vr) * LDV + vch * 8]); \
    sr_[i].k1 = *reinterpret_cast<const bf16x8*>(&Kh[(long)((k0) + kr1) * LDKK + kch1 * 8]); sr_[i].k2 = *reinterpret_cast<const bf16x8*>(&Kh[(long)((k0) + kr2) * LDKK + kch2 * 8]); } while (0)
#define SWRITE(b, i) do { *(bf16x8*)(V_lds + (b) * SHM_V + vst) = sr_[i].v; *(bf16x8*)(K_lds + (b) * SHM_K + kst1) = sr_[i].k1; *(bf16x8*)(K_lds + (b) * SHM_K + kst2) = sr_[i].k2; } while (0)
#define RESC(a) do { if (__any((a) < 1.f)) { if (hi == 0) al_l[r32] = (a); asm volatile("s_waitcnt lgkmcnt(0)" ::: "memory"); \
    _Pragma("unroll") for (int d = 0; d < 2; ++d) _Pragma("unroll") for (int r = 0; r < 16; ++r) o[d][r] *= al_l[crow(r, hi)]; } } while (0)
  f32x16 pA0, pA1, pB0, pB1; float mnA, mnB, alA, alB; bf16x8 pa0, pa1, pa2, pa3; const int NT = seq / KVBLK;
  constexpr int SE = 0, SO = 1;
  SLOAD(SE, 0); asm volatile("s_waitcnt vmcnt(0)" ::: "memory"); SWRITE(0, SE); __syncthreads();
  qkt(pA0, pA1, K_lds, qr, r32, hi); partialSM(pA0, pA1, m_reg, mnA, alA);
  SLOAD(SO, KVBLK); if (2 < NT) SLOAD(SE, 2 * KVBLK);
  SWRITE(1, SO); __syncthreads();
  for (int j = 1; j + 1 < NT; j += 2) {
    SBAR(); qkt(pB0, pB1, K_lds + SHM_K, qr, r32, hi);
    finishSM(pA0, pA1, alA, l_reg, pa0, pa1, pa2, pa3); SBAR();
    SLOAD(SO, (j + 2) * KVBLK); SBAR();
    pv_d0(o, vb0, pa0, pa1, pa2, pa3); partialSM(pB0, pB1, m_reg, mnB, alB);
    __syncthreads(); SWRITE(0, SE);
    RESC(alB); __syncthreads();
    SBAR(); qkt(pA0, pA1, K_lds, qr, r32, hi);
    finishSM(pB0, pB1, alB, l_reg, pa0, pa1, pa2, pa3); SBAR();
    if (j + 3 < NT) SLOAD(SE, (j + 3) * KVBLK); SBAR();
    pv_d0(o, vb0 + SHM_V, pa0, pa1, pa2, pa3); partialSM(pA0, pA1, m_reg, mnA, alA);
    __syncthreads(); SWRITE(1, SO);
    RESC(alA); __syncthreads();
  }
  SBAR(); qkt(pB0, pB1, K_lds + SHM_K, qr, r32, hi);
  finishSM(pA0, pA1, alA, l_reg, pa0, pa1, pa2, pa3); SBAR();
  pv_d0(o, vb0, pa0, pa1, pa2, pa3); partialSM(pB0, pB1, m_reg, mnB, alB);
  __syncthreads(); RESC(alB);
  finishSM(pB0, pB1, alB, l_reg, pa0, pa1, pa2, pa3); SBAR();
  pv_d0(o, vb0 + SHM_V, pa0, pa1, pa2, pa3);
  if (hi == 0) li_l[r32] = l_reg; asm volatile("s_waitcnt lgkmcnt(0)" ::: "memory");
  float rli[16];
#pragma unroll
  for (int r = 0; r < 16; ++r) rli[r] = __builtin_amdgcn_rcpf(li_l[crow(r, hi)]);
  bf16_t* Ow = Ob + (long)(wid * QBLK) * LDO;
#pragma unroll
  for (int r = 0; r < 16; ++r) { const int orow = crow(r, hi);
#pragma unroll
    for (int d0 = 0; d0 < 2; ++d0) Ow[(long)orow * LDO + d0 * 32 + r32] = f2bf(o[d0][r] * rli[r]); }
#undef SLOAD
#undef SWRITE
#undef RESC
}
}

DI void phase_attn(const bf16_t* Q, const bf16_t* KA, const bf16_t* VA, bf16_t* MIX, bool last, char* lds) {
    const int c = blockIdx.x, G = gridDim.x, NU = 2048 + (last ? 0 : 256);
    for (int L = c; L < NU; L += G) {
        int bh, seq; long qrow0;
        if (L < 2048) { int qb;
            if (G == 256) { const int i = L >> 8, cc = L & 255, xcd = cc & 7, slot = cc >> 3; bh = i * 32 + xcd * 4 + (slot >> 3); qb = slot & 7; }
            else { bh = L >> 3; qb = L & 7; }
            qrow0 = (long)(bh >> 3) * TT + TC + qb * 256; seq = TT; }
        else { bh = L - 2048; qrow0 = (long)(bh >> 3) * TT; seq = TC; }
        const int b = bh >> 3, h = bh & 7;
        att::attn_body(Q + qrow0 * 768 + h * 96, KA + (long)b * TT * 768 + h * 96, VA + (long)b * TT * 512 + h * 64, MIX + qrow0 * 1024 + h * 64, seq, lds);
        __syncthreads();
    }
}

DI float rowsum16(float x) {
    x += __int_as_float(__builtin_amdgcn_update_dpp(0, __float_as_int(x), 0x128, 0xf, 0xf, false));
    x += __int_as_float(__builtin_amdgcn_update_dpp(0, __float_as_int(x), 0x124, 0xf, 0xf, false));
    x += __int_as_float(__builtin_amdgcn_update_dpp(0, __float_as_int(x), 0x122, 0xf, 0xf, false));
    x += __int_as_float(__builtin_amdgcn_update_dpp(0, __float_as_int(x), 0x121, 0xf, 0xf, false));
    return x;
}
#define RS8_STEP(R) "v_add_f32_dpp %0, %0, %0 " R " row_mask:0xf bank_mask:0xf\n\tv_add_f32_dpp %1, %1, %1 " R " row_mask:0xf bank_mask:0xf\n\t" \
                    "v_add_f32_dpp %2, %2, %2 " R " row_mask:0xf bank_mask:0xf\n\tv_add_f32_dpp %3, %3, %3 " R " row_mask:0xf bank_mask:0xf\n\t" \
                    "v_add_f32_dpp %4, %4, %4 " R " row_mask:0xf bank_mask:0xf\n\tv_add_f32_dpp %5, %5, %5 " R " row_mask:0xf bank_mask:0xf\n\t" \
                    "v_add_f32_dpp %6, %6, %6 " R " row_mask:0xf bank_mask:0xf\n\tv_add_f32_dpp %7, %7, %7 " R " row_mask:0xf bank_mask:0xf\n\t"
DI void sum8x8(float& x0, float& x1, float& x2, float& x3, float& x4, float& x5, float& x6, float& x7) {
    asm volatile("s_nop 1\n\t" RS8_STEP("quad_perm:[1,0,3,2]") RS8_STEP("quad_perm:[2,3,0,1]") RS8_STEP("row_half_mirror")
                 : "+v"(x0), "+v"(x1), "+v"(x2), "+v"(x3), "+v"(x4), "+v"(x5), "+v"(x6), "+v"(x7));
}
typedef float f32x2 __attribute__((ext_vector_type(2)));
DI float dot8(const f32x2 (&s)[4], const f32x4& x0, const f32x4& x1) {
    f32x2 t = s[0] * (f32x2){x0[0], x0[1]};
    t = __builtin_elementwise_fma(s[1], (f32x2){x0[2], x0[3]}, t);
    t = __builtin_elementwise_fma(s[2], (f32x2){x1[0], x1[1]}, t);
    t = __builtin_elementwise_fma(s[3], (f32x2){x1[2], x1[3]}, t);
    return t.x + t.y;
}
DI int scan_row(int d, int b, int n) { const int tt = d == 0 ? n : (n < TC ? TC - 1 - n : TT + TC - 1 - n); return b * TT + tt; }
struct ScanStep { f32x4 a0, a1, w0, w1, b0, b1, k0, k1, q0, q1, v; float br, kr; };
DI void scan_ld(ScanStep& t, const float* p, const float* sc, int cgp, int vrow) {
    t.a0 = *(const f32x4*)(p + 8 * cgp); t.a1 = *(const f32x4*)(p + 8 * cgp + 4); t.w0 = *(const f32x4*)(p + 64 + 8 * cgp); t.w1 = *(const f32x4*)(p + 64 + 8 * cgp + 4);
    t.b0 = *(const f32x4*)(p + 128 + 8 * cgp); t.b1 = *(const f32x4*)(p + 128 + 8 * cgp + 4); t.k0 = *(const f32x4*)(p + 192 + 8 * cgp); t.k1 = *(const f32x4*)(p + 192 + 8 * cgp + 4);
    t.q0 = *(const f32x4*)(p + 256 + 8 * cgp); t.q1 = *(const f32x4*)(p + 256 + 8 * cgp + 4); t.v = *(const f32x4*)(p + 320 + vrow); t.br = sc[0]; t.kr = sc[1];
}
DI void phase_scan(const bf16_t* R, const bf16_t* Kk, const bf16_t* V, const __half* DEC, const bf16_t* AA, const float* INV, const float* kkp, const float* kap,
                   bf16_t* MIX, bf16_t* YB, char* lds) {
    const int tid = ltid(); const bool consumer = tid < 256;
    float* bufA = (float*)lds; float* ybufA = (float*)(lds + 98304); float* sbufA = (float*)(lds + 114688);
    constexpr int NCH = TT / 16;
    for (int s0 = blockIdx.x * 2; s0 < 512; s0 += gridDim.x * 2) {
        const int p_ = tid & 255, pst = p_ >> 4, pj0 = (p_ & 15) * 4;
        const int cw = tid >> 6, cgrp = (cw >> 1) & 1, ws_ = cw & 1, lane = tid & 63, rgl = lane >> 3, cgp = lane & 7, vrow = ws_ * 32 + rgl * 4;
        f32x2 S[4][4];
#pragma unroll
        for (int i = 0; i < 4; ++i)
#pragma unroll
            for (int j = 0; j < 4; ++j) S[i][j] = (f32x2){0.f, 0.f};
#define PRODUCE(c, bsel) do { _Pragma("unroll") for (int gq = 0; gq < 2; ++gq) { \
            const int sid = s0 + gq, d = sid >> 8, b = (sid >> 3) & 31, h = sid & 7, hc = h * 64 + pj0; \
            const size_t m_ = (size_t)scan_row(d, b, (c) * 16 + pst); \
            const u32x2 lr = *(const u32x2*)(R + m_ * 512 + hc), lk = *(const u32x2*)(Kk + m_ * 512 + hc), lv = *(const u32x2*)(V + m_ * 512 + hc), \
                        ld_ = *(const u32x2*)(DEC + m_ * 1024 + d * 512 + hc), la = *(const u32x2*)(AA + m_ * 1024 + d * 512 + hc); const float linv = INV[m_ * 8 + h]; \
            const f32x4 kk4 = *(const f32x4*)(kkp + hc), ka4 = *(const f32x4*)(kap + hc); \
            float* q_ = bufA + gq * 12288 + (bsel) * 6144 + pst * 384 + pj0; float* sd_ = sbufA + gq * 64 + (bsel) * 32; \
            const float k0 = bflo(lk.x), k1 = bfhi(lk.x), k2 = bflo(lk.y), k3 = bfhi(lk.y), a0 = bflo(la.x), a1 = bfhi(la.x), a2 = bflo(la.y), a3 = bfhi(la.y); \
            const float q0 = k0 * kk4[0] * linv, q1 = k1 * kk4[1] * linv, q2 = k2 * kk4[2] * linv, q3 = k3 * kk4[3] * linv; \
            const float w0 = __builtin_amdgcn_exp2f(h2f(ld_.x & 0xffffu)), w1 = __builtin_amdgcn_exp2f(h2f(ld_.x >> 16)), w2 = __builtin_amdgcn_exp2f(h2f(ld_.y & 0xffffu)), w3 = __builtin_amdgcn_exp2f(h2f(ld_.y >> 16)); \
            const float r0 = bflo(lr.x), r1 = bfhi(lr.x), r2 = bflo(lr.y), r3 = bfhi(lr.y); \
            const float b0 = q0 * a0, b1 = q1 * a1, b2 = q2 * a2, b3 = q3 * a3; \
            const float d0 = k0 * (1.f + (a0 - 1.f) * ka4[0]), d1 = k1 * (1.f + (a1 - 1.f) * ka4[1]), d2 = k2 * (1.f + (a2 - 1.f) * ka4[2]), d3 = k3 * (1.f + (a3 - 1.f) * ka4[3]); \
            *(f32x4*)(q_) = (f32x4){-q0, -q1, -q2, -q3}; \
            *(f32x4*)(q_ + 64) = (f32x4){w0, w1, w2, w3}; \
            *(f32x4*)(q_ + 128) = (f32x4){b0, b1, b2, b3}; \
            *(f32x4*)(q_ + 192) = (f32x4){d0, d1, d2, d3}; \
            *(f32x4*)(q_ + 256) = (f32x4){w0 * r0, w1 * r1, w2 * r2, w3 * r3}; \
            *(f32x4*)(q_ + 320) = (f32x4){bflo(lv.x), bfhi(lv.x), bflo(lv.y), bfhi(lv.y)}; \
            const float br_ = rowsum16(b0 * r0 + b1 * r1 + b2 * r2 + b3 * r3), kr_ = rowsum16(d0 * r0 + d1 * r1 + d2 * r2 + d3 * r3); \
            if ((p_ & 15) == 0) { sd_[pst * 2] = br_; sd_[pst * 2 + 1] = kr_; } } } while (0)
#define OUTPUT(c, bsel) do { _Pragma("unroll") for (int gq = 0; gq < 2; ++gq) { \
            const int sid = s0 + gq, d = sid >> 8, b = (sid >> 3) & 31, h = sid & 7, hc = h * 64 + pj0; \
            const f32x4 yv = *(const f32x4*)(ybufA + gq * 2048 + (bsel) * 1024 + pst * 64 + pj0); const size_t m_ = (size_t)scan_row(d, b, (c) * 16 + pst); \
            u32x2 w; w.x = cvtpk(yv[0], yv[1]); w.y = cvtpk(yv[2], yv[3]); \
            if (d == 0) *(u32x2*)(MIX + m_ * 1024 + 512 + hc) = w; else *(u32x2*)(YB + m_ * 512 + hc) = w; } } while (0)
        if (!consumer) PRODUCE(0, 0);
        __syncthreads();
        for (int c = 0; c < NCH; ++c) {
            if (consumer) {
                const float* cur = bufA + cgrp * 12288 + (c & 1) * 6144; float* yb = ybufA + cgrp * 2048 + (c & 1) * 1024; const float* sc = sbufA + cgrp * 64 + (c & 1) * 32;
                ScanStep t; scan_ld(t, cur, sc, cgp, vrow);
#pragma unroll 2
                for (int st = 0; st < 16; ++st) {
                    ScanStep n; scan_ld(n, cur + (st + 1) * 384, sc + (st + 1) * 2, cgp, vrow);
                    float sa0 = dot8(S[0], t.a0, t.a1), sa1 = dot8(S[1], t.a0, t.a1), sa2 = dot8(S[2], t.a0, t.a1), sa3 = dot8(S[3], t.a0, t.a1);
                    float z0 = dot8(S[0], t.q0, t.q1), z1 = dot8(S[1], t.q0, t.q1), z2 = dot8(S[2], t.q0, t.q1), z3 = dot8(S[3], t.q0, t.q1);
                    sum8x8(sa0, sa1, sa2, sa3, z0, z1, z2, z3);
                    const f32x2 w01 = {t.w0[0], t.w0[1]}, w23 = {t.w0[2], t.w0[3]}, w45 = {t.w1[0], t.w1[1]}, w67 = {t.w1[2], t.w1[3]};
                    const f32x2 b01 = {t.b0[0], t.b0[1]}, b23 = {t.b0[2], t.b0[3]}, b45 = {t.b1[0], t.b1[1]}, b67 = {t.b1[2], t.b1[3]};
                    const f32x2 k01 = {t.k0[0], t.k0[1]}, k23 = {t.k0[2], t.k0[3]}, k45 = {t.k1[0], t.k1[1]}, k67 = {t.k1[2], t.k1[3]};
                    const float sa[4] = {sa0, sa1, sa2, sa3};
                    const f32x2 wv[4] = {w01, w23, w45, w67}, bv[4] = {b01, b23, b45, b67}, kv[4] = {k01, k23, k45, k67};
#pragma unroll
                    for (int i = 0; i < 4; ++i)
#pragma unroll
                        for (int j = 0; j < 4; ++j) S[i][j] = S[i][j] * wv[j];
#pragma unroll
                    for (int i = 0; i < 4; ++i) { const f32x2 s2 = {sa[i], sa[i]};
#pragma unroll
                        for (int j = 0; j < 4; ++j) S[i][j] = __builtin_elementwise_fma(s2, bv[j], S[i][j]); }
#pragma unroll
                    for (int i = 0; i < 4; ++i) { const f32x2 v2 = {t.v[i], t.v[i]};
#pragma unroll
                        for (int j = 0; j < 4; ++j) S[i][j] = __builtin_elementwise_fma(v2, kv[j], S[i][j]); }
                    if (cgp == 0) *(f32x4*)(yb + st * 64 + vrow) = (f32x4){z0 + sa0 * t.br + t.v[0] * t.kr, z1 + sa1 * t.br + t.v[1] * t.kr, z2 + sa2 * t.br + t.v[2] * t.kr, z3 + sa3 * t.br + t.v[3] * t.kr};
                    t = n;
                }
            } else {
                if (c + 1 < NCH) PRODUCE(c + 1, (c + 1) & 1);
                if (c > 0) OUTPUT(c - 1, (c - 1) & 1);
            }
            __syncthreads();
        }
        if (!consumer) OUTPUT(NCH - 1, (NCH - 1) & 1);
        __syncthreads();
#undef PRODUCE
#undef OUTPUT
    }
}

DI void phase_prologue(const Args& a, unsigned char* lds) {
    const int tid = ltid(), G = gridDim.x;
    float* out = a.out; float* xc = (float*)(a.ws + WS_XC);
    if (blockIdx.x == 0) {
        float* rope = (float*)(a.ws + WS_ROPE); const int pos = tid >> 3, j = tid & 7;
        const float inv_freq = powf(10000.f, -(float)j / 8.f), ang = (float)pos * inv_freq;
        rope[tid] = cosf(ang); rope[512 + tid] = sinf(ang);
    }
    float* sv = (float*)lds; float* red = sv + 33 * 1024;
    for (int i = tid; i < 33 * 1024; i += 512) { const float v = i < 32 * 1024 ? a.in[I_C][i] : a.in[I_CCTX][i - 32 * 1024]; sv[i] = v / (1.f + __expf(-v)); }
    __syncthreads();
    const int wave = tid >> 6, lane = tid & 63;
    float* mods = (float*)(a.ws + WS_MODS);
    for (int it = blockIdx.x; it < NL * 96; it += G) {
        const int l = it / 96, n0 = (it - l * 96) * 64;
        const float* w = a.in[I_ADAW] + (size_t)l * 1024 * 6144 + n0 + lane;
        float acc[33];
#pragma unroll
        for (int r = 0; r < 33; ++r) acc[r] = 0.f;
        for (int k = wave * 128; k < wave * 128 + 128; k += 8) { float wv[8];
#pragma unroll
            for (int u = 0; u < 8; ++u) wv[u] = w[(size_t)(k + u) * 6144];
#pragma unroll
            for (int u = 0; u < 8; ++u)
#pragma unroll
                for (int r = 0; r < 33; ++r) acc[r] += sv[r * 1024 + k + u] * wv[u]; }
        for (int i = tid; i < 33 * 64; i += 512) red[i] = 0.f;
        __syncthreads();
        for (int ww = 0; ww < 8; ++ww) { if (wave == ww) {
#pragma unroll
                for (int r = 0; r < 33; ++r) red[r * 64 + lane] += acc[r]; }
            __syncthreads(); }
        for (int i = tid; i < 33 * 64; i += 512) { const int r = i >> 6, n = n0 + (i & 63); mods[((size_t)l * 33 + r) * 6144 + n] = red[i] + a.in[I_ADAB][l * 6144 + n]; }
        __syncthreads();
    }
}

template <class Gt> DI void cvt_tile(bf16_t* __restrict__ dst, int ldk, int n0, int k0, const Gt& get, float*) {
    const int lane = ltid() & 63, n = n0 + lane;
#pragma unroll
    for (int ch = 0; ch < 4; ++ch) { float v[16];
#pragma unroll
        for (int kk = 0; kk < 16; ++kk) v[kk] = get(n, k0 + ch * 16 + kk);
        u32x4 w0, w1; w0.x = cvtpk(v[0], v[1]); w0.y = cvtpk(v[2], v[3]); w0.z = cvtpk(v[4], v[5]); w0.w = cvtpk(v[6], v[7]);
        w1.x = cvtpk(v[8], v[9]); w1.y = cvtpk(v[10], v[11]); w1.z = cvtpk(v[12], v[13]); w1.w = cvtpk(v[14], v[15]);
        bf16_t* p = dst + (size_t)n * ldk + k0 + ch * 16; *(u32x4*)p = w0; *(u32x4*)(p + 8) = w1; }
}
DI void convert_weights(const Args& a, int l, unsigned char* lds) {
    float* tl = (float*)lds; unsigned char* ws = a.ws;
    const float* w_in = a.in[I_WIN] + (size_t)l * 1024 * CIN; const float* v1 = a.in[I_V1] + (size_t)(l > 0 ? l - 1 : 0) * 1024 * 32;
    const float* w_uq = a.in[I_WUQ] + (size_t)l * 256 * 768; const float* w_ukv = a.in[I_WUKV] + (size_t)l * 128 * 1024;
    const float* w2 = a.in[I_W2] + (size_t)l * 2 * 64 * 512; const float* a2 = a.in[I_A2] + (size_t)l * 2 * 64 * 512;
    const float* g2 = a.in[I_G2] + (size_t)l * 128 * 512; const float* v2 = a.in[I_V2] + (size_t)(l > 0 ? l - 1 : 0) * 32 * 512;
    const float* w_out = a.in[I_WOUT] + (size_t)l * 1024 * 1024; const float* m1 = a.in[I_M1] + (size_t)l * 1024 * 4096; const float* m2 = a.in[I_M2] + (size_t)l * 4096 * 1024;
    constexpr int T0 = 640, T1 = T0 + 48, T2 = T1 + 64, T3 = T2 + 128, T4 = T3 + 64, T5 = T4 + 256, T6 = T5 + 1024, T7 = T6 + 1024;
    for (int t = blockIdx.x * 8 + (ltid() >> 6); t < T7; t += gridDim.x * 8) {
        if (t < T0) { const int nt = t >> 4, kt = t & 15;
            cvt_tile((bf16_t*)(ws + WT_IN), 1024, nt * 64, kt * 64, [&](int n, int k) -> float { return n < CIN ? w_in[(size_t)k * CIN + n] : ((n < CINX && l > 0) ? v1[k * 32 + (n - CIN)] : 0.f); }, tl); }
        else if (t < T1) { const int u = t - T0, nt = u >> 2, kt = u & 3;
            cvt_tile((bf16_t*)(ws + WT_UQ), 256, nt * 64, kt * 64, [&](int n, int k) -> float { return w_uq[k * 768 + n]; }, tl); }
        else if (t < T2) { const int u = t - T1, nt = u >> 2, kt = u & 3;
            cvt_tile((bf16_t*)(ws + WT_UKV), 256, nt * 64, kt * 64, [&](int n, int k) -> float { return k < 128 ? w_ukv[k * 1024 + n] : 0.f; }, tl); }
        else if (t < T3) { const int u = t - T2, nt = u >> 2, kt = u & 3;
            cvt_tile((bf16_t*)(ws + WT_L1), 256, nt * 64, kt * 64, [&](int n, int k) -> float {
                if (n < 1024) { const int d = n >> 9, c = n & 511; return (k < 128 && (k >> 6) == d) ? w2[(d * 64 + (k & 63)) * 512 + c] : 0.f; }
                const int n2 = n - 1024, d = n2 >> 9, c = n2 & 511; return (k >= 128 && ((k - 128) >> 6) == d) ? a2[(d * 64 + ((k - 128) & 63)) * 512 + c] : 0.f; }, tl); }
        else if (t < T4) { const int u = t - T3, nt = u >> 2, kt = u & 3;
            cvt_tile((bf16_t*)(ws + WT_L2), 256, nt * 64, kt * 64, [&](int n, int k) -> float {
                if (n < 512) return k < 128 ? g2[k * 512 + n] : 0.f;
                return (l > 0 && k >= 128 && k < 160) ? v2[(k - 128) * 512 + (n - 512)] : 0.f; }, tl); }
        else if (t < T5) { const int u = t - T4, nt = u >> 4, kt = u & 15;
            cvt_tile((bf16_t*)(ws + WT_OUT), 1024, nt * 64, kt * 64, [&](int n, int k) -> float { return w_out[(size_t)k * 1024 + n]; }, tl); }
        else if (t < T6) { const int u = t - T5, nt = u >> 4, kt = u & 15;
            cvt_tile((bf16_t*)(ws + WT_M1), 1024, nt * 64, kt * 64, [&](int n, int k) -> float { return m1[(size_t)k * 4096 + n]; }, tl); }
        else { const int u = t - T6, nt = u >> 6, kt = u & 63;
            cvt_tile((bf16_t*)(ws + WT_M2), 4096, nt * 64, kt * 64, [&](int n, int k) -> float { return m2[(size_t)k * 1024 + n]; }, tl); }
    }
}

DI void phase_norm(const Args& a, int l, const float* __restrict__ gamma, int shift_idx, int scale_idx, bool latent_only, bool from_input) {
    const int lane = ltid() & 63, gw = blockIdx.x * 8 + (ltid() >> 6), nw = gridDim.x * 8;
    float* xc = from_input ? (float*)a.in[I_CTX] : (float*)(a.ws + WS_XC); float* xo = from_input ? (float*)a.in[I_X] : a.out;
    bf16_t* __restrict__ H = (bf16_t*)(a.ws + WS_H); const float* __restrict__ mods = (const float*)(a.ws + WS_MODS) + (size_t)l * 33 * 6144;
    const int nrows = latent_only ? NB * SEQ : TALL;
    auto rowof = [&](int i) -> int { return latent_only ? (i >> 11) * TT + TC + (i & 2047) : i; };
    f32x4 v[4], nv[4];
    int i = gw;
    if (i < nrows) { const float* xr = xrow(xo, xc, rowof(i));
#pragma unroll
        for (int q = 0; q < 4; ++q) v[q] = *(const f32x4*)(xr + q * 256 + lane * 4); }
    for (; i < nrows; i += nw) {
        const int m = rowof(i), b = m / TT, tt = m - b * TT; const bool ctx = tt < TC;
        const bool hn = i + nw < nrows;
        if (hn) { const float* xn = xrow(xo, xc, rowof(i + nw));
#pragma unroll
            for (int q = 0; q < 4; ++q) nv[q] = *(const f32x4*)(xn + q * 256 + lane * 4); }
        const float* md = mods + (size_t)(ctx ? 32 : b) * 6144;
        float ss = 0.f;
#pragma unroll
        for (int q = 0; q < 4; ++q) ss += v[q][0] * v[q][0] + v[q][1] * v[q][1] + v[q][2] * v[q][2] + v[q][3] * v[q][3];
#pragma unroll
        for (int k = 1; k < 64; k <<= 1) ss = xorsum(ss, k);
        const float rstd = rsqrtf(ss * (1.f / 1024.f) + 1e-6f);
#pragma unroll
        for (int q = 0; q < 4; ++q) { const int col = q * 256 + lane * 4; const f32x4 g = *(const f32x4*)(gamma + col), sc = *(const f32x4*)(md + scale_idx * 1024 + col), sh = *(const f32x4*)(md + shift_idx * 1024 + col);
            float o[4];
#pragma unroll
            for (int j = 0; j < 4; ++j) o[j] = v[q][j] * rstd * g[j] * (1.f + sc[j]) + sh[j];
            u32x2 w; w.x = cvtpk(o[0], o[1]); w.y = cvtpk(o[2], o[3]); *(u32x2*)(H + (size_t)m * 1024 + col) = w; }
#pragma unroll
        for (int q = 0; q < 4; ++q) v[q] = nv[q];
    }
}

DI void unpack8(const u32x4& w, float (&f)[8]) { f[0] = bflo(w.x); f[1] = bfhi(w.x); f[2] = bflo(w.y); f[3] = bfhi(w.y); f[4] = bflo(w.z); f[5] = bfhi(w.z); f[6] = bflo(w.w); f[7] = bfhi(w.w); }
DI void shift8r(const u32x4& c_, const u32x4& p_, const u32x4& n_, const float* __restrict__ mu, int col, float (&o)[8]) {
    float c[8], p[8], n[8], u[8]; unpack8(c_, c); unpack8(p_, p); unpack8(n_, n); loadf8(mu + (col - OFF_R), u);
#pragma unroll
    for (int j = 0; j < 8; ++j) o[j] = c[j] + u[j] * (0.5f * (p[j] + n[j]) - c[j]);
}
DI void phase_split(const Args& a, int l) {
    const int lane = ltid() & 63, gw = blockIdx.x * 8 + (ltid() >> 6), nw = gridDim.x * 8;
    unsigned char* ws = a.ws;
    const bf16_t* __restrict__ F = (const bf16_t*)(ws + WS_F); bf16_t* __restrict__ R = (bf16_t*)(ws + WS_R); bf16_t* __restrict__ Kb = (bf16_t*)(ws + WS_K); bf16_t* __restrict__ Vb = (bf16_t*)(ws + (l == 0 ? WS_VF : WS_V));
    bf16_t* __restrict__ A1 = (bf16_t*)(ws + WS_A1); bf16_t* __restrict__ A2 = (bf16_t*)(ws + WS_A2); bf16_t* __restrict__ CQN = (bf16_t*)(ws + WS_CQN); bf16_t* __restrict__ CKVN = (bf16_t*)(ws + WS_CKVN); bf16_t* __restrict__ KA = (bf16_t*)(ws + WS_KATT);
    float* __restrict__ INV = (float*)(ws + WS_INV); const float* __restrict__ rope = (const float*)(ws + WS_ROPE);
    const float* __restrict__ mu = a.in[I_MU] + (size_t)l * 1920; const float* __restrict__ kkp = a.in[I_KK] + l * 512; const float* __restrict__ qg = a.in[I_QNG] + l * 256; const float* __restrict__ kvg = a.in[I_KVNG] + l * 128;
    const u32x4 zero4 = {0u, 0u, 0u, 0u};
    const int lcol = lane < 48 ? OFF_WLO + lane * 8 : (lane < 52 ? OFF_HV + (lane - 48) * 8 : 0);
    const int mcol = lane < 32 ? lane * 8 : (lane < 48 ? 256 + (lane - 32) * 8 : 384 + ((lane - 48) & 3) * 8);
    const int chunk = (TALL + nw - 1) / nw, m0 = gw * chunk, m1 = (m0 + chunk < TALL) ? m0 + chunk : TALL;
    struct Raw { u32x4 r, k, v, l; };
    auto ld4 = [&](int m) -> Raw { Raw t; if (m >= 0 && m < TALL) { const bf16_t* Fq = F + (size_t)m * CINX; t.r = *(const u32x4*)(Fq + OFF_R + lane * 8); t.k = *(const u32x4*)(Fq + OFF_K + lane * 8);
            t.v = *(const u32x4*)(Fq + OFF_V + lane * 8); t.l = (lane < 52) ? *(const u32x4*)(Fq + lcol) : zero4; } else { t.r = zero4; t.k = zero4; t.v = zero4; t.l = zero4; } return t; };
    auto ldm = [&](int m) -> u32x4 { return (m < TALL) ? *(const u32x4*)(F + (size_t)m * CINX + mcol) : zero4; };
    Raw P = ld4(m0 - 1), C = ld4(m0), N = ld4(m0 + 1); u32x4 M = ldm(m0);
    for (int m = m0; m < m1; ++m) {
        const int b = m / TT, tt = m - b * TT; const bool ctx = tt < TC;
        const bool pok = !(tt == 0 || tt == TC), nok = !(tt == TC - 1 || tt == TT - 1);
        const Raw NN = ld4(m + 2); const u32x4 MN = ldm(m + 1);
        u32x4 rc = C.r, kc = C.k, vc = C.v, lc = C.l, rp = P.r, kp = P.k, vp = P.v, lp = P.l, rn = N.r, kn = N.k, vn = N.v, ln = N.l; const u32x4 mc = M;
        if (!pok) { rp = zero4; kp = zero4; vp = zero4; lp = zero4; }
        if (!nok) { rn = zero4; kn = zero4; vn = zero4; ln = zero4; }
        P = C; C = N; N = NN; M = MN;
        float x[8];
        shift8r(rc, rp, rn, mu, OFF_R + lane * 8, x); store8(R + (size_t)m * 512 + lane * 8, x);
        shift8r(kc, kp, kn, mu, OFF_K + lane * 8, x); store8(Kb + (size_t)m * 512 + lane * 8, x);
        { float kq[8], ss = 0.f; loadf8(kkp + lane * 8, kq);
#pragma unroll
          for (int j = 0; j < 8; ++j) { const float t = x[j] * kq[j]; ss += t * t; }
          ss = xorsum(ss, 1); ss = xorsum(ss, 2); ss = xorsum(ss, 4);
          if ((lane & 7) == 0) INV[(size_t)m * 8 + (lane >> 3)] = 1.f / fmaxf(sqrtf(ss), 1e-12f); }
        shift8r(vc, vp, vn, mu, OFF_V + lane * 8, x); store8(Vb + (size_t)m * 512 + lane * 8, x);
        if (lane < 48) { shift8r(lc, lp, ln, mu, lcol, x);
            if (lane < 16) {
#pragma unroll
                for (int j = 0; j < 8; ++j) x[j] = tanhf(x[j]); }
            else if (lane >= 32) {
#pragma unroll
                for (int j = 0; j < 8; ++j) x[j] = sigmoidf_(x[j]); }
            if (lane < 32) store8(A1 + (size_t)m * 256 + lane * 8, x); else store8(A2 + (size_t)m * 256 + (lane - 32) * 8, x); }
        else { unpack8(lc, x); store8(A2 + (size_t)m * 256 + 128 + (lane - 48) * 8, x); }
        { unpack8(mc, x); float ss = 0.f;
#pragma unroll
          for (int j = 0; j < 8; ++j) ss += x[j] * x[j];
          ss = xorsum(ss, 1); ss = xorsum(ss, 2); ss = xorsum(ss, 4); ss = xorsum(ss, 8); const float ss32 = xorsum(ss, 16);
          float px[8]; const int q = (lane - 48) & 3;
#pragma unroll
          for (int j = 0; j < 8; ++j) px[j] = __shfl_xor(x[j], 1, 64);
          if (lane < 32) { const float rstd = rsqrtf(ss32 * (1.f / 256.f) + 1e-6f); float g[8]; loadf8(qg + lane * 8, g);
#pragma unroll
              for (int j = 0; j < 8; ++j) x[j] = x[j] * rstd * g[j];
              store8(CQN + (size_t)m * 256 + lane * 8, x); }
          else if (lane < 48) { const float rstd = rsqrtf(ss * (1.f / 128.f) + 1e-6f); float g[8]; loadf8(kvg + (lane - 32) * 8, g);
#pragma unroll
              for (int j = 0; j < 8; ++j) x[j] = x[j] * rstd * g[j];
              store8(CKVN + (size_t)m * 256 + (lane - 32) * 8, x); }
          else { if (lane < 52) {
                  if (!ctx) { const int s = tt - TC, pos = (q < 2) ? (s >> 6) : (s & 63); float cs[8], sn[8]; loadf8(rope + pos * 8, cs); loadf8(rope + 512 + pos * 8, sn); const float sg = (q & 1) ? 1.f : -1.f;
#pragma unroll
                      for (int j = 0; j < 8; ++j) x[j] = x[j] * cs[j] + sg * px[j] * sn[j]; }
#pragma unroll
                  for (int hh = 0; hh < 8; ++hh) store8(KA + (size_t)m * 768 + hh * 96 + 64 + q * 8, x); }
              float z[8];
#pragma unroll
              for (int j = 0; j < 8; ++j) z[j] = 0.f;
              store8(CKVN + (size_t)m * 256 + 128 + (lane - 48) * 8, z); } }
    }
}

DI void phase_rwkv_out(const Args& a, int l, bool latent_only) {
    const int lane = ltid() & 63, gw = blockIdx.x * 8 + (ltid() >> 6), nw = gridDim.x * 8;
    unsigned char* ws = a.ws;
    const bf16_t* R = (const bf16_t*)(ws + WS_R); const bf16_t* Kb = (const bf16_t*)(ws + WS_K); const bf16_t* Vb = (const bf16_t*)(ws + (l == 0 ? WS_VF : WS_V));
    const bf16_t* AA = (const bf16_t*)(ws + WS_AA); const bf16_t* Gb = (const bf16_t*)(ws + WS_G); const bf16_t* YB = (const bf16_t*)(ws + WS_YB); bf16_t* MIX = (bf16_t*)(ws + WS_MIX);
    const int c = lane * 8; float ka[8], rk[8], lw[8], lb[8];
    loadf8(a.in[I_KA] + l * 512 + c, ka); loadf8(a.in[I_RK] + l * 512 + c, rk); loadf8(a.in[I_LNW] + l * 512 + c, lw); loadf8(a.in[I_LNB] + l * 512 + c, lb);
    for (int m = gw; m < TALL; m += nw) {
        const int tt = m % TT; if (latent_only && tt < TC) continue;
        float yf[8], yb[8], r[8], k[8], v[8], a0[8], a1[8], g[8];
        load8(MIX + (size_t)m * 1024 + 512 + c, yf); load8(YB + (size_t)m * 512 + c, yb); load8(R + (size_t)m * 512 + c, r); load8(Kb + (size_t)m * 512 + c, k); load8(Vb + (size_t)m * 512 + c, v);
        load8(AA + (size_t)m * 1024 + c, a0); load8(AA + (size_t)m * 1024 + 512 + c, a1); load8(Gb + (size_t)m * 512 + c, g);
        float s = 0.f, bon = 0.f;
#pragma unroll
        for (int j = 0; j < 8; ++j) { yf[j] += yb[j]; s += yf[j]; bon += r[j] * k[j] * (2.f + (a0[j] + a1[j] - 2.f) * ka[j]) * rk[j]; }
        s = xorsum(s, 1); s = xorsum(s, 2); s = xorsum(s, 4); bon = xorsum(bon, 1); bon = xorsum(bon, 2); bon = xorsum(bon, 4);
        const float mean = s * (1.f / 64.f); float vs = 0.f;
#pragma unroll
        for (int j = 0; j < 8; ++j) { yf[j] -= mean; vs += yf[j] * yf[j]; }
        vs = xorsum(vs, 1); vs = xorsum(vs, 2); vs = xorsum(vs, 4);
        const float rstd = rsqrtf(vs * (1.f / 64.f) + 64e-5f);
#pragma unroll
        for (int j = 0; j < 8; ++j) yf[j] = (yf[j] * rstd * lw[j] + lb[j] + bon * v[j]) * g[j];
        store8(MIX + (size_t)m * 1024 + 512 + c, yf);
    }
}

DI void phase_final(const Args& a) {
    const int lane = ltid() & 63, gw = blockIdx.x * 8 + (ltid() >> 6), nw = gridDim.x * 8; const float* gamma = a.in[I_FG];
    for (int m = gw; m < NB * SEQ; m += nw) {
        float* xr = a.out + (size_t)m * DM; f32x4 v[4]; float ss = 0.f;
#pragma unroll
        for (int i = 0; i < 4; ++i) { v[i] = *(const f32x4*)(xr + i * 256 + lane * 4); ss += v[i][0] * v[i][0] + v[i][1] * v[i][1] + v[i][2] * v[i][2] + v[i][3] * v[i][3]; }
#pragma unroll
        for (int k = 1; k < 64; k <<= 1) ss = xorsum(ss, k);
        const float rstd = rsqrtf(ss * (1.f / 1024.f) + 1e-6f);
#pragma unroll
        for (int i = 0; i < 4; ++i) { const int col = i * 256 + lane * 4; const f32x4 g = *(const f32x4*)(gamma + col); *(f32x4*)(xr + col) = v[i] * rstd * g; }
    }
}

#define LAS __attribute__((address_space(3)))
#define XB_TMO      128
#define XB_XCNT(j)  (256  + 64 * (j))
#define XB_XSUB(j)  (1280 + 64 * (j))
#define XB_XGEN(j)  (2304 + 64 * (j))
#define XB_TOP      3328
#define XB_TOPGEN   3392
#define XCD_BAR_WORDS 3456
#define XB_SPIN_CAP (1u << 18)

__device__ __forceinline__ unsigned xb_ld(unsigned* p)              { return __hip_atomic_load(p, __ATOMIC_RELAXED, __HIP_MEMORY_SCOPE_AGENT); }
__device__ __forceinline__ unsigned xb_add(unsigned* p, unsigned v) { return __hip_atomic_fetch_add(p, v, __ATOMIC_RELAXED, __HIP_MEMORY_SCOPE_AGENT); }
__device__ __forceinline__ unsigned xb_xcc_id() { return (unsigned)__builtin_amdgcn_s_getreg((3 << 11) | 20) & 0xFu; }
#define XB_SPIN(cond, bar) do { unsigned _sp = 0; while (cond) { __builtin_amdgcn_s_sleep(1); \
    if ((++_sp & 255u) == 0u) { if (xb_ld(&(bar)[XB_TMO])) break; if (_sp > XB_SPIN_CAP) { atomicAdd(&(bar)[XB_TMO], 1u); break; } } } } while (0)

struct XcdBarrier {
    unsigned* bar; unsigned x;
    volatile LAS unsigned* st;
};

__device__ __forceinline__ XcdBarrier xcd_barrier_post(unsigned* bar, volatile LAS unsigned* st) {
    XcdBarrier b; b.bar = bar; b.x = xb_xcc_id(); b.st = st;
    if (threadIdx.x == 0) (void)xb_add(&bar[XB_XCNT(b.x)], 1u);
    return b;
}
__device__ __forceinline__ void xcd_barrier_complete(unsigned* bar, unsigned x, unsigned& nloc, unsigned& nx) {
    const unsigned G = gridDim.x * gridDim.y * gridDim.z;
    unsigned sum, cnt, mine, sp = 0u;
    for (;;) {
        sum = 0u; cnt = 0u; mine = 0u;
#pragma unroll
        for (unsigned j = 0; j < 16; ++j) { const unsigned c = xb_ld(&bar[XB_XCNT(j)]); sum += c; cnt += (c > 0u) ? 1u : 0u; mine = (j == x) ? c : mine; }
        if (sum == G) break;
        __builtin_amdgcn_s_sleep(1);
        if ((++sp & 255u) == 0u) { if (xb_ld(&bar[XB_TMO])) break; if (sp > XB_SPIN_CAP) { atomicAdd(&bar[XB_TMO], 1u); break; } }
    }
    nloc = mine > 0u ? mine : 1u; nx = cnt > 0u ? cnt : 1u;
}

__device__ __forceinline__ void xcd_barrier(const XcdBarrier& b) {
    asm volatile("s_waitcnt vmcnt(0)" ::: "memory");
    __syncthreads();
    if (threadIdx.x == 0) {
        unsigned* bar = b.bar;
        __builtin_amdgcn_s_waitcnt(0);
        unsigned nloc = b.st[0], nx = b.st[1];
        if (nloc == 0u) { xcd_barrier_complete(bar, b.x, nloc, nx); b.st[0] = nloc; b.st[1] = nx; }
        const unsigned old = xb_add(&bar[XB_XSUB(b.x)], 1u);
        const unsigned gen = old / nloc;
        if (old + 1u == (gen + 1u) * nloc) {
            __builtin_amdgcn_fence(__ATOMIC_RELEASE, "agent");
            asm volatile("s_waitcnt vmcnt(0)" ::: "memory");
            const unsigned og = xb_add(&bar[XB_TOP], 1u);
            const unsigned tg = og / nx;
            if (og + 1u == (tg + 1u) * nx) xb_add(&bar[XB_TOPGEN], 1u);
            else XB_SPIN(xb_ld(&bar[XB_TOPGEN]) == tg, bar);
            __builtin_amdgcn_fence(__ATOMIC_ACQUIRE, "agent");
            xb_add(&bar[XB_XGEN(b.x)], 1u);
            asm volatile("s_waitcnt vmcnt(0)" ::: "memory");
        } else {
            XB_SPIN(xb_ld(&bar[XB_XGEN(b.x)]) == gen, bar);
            __builtin_amdgcn_fence(__ATOMIC_ACQUIRE, "agent");
            asm volatile("s_waitcnt vmcnt(0)" ::: "memory");
        }
    }
    __syncthreads();
}

#ifndef DUPMASK
#define DUPMASK 0
#endif
#ifndef SUBM
#define SUBM 3
#endif
#ifndef PHMASK
#define PHMASK 0xfff
#endif
__global__ void __launch_bounds__(512, 2) trunk_fwd(Args ka) {
    extern __shared__ __attribute__((aligned(16))) unsigned char lds[];
    cg::grid_group grid = cg::this_grid();
    volatile LAS unsigned* bst = (volatile LAS unsigned*)((LAS unsigned char*)lds + (LDS_BYTES - 16));
    if (threadIdx.x < 4) bst[threadIdx.x] = 0u;
    __syncthreads();
    XcdBarrier xbar = xcd_barrier_post((unsigned*)(ka.ws + WS_BAR), bst);
    const int ph_lo = ka.lo, ph_hi = ka.hi;
    for (int ph = ph_lo; ph < ph_hi; ++ph) {
        Args a = ka; asm volatile("" : "+s"(a.ws)); asm volatile("" : "+s"(a.out));
        unsigned char* ws = a.ws;
        if (ph == 0) phase_prologue(a, lds);
        else if (ph == NPH - 1) phase_final(a);
        else {
            const int l = (ph - 1) / 12, s = (ph - 1) % 12; const bool last = (l == NL - 1);
            const float* mods = (const float*)(ws + WS_MODS) + (size_t)l * 33 * 6144;
            if (s == 0 && ((PHMASK >> 0) & 1)) for (int rep_ = 0; rep_ < (((DUPMASK >> 0) & 1) ? 2 : 1); ++rep_) { convert_weights(a, l, lds); phase_norm(a, l, a.in[I_N1G] + l * 1024, 0, 1, false, l == 0); }
            if (s == 1 && ((PHMASK >> 1) & 1)) for (int rep_ = 0; rep_ < (((DUPMASK >> 1) & 1) ? 2 : 1); ++rep_) { run_gemm<NIN, 1024>(lds, (const bf16_t*)(ws + WS_H), (const bf16_t*)(ws + WT_IN), 0, FnF{(bf16_t*)(ws + WS_F)}); }
            if (s == 2 && ((PHMASK >> 2) & 1)) for (int rep_ = 0; rep_ < (((DUPMASK >> 2) & 1) ? 2 : 1); ++rep_) { phase_split(a, l); }
            if (s == 3 && ((PHMASK >> 3) & 1)) for (int rep_ = 0; rep_ < (((DUPMASK >> 3) & 1) ? 2 : 1); ++rep_) { if (SUBM & 1) run_gemm<768, 256>(lds, (const bf16_t*)(ws + WS_CQN), (const bf16_t*)(ws + WT_UQ), 0, FnQ{(bf16_t*)(ws + WS_Q), (const float*)(ws + WS_ROPE)});
                    if (SUBM & 2) run_gemm<1024, 256>(lds, (const bf16_t*)(ws + WS_CKVN), (const bf16_t*)(ws + WT_UKV), 0, FnKV{(bf16_t*)(ws + WS_KATT), (bf16_t*)(ws + WS_VATT)}); }
            if (s == 4 && ((PHMASK >> 4) & 1)) for (int rep_ = 0; rep_ < (((DUPMASK >> 4) & 1) ? 2 : 1); ++rep_) { phase_attn((const bf16_t*)(ws + WS_Q), (const bf16_t*)(ws + WS_KATT), (const bf16_t*)(ws + WS_VATT), (bf16_t*)(ws + WS_MIX), last, (char*)lds); }
            if (s == 5 && ((PHMASK >> 5) & 1)) for (int rep_ = 0; rep_ < (((DUPMASK >> 5) & 1) ? 2 : 1); ++rep_) { if (SUBM & 1) run_gemm<2048, 256>(lds, (const bf16_t*)(ws + WS_A1), (const bf16_t*)(ws + WT_L1), 0, FnL1{(__half*)(ws + WS_DEC), (bf16_t*)(ws + WS_AA), a.in[I_W0] + l * 1024, a.in[I_A0] + l * 1024});
                    if (SUBM & 2) run_gemm<1024, 256>(lds, (const bf16_t*)(ws + WS_A2), (const bf16_t*)(ws + WT_L2), 0,
                             FnL2{(bf16_t*)(ws + WS_G), (bf16_t*)(ws + WS_V), (const bf16_t*)(ws + WS_VF), a.in[I_V0] + (l > 0 ? l - 1 : 0) * 512, l > 0 ? 1 : 0}); }
            if (s == 6 && ((PHMASK >> 6) & 1)) for (int rep_ = 0; rep_ < (((DUPMASK >> 6) & 1) ? 2 : 1); ++rep_) { phase_scan((const bf16_t*)(ws + WS_R), (const bf16_t*)(ws + WS_K), (const bf16_t*)(ws + (l == 0 ? WS_VF : WS_V)), (const __half*)(ws + WS_DEC), (const bf16_t*)(ws + WS_AA),
                               (const float*)(ws + WS_INV), a.in[I_KK] + l * 512, a.in[I_KA] + l * 512, (bf16_t*)(ws + WS_MIX), (bf16_t*)(ws + WS_YB), (char*)lds); }
            if (s == 7 && ((PHMASK >> 7) & 1)) for (int rep_ = 0; rep_ < (((DUPMASK >> 7) & 1) ? 2 : 1); ++rep_) { phase_rwkv_out(a, l, last); }
            if (s == 8 && ((PHMASK >> 8) & 1)) for (int rep_ = 0; rep_ < (((DUPMASK >> 8) & 1) ? 2 : 1); ++rep_) { run_gemm<1024, 1024>(lds, (const bf16_t*)(ws + WS_MIX), (const bf16_t*)(ws + WT_OUT), last ? 1 : 0, FnRes{a.out, (float*)(ws + WS_XC), l == 0 ? a.in[I_X] : a.out, l == 0 ? a.in[I_CTX] : (const float*)(ws + WS_XC), mods, 2}); }
            if (s == 9 && ((PHMASK >> 9) & 1)) for (int rep_ = 0; rep_ < (((DUPMASK >> 9) & 1) ? 2 : 1); ++rep_) { phase_norm(a, l, a.in[I_N2G] + l * 1024, 3, 4, last, false); }
            if (s == 10 && ((PHMASK >> 10) & 1)) for (int rep_ = 0; rep_ < (((DUPMASK >> 10) & 1) ? 2 : 1); ++rep_) { run_gemm<DFF, 1024>(lds, (const bf16_t*)(ws + WS_H), (const bf16_t*)(ws + WT_M1), last ? 1 : 0, FnM1{(bf16_t*)(ws + WS_HID)}); }
            if (s == 11 && ((PHMASK >> 11) & 1)) for (int rep_ = 0; rep_ < (((DUPMASK >> 11) & 1) ? 2 : 1); ++rep_) { run_gemm<1024, DFF>(lds, (const bf16_t*)(ws + WS_HID), (const bf16_t*)(ws + WT_M2), last ? 1 : 0, FnRes{a.out, (float*)(ws + WS_XC), a.out, (const float*)(ws + WS_XC), mods, 5}); }
        }
        if (ph + 1 < ph_hi) { if (ph == 0) grid.sync(); else xcd_barrier(xbar); }
    }
}

extern "C" void kernel_launch(void* const* d_in, const int* in_sizes, int n_in, void* d_out, int out_size, void* d_ws, size_t ws_size, hipStream_t stream) {
    static int grid = 0;
    if (grid == 0) {
        if (n_in != 31 || out_size != NB * SEQ * DM || ws_size < WS_END) { fprintf(stderr, "kernel_launch: unexpected shapes: n_in %d out %d ws %zu (need %zu)\n", n_in, out_size, ws_size, (size_t)WS_END); grid = -1; return; }
        int dev = 0, cus = 0, per_cu = 0;
        (void)hipGetDevice(&dev); (void)hipDeviceGetAttribute(&cus, hipDeviceAttributeMultiprocessorCount, dev);
        if (hipFuncSetAttribute((const void*)trunk_fwd, hipFuncAttributeMaxDynamicSharedMemorySize, LDS_BYTES) != hipSuccess) { fprintf(stderr, "kernel_launch: hipFuncSetAttribute failed\n"); grid = -1; return; }
        if (hipOccupancyMaxActiveBlocksPerMultiprocessor(&per_cu, (const void*)trunk_fwd, 512, LDS_BYTES) != hipSuccess || per_cu < 1) { fprintf(stderr, "kernel_launch: occupancy query gave %d\n", per_cu); per_cu = 1; }
        (void)hipGetLastError();
        grid = cus * 1;
    }
    if (grid < 0) return;
    if (hipMemsetAsync((char*)d_ws + WS_BAR, 0, BAR_BYTES, stream) != hipSuccess) { fprintf(stderr, "kernel_launch: hipMemsetAsync failed\n"); return; }
    Args a{};
    for (int i = 0; i < 31; ++i) a.in[i] = (const float*)d_in[i];
    a.out = (float*)d_out; a.ws = (unsigned char*)d_ws; a.lo = 0; a.hi = NPH;
    void* args[] = {&a};
    hipError_t e = hipLaunchCooperativeKernel((const void*)trunk_fwd, dim3(grid), dim3(512), args, LDS_BYTES, stream);
    if (e != hipSuccess) fprintf(stderr, "kernel_launch: cooperative launch failed: %s (grid %d)\n", hipGetErrorString(e), grid);
}
```

```cpp
#include <hip/hip_runtime.h>
#include <hip/hip_cooperative_groups.h>
#include <hip/hip_fp16.h>
#include <cstdio>
#include <cstdint>
namespace cg = cooperative_groups;
#define DI __device__ __forceinline__
DI int ltid() { int t = threadIdx.x; asm volatile("" : "+v"(t)); return t; }
namespace pg8 {
#define PG8_LAS __attribute__((address_space(3)))
typedef unsigned short bf16_t;
typedef short bf16x8 __attribute__((ext_vector_type(8)));
typedef float f32x4 __attribute__((ext_vector_type(4)));
typedef unsigned u32x4 __attribute__((ext_vector_type(4)));
constexpr int BM = 256, BK = 64, HALF = 128, HTB = HALF * BK * 2  , STAGE_BYTES = 8 * HTB, NXCD = 8, WGM = 8;

__host__ __device__ __forceinline__ int lds_byte(int r, int c) { const int st = (r >> 4) * 2 + (c >> 5), rr = r & 15, cc = c & 31, ob = rr * 64 + cc * 2; return st * 1024 + (ob ^ (((ob >> 9) & 1) << 5)); }
__host__ __device__ __forceinline__ void stage_rc(int b, int& R, int& C) { const int st = b / 1024, sb = b % 1024, swz = sb ^ (((sb >> 9) & 1) << 5); R = (st >> 1) * 16 + swz / 64; C = (st & 1) * 32 + (swz % 64) / 2; }
__host__ __device__ __forceinline__ int perm32(int rho) { const int n = rho >> 4, i = rho & 15; return 8 * (i >> 2) + 4 * n + (i & 3); }

struct Unit { int pm, pn; };
struct Gemm { const bf16_t* A; const bf16_t* Bt; int M, N, K; };

struct StaticOrder {
    int nM, nN, nwg, G, c;
    __host__ __device__ void init(int M, int N, int G_, int c_) { nM = M / BM; nN = N / BM; nwg = nM * nN; G = G_; c = c_; }
    __host__ __device__ bool next(int i, Unit& u) const {
        const long L = (long)i * G + c; if (L >= nwg) return false;
        int wgid = (int)L; { const int q = nwg / NXCD, r = nwg % NXCD, xcd = wgid % NXCD, off = wgid / NXCD; wgid = (xcd < r ? xcd * (q + 1) : r * (q + 1) + (xcd - r) * q) + off; }
        const int nig = WGM * nN, gid = wgid / nig, fm = gid * WGM, gsz = (nM - fm) < WGM ? (nM - fm) : WGM;
        u.pm = fm + ((wgid % nig) % gsz); u.pn = (wgid % nig) / gsz; return true;
    }
    __device__ __forceinline__ void a_ready(const Unit&) const {}
    __device__ __forceinline__ void done(const Unit&) const {}
};

__device__ __forceinline__ unsigned cvt_pk_bf16(float lo, float hi) { unsigned r; asm volatile("v_cvt_pk_bf16_f32 %0, %1, %2" : "=v"(r) : "v"(lo), "v"(hi)); return r; }

template <class Epi, class Sched, bool ALIGN_EPI = false, bool SP2 = false>
__device__ __forceinline__ void gemm_phase(PG8_LAS unsigned char* lds, const Gemm g, const Sched& S, const Epi& E) {
    const int tid = ltid(), wid = __builtin_amdgcn_readfirstlane(tid >> 6), lane = tid & 63, wr = wid >> 2, wc = wid & 3, fr = lane & 15, fq = lane >> 4;
    const int K = g.K, nt = K / BK;
    unsigned voffA[2], voffB[2];
#pragma unroll
    for (int i = 0; i < 2; ++i) { int R, C; stage_rc(tid * 16 + i * 8192, R, C); const int Rb = Epi::PERM ? ((R & ~31) + perm32(R & 31)) : R;
        voffA[i] = (unsigned)(R * K + C) * 2u; voffB[i] = (unsigned)(Rb * K + C) * 2u; }
    const size_t kstep = (size_t)(BK * 2);
    const size_t hstep = (size_t)HALF * K * 2;
    const size_t tstep = 2 * hstep;
    const unsigned ldsw = (unsigned)wid * 1024u;
    const int aoff = lds_byte(wr * 64 + fr, fq * 8), boff = lds_byte(wc * 32 + fr, fq * 8);
#define PG8_SA(b, h) (((b) * 2 + (h)) * HTB)
#define PG8_SB(b, h) ((4 + (b) * 2 + (h)) * HTB)
#define PG8_STAGE(bufoff, gbase, voff) do { _Pragma("unroll") for (int _i = 0; _i < 2; ++_i) \
        __builtin_amdgcn_global_load_lds((const unsigned*)((const char*)(gbase) + (voff)[_i]), (PG8_LAS unsigned*)(lds + (bufoff) + ldsw + _i * 8192), 16, 0, 0); } while (0)
#define PG8_LDA(dst, b, h) do { _Pragma("unroll") for (int m = 0; m < 4; ++m) _Pragma("unroll") for (int k = 0; k < 2; ++k) dst[m][k] = *(const PG8_LAS bf16x8*)(lds + PG8_SA(b, h) + aoff + m * 2048 + k * 1024); } while (0)
#define PG8_LDB(dst, b, h) do { _Pragma("unroll") for (int n = 0; n < 2; ++n) _Pragma("unroll") for (int k = 0; k < 2; ++k) dst[n][k] = *(const PG8_LAS bf16x8*)(lds + PG8_SB(b, h) + boff + n * 2048 + k * 1024); } while (0)
#define PG8_MMA(ai, bj, At, Bt) do { __builtin_amdgcn_s_setprio(1); _Pragma("unroll") for (int m = 0; m < 4; ++m) _Pragma("unroll") for (int n = 0; n < 2; ++n) _Pragma("unroll") for (int k = 0; k < 2; ++k) \
        acc[ai][bj][m][n] = __builtin_amdgcn_mfma_f32_16x16x32_bf16(Bt[n][k], At[m][k], acc[ai][bj][m][n], 0, 0, 0); __builtin_amdgcn_s_setprio(0); } while (0)
#define PG8_WAIT_V(n) asm volatile("s_waitcnt vmcnt(" #n ")" ::: "memory")
#define PG8_WAIT_L(n) asm volatile("s_waitcnt lgkmcnt(" #n ")" ::: "memory")
#define PG8_BAR __builtin_amdgcn_s_barrier()
#define PG8_SCHED __builtin_amdgcn_sched_barrier(0)
    Unit cur, nxt; int ui = 0;
    if (!S.next(0, cur)) return;
    f32x4 acc[2][2][4][2];
#pragma unroll
    for (int a = 0; a < 2; ++a)
#pragma unroll
        for (int b = 0; b < 2; ++b)
#pragma unroll
            for (int m = 0; m < 4; ++m)
#pragma unroll
                for (int n = 0; n < 2; ++n) acc[a][b][m][n] = (f32x4){0.f, 0.f, 0.f, 0.f};
    bf16x8 At[4][2], B0[2][2], B1[2][2];
    const char* cA = (const char*)g.A + (size_t)cur.pm * tstep; const char* cB = (const char*)g.Bt + (size_t)cur.pn * tstep;
    S.a_ready(cur);
    if constexpr (SP2) {
        PG8_STAGE(PG8_SB(0, 0), cB, voffB); PG8_STAGE(PG8_SB(0, 1), cB + hstep, voffB); PG8_STAGE(PG8_SA(0, 0), cA, voffA); PG8_STAGE(PG8_SA(0, 1), cA + hstep, voffA);
        if (wr == 1) PG8_BAR;
        PG8_WAIT_V(2); PG8_BAR;
        PG8_STAGE(PG8_SB(1, 0), cB + kstep, voffB); PG8_STAGE(PG8_SA(1, 0), cA + kstep, voffA); PG8_STAGE(PG8_SB(1, 1), cB + hstep + kstep, voffB);
        PG8_WAIT_V(6); PG8_BAR;
    } else {
        PG8_STAGE(PG8_SB(0, 0), cB, voffB); PG8_STAGE(PG8_SA(0, 0), cA, voffA); PG8_STAGE(PG8_SB(0, 1), cB + hstep, voffB); PG8_STAGE(PG8_SA(0, 1), cA + hstep, voffA);
        if (wr == 1) PG8_BAR;
        PG8_WAIT_V(4); PG8_BAR;
        PG8_STAGE(PG8_SB(1, 0), cB + kstep, voffB); PG8_STAGE(PG8_SA(1, 0), cA + kstep, voffA); PG8_STAGE(PG8_SB(1, 1), cB + hstep + kstep, voffB);
        PG8_WAIT_V(6); PG8_BAR;
    }
    for (;;) {
        const bool has_next = S.next(ui + 1, nxt);
        const char* nA = has_next ? (const char*)g.A + (size_t)nxt.pm * tstep : cA; const char* nB = has_next ? (const char*)g.Bt + (size_t)nxt.pn * tstep : cB;
#pragma nounroll
        for (int t = 0; t < nt; t += 2) {
            const bool last = (t == nt - 2);
            const char* a1 = cA + (size_t)(t + 1) * kstep;
            const char* a2 = last ? nA : cA + (size_t)(t + 2) * kstep; const char* b2 = last ? nB : cB + (size_t)(t + 2) * kstep;
            const char* a3 = a2 + kstep; const char* b3 = b2 + kstep;
            if (last && has_next) S.a_ready(nxt);
            if constexpr (SP2) {
            PG8_LDB(B0, 0, 0); PG8_LDB(B1, 0, 1); PG8_SCHED; PG8_LDA(At, 0, 0); PG8_STAGE(PG8_SA(1, 1), a1 + hstep, voffA);
            PG8_WAIT_V(8); PG8_WAIT_L(0); PG8_BAR; PG8_MMA(0, 0, At, B0); PG8_MMA(0, 1, At, B1); PG8_BAR; PG8_SCHED;
            PG8_LDA(At, 0, 1); PG8_STAGE(PG8_SB(0, 0), b2, voffB); PG8_STAGE(PG8_SB(0, 1), b2 + hstep, voffB); PG8_STAGE(PG8_SA(0, 0), a2, voffA);
            PG8_WAIT_V(8); PG8_WAIT_L(0); PG8_BAR; PG8_MMA(1, 0, At, B0); PG8_MMA(1, 1, At, B1); PG8_BAR; PG8_SCHED;
            PG8_LDB(B0, 1, 0); PG8_LDB(B1, 1, 1); PG8_SCHED; PG8_LDA(At, 1, 0); PG8_STAGE(PG8_SA(0, 1), a2 + hstep, voffA);
            PG8_WAIT_V(8); PG8_WAIT_L(0); PG8_BAR; PG8_MMA(0, 0, At, B0); PG8_MMA(0, 1, At, B1); PG8_BAR; PG8_SCHED;
            PG8_LDA(At, 1, 1); PG8_STAGE(PG8_SB(1, 0), b3, voffB); PG8_STAGE(PG8_SB(1, 1), b3 + hstep, voffB); PG8_STAGE(PG8_SA(1, 0), a3, voffA);
            PG8_WAIT_V(8); PG8_WAIT_L(0); PG8_BAR; PG8_MMA(1, 0, At, B0); PG8_MMA(1, 1, At, B1); PG8_BAR; PG8_SCHED;
            } else {
            PG8_LDB(B0, 0, 0); PG8_SCHED; PG8_LDA(At, 0, 0); PG8_STAGE(PG8_SA(1, 1), a1 + hstep, voffA);
            PG8_WAIT_L(8); PG8_BAR; PG8_WAIT_L(0); PG8_MMA(0, 0, At, B0); PG8_BAR; PG8_SCHED;
            PG8_LDB(B1, 0, 1); PG8_STAGE(PG8_SB(0, 0), b2, voffB);
            PG8_BAR; PG8_WAIT_L(0); PG8_MMA(0, 1, At, B1); PG8_BAR;
            PG8_LDA(At, 0, 1); PG8_STAGE(PG8_SA(0, 0), a2, voffA);
            PG8_BAR; PG8_WAIT_L(0); PG8_MMA(1, 0, At, B0); PG8_BAR; PG8_SCHED;
            PG8_STAGE(PG8_SB(0, 1), b2 + hstep, voffB);
            PG8_WAIT_V(6); PG8_BAR; PG8_MMA(1, 1, At, B1); PG8_BAR;
            PG8_LDB(B0, 1, 0); PG8_SCHED; PG8_LDA(At, 1, 0); PG8_STAGE(PG8_SA(0, 1), a2 + hstep, voffA);
            PG8_WAIT_L(8); PG8_BAR; PG8_WAIT_L(0); PG8_MMA(0, 0, At, B0); PG8_BAR; PG8_SCHED;
            PG8_LDB(B1, 1, 1); PG8_STAGE(PG8_SB(1, 0), b3, voffB);
            PG8_BAR; PG8_WAIT_L(0); PG8_MMA(0, 1, At, B1); PG8_BAR;
            PG8_LDA(At, 1, 1); PG8_STAGE(PG8_SA(1, 0), a3, voffA);
            PG8_BAR; PG8_WAIT_L(0); PG8_MMA(1, 0, At, B0); PG8_BAR; PG8_SCHED;
            PG8_STAGE(PG8_SB(1, 1), b3 + hstep, voffB);
            PG8_WAIT_V(6); PG8_BAR; PG8_MMA(1, 1, At, B1); PG8_BAR;
            }
        }
        if constexpr (ALIGN_EPI) { if (wr == 0) PG8_BAR; }
        if constexpr (!Epi::AFTER_DRAIN) { E(acc, cur, wr, wc, fr, fq); S.done(cur); }
        if (!has_next) break;
#pragma unroll
        for (int a = 0; a < 2; ++a)
#pragma unroll
            for (int b = 0; b < 2; ++b)
#pragma unroll
                for (int m = 0; m < 4; ++m)
#pragma unroll
                    for (int n = 0; n < 2; ++n) acc[a][b][m][n] = (f32x4){0.f, 0.f, 0.f, 0.f};
        cur = nxt; cA = nA; cB = nB; ++ui;
        if constexpr (ALIGN_EPI) { if (wr == 1) PG8_BAR; }
    }
    PG8_WAIT_V(0);
    if constexpr (!ALIGN_EPI) { if (wr == 0) PG8_BAR; }
    PG8_BAR;
    if constexpr (Epi::AFTER_DRAIN) { E.fused(acc, cur, wr, wc, fr, fq, lds, wid, lane); S.done(cur); }
#undef PG8_SA
#undef PG8_SB
#undef PG8_STAGE
#undef PG8_LDA
#undef PG8_LDB
#undef PG8_MMA
#undef PG8_WAIT_V
#undef PG8_WAIT_L
#undef PG8_BAR
#undef PG8_SCHED
}
}
typedef unsigned short bf16_t;
using bf16x8 = __attribute__((ext_vector_type(8))) short;
using s16x4  = __attribute__((ext_vector_type(4))) short;
using f32x16 = __attribute__((ext_vector_type(16))) float;
using f32x4  = __attribute__((ext_vector_type(4))) float;
using u32x4  = __attribute__((ext_vector_type(4))) unsigned;
using u32x2  = __attribute__((ext_vector_type(2))) unsigned;

constexpr int DM = 1024, NB = 32, SEQ = 2048, TC = 256, TT = 2304, TALL = NB * TT, NL = 4;
constexpr int CIN = 2336, CINX = 2368, NIN = 2560, DFF = 4096;
constexpr int OFF_R = 416, OFF_K = 928, OFF_V = 1440, OFF_WLO = 1952, OFF_HV = 2336;
constexpr int NPH = 43, LDS_BYTES = 147456;
constexpr size_t MiB = 1u << 20;
constexpr size_t WS_MODS = 0, WS_ROPE = 3 * MiB + 512 * 1024, WS_BAR = 3 * MiB + 768 * 1024, BAR_BYTES = 16384, WS_TAB = 3 * MiB + 800 * 1024, WS_XC = 4 * MiB, WS_VF = 36 * MiB, WS_WT = 108 * MiB, WS_INV = 134 * MiB, TR = 137 * MiB;
constexpr size_t WT_IN = WS_WT, WT_UQ = WS_WT + 5 * MiB, WT_UKV = WS_WT + 5 * MiB + 512 * 1024, WT_L1 = WS_WT + 6 * MiB, WT_L2 = WS_WT + 7 * MiB,
                 WT_OUT = WS_WT + 8 * MiB, WT_M1 = WS_WT + 10 * MiB, WT_M2 = WS_WT + 18 * MiB;
constexpr size_t WS_R = TR, WS_K = TR + 72 * MiB, WS_H = TR, WS_F = TR + 144 * MiB, WS_Q = TR + 144 * MiB, WS_VATT = TR + 252 * MiB, WS_MIX = TR + 324 * MiB,
                 WS_DEC = TR + 144 * MiB, WS_HID = TR + 144 * MiB, WS_A1 = TR + 477 * MiB, WS_A2 = TR + 513 * MiB, WS_YB = TR + 477 * MiB,
                 WS_CQN = TR + 549 * MiB, WS_CKVN = TR + 585 * MiB, WS_KATT = TR + 621 * MiB, WS_AA = TR + 585 * MiB, WS_G = TR + 729 * MiB,
                 WS_V = TR + 801 * MiB, WS_C1 = 1010 * MiB, WS_C2 = 1012 * MiB, WS_GP1 = 1015 * MiB, WS_GP2 = 1016 * MiB, WS_END = 1017 * MiB;
constexpr size_t WS_RSA = 136 * MiB + 256 * 1024, WS_RSB = 136 * MiB + 640 * 1024;

struct Args { const float* in[31]; float* out; unsigned char* ws; int lo, hi; };
enum { I_X = 0, I_C, I_CTX, I_CCTX, I_ADAW, I_ADAB, I_N1G, I_N2G, I_WIN, I_QNG, I_WUQ, I_KVNG, I_WUKV, I_MU, I_W0, I_W2, I_A0, I_A2, I_G2, I_KK, I_KA, I_RK,
       I_LNW, I_LNB, I_V1, I_V2, I_V0, I_WOUT, I_M1, I_M2, I_FG };

DI float bflo(unsigned w) { return __uint_as_float(w << 16); }
DI float bfhi(unsigned w) { return __uint_as_float(w & 0xffff0000u); }
DI unsigned cvtpk(float lo, float hi) { return pg8::cvt_pk_bf16(lo, hi); }
DI bf16_t f2bf(float f) { return (bf16_t)(cvtpk(f, 0.f) & 0xffffu); }
DI void load8(const bf16_t* p, float (&f)[8]) { const u32x4 w = *(const u32x4*)p; f[0] = bflo(w.x); f[1] = bfhi(w.x); f[2] = bflo(w.y); f[3] = bfhi(w.y); f[4] = bflo(w.z); f[5] = bfhi(w.z); f[6] = bflo(w.w); f[7] = bfhi(w.w); }
DI void store8(bf16_t* p, const float (&f)[8]) { u32x4 w; w.x = cvtpk(f[0], f[1]); w.y = cvtpk(f[2], f[3]); w.z = cvtpk(f[4], f[5]); w.w = cvtpk(f[6], f[7]); *(u32x4*)p = w; }
DI void loadf8(const float* p, float (&f)[8]) { const f32x4 a = *(const f32x4*)p, b = *(const f32x4*)(p + 4); f[0] = a[0]; f[1] = a[1]; f[2] = a[2]; f[3] = a[3]; f[4] = b[0]; f[5] = b[1]; f[6] = b[2]; f[7] = b[3]; }
DI float h2f(unsigned b) { return __half2float(__ushort_as_half((unsigned short)b)); }
DI float sigmoidf_(float x) { return 1.f / (1.f + __expf(-x)); }
DI float xorsum(float v, int mask) { return v + __shfl_xor(v, mask, 64); }
DI float* xrow(float* out, float* xc, int m) { const int b = m / TT, tt = m - b * TT; return tt < TC ? xc + (size_t)(b * TC + tt) * DM : out + (size_t)(b * SEQ + tt - TC) * DM; }

template <class Fn> struct Epi8 {
    static constexpr bool PERM = true, AFTER_DRAIN = false; Fn f;
    DI void operator()(const pg8::f32x4 (&acc)[2][2][4][2], const pg8::Unit& u, int wr, int wc, int fr, int fq) const {
        asm volatile("" : "+v"(fr), "+v"(fq));
#pragma unroll
        for (int ai = 0; ai < 2; ++ai)
#pragma unroll
            for (int m = 0; m < 4; ++m) { const int rit = ai * 128 + wr * 64 + m * 16 + fr;
#pragma unroll
                for (int bj = 0; bj < 2; ++bj) { f(rit, u.pn * 256 + bj * 128 + wc * 32 + 8 * fq, acc[ai][bj][m][0], acc[ai][bj][m][1], u, fq); __builtin_amdgcn_sched_barrier(0); } }
    }
};
DI void st8(bf16_t* p, const pg8::f32x4& v0, const pg8::f32x4& v1) { u32x4 w; w.x = cvtpk(v0[0], v0[1]); w.y = cvtpk(v0[2], v0[3]); w.z = cvtpk(v1[0], v1[1]); w.w = cvtpk(v1[2], v1[3]); *(u32x4*)p = w; }

struct FnF { bf16_t* F; const float* rs; const float* c1;
    DI void operator()(int rit, int col0, const pg8::f32x4& v0, const pg8::f32x4& v1, const pg8::Unit& u, int) const {
        if (col0 < CINX) { const int row = u.pm * 256 + rit, b = u.pm / 9, mrow = (u.pm - b * 9 == 0) ? 32 : b;
            const float rstd = rsqrtf(rs[row] * (1.f / 1024.f) + 1e-6f); const float* c = c1 + (size_t)mrow * NIN + col0;
            const pg8::f32x4 b0 = *(const pg8::f32x4*)c, b1 = *(const pg8::f32x4*)(c + 4);
            st8(F + (size_t)row * CINX + col0, v0 * rstd + b0, v1 * rstd + b1); } } };
struct FnQ { bf16_t* Q; const float* rope;
    DI void operator()(int rit, int col0, const pg8::f32x4& v0, const pg8::f32x4& v1, const pg8::Unit& u, int fq) const {
        const int seg = u.pm % 9; const bool isrope = (seg != 0) && (((col0 >> 5) % 3) == 2);
        float x[8] = {v0[0], v0[1], v0[2], v0[3], v1[0], v1[1], v1[2], v1[3]};
        if (isrope) { const int s = (seg - 1) * 256 + rit, pos = (fq < 2) ? (s >> 6) : (s & 63); float cs[8], sn[8]; loadf8(rope + pos * 8, cs); loadf8(rope + 512 + pos * 8, sn);
            const float sg = (fq & 1) ? 1.f : -1.f;
#pragma unroll
            for (int j = 0; j < 8; ++j) { const float p = __shfl_xor(x[j], 16, 64); x[j] = x[j] * cs[j] + sg * p * sn[j]; } }
        store8(Q + (size_t)(u.pm * 256 + rit) * 768 + col0, x); } };
struct FnKV { bf16_t* KA; bf16_t* VA;
    DI void operator()(int rit, int col0, const pg8::f32x4& v0, const pg8::f32x4& v1, const pg8::Unit& u, int) const {
        const size_t row = (size_t)(u.pm * 256 + rit); const int h = col0 >> 7, c = col0 & 127;
        if (c < 64) st8(KA + row * 768 + h * 96 + c, v0, v1); else st8(VA + row * 512 + h * 64 + (c - 64), v0, v1); } };
struct FnL1 { __half* DEC; bf16_t* AA; const float* w0; const float* a0;
    DI void operator()(int rit, int col0, const pg8::f32x4& v0, const pg8::f32x4& v1, const pg8::Unit& u, int) const {
        const size_t row = (size_t)(u.pm * 256 + rit); float x[8] = {v0[0], v0[1], v0[2], v0[3], v1[0], v1[1], v1[2], v1[3]};
        if (col0 < 1024) { float b[8]; loadf8(w0 + col0, b); u32x4 w; unsigned hh[8];
#pragma unroll
            for (int j = 0; j < 8; ++j) { const float uu = 0.6065306597f * sigmoidf_(x[j] + b[j]); hh[j] = (unsigned)__half_as_ushort(__float2half(-uu * 1.4426950409f)); }
            w.x = hh[0] | (hh[1] << 16); w.y = hh[2] | (hh[3] << 16); w.z = hh[4] | (hh[5] << 16); w.w = hh[6] | (hh[7] << 16);
            *(u32x4*)(DEC + row * 1024 + col0) = w;
        } else { const int c = col0 - 1024; float b[8]; loadf8(a0 + c, b);
#pragma unroll
            for (int j = 0; j < 8; ++j) x[j] = sigmoidf_(x[j] + b[j]);
            store8(AA + row * 1024 + c, x); } } };
struct FnL2 { bf16_t* G; bf16_t* V; const bf16_t* VF; const float* v0p; int dovres;
    DI void operator()(int rit, int col0, const pg8::f32x4& v0, const pg8::f32x4& v1, const pg8::Unit& u, int) const {
        const size_t row = (size_t)(u.pm * 256 + rit);
        if (col0 < 512) st8(G + row * 512 + col0, v0, v1);
        else if (dovres) { const int c = col0 - 512; float x[8] = {v0[0], v0[1], v0[2], v0[3], v1[0], v1[1], v1[2], v1[3]}, b[8], v[8], vf[8]; loadf8(v0p + c, b); load8(V + row * 512 + c, v); load8(VF + row * 512 + c, vf);
#pragma unroll
            for (int j = 0; j < 8; ++j) v[j] = v[j] + (vf[j] - v[j]) * sigmoidf_(b[j] + x[j]);
            store8(V + row * 512 + c, v); } } };
struct FnM1 { bf16_t* HID; const float* rs; const float* c2;
    DI void operator()(int rit, int col0, const pg8::f32x4& v0, const pg8::f32x4& v1, const pg8::Unit& u, int) const {
        const int row = u.pm * 256 + rit, b = u.pm / 9, mrow = (u.pm - b * 9 == 0) ? 32 : b;
        const float rstd = rsqrtf(rs[row] * (1.f / 1024.f) + 1e-6f); const float* c = c2 + (size_t)mrow * DFF + col0;
        const pg8::f32x4 b0 = *(const pg8::f32x4*)c, b1 = *(const pg8::f32x4*)(c + 4);
        const pg8::f32x4 y0 = v0 * rstd + b0, y1 = v1 * rstd + b1;
        float x[8] = {y0[0], y0[1], y0[2], y0[3], y1[0], y1[1], y1[2], y1[3]};
#pragma unroll
        for (int j = 0; j < 8; ++j) { const float r = fmaxf(x[j], 0.f); x[j] = r * r; }
        store8(HID + (size_t)row * DFF + col0, x); } };
struct EpiRes { static constexpr bool PERM = true, AFTER_DRAIN = false;
    float* out; float* xc; const float* sx; const float* sc; const float* mods; int gidx; const float* gp; bf16_t* H; float* rs; int emit;
    DI void operator()(const pg8::f32x4 (&acc)[2][2][4][2], const pg8::Unit& u, int wr, int wc, int fr, int fq) const {
        asm volatile("" : "+v"(fr), "+v"(fq));
        const int b = u.pm / 9, seg = u.pm - b * 9, mrow = seg == 0 ? 32 : b;
        const float* gbase = mods + (size_t)mrow * 6144 + gidx * 1024; const float* gpb = gp + (size_t)mrow * 1024;
#pragma unroll
        for (int ai = 0; ai < 2; ++ai)
#pragma unroll
            for (int m = 0; m < 4; ++m) { const int rit = ai * 128 + wr * 64 + m * 16 + fr; float ss = 0.f;
                const size_t roff = (seg == 0 ? (size_t)(b * TC + rit) * DM : (size_t)(b * SEQ + (seg - 1) * 256 + rit) * DM);
#pragma unroll
                for (int bj = 0; bj < 2; ++bj) { const int col0 = u.pn * 256 + bj * 128 + wc * 32 + 8 * fq;
                    float* p = (seg == 0 ? xc : out) + roff + col0; const float* q = (seg == 0 ? sc : sx) + roff + col0;
                    const pg8::f32x4 g0 = *(const pg8::f32x4*)(gbase + col0), g1 = *(const pg8::f32x4*)(gbase + col0 + 4); pg8::f32x4 x0 = *(const pg8::f32x4*)q, x1 = *(const pg8::f32x4*)(q + 4);
                    x0 += g0 * acc[ai][bj][m][0]; x1 += g1 * acc[ai][bj][m][1]; *(pg8::f32x4*)p = x0; *(pg8::f32x4*)(p + 4) = x1;
                    if (emit) { const pg8::f32x4 p0 = *(const pg8::f32x4*)(gpb + col0), p1 = *(const pg8::f32x4*)(gpb + col0 + 4);
                        ss += x0[0] * x0[0] + x0[1] * x0[1] + x0[2] * x0[2] + x0[3] * x0[3] + x1[0] * x1[0] + x1[1] * x1[1] + x1[2] * x1[2] + x1[3] * x1[3];
                        st8(H + (size_t)(u.pm * 256 + rit) * 1024 + col0, x0 * p0, x1 * p1); }
                    __builtin_amdgcn_sched_barrier(0); }
                if (emit) { ss += __shfl_xor(ss, 16, 64); ss += __shfl_xor(ss, 32, 64); if (fq == 0) atomicAdd(rs + u.pm * 256 + rit, ss); }
            }
    }
};
struct Order { pg8::StaticOrder s; int lat;
    DI void init(int lat_, int N) { lat = lat_; s.init(lat_ ? NB * SEQ : TALL, N, (int)gridDim.x, (int)blockIdx.x); }
    DI bool next(int i, pg8::Unit& u) const { if (!s.next(i, u)) return false; if (lat) u.pm = (u.pm >> 3) * 9 + 1 + (u.pm & 7); return true; }
    DI void a_ready(const pg8::Unit&) const {}
    DI void done(const pg8::Unit&) const {}
};
template <int N, int K, class Fn> DI void run_gemm(unsigned char* lds, const bf16_t* A, const bf16_t* Bt, int lat, const Fn& fn) {
    pg8::Gemm g{A, Bt, lat ? NB * SEQ : TALL, N, K}; Order S; S.init(lat, N); Epi8<Fn> E{fn};
    pg8::gemm_phase<Epi8<Fn>, Order, true, true>((PG8_LAS unsigned char*)lds, g, S, E);
    __syncthreads();
}
template <int N, int K, class Epi> DI void run_gemm_epi(unsigned char* lds, const bf16_t* A, const bf16_t* Bt, int lat, const Epi& E) {
    pg8::Gemm g{A, Bt, lat ? NB * SEQ : TALL, N, K}; Order S; S.init(lat, N);
    pg8::gemm_phase<Epi, Order, true, true>((PG8_LAS unsigned char*)lds, g, S, E);
    __syncthreads();
}
namespace att {
constexpr int NW = 8, QBLK = 32, KVBLK = 64;
constexpr float SCALE = 0.10206207261596577f, THR = 8.f;
constexpr int LDQ = 768, LDKK = 768, LDV = 512, LDO = 1024;
constexpr int SHM_V = KVBLK * 64 * 2, SHM_K = KVBLK * 256, SHM_ATTN = 2 * SHM_V + 2 * SHM_K + NW * 64 * 4;
#define KSWZ(row, colB) ((row) * 256 + ((colB) ^ (((row) & 7) << 4)))
#define SBAR() __builtin_amdgcn_sched_barrier(0)
DI int crow(int r, int hi) { return (r & 3) + 8 * (r >> 2) + 4 * hi; }
DI unsigned cvtpk_(float lo, float hi) { unsigned r; asm volatile("v_cvt_pk_bf16_f32 %0, %1, %2" : "=v"(r) : "v"(lo), "v"(hi)); return r; }
DI void partialSM(f32x16& p0, f32x16& p1, float& m_reg, float& mn, float& alpha) {
  constexpr float C = SCALE * 1.4426950408889634f;
  float pmax = p0[0];
#pragma unroll
  for (int r = 1; r < 16; ++r) pmax = fmaxf(pmax, p0[r]);
#pragma unroll
  for (int r = 0; r < 16; ++r) pmax = fmaxf(pmax, p1[r]);
  { auto rr = __builtin_amdgcn_permlane32_swap(__float_as_uint(pmax), __float_as_uint(pmax), false, false);
    pmax = fmaxf(__uint_as_float(rr[0]), __uint_as_float(rr[1])); }
  if (__builtin_expect(__all(pmax - m_reg <= THR / SCALE), 1)) { mn = m_reg; alpha = 1.f; }
  else { mn = fmaxf(m_reg, pmax); alpha = __builtin_amdgcn_exp2f((m_reg - mn) * C); m_reg = mn; }
  const float mnC = -mn * C;
#pragma unroll
  for (int r = 0; r < 16; ++r) p0[r] = fmaf(p0[r], C, mnC);
#pragma unroll
  for (int r = 0; r < 16; ++r) p1[r] = fmaf(p1[r], C, mnC);
#pragma unroll
  for (int r = 0; r < 16; ++r) p0[r] = __builtin_amdgcn_exp2f(p0[r]);
}
DI void finishSM(f32x16& p0, f32x16& p1, float alpha, float& l_reg, bf16x8& pa0, bf16x8& pa1, bf16x8& pa2, bf16x8& pa3) {
#pragma unroll
  for (int r = 0; r < 16; ++r) p1[r] = __builtin_amdgcn_exp2f(p1[r]);
  float ps = 0;
#pragma unroll
  for (int r = 0; r < 16; ++r) ps += p0[r];
#pragma unroll
  for (int r = 0; r < 16; ++r) ps += p1[r];
  { auto rr = __builtin_amdgcn_permlane32_swap(__float_as_uint(ps), __float_as_uint(ps), false, false);
    ps = __uint_as_float(rr[0]) + __uint_as_float(rr[1]); }
  l_reg = l_reg * alpha + ps;
#define PK4(P, BASE, OUT) do { unsigned a0 = cvtpk_(P[BASE + 0], P[BASE + 1]), a1 = cvtpk_(P[BASE + 2], P[BASE + 3]);   \
    unsigned b0 = cvtpk_(P[BASE + 4], P[BASE + 5]), b1 = cvtpk_(P[BASE + 6], P[BASE + 7]);                              \
    auto r0 = __builtin_amdgcn_permlane32_swap(a0, b0, false, false); auto r1 = __builtin_amdgcn_permlane32_swap(a1, b1, false, false); \
    u32x4 w = {r0[0], r1[0], r0[1], r1[1]}; OUT = *reinterpret_cast<bf16x8*>(&w); } while (0)
  PK4(p0, 0, pa0); PK4(p0, 8, pa1); PK4(p1, 0, pa2); PK4(p1, 8, pa3);
#undef PK4
}
DI void qkt(f32x16& p0, f32x16& p1, const char* Ks, const bf16x8* qr, int r32, int hi) {
  p0 = f32x16{}; p1 = f32x16{};
#pragma unroll
  for (int d0 = 0; d0 < 6; ++d0) { const int cb = (d0 * 16 + hi * 8) * 2;
    bf16x8 b0 = *reinterpret_cast<const bf16x8*>(Ks + KSWZ(r32, cb));
    bf16x8 b1 = *reinterpret_cast<const bf16x8*>(Ks + KSWZ(32 + r32, cb));
    p0 = __builtin_amdgcn_mfma_f32_32x32x16_bf16(b0, qr[d0], p0, 0, 0, 0);
    p1 = __builtin_amdgcn_mfma_f32_32x32x16_bf16(b1, qr[d0], p1, 0, 0, 0); }
}
DI int v_st(int k, int c) { const int kk = (k & ~0xC) | ((k & 4) << 1) | ((k & 8) >> 1); return ((kk >> 3) * 2 + (c >> 5)) * 512 + ((kk & 7) * 32 + (c & 31)) * 2; }
DI int v_rd_base(int lane) { return ((lane & 3) << 3) | (((lane >> 2) & 3) << 6) | (((lane >> 4) & 1) << 5) | (((lane >> 5) & 1) << 8); }
constexpr int v_rd_off(int d0, int ks, int half) { return d0 * 512 + ks * 2048 + half * 1024; }
template <int OFF> DI s16x4 tr_read(int vb) {
  s16x4 r; asm volatile("ds_read_b64_tr_b16 %0, %1 offset:%2" : "=&v"(r) : "v"(vb), "i"(OFF) : "memory"); return r;
}
template <int D0> DI void pv_one(f32x16& od, int vb, bf16x8 pa0, bf16x8 pa1, bf16x8 pa2, bf16x8 pa3) {
  const s16x4 l0 = tr_read<v_rd_off(D0, 0, 0)>(vb), h0 = tr_read<v_rd_off(D0, 0, 1)>(vb), l1 = tr_read<v_rd_off(D0, 1, 0)>(vb), h1 = tr_read<v_rd_off(D0, 1, 1)>(vb);
  const s16x4 l2 = tr_read<v_rd_off(D0, 2, 0)>(vb), h2 = tr_read<v_rd_off(D0, 2, 1)>(vb), l3 = tr_read<v_rd_off(D0, 3, 0)>(vb), h3 = tr_read<v_rd_off(D0, 3, 1)>(vb);
  asm volatile("s_waitcnt lgkmcnt(0)" ::: "memory"); SBAR();
#define PK(L, H) (bf16x8){L[0], L[1], L[2], L[3], H[0], H[1], H[2], H[3]}
  od = __builtin_amdgcn_mfma_f32_32x32x16_bf16(pa0, PK(l0, h0), od, 0, 0, 0);
  od = __builtin_amdgcn_mfma_f32_32x32x16_bf16(pa1, PK(l1, h1), od, 0, 0, 0);
  od = __builtin_amdgcn_mfma_f32_32x32x16_bf16(pa2, PK(l2, h2), od, 0, 0, 0);
  od = __builtin_amdgcn_mfma_f32_32x32x16_bf16(pa3, PK(l3, h3), od, 0, 0, 0);
#undef PK
}
DI void pv_d0(f32x16* o, int vb, bf16x8 pa0, bf16x8 pa1, bf16x8 pa2, bf16x8 pa3) {
  pv_one<0>(o[0], vb, pa0, pa1, pa2, pa3); pv_one<1>(o[1], vb, pa0, pa1, pa2, pa3);
}
DI void attn_body(const bf16_t* __restrict__ Qb, const bf16_t* __restrict__ Kh, const bf16_t* __restrict__ Vh, bf16_t* __restrict__ Ob, int seq, char* lds) {
  const int tid = ltid(), wid = tid >> 6, lane = tid & 63, r32 = lane & 31, hi = lane >> 5;
  char* V_lds = lds; char* K_lds = lds + 2 * SHM_V;
  float* ws = (float*)(lds + 2 * SHM_V + 2 * SHM_K) + wid * 64; float* li_l = ws; float* al_l = ws + 32;
  float m_reg = -1e30f, l_reg = 0; f32x16 o[2] = {}; bf16x8 qr[6];
  const bf16_t* Qw = Qb + (long)(wid * QBLK + r32) * LDQ + hi * 8;
#pragma unroll
  for (int d0 = 0; d0 < 6; ++d0) qr[d0] = *reinterpret_cast<const bf16x8*>(Qw + d0 * 16);
  const int kc2 = 512 + (tid & 255);
  const int kr1 = tid / 12, kch1 = tid - kr1 * 12, kr2 = kc2 / 12, kch2 = kc2 - kr2 * 12, vr = tid >> 3, vch = tid & 7;
  const int vst = v_st(vr, vch * 8), kst1 = KSWZ(kr1, kch1 * 16), kst2 = KSWZ(kr2, kch2 * 16);
  const int vb0 = (int)(uintptr_t)V_lds + v_rd_base(lane);
  struct { bf16x8 v, k1, k2; } sr_[2];
#define SLOAD(i, k0) do { sr_[i].v = *reinterpret_cast<const bf16x8*>(&Vh[(long)((k0) + vr) * LDV + vch * 8]); \
    sr_[i].k1 = *reinterpret_cast<const bf16x8*>(&Kh[(long)((k0) + kr1) * LDKK + kch1 * 8]); sr_[i].k2 = *reinterpret_cast<const bf16x8*>(&Kh[(long)((k0) + kr2) * LDKK + kch2 * 8]); } while (0)
#define SWRITE(b, i) do { *(bf16x8*)(V_lds + (b) * SHM_V + vst) = sr_[i].v; *(bf16x8*)(K_lds + (b) * SHM_K + kst1) = sr_[i].k1; *(bf16x8*)(K_lds + (b) * SHM_K + kst2) = sr_[i].k2; } while (0)
#define RESC(a) do { if (__any((a) < 1.f)) { if (hi == 0) al_l[r32] = (a); asm volatile("s_waitcnt lgkmcnt(0)" ::: "memory"); \
    _Pragma("unroll") for (int d = 0; d < 2; ++d) _Pragma("unroll") for (int r = 0; r < 16; ++r) o[d][r] *= al_l[crow(r, hi)]; } } while (0)
  f32x16 pA0, pA1, pB0, pB1; float mnA, mnB, alA, alB; bf16x8 pa0, pa1, pa2, pa3; const int NT = seq / KVBLK;
  constexpr int SE = 0, SO = 1;
  SLOAD(SE, 0); asm volatile("s_waitcnt vmcnt(0)" ::: "memory"); SWRITE(0, SE); __syncthreads();
  qkt(pA0, pA1, K_lds, qr, r32, hi); partialSM(pA0, pA1, m_reg, mnA, alA);
  SLOAD(SO, KVBLK); if (2 < NT) SLOAD(SE, 2 * KVBLK);
  SWRITE(1, SO); __syncthreads();
  for (int j = 1; j + 1 < NT; j += 2) {
    SBAR(); qkt(pB0, pB1, K_lds + SHM_K, qr, r32, hi);
    finishSM(pA0, pA1, alA, l_reg, pa0, pa1, pa2, pa3); SBAR();
    SLOAD(SO, (j + 2) * KVBLK); SBAR();
    pv_d0(o, vb0, pa0, pa1, pa2, pa3); partialSM(pB0, pB1, m_reg, mnB, alB);
    __syncthreads(); SWRITE(0, SE);
    RESC(alB); __syncthreads();
    SBAR(); qkt(pA0, pA1, K_lds, qr, r32, hi);
    finishSM(pB0, pB1, alB, l_reg, pa0, pa1, pa2, pa3); SBAR();
    if (j + 3 < NT) SLOAD(SE, (j + 3) * KVBLK); SBAR();
    pv_d0(o, vb0 + SHM_V, pa0, pa1, pa2, pa3); partialSM(pA0, pA1, m_reg, mnA, alA);
    __syncthreads(); SWRITE(1, SO);
    RESC(alA); __syncthreads();
  }
  SBAR(); qkt(pB0, pB1, K_lds + SHM_K, qr, r32, hi);
  finishSM(pA0, pA1, alA, l_reg, pa0, pa1, pa2, pa3); SBAR();
  pv_d0(o, vb0, pa0, pa1, pa2, pa3); partialSM(pB0, pB1, m_reg, mnB, alB);
  __syncthreads(); RESC(alB);
  finishSM(pB0, pB1, alB, l_reg, pa0, pa1, pa2, pa3); SBAR();
  pv_d0(o, vb0 + SHM_V, pa0, pa1, pa2, pa3);
  if (hi == 0) li_l[r32] = l_reg; asm volatile("s_waitcnt lgkmcnt(0)" ::: "memory");
  float rli[16];
#pragma unroll
  for (int r = 0; r < 16; ++r) rli[r] = __builtin_amdgcn_rcpf(li_l[crow(r, hi)]);
  bf16_t* Ow = Ob + (long)(wid * QBLK) * LDO;
#pragma unroll
  for (int r = 0; r < 16; ++r) { const int orow = crow(r, hi);
#pragma unroll
    for (int d0 = 0; d0 < 2; ++d0) Ow[(long)orow * LDO + d0 * 32 + r32] = f2bf(o[d0][r] * rli[r]); }
#undef SLOAD
#undef SWRITE
#undef RESC
}
}

DI void phase_attn(const bf16_t* Q, const bf16_t* KA, const bf16_t* VA, bf16_t* MIX, bool last, char* lds) {
    const int c = blockIdx.x, G = gridDim.x, NU = 2048 + (last ? 0 : 256);
    for (int L = c; L < NU; L += G) {
        int bh, seq; long qrow0;
        if (L < 2048) { int qb;
            if (G == 256) { const int i = L >> 8, cc = L & 255, xcd = cc & 7, slot = cc >> 3; bh = i * 32 + xcd * 4 + (slot >> 3); qb = slot & 7; }
            else { bh = L >> 3; qb = L & 7; }
            qrow0 = (long)(bh >> 3) * TT + TC + qb * 256; seq = TT; }
        else { bh = L - 2048; qrow0 = (long)(bh >> 3) * TT; seq = TC; }
        const int b = bh >> 3, h = bh & 7;
        att::attn_body(Q + qrow0 * 768 + h * 96, KA + (long)b * TT * 768 + h * 96, VA + (long)b * TT * 512 + h * 64, MIX + qrow0 * 1024 + h * 64, seq, lds);
        __syncthreads();
    }
}

DI float rowsum16(float x) {
    x += __int_as_float(__builtin_amdgcn_update_dpp(0, __float_as_int(x), 0x128, 0xf, 0xf, false));
    x += __int_as_float(__builtin_amdgcn_update_dpp(0, __float_as_int(x), 0x124, 0xf, 0xf, false));
    x += __int_as_float(__builtin_amdgcn_update_dpp(0, __float_as_int(x), 0x122, 0xf, 0xf, false));
    x += __int_as_float(__builtin_amdgcn_update_dpp(0, __float_as_int(x), 0x121, 0xf, 0xf, false));
    return x;
}
#define RS8_STEP(R) "v_add_f32_dpp %0, %0, %0 " R " row_mask:0xf bank_mask:0xf\n\tv_add_f32_dpp %1, %1, %1 " R " row_mask:0xf bank_mask:0xf\n\t" \
                    "v_add_f32_dpp %2, %2, %2 " R " row_mask:0xf bank_mask:0xf\n\tv_add_f32_dpp %3, %3, %3 " R " row_mask:0xf bank_mask:0xf\n\t" \
                    "v_add_f32_dpp %4, %4, %4 " R " row_mask:0xf bank_mask:0xf\n\tv_add_f32_dpp %5, %5, %5 " R " row_mask:0xf bank_mask:0xf\n\t" \
                    "v_add_f32_dpp %6, %6, %6 " R " row_mask:0xf bank_mask:0xf\n\tv_add_f32_dpp %7, %7, %7 " R " row_mask:0xf bank_mask:0xf\n\t"
DI void sum8x8(float& x0, float& x1, float& x2, float& x3, float& x4, float& x5, float& x6, float& x7) {
    asm volatile("s_nop 1\n\t" RS8_STEP("quad_perm:[1,0,3,2]") RS8_STEP("quad_perm:[2,3,0,1]") RS8_STEP("row_half_mirror")
                 : "+v"(x0), "+v"(x1), "+v"(x2), "+v"(x3), "+v"(x4), "+v"(x5), "+v"(x6), "+v"(x7));
}
typedef float f32x2 __attribute__((ext_vector_type(2)));
DI float dot8(const f32x2 (&s)[4], const f32x4& x0, const f32x4& x1) {
    f32x2 t = s[0] * (f32x2){x0[0], x0[1]};
    t = __builtin_elementwise_fma(s[1], (f32x2){x0[2], x0[3]}, t);
    t = __builtin_elementwise_fma(s[2], (f32x2){x1[0], x1[1]}, t);
    t = __builtin_elementwise_fma(s[3], (f32x2){x1[2], x1[3]}, t);
    return t.x + t.y;
}
DI int scan_row(int d, int b, int n) { const int tt = d == 0 ? n : (n < TC ? TC - 1 - n : TT + TC - 1 - n); return b * TT + tt; }
struct ScanStep { f32x4 a0, a1, w0, w1, b0, b1, k0, k1, q0, q1, v; float br, kr; };
DI void scan_ld(ScanStep& t, const float* p, const float* sc, int cgp, int vrow) {
    t.a0 = *(const f32x4*)(p + 8 * cgp); t.a1 = *(const f32x4*)(p + 8 * cgp + 4); t.w0 = *(const f32x4*)(p + 64 + 8 * cgp); t.w1 = *(const f32x4*)(p + 64 + 8 * cgp + 4);
    t.b0 = *(const f32x4*)(p + 128 + 8 * cgp); t.b1 = *(const f32x4*)(p + 128 + 8 * cgp + 4); t.k0 = *(const f32x4*)(p + 192 + 8 * cgp); t.k1 = *(const f32x4*)(p + 192 + 8 * cgp + 4);
    t.q0 = *(const f32x4*)(p + 256 + 8 * cgp); t.q1 = *(const f32x4*)(p + 256 + 8 * cgp + 4); t.v = *(const f32x4*)(p + 320 + vrow); t.br = sc[0]; t.kr = sc[1];
}
DI void phase_scan(const bf16_t* R, const bf16_t* Kk, const bf16_t* V, const __half* DEC, const bf16_t* AA, const float* INV, const float* kkp, const float* kap,
                   bf16_t* MIX, bf16_t* YB, char* lds) {
    const int tid = ltid(); const bool consumer = tid < 256;
    float* bufA = (float*)lds; float* ybufA = (float*)(lds + 98304); float* sbufA = (float*)(lds + 114688);
    constexpr int NCH = TT / 16;
    for (int s0 = blockIdx.x * 2; s0 < 512; s0 += gridDim.x * 2) {
        const int p_ = tid & 255, pst = p_ >> 4, pj0 = (p_ & 15) * 4;
        const int cw = tid >> 6, cgrp = (cw >> 1) & 1, ws_ = cw & 1, lane = tid & 63, rgl = lane >> 3, cgp = lane & 7, vrow = ws_ * 32 + rgl * 4;
        f32x2 S[4][4];
#pragma unroll
        for (int i = 0; i < 4; ++i)
#pragma unroll
            for (int j = 0; j < 4; ++j) S[i][j] = (f32x2){0.f, 0.f};
#define PRODUCE(c, bsel) do { _Pragma("unroll") for (int gq = 0; gq < 2; ++gq) { \
            const int sid = s0 + gq, d = sid >> 8, b = (sid >> 3) & 31, h = sid & 7, hc = h * 64 + pj0; \
            const size_t m_ = (size_t)scan_row(d, b, (c) * 16 + pst); \
            const u32x2 lr = *(const u32x2*)(R + m_ * 512 + hc), lk = *(const u32x2*)(Kk + m_ * 512 + hc), lv = *(const u32x2*)(V + m_ * 512 + hc), \
                        ld_ = *(const u32x2*)(DEC + m_ * 1024 + d * 512 + hc), la = *(const u32x2*)(AA + m_ * 1024 + d * 512 + hc); const float linv = INV[m_ * 8 + h]; \
            const f32x4 kk4 = *(const f32x4*)(kkp + hc), ka4 = *(const f32x4*)(kap + hc); \
            float* q_ = bufA + gq * 12288 + (bsel) * 6144 + pst * 384 + pj0; float* sd_ = sbufA + gq * 64 + (bsel) * 32; \
            const float k0 = bflo(lk.x), k1 = bfhi(lk.x), k2 = bflo(lk.y), k3 = bfhi(lk.y), a0 = bflo(la.x), a1 = bfhi(la.x), a2 = bflo(la.y), a3 = bfhi(la.y); \
            const float q0 = k0 * kk4[0] * linv, q1 = k1 * kk4[1] * linv, q2 = k2 * kk4[2] * linv, q3 = k3 * kk4[3] * linv; \
            const float w0 = __builtin_amdgcn_exp2f(h2f(ld_.x & 0xffffu)), w1 = __builtin_amdgcn_exp2f(h2f(ld_.x >> 16)), w2 = __builtin_amdgcn_exp2f(h2f(ld_.y & 0xffffu)), w3 = __builtin_amdgcn_exp2f(h2f(ld_.y >> 16)); \
            const float r0 = bflo(lr.x), r1 = bfhi(lr.x), r2 = bflo(lr.y), r3 = bfhi(lr.y); \
            const float b0 = q0 * a0, b1 = q1 * a1, b2 = q2 * a2, b3 = q3 * a3; \
            const float d0 = k0 * (1.f + (a0 - 1.f) * ka4[0]), d1 = k1 * (1.f + (a1 - 1.f) * ka4[1]), d2 = k2 * (1.f + (a2 - 1.f) * ka4[2]), d3 = k3 * (1.f + (a3 - 1.f) * ka4[3]); \
            *(f32x4*)(q_) = (f32x4){-q0, -q1, -q2, -q3}; \
            *(f32x4*)(q_ + 64) = (f32x4){w0, w1, w2, w3}; \
            *(f32x4*)(q_ + 128) = (f32x4){b0, b1, b2, b3}; \
            *(f32x4*)(q_ + 192) = (f32x4){d0, d1, d2, d3}; \
            *(f32x4*)(q_ + 256) = (f32x4){w0 * r0, w1 * r1, w2 * r2, w3 * r3}; \
            *(f32x4*)(q_ + 320) = (f32x4){bflo(lv.x), bfhi(lv.x), bflo(lv.y), bfhi(lv.y)}; \
            const float br_ = rowsum16(b0 * r0 + b1 * r1 + b2 * r2 + b3 * r3), kr_ = rowsum16(d0 * r0 + d1 * r1 + d2 * r2 + d3 * r3); \
            if ((p_ & 15) == 0) { sd_[pst * 2] = br_; sd_[pst * 2 + 1] = kr_; } } } while (0)
#define OUTPUT(c, bsel) do { _Pragma("unroll") for (int gq = 0; gq < 2; ++gq) { \
            const int sid = s0 + gq, d = sid >> 8, b = (sid >> 3) & 31, h = sid & 7, hc = h * 64 + pj0; \
            const f32x4 yv = *(const f32x4*)(ybufA + gq * 2048 + (bsel) * 1024 + pst * 64 + pj0); const size_t m_ = (size_t)scan_row(d, b, (c) * 16 + pst); \
            u32x2 w; w.x = cvtpk(yv[0], yv[1]); w.y = cvtpk(yv[2], yv[3]); \
            if (d == 0) *(u32x2*)(MIX + m_ * 1024 + 512 + hc) = w; else *(u32x2*)(YB + m_ * 512 + hc) = w; } } while (0)
        if (!consumer) PRODUCE(0, 0);
        __syncthreads();
        for (int c = 0; c < NCH; ++c) {
            if (consumer) {
                const float* cur = bufA + cgrp * 12288 + (c & 1) * 6144; float* yb = ybufA + cgrp * 2048 + (c & 1) * 1024; const float* sc = sbufA + cgrp * 64 + (c & 1) * 32;
                ScanStep t; scan_ld(t, cur, sc, cgp, vrow);
#pragma unroll 2
                for (int st = 0; st < 16; ++st) {
                    ScanStep n; scan_ld(n, cur + (st + 1) * 384, sc + (st + 1) * 2, cgp, vrow);
                    float sa0 = dot8(S[0], t.a0, t.a1), sa1 = dot8(S[1], t.a0, t.a1), sa2 = dot8(S[2], t.a0, t.a1), sa3 = dot8(S[3], t.a0, t.a1);
                    float z0 = dot8(S[0], t.q0, t.q1), z1 = dot8(S[1], t.q0, t.q1), z2 = dot8(S[2], t.q0, t.q1), z3 = dot8(S[3], t.q0, t.q1);
                    sum8x8(sa0, sa1, sa2, sa3, z0, z1, z2, z3);
                    const f32x2 w01 = {t.w0[0], t.w0[1]}, w23 = {t.w0[2], t.w0[3]}, w45 = {t.w1[0], t.w1[1]}, w67 = {t.w1[2], t.w1[3]};
                    const f32x2 b01 = {t.b0[0], t.b0[1]}, b23 = {t.b0[2], t.b0[3]}, b45 = {t.b1[0], t.b1[1]}, b67 = {t.b1[2], t.b1[3]};
                    const f32x2 k01 = {t.k0[0], t.k0[1]}, k23 = {t.k0[2], t.k0[3]}, k45 = {t.k1[0], t.k1[1]}, k67 = {t.k1[2], t.k1[3]};
                    const float sa[4] = {sa0, sa1, sa2, sa3};
                    const f32x2 wv[4] = {w01, w23, w45, w67}, bv[4] = {b01, b23, b45, b67}, kv[4] = {k01, k23, k45, k67};
#pragma unroll
                    for (int i = 0; i < 4; ++i)
#pragma unroll
                        for (int j = 0; j < 4; ++j) S[i][j] = S[i][j] * wv[j];
#pragma unroll
                    for (int i = 0; i < 4; ++i) { const f32x2 s2 = {sa[i], sa[i]};
#pragma unroll
                        for (int j = 0; j < 4; ++j) S[i][j] = __builtin_elementwise_fma(s2, bv[j], S[i][j]); }
#pragma unroll
                    for (int i = 0; i < 4; ++i) { const f32x2 v2 = {t.v[i], t.v[i]};
#pragma unroll
                        for (int j = 0; j < 4; ++j) S[i][j] = __builtin_elementwise_fma(v2, kv[j], S[i][j]); }
                    if (cgp == 0) *(f32x4*)(yb + st * 64 + vrow) = (f32x4){z0 + sa0 * t.br + t.v[0] * t.kr, z1 + sa1 * t.br + t.v[1] * t.kr, z2 + sa2 * t.br + t.v[2] * t.kr, z3 + sa3 * t.br + t.v[3] * t.kr};
                    t = n;
                }
            } else {
                if (c + 1 < NCH) PRODUCE(c + 1, (c + 1) & 1);
                if (c > 0) OUTPUT(c - 1, (c - 1) & 1);
            }
            __syncthreads();
        }
        if (!consumer) OUTPUT(NCH - 1, (NCH - 1) & 1);
        __syncthreads();
#undef PRODUCE
#undef OUTPUT
    }
}

DI void phase_prologue(const Args& a, unsigned char* lds) {
    const int tid = ltid(), G = gridDim.x;
    float* out = a.out; float* xc = (float*)(a.ws + WS_XC);
    if (blockIdx.x == 0) {
        float* rope = (float*)(a.ws + WS_ROPE); const int pos = tid >> 3, j = tid & 7;
        const float inv_freq = powf(10000.f, -(float)j / 8.f), ang = (float)pos * inv_freq;
        rope[tid] = cosf(ang); rope[512 + tid] = sinf(ang);
    }
    float* sv = (float*)lds; float* red = sv + 33 * 1024;
    for (int i = tid; i < 33 * 1024; i += 512) { const float v = i < 32 * 1024 ? a.in[I_C][i] : a.in[I_CCTX][i - 32 * 1024]; sv[i] = v / (1.f + __expf(-v)); }
    __syncthreads();
    const int wave = tid >> 6, lane = tid & 63;
    float* mods = (float*)(a.ws + WS_MODS);
    for (int it = blockIdx.x; it < NL * 96; it += G) {
        const int l = it / 96, n0 = (it - l * 96) * 64;
        const float* w = a.in[I_ADAW] + (size_t)l * 1024 * 6144 + n0 + lane;
        float acc[33];
#pragma unroll
        for (int r = 0; r < 33; ++r) acc[r] = 0.f;
        for (int k = wave * 128; k < wave * 128 + 128; k += 8) { float wv[8];
#pragma unroll
            for (int u = 0; u < 8; ++u) wv[u] = w[(size_t)(k + u) * 6144];
#pragma unroll
            for (int u = 0; u < 8; ++u)
#pragma unroll
                for (int r = 0; r < 33; ++r) acc[r] += sv[r * 1024 + k + u] * wv[u]; }
        for (int i = tid; i < 33 * 64; i += 512) red[i] = 0.f;
        __syncthreads();
        for (int ww = 0; ww < 8; ++ww) { if (wave == ww) {
#pragma unroll
                for (int r = 0; r < 33; ++r) red[r * 64 + lane] += acc[r]; }
            __syncthreads(); }
        for (int i = tid; i < 33 * 64; i += 512) { const int r = i >> 6, n = n0 + (i & 63); mods[((size_t)l * 33 + r) * 6144 + n] = red[i] + a.in[I_ADAB][l * 6144 + n]; }
        __syncthreads();
    }
}

DI void phase_vectors(const Args& a, unsigned char* lds) {
    const int tid = ltid(), G = gridDim.x, wave = tid >> 6, lane = tid & 63;
    const float* mods = (const float*)(a.ws + WS_MODS);
    float* gp1 = (float*)(a.ws + WS_GP1); float* gp2 = (float*)(a.ws + WS_GP2);
    for (int i = blockIdx.x * 512 + tid; i < NL * 33 * 1024; i += G * 512) { const int c = i & 1023, lr = i >> 10, l = lr / 33;
        gp1[i] = a.in[I_N1G][l * 1024 + c] * (1.f + mods[(size_t)lr * 6144 + 1024 + c]); gp2[i] = a.in[I_N2G][l * 1024 + c] * (1.f + mods[(size_t)lr * 6144 + 4 * 1024 + c]); }
    float* sv = (float*)lds; float* red = sv + 33 * 1024;
    for (int it = blockIdx.x; it < NL * 101; it += G) {
        const int l = it / 101, ci = it - l * 101, which = ci < 37 ? 0 : 1, n0 = (which ? ci - 37 : ci) * 64, n = n0 + lane;
        __syncthreads();
        for (int i = tid; i < 33 * 1024; i += 512) sv[i] = mods[((size_t)l * 33 + (i >> 10)) * 6144 + (which ? 3 * 1024 : 0) + (i & 1023)];
        for (int i = tid; i < 33 * 64; i += 512) red[i] = 0.f;
        __syncthreads();
        const float* w; int ld; float live = 1.f;
        if (which) { w = a.in[I_M1] + (size_t)l * 1024 * 4096 + n; ld = 4096; }
        else if (n < CIN) { w = a.in[I_WIN] + (size_t)l * 1024 * CIN + n; ld = CIN; }
        else if (n < CINX && l > 0) { w = a.in[I_V1] + (size_t)(l - 1) * 1024 * 32 + (n - CIN); ld = 32; }
        else { w = a.in[I_WIN]; ld = 0; live = 0.f; }
        float acc[33];
#pragma unroll
        for (int r = 0; r < 33; ++r) acc[r] = 0.f;
        for (int k = wave * 128; k < wave * 128 + 128; k += 8) { float wv[8];
#pragma unroll
            for (int u = 0; u < 8; ++u) wv[u] = w[(size_t)(k + u) * ld] * live;
#pragma unroll
            for (int u = 0; u < 8; ++u)
#pragma unroll
                for (int r = 0; r < 33; ++r) acc[r] += sv[r * 1024 + k + u] * wv[u]; }
        for (int ww = 0; ww < 8; ++ww) { if (wave == ww) {
#pragma unroll
                for (int r = 0; r < 33; ++r) red[r * 64 + lane] += acc[r]; }
            __syncthreads(); }
        float* outp = which ? (float*)(a.ws + WS_C2) + (size_t)l * 33 * DFF : (float*)(a.ws + WS_C1) + (size_t)l * 33 * NIN; const int ldo = which ? DFF : NIN;
        for (int i = tid; i < 33 * 64; i += 512) outp[(size_t)(i >> 6) * ldo + n0 + (i & 63)] = red[i];
    }
    {
        const int gw = blockIdx.x * 8 + wave, nw = G * 8; bf16_t* __restrict__ H = (bf16_t*)(a.ws + WS_H); float* __restrict__ rsa = (float*)(a.ws + WS_RSA); const float* __restrict__ gamma = a.in[I_N1G];
        for (int m = gw; m < TALL; m += nw) { const int b = m / TT, tt = m - b * TT; const bool ctx = tt < TC;
            const float* xr = ctx ? a.in[I_CTX] + (size_t)(b * TC + tt) * DM : a.in[I_X] + (size_t)(b * SEQ + tt - TC) * DM; const float* md = mods + (size_t)(ctx ? 32 : b) * 6144 + 1024;
            f32x4 v[4]; float ss = 0.f;
#pragma unroll
            for (int q = 0; q < 4; ++q) { v[q] = *(const f32x4*)(xr + q * 256 + lane * 4); ss += v[q][0] * v[q][0] + v[q][1] * v[q][1] + v[q][2] * v[q][2] + v[q][3] * v[q][3]; }
#pragma unroll
            for (int k = 1; k < 64; k <<= 1) ss = xorsum(ss, k);
            if (lane == 0) rsa[m] = ss;
#pragma unroll
            for (int q = 0; q < 4; ++q) { const int col = q * 256 + lane * 4; const f32x4 g = *(const f32x4*)(gamma + col), sc = *(const f32x4*)(md + col);
                u32x2 w; w.x = cvtpk(v[q][0] * g[0] * (1.f + sc[0]), v[q][1] * g[1] * (1.f + sc[1])); w.y = cvtpk(v[q][2] * g[2] * (1.f + sc[2]), v[q][3] * g[3] * (1.f + sc[3]));
                *(u32x2*)(H + (size_t)m * 1024 + col) = w; } }
    }
}

template <class Gt> DI void cvt_tile(bf16_t* __restrict__ dst, int ldk, int n0, int k0, const Gt& get, float*) {
    const int lane = ltid() & 63, n = n0 + lane;
#pragma unroll
    for (int ch = 0; ch < 4; ++ch) { float v[16];
#pragma unroll
        for (int kk = 0; kk < 16; ++kk) v[kk] = get(n, k0 + ch * 16 + kk);
        u32x4 w0, w1; w0.x = cvtpk(v[0], v[1]); w0.y = cvtpk(v[2], v[3]); w0.z = cvtpk(v[4], v[5]); w0.w = cvtpk(v[6], v[7]);
        w1.x = cvtpk(v[8], v[9]); w1.y = cvtpk(v[10], v[11]); w1.z = cvtpk(v[12], v[13]); w1.w = cvtpk(v[14], v[15]);
        bf16_t* p = dst + (size_t)n * ldk + k0 + ch * 16; *(u32x4*)p = w0; *(u32x4*)(p + 8) = w1; }
}
DI void convert_weights(const Args& a, int l, unsigned char* lds, int group) {
    float* tl = (float*)lds; unsigned char* ws = a.ws;
    const float* w_in = a.in[I_WIN] + (size_t)l * 1024 * CIN; const float* v1 = a.in[I_V1] + (size_t)(l > 0 ? l - 1 : 0) * 1024 * 32;
    const float* w_uq = a.in[I_WUQ] + (size_t)l * 256 * 768; const float* w_ukv = a.in[I_WUKV] + (size_t)l * 128 * 1024;
    const float* w2 = a.in[I_W2] + (size_t)l * 2 * 64 * 512; const float* a2 = a.in[I_A2] + (size_t)l * 2 * 64 * 512;
    const float* g2 = a.in[I_G2] + (size_t)l * 128 * 512; const float* v2 = a.in[I_V2] + (size_t)(l > 0 ? l - 1 : 0) * 32 * 512;
    const float* w_out = a.in[I_WOUT] + (size_t)l * 1024 * 1024; const float* m1 = a.in[I_M1] + (size_t)l * 1024 * 4096; const float* m2 = a.in[I_M2] + (size_t)l * 4096 * 1024;
    constexpr int T0 = 640, T1 = T0 + 48, T2 = T1 + 64, T3 = T2 + 128, T4 = T3 + 64, T5 = T4 + 256, T6 = T5 + 1024, T7 = T6 + 1024;
    const int tb = group == 0 ? 0 : T4, te = group == 0 ? T4 : T7;
    for (int t = tb + blockIdx.x * 8 + (ltid() >> 6); t < te; t += gridDim.x * 8) {
        if (t < T0) { const int nt = t >> 4, kt = t & 15;
            cvt_tile((bf16_t*)(ws + WT_IN), 1024, nt * 64, kt * 64, [&](int n, int k) -> float { return n < CIN ? w_in[(size_t)k * CIN + n] : ((n < CINX && l > 0) ? v1[k * 32 + (n - CIN)] : 0.f); }, tl); }
        else if (t < T1) { const int u = t - T0, nt = u >> 2, kt = u & 3;
            cvt_tile((bf16_t*)(ws + WT_UQ), 256, nt * 64, kt * 64, [&](int n, int k) -> float { return w_uq[k * 768 + n]; }, tl); }
        else if (t < T2) { const int u = t - T1, nt = u >> 2, kt = u & 3;
            cvt_tile((bf16_t*)(ws + WT_UKV), 256, nt * 64, kt * 64, [&](int n, int k) -> float { return k < 128 ? w_ukv[k * 1024 + n] : 0.f; }, tl); }
        else if (t < T3) { const int u = t - T2, nt = u >> 2, kt = u & 3;
            cvt_tile((bf16_t*)(ws + WT_L1), 256, nt * 64, kt * 64, [&](int n, int k) -> float {
                if (n < 1024) { const int d = n >> 9, c = n & 511; return (k < 128 && (k >> 6) == d) ? w2[(d * 64 + (k & 63)) * 512 + c] : 0.f; }
                const int n2 = n - 1024, d = n2 >> 9, c = n2 & 511; return (k >= 128 && ((k - 128) >> 6) == d) ? a2[(d * 64 + ((k - 128) & 63)) * 512 + c] : 0.f; }, tl); }
        else if (t < T4) { const int u = t - T3, nt = u >> 2, kt = u & 3;
            cvt_tile((bf16_t*)(ws + WT_L2), 256, nt * 64, kt * 64, [&](int n, int k) -> float {
                if (n < 512) return k < 128 ? g2[k * 512 + n] : 0.f;
                return (l > 0 && k >= 128 && k < 160) ? v2[(k - 128) * 512 + (n - 512)] : 0.f; }, tl); }
        else if (t < T5) { const int u = t - T4, nt = u >> 4, kt = u & 15;
            cvt_tile((bf16_t*)(ws + WT_OUT), 1024, nt * 64, kt * 64, [&](int n, int k) -> float { return w_out[(size_t)k * 1024 + n]; }, tl); }
        else if (t < T6) { const int u = t - T5, nt = u >> 4, kt = u & 15;
            cvt_tile((bf16_t*)(ws + WT_M1), 1024, nt * 64, kt * 64, [&](int n, int k) -> float { return m1[(size_t)k * 4096 + n]; }, tl); }
        else { const int u = t - T6, nt = u >> 6, kt = u & 63;
            cvt_tile((bf16_t*)(ws + WT_M2), 4096, nt * 64, kt * 64, [&](int n, int k) -> float { return m2[(size_t)k * 1024 + n]; }, tl); }
    }
}

DI void phase_norm(const Args& a, int l, const float* __restrict__ gamma, int shift_idx, int scale_idx, bool latent_only, bool from_input) {
    const int lane = ltid() & 63, gw = blockIdx.x * 8 + (ltid() >> 6), nw = gridDim.x * 8;
    float* xc = from_input ? (float*)a.in[I_CTX] : (float*)(a.ws + WS_XC); float* xo = from_input ? (float*)a.in[I_X] : a.out;
    bf16_t* __restrict__ H = (bf16_t*)(a.ws + WS_H); const float* __restrict__ mods = (const float*)(a.ws + WS_MODS) + (size_t)l * 33 * 6144;
    const int nrows = latent_only ? NB * SEQ : TALL;
    auto rowof = [&](int i) -> int { return latent_only ? (i >> 11) * TT + TC + (i & 2047) : i; };
    f32x4 v[4], nv[4];
    int i = gw;
    if (i < nrows) { const float* xr = xrow(xo, xc, rowof(i));
#pragma unroll
        for (int q = 0; q < 4; ++q) v[q] = *(const f32x4*)(xr + q * 256 + lane * 4); }
    for (; i < nrows; i += nw) {
        const int m = rowof(i), b = m / TT, tt = m - b * TT; const bool ctx = tt < TC;
        const bool hn = i + nw < nrows;
        if (hn) { const float* xn = xrow(xo, xc, rowof(i + nw));
#pragma unroll
            for (int q = 0; q < 4; ++q) nv[q] = *(const f32x4*)(xn + q * 256 + lane * 4); }
        const float* md = mods + (size_t)(ctx ? 32 : b) * 6144;
        float ss = 0.f;
#pragma unroll
        for (int q = 0; q < 4; ++q) ss += v[q][0] * v[q][0] + v[q][1] * v[q][1] + v[q][2] * v[q][2] + v[q][3] * v[q][3];
#pragma unroll
        for (int k = 1; k < 64; k <<= 1) ss = xorsum(ss, k);
        const float rstd = rsqrtf(ss * (1.f / 1024.f) + 1e-6f);
#pragma unroll
        for (int q = 0; q < 4; ++q) { const int col = q * 256 + lane * 4; const f32x4 g = *(const f32x4*)(gamma + col), sc = *(const f32x4*)(md + scale_idx * 1024 + col), sh = *(const f32x4*)(md + shift_idx * 1024 + col);
            float o[4];
#pragma unroll
            for (int j = 0; j < 4; ++j) o[j] = v[q][j] * rstd * g[j] * (1.f + sc[j]) + sh[j];
            u32x2 w; w.x = cvtpk(o[0], o[1]); w.y = cvtpk(o[2], o[3]); *(u32x2*)(H + (size_t)m * 1024 + col) = w; }
#pragma unroll
        for (int q = 0; q < 4; ++q) v[q] = nv[q];
    }
}

DI void unpack8(const u32x4& w, float (&f)[8]) { f[0] = bflo(w.x); f[1] = bfhi(w.x); f[2] = bflo(w.y); f[3] = bfhi(w.y); f[4] = bflo(w.z); f[5] = bfhi(w.z); f[6] = bflo(w.w); f[7] = bfhi(w.w); }
DI void shift8r(const u32x4& c_, const u32x4& p_, const u32x4& n_, const float* __restrict__ mu, int col, float (&o)[8]) {
    float c[8], p[8], n[8], u[8]; unpack8(c_, c); unpack8(p_, p); unpack8(n_, n); loadf8(mu + (col - OFF_R), u);
#pragma unroll
    for (int j = 0; j < 8; ++j) o[j] = c[j] + u[j] * (0.5f * (p[j] + n[j]) - c[j]);
}
DI void phase_split(const Args& a, int l) {
    const int lane = ltid() & 63, gw = blockIdx.x * 8 + (ltid() >> 6), nw = gridDim.x * 8;
    unsigned char* ws = a.ws;
    const bf16_t* __restrict__ F = (const bf16_t*)(ws + WS_F); bf16_t* __restrict__ R = (bf16_t*)(ws + WS_R); bf16_t* __restrict__ Kb = (bf16_t*)(ws + WS_K); bf16_t* __restrict__ Vb = (bf16_t*)(ws + (l == 0 ? WS_VF : WS_V));
    bf16_t* __restrict__ A1 = (bf16_t*)(ws + WS_A1); bf16_t* __restrict__ A2 = (bf16_t*)(ws + WS_A2); bf16_t* __restrict__ CQN = (bf16_t*)(ws + WS_CQN); bf16_t* __restrict__ CKVN = (bf16_t*)(ws + WS_CKVN); bf16_t* __restrict__ KA = (bf16_t*)(ws + WS_KATT);
    float* __restrict__ INV = (float*)(ws + WS_INV); const float* __restrict__ rope = (const float*)(ws + WS_ROPE);
    const float* __restrict__ mu = a.in[I_MU] + (size_t)l * 1920; const float* __restrict__ kkp = a.in[I_KK] + l * 512; const float* __restrict__ qg = a.in[I_QNG] + l * 256; const float* __restrict__ kvg = a.in[I_KVNG] + l * 128;
    const u32x4 zero4 = {0u, 0u, 0u, 0u};
    const int lcol = lane < 48 ? OFF_WLO + lane * 8 : (lane < 52 ? OFF_HV + (lane - 48) * 8 : 0);
    const int mcol = lane < 32 ? lane * 8 : (lane < 48 ? 256 + (lane - 32) * 8 : 384 + ((lane - 48) & 3) * 8);
    const int chunk = (TALL + nw - 1) / nw, m0 = gw * chunk, m1 = (m0 + chunk < TALL) ? m0 + chunk : TALL;
    struct Raw { u32x4 r, k, v, l; };
    auto ld4 = [&](int m) -> Raw { Raw t; if (m >= 0 && m < TALL) { const bf16_t* Fq = F + (size_t)m * CINX; t.r = *(const u32x4*)(Fq + OFF_R + lane * 8); t.k = *(const u32x4*)(Fq + OFF_K + lane * 8);
            t.v = *(const u32x4*)(Fq + OFF_V + lane * 8); t.l = (lane < 52) ? *(const u32x4*)(Fq + lcol) : zero4; } else { t.r = zero4; t.k = zero4; t.v = zero4; t.l = zero4; } return t; };
    auto ldm = [&](int m) -> u32x4 { return (m < TALL) ? *(const u32x4*)(F + (size_t)m * CINX + mcol) : zero4; };
    Raw P = ld4(m0 - 1), C = ld4(m0), N = ld4(m0 + 1); u32x4 M = ldm(m0);
    for (int m = m0; m < m1; ++m) {
        const int b = m / TT, tt = m - b * TT; const bool ctx = tt < TC;
        const bool pok = !(tt == 0 || tt == TC), nok = !(tt == TC - 1 || tt == TT - 1);
        const Raw NN = ld4(m + 2); const u32x4 MN = ldm(m + 1);
        u32x4 rc = C.r, kc = C.k, vc = C.v, lc = C.l, rp = P.r, kp = P.k, vp = P.v, lp = P.l, rn = N.r, kn = N.k, vn = N.v, ln = N.l; const u32x4 mc = M;
        if (!pok) { rp = zero4; kp = zero4; vp = zero4; lp = zero4; }
        if (!nok) { rn = zero4; kn = zero4; vn = zero4; ln = zero4; }
        P = C; C = N; N = NN; M = MN;
        float x[8];
        shift8r(rc, rp, rn, mu, OFF_R + lane * 8, x); store8(R + (size_t)m * 512 + lane * 8, x);
        shift8r(kc, kp, kn, mu, OFF_K + lane * 8, x); store8(Kb + (size_t)m * 512 + lane * 8, x);
        { float kq[8], ss = 0.f; loadf8(kkp + lane * 8, kq);
#pragma unroll
          for (int j = 0; j < 8; ++j) { const float t = x[j] * kq[j]; ss += t * t; }
          ss = xorsum(ss, 1); ss = xorsum(ss, 2); ss = xorsum(ss, 4);
          if ((lane & 7) == 0) INV[(size_t)m * 8 + (lane >> 3)] = 1.f / fmaxf(sqrtf(ss), 1e-12f); }
        shift8r(vc, vp, vn, mu, OFF_V + lane * 8, x); store8(Vb + (size_t)m * 512 + lane * 8, x);
        if (lane < 48) { shift8r(lc, lp, ln, mu, lcol, x);
            if (lane < 16) {
#pragma unroll
                for (int j = 0; j < 8; ++j) x[j] = tanhf(x[j]); }
            else if (lane >= 32) {
#pragma unroll
                for (int j = 0; j < 8; ++j) x[j] = sigmoidf_(x[j]); }
            if (lane < 32) store8(A1 + (size_t)m * 256 + lane * 8, x); else store8(A2 + (size_t)m * 256 + (lane - 32) * 8, x); }
        else { unpack8(lc, x); store8(A2 + (size_t)m * 256 + 128 + (lane - 48) * 8, x); }
        { unpack8(mc, x); float ss = 0.f;
#pragma unroll
          for (int j = 0; j < 8; ++j) ss += x[j] * x[j];
          ss = xorsum(ss, 1); ss = xorsum(ss, 2); ss = xorsum(ss, 4); ss = xorsum(ss, 8); const float ss32 = xorsum(ss, 16);
          float px[8]; const int q = (lane - 48) & 3;
#pragma unroll
          for (int j = 0; j < 8; ++j) px[j] = __shfl_xor(x[j], 1, 64);
          if (lane < 32) { const float rstd = rsqrtf(ss32 * (1.f / 256.f) + 1e-6f); float g[8]; loadf8(qg + lane * 8, g);
#pragma unroll
              for (int j = 0; j < 8; ++j) x[j] = x[j] * rstd * g[j];
              store8(CQN + (size_t)m * 256 + lane * 8, x); }
          else if (lane < 48) { const float rstd = rsqrtf(ss * (1.f / 128.f) + 1e-6f); float g[8]; loadf8(kvg + (lane - 32) * 8, g);
#pragma unroll
              for (int j = 0; j < 8; ++j) x[j] = x[j] * rstd * g[j];
              store8(CKVN + (size_t)m * 256 + (lane - 32) * 8, x); }
          else { if (lane < 52) {
                  if (!ctx) { const int s = tt - TC, pos = (q < 2) ? (s >> 6) : (s & 63); float cs[8], sn[8]; loadf8(rope + pos * 8, cs); loadf8(rope + 512 + pos * 8, sn); const float sg = (q & 1) ? 1.f : -1.f;
#pragma unroll
                      for (int j = 0; j < 8; ++j) x[j] = x[j] * cs[j] + sg * px[j] * sn[j]; }
#pragma unroll
                  for (int hh = 0; hh < 8; ++hh) store8(KA + (size_t)m * 768 + hh * 96 + 64 + q * 8, x); }
              float z[8];
#pragma unroll
              for (int j = 0; j < 8; ++j) z[j] = 0.f;
              store8(CKVN + (size_t)m * 256 + 128 + (lane - 48) * 8, z); } }
    }
}

DI void phase_rwkv_out(const Args& a, int l, bool latent_only) {
    const int lane = ltid() & 63, gw = blockIdx.x * 8 + (ltid() >> 6), nw = gridDim.x * 8;
    unsigned char* ws = a.ws;
    const bf16_t* R = (const bf16_t*)(ws + WS_R); const bf16_t* Kb = (const bf16_t*)(ws + WS_K); const bf16_t* Vb = (const bf16_t*)(ws + (l == 0 ? WS_VF : WS_V));
    const bf16_t* AA = (const bf16_t*)(ws + WS_AA); const bf16_t* Gb = (const bf16_t*)(ws + WS_G); const bf16_t* YB = (const bf16_t*)(ws + WS_YB); bf16_t* MIX = (bf16_t*)(ws + WS_MIX);
    const int c = lane * 8; float ka[8], rk[8], lw[8], lb[8];
    loadf8(a.in[I_KA] + l * 512 + c, ka); loadf8(a.in[I_RK] + l * 512 + c, rk); loadf8(a.in[I_LNW] + l * 512 + c, lw); loadf8(a.in[I_LNB] + l * 512 + c, lb);
    for (int m = gw; m < TALL; m += nw) {
        const int tt = m % TT; if (latent_only && tt < TC) continue;
        float yf[8], yb[8], r[8], k[8], v[8], a0[8], a1[8], g[8];
        load8(MIX + (size_t)m * 1024 + 512 + c, yf); load8(YB + (size_t)m * 512 + c, yb); load8(R + (size_t)m * 512 + c, r); load8(Kb + (size_t)m * 512 + c, k); load8(Vb + (size_t)m * 512 + c, v);
        load8(AA + (size_t)m * 1024 + c, a0); load8(AA + (size_t)m * 1024 + 512 + c, a1); load8(Gb + (size_t)m * 512 + c, g);
        float s = 0.f, bon = 0.f;
#pragma unroll
        for (int j = 0; j < 8; ++j) { yf[j] += yb[j]; s += yf[j]; bon += r[j] * k[j] * (2.f + (a0[j] + a1[j] - 2.f) * ka[j]) * rk[j]; }
        s = xorsum(s, 1); s = xorsum(s, 2); s = xorsum(s, 4); bon = xorsum(bon, 1); bon = xorsum(bon, 2); bon = xorsum(bon, 4);
        const float mean = s * (1.f / 64.f); float vs = 0.f;
#pragma unroll
        for (int j = 0; j < 8; ++j) { yf[j] -= mean; vs += yf[j] * yf[j]; }
        vs = xorsum(vs, 1); vs = xorsum(vs, 2); vs = xorsum(vs, 4);
        const float rstd = rsqrtf(vs * (1.f / 64.f) + 64e-5f);
#pragma unroll
        for (int j = 0; j < 8; ++j) yf[j] = (yf[j] * rstd * lw[j] + lb[j] + bon * v[j]) * g[j];
        store8(MIX + (size_t)m * 1024 + 512 + c, yf);
    }
}

DI void phase_final(const Args& a) {
    const int lane = ltid() & 63, gw = blockIdx.x * 8 + (ltid() >> 6), nw = gridDim.x * 8; const float* gamma = a.in[I_FG];
    for (int m = gw; m < NB * SEQ; m += nw) {
        float* xr = a.out + (size_t)m * DM; f32x4 v[4]; float ss = 0.f;
#pragma unroll
        for (int i = 0; i < 4; ++i) { v[i] = *(const f32x4*)(xr + i * 256 + lane * 4); ss += v[i][0] * v[i][0] + v[i][1] * v[i][1] + v[i][2] * v[i][2] + v[i][3] * v[i][3]; }
#pragma unroll
        for (int k = 1; k < 64; k <<= 1) ss = xorsum(ss, k);
        const float rstd = rsqrtf(ss * (1.f / 1024.f) + 1e-6f);
#pragma unroll
        for (int i = 0; i < 4; ++i) { const int col = i * 256 + lane * 4; const f32x4 g = *(const f32x4*)(gamma + col); *(f32x4*)(xr + col) = v[i] * rstd * g; }
    }
}

#define LAS __attribute__((address_space(3)))
#define XB_TMO      128
#define XB_XCNT(j)  (256  + 64 * (j))
#define XB_XSUB(j)  (1280 + 64 * (j))
#define XB_XGEN(j)  (2304 + 64 * (j))
#define XB_TOP      3328
#define XB_TOPGEN   3392
#define XCD_BAR_WORDS 3456
#define XB_SPIN_CAP (1u << 18)

__device__ __forceinline__ unsigned xb_ld(unsigned* p)              { return __hip_atomic_load(p, __ATOMIC_RELAXED, __HIP_MEMORY_SCOPE_AGENT); }
__device__ __forceinline__ unsigned xb_add(unsigned* p, unsigned v) { return __hip_atomic_fetch_add(p, v, __ATOMIC_RELAXED, __HIP_MEMORY_SCOPE_AGENT); }
__device__ __forceinline__ unsigned xb_xcc_id() { return (unsigned)__builtin_amdgcn_s_getreg((3 << 11) | 20) & 0xFu; }
#define XB_SPIN(cond, bar) do { unsigned _sp = 0; while (cond) { __builtin_amdgcn_s_sleep(1); \
    if ((++_sp & 255u) == 0u) { if (xb_ld(&(bar)[XB_TMO])) break; if (_sp > XB_SPIN_CAP) { atomicAdd(&(bar)[XB_TMO], 1u); break; } } } } while (0)

struct XcdBarrier {
    unsigned* bar; unsigned x;
    volatile LAS unsigned* st;
};

__device__ __forceinline__ XcdBarrier xcd_barrier_post(unsigned* bar, volatile LAS unsigned* st) {
    XcdBarrier b; b.bar = bar; b.x = xb_xcc_id(); b.st = st;
    if (threadIdx.x == 0) (void)xb_add(&bar[XB_XCNT(b.x)], 1u);
    return b;
}
__device__ __forceinline__ void xcd_barrier_complete(unsigned* bar, unsigned x, unsigned& nloc, unsigned& nx) {
    const unsigned G = gridDim.x * gridDim.y * gridDim.z;
    unsigned sum, cnt, mine, sp = 0u;
    for (;;) {
        sum = 0u; cnt = 0u; mine = 0u;
#pragma unroll
        for (unsigned j = 0; j < 16; ++j) { const unsigned c = xb_ld(&bar[XB_XCNT(j)]); sum += c; cnt += (c > 0u) ? 1u : 0u; mine = (j == x) ? c : mine; }
        if (sum == G) break;
        __builtin_amdgcn_s_sleep(1);
        if ((++sp & 255u) == 0u) { if (xb_ld(&bar[XB_TMO])) break; if (sp > XB_SPIN_CAP) { atomicAdd(&bar[XB_TMO], 1u); break; } }
    }
    nloc = mine > 0u ? mine : 1u; nx = cnt > 0u ? cnt : 1u;
}

__device__ __forceinline__ void xcd_barrier(const XcdBarrier& b) {
    asm volatile("s_waitcnt vmcnt(0)" ::: "memory");
    __syncthreads();
    if (threadIdx.x == 0) {
        unsigned* bar = b.bar;
        __builtin_amdgcn_s_waitcnt(0);
        unsigned nloc = b.st[0], nx = b.st[1];
        if (nloc == 0u) { xcd_barrier_complete(bar, b.x, nloc, nx); b.st[0] = nloc; b.st[1] = nx; }
        const unsigned old = xb_add(&bar[XB_XSUB(b.x)], 1u);
        const unsigned gen = old / nloc;
        if (old + 1u == (gen + 1u) * nloc) {
            __builtin_amdgcn_fence(__ATOMIC_RELEASE, "agent");
            asm volatile("s_waitcnt vmcnt(0)" ::: "memory");
            const unsigned og = xb_add(&bar[XB_TOP], 1u);
            const unsigned tg = og / nx;
            if (og + 1u == (tg + 1u) * nx) xb_add(&bar[XB_TOPGEN], 1u);
            else XB_SPIN(xb_ld(&bar[XB_TOPGEN]) == tg, bar);
            __builtin_amdgcn_fence(__ATOMIC_ACQUIRE, "agent");
            xb_add(&bar[XB_XGEN(b.x)], 1u);
            asm volatile("s_waitcnt vmcnt(0)" ::: "memory");
        } else {
            XB_SPIN(xb_ld(&bar[XB_XGEN(b.x)]) == gen, bar);
            __builtin_amdgcn_fence(__ATOMIC_ACQUIRE, "agent");
            asm volatile("s_waitcnt vmcnt(0)" ::: "memory");
        }
    }
    __syncthreads();
}

#ifndef DUPMASK
#define DUPMASK 0
#endif
#ifndef SUBM
#define SUBM 3
#endif
#ifndef PHMASK
#define PHMASK 0xfff
#endif
__global__ void __launch_bounds__(512, 2) trunk_fwd(Args ka) {
    extern __shared__ __attribute__((aligned(16))) unsigned char lds[];
    cg::grid_group grid = cg::this_grid();
    volatile LAS unsigned* bst = (volatile LAS unsigned*)((LAS unsigned char*)lds + (LDS_BYTES - 16));
    if (threadIdx.x < 4) bst[threadIdx.x] = 0u;
    __syncthreads();
    XcdBarrier xbar = xcd_barrier_post((unsigned*)(ka.ws + WS_BAR), bst);
    const int ph_hi = ka.hi;
    {
        if (blockIdx.x == 0 && threadIdx.x == 0) {
#pragma unroll
            for (int i = 0; i < 31; ++i) ((const float**)(ka.ws + WS_TAB))[i] = ka.in[i]; }
        phase_prologue(ka, lds); convert_weights(ka, 0, lds, 0);
        grid.sync();
    }
    for (int ph = 1; ph < ph_hi; ++ph) {
        Args a; a.ws = ka.ws; a.out = ka.out; asm volatile("" : "+s"(a.ws)); asm volatile("" : "+s"(a.out));
        { const float* const* tab = (const float* const*)(a.ws + WS_TAB);
#define LD4(i) asm volatile("s_load_dwordx2 %0, %4, %5\n\ts_load_dwordx2 %1, %4, %6\n\ts_load_dwordx2 %2, %4, %7\n\ts_load_dwordx2 %3, %4, %8\n\ts_waitcnt lgkmcnt(0)" \
              : "=&s"(a.in[i]), "=&s"(a.in[i + 1]), "=&s"(a.in[i + 2]), "=&s"(a.in[i + 3]) : "s"(tab), "i"((i) * 8), "i"((i) * 8 + 8), "i"((i) * 8 + 16), "i"((i) * 8 + 24))
          LD4(0); LD4(4); LD4(8); LD4(12); LD4(16); LD4(20); LD4(24);
          asm volatile("s_load_dwordx2 %0, %3, %4\n\ts_load_dwordx2 %1, %3, %5\n\ts_load_dwordx2 %2, %3, %6\n\ts_waitcnt lgkmcnt(0)" : "=&s"(a.in[28]), "=&s"(a.in[29]), "=&s"(a.in[30]) : "s"(tab), "i"(224), "i"(232), "i"(240));
#undef LD4
        }
        a.lo = 0; a.hi = 0;
        unsigned char* ws = a.ws;
        if (ph == 1) phase_vectors(a, lds);
        else if (ph == NPH - 1) phase_final(a);
        else {
            const int l = (ph - 2) / 10, s = (ph - 2) % 10; const bool last = (l == NL - 1);
            const float* mods = (const float*)(ws + WS_MODS) + (size_t)l * 33 * 6144;
            float* rsa = (float*)(ws + WS_RSA); float* rsb = (float*)(ws + WS_RSB);
            if (s == 0) { run_gemm<NIN, 1024>(lds, (const bf16_t*)(ws + WS_H), (const bf16_t*)(ws + WT_IN), 0, FnF{(bf16_t*)(ws + WS_F), rsa, (const float*)(ws + WS_C1) + (size_t)l * 33 * NIN}); }
            else if (s == 1) { phase_split(a, l); convert_weights(a, l, lds, 1);
                for (int i = blockIdx.x * 512 + ltid(); i < TALL; i += gridDim.x * 512) { rsa[i] = 0.f; rsb[i] = 0.f; } }
            else if (s == 2) { run_gemm<768, 256>(lds, (const bf16_t*)(ws + WS_CQN), (const bf16_t*)(ws + WT_UQ), 0, FnQ{(bf16_t*)(ws + WS_Q), (const float*)(ws + WS_ROPE)});
                    run_gemm<1024, 256>(lds, (const bf16_t*)(ws + WS_CKVN), (const bf16_t*)(ws + WT_UKV), 0, FnKV{(bf16_t*)(ws + WS_KATT), (bf16_t*)(ws + WS_VATT)}); }
            else if (s == 3) { phase_attn((const bf16_t*)(ws + WS_Q), (const bf16_t*)(ws + WS_KATT), (const bf16_t*)(ws + WS_VATT), (bf16_t*)(ws + WS_MIX), last, (char*)lds); }
            else if (s == 4) { run_gemm<2048, 256>(lds, (const bf16_t*)(ws + WS_A1), (const bf16_t*)(ws + WT_L1), 0, FnL1{(__half*)(ws + WS_DEC), (bf16_t*)(ws + WS_AA), a.in[I_W0] + l * 1024, a.in[I_A0] + l * 1024});
                    run_gemm<1024, 256>(lds, (const bf16_t*)(ws + WS_A2), (const bf16_t*)(ws + WT_L2), 0,
                             FnL2{(bf16_t*)(ws + WS_G), (bf16_t*)(ws + WS_V), (const bf16_t*)(ws + WS_VF), a.in[I_V0] + (l > 0 ? l - 1 : 0) * 512, l > 0 ? 1 : 0}); }
            else if (s == 5) { phase_scan((const bf16_t*)(ws + WS_R), (const bf16_t*)(ws + WS_K), (const bf16_t*)(ws + (l == 0 ? WS_VF : WS_V)), (const __half*)(ws + WS_DEC), (const bf16_t*)(ws + WS_AA),
                               (const float*)(ws + WS_INV), a.in[I_KK] + l * 512, a.in[I_KA] + l * 512, (bf16_t*)(ws + WS_MIX), (bf16_t*)(ws + WS_YB), (char*)lds); }
            else if (s == 6) { phase_rwkv_out(a, l, last); if (!last) convert_weights(a, l + 1, lds, 0); }
            else if (s == 7) { run_gemm_epi<1024, 1024>(lds, (const bf16_t*)(ws + WS_MIX), (const bf16_t*)(ws + WT_OUT), last ? 1 : 0,
                             EpiRes{a.out, (float*)(ws + WS_XC), l == 0 ? a.in[I_X] : a.out, l == 0 ? a.in[I_CTX] : (const float*)(ws + WS_XC), mods, 2,
                                    (const float*)(ws + WS_GP2) + (size_t)l * 33 * 1024, (bf16_t*)(ws + WS_H), rsb, 1}); }
            else if (s == 8) { run_gemm<DFF, 1024>(lds, (const bf16_t*)(ws + WS_H), (const bf16_t*)(ws + WT_M1), last ? 1 : 0, FnM1{(bf16_t*)(ws + WS_HID), rsb, (const float*)(ws + WS_C2) + (size_t)l * 33 * DFF}); }
            else if (s == 9) { run_gemm_epi<1024, DFF>(lds, (const bf16_t*)(ws + WS_HID), (const bf16_t*)(ws + WT_M2), last ? 1 : 0,
                             EpiRes{a.out, (float*)(ws + WS_XC), a.out, (const float*)(ws + WS_XC), mods, 5,
                                    (const float*)(ws + WS_GP1) + (size_t)(last ? l : l + 1) * 33 * 1024, (bf16_t*)(ws + WS_H), rsa, last ? 0 : 1}); }
        }
        if (ph + 1 < ph_hi) { XcdBarrier xb = xbar; asm volatile("" : "+s"(xb.bar)); xcd_barrier(xb); }
    }
}

extern "C" void kernel_launch(void* const* d_in, const int* in_sizes, int n_in, void* d_out, int out_size, void* d_ws, size_t ws_size, hipStream_t stream) {
    static int grid = 0;
    if (grid == 0) {
        if (n_in != 31 || out_size != NB * SEQ * DM || ws_size < WS_END) { fprintf(stderr, "kernel_launch: unexpected shapes: n_in %d out %d ws %zu (need %zu)\n", n_in, out_size, ws_size, (size_t)WS_END); grid = -1; return; }
        int dev = 0, cus = 0, per_cu = 0;
        (void)hipGetDevice(&dev); (void)hipDeviceGetAttribute(&cus, hipDeviceAttributeMultiprocessorCount, dev);
        if (hipFuncSetAttribute((const void*)trunk_fwd, hipFuncAttributeMaxDynamicSharedMemorySize, LDS_BYTES) != hipSuccess) { fprintf(stderr, "kernel_launch: hipFuncSetAttribute failed\n"); grid = -1; return; }
        if (hipOccupancyMaxActiveBlocksPerMultiprocessor(&per_cu, (const void*)trunk_fwd, 512, LDS_BYTES) != hipSuccess || per_cu < 1) { fprintf(stderr, "kernel_launch: occupancy query gave %d\n", per_cu); per_cu = 1; }
        (void)hipGetLastError();
        grid = cus * 1;
    }
    if (grid < 0) return;
    if (hipMemsetAsync((char*)d_ws + WS_BAR, 0, BAR_BYTES, stream) != hipSuccess) { fprintf(stderr, "kernel_launch: hipMemsetAsync failed\n"); return; }
    Args a{};
    for (int i = 0; i < 31; ++i) a.in[i] = (const float*)d_in[i];
    a.out = (float*)d_out; a.ws = (unsigned char*)d_ws; a.lo = 0; a.hi = NPH;
    void* args[] = {&a};
    hipError_t e = hipLaunchCooperativeKernel((const void*)trunk_fwd, dim3(grid), dim3(512), args, LDS_BYTES, stream);
    if (e != hipSuccess) fprintf(stderr, "kernel_launch: cooperative launch failed: %s (grid %d)\n", hipGetErrorString(e), grid);
}
```

```cpp
#include <hip/hip_runtime.h>
#include <hip/hip_cooperative_groups.h>
#include <hip/hip_fp16.h>
#include <cstdio>
#include <cstdint>
namespace cg = cooperative_groups;
#define DI __device__ __forceinline__
DI int ltid() { int t = threadIdx.x; asm volatile("" : "+v"(t)); return t; }
namespace pg8 {
#define PG8_LAS __attribute__((address_space(3)))
typedef unsigned short bf16_t;
typedef short bf16x8 __attribute__((ext_vector_type(8)));
typedef float f32x4 __attribute__((ext_vector_type(4)));
typedef unsigned u32x4 __attribute__((ext_vector_type(4)));
constexpr int BM = 256, BK = 64, HALF = 128, HTB = HALF * BK * 2  , STAGE_BYTES = 8 * HTB, NXCD = 8, WGM = 8;

__host__ __device__ __forceinline__ int lds_byte(int r, int c) { const int st = (r >> 4) * 2 + (c >> 5), rr = r & 15, cc = c & 31, ob = rr * 64 + cc * 2; return st * 1024 + (ob ^ (((ob >> 9) & 1) << 5)); }
__host__ __device__ __forceinline__ void stage_rc(int b, int& R, int& C) { const int st = b / 1024, sb = b % 1024, swz = sb ^ (((sb >> 9) & 1) << 5); R = (st >> 1) * 16 + swz / 64; C = (st & 1) * 32 + (swz % 64) / 2; }
__host__ __device__ __forceinline__ int perm32(int rho) { const int n = rho >> 4, i = rho & 15; return 8 * (i >> 2) + 4 * n + (i & 3); }

struct Unit { int pm, pn; };
struct Gemm { const bf16_t* A; const bf16_t* Bt; int M, N, K; };

struct StaticOrder {
    int nM, nN, nwg, G, c;
    __host__ __device__ void init(int M, int N, int G_, int c_) { nM = M / BM; nN = N / BM; nwg = nM * nN; G = G_; c = c_; }
    __host__ __device__ bool next(int i, Unit& u) const {
        const long L = (long)i * G + c; if (L >= nwg) return false;
        int wgid = (int)L; { const int q = nwg / NXCD, r = nwg % NXCD, xcd = wgid % NXCD, off = wgid / NXCD; wgid = (xcd < r ? xcd * (q + 1) : r * (q + 1) + (xcd - r) * q) + off; }
        const int nig = WGM * nN, gid = wgid / nig, fm = gid * WGM, gsz = (nM - fm) < WGM ? (nM - fm) : WGM;
        u.pm = fm + ((wgid % nig) % gsz); u.pn = (wgid % nig) / gsz; return true;
    }
    __device__ __forceinline__ void a_ready(const Unit&) const {}
    __device__ __forceinline__ void done(const Unit&) const {}
};

__device__ __forceinline__ unsigned cvt_pk_bf16(float lo, float hi) { unsigned r; asm volatile("v_cvt_pk_bf16_f32 %0, %1, %2" : "=v"(r) : "v"(lo), "v"(hi)); return r; }

template <class Epi, class Sched, bool ALIGN_EPI = false, bool SP2 = false>
__device__ __forceinline__ void gemm_phase(PG8_LAS unsigned char* lds, const Gemm g, const Sched& S, const Epi& E) {
    const int tid = ltid(), wid = __builtin_amdgcn_readfirstlane(tid >> 6), lane = tid & 63, wr = wid >> 2, wc = wid & 3, fr = lane & 15, fq = lane >> 4;
    const int K = g.K, nt = K / BK;
    unsigned voffA[2], voffB[2];
#pragma unroll
    for (int i = 0; i < 2; ++i) { int R, C; stage_rc(tid * 16 + i * 8192, R, C); const int Rb = Epi::PERM ? ((R & ~31) + perm32(R & 31)) : R;
        voffA[i] = (unsigned)(R * K + C) * 2u; voffB[i] = (unsigned)(Rb * K + C) * 2u; }
    const size_t kstep = (size_t)(BK * 2);
    const size_t hstep = (size_t)HALF * K * 2;
    const size_t tstep = 2 * hstep;
    const unsigned ldsw = (unsigned)wid * 1024u;
    const int aoff = lds_byte(wr * 64 + fr, fq * 8), boff = lds_byte(wc * 32 + fr, fq * 8);
#define PG8_SA(b, h) (((b) * 2 + (h)) * HTB)
#define PG8_SB(b, h) ((4 + (b) * 2 + (h)) * HTB)
#define PG8_STAGE(bufoff, gbase, voff) do { _Pragma("unroll") for (int _i = 0; _i < 2; ++_i) \
        __builtin_amdgcn_global_load_lds((const unsigned*)((const char*)(gbase) + (voff)[_i]), (PG8_LAS unsigned*)(lds + (bufoff) + ldsw + _i * 8192), 16, 0, 0); } while (0)
#define PG8_LDA(dst, b, h) do { _Pragma("unroll") for (int m = 0; m < 4; ++m) _Pragma("unroll") for (int k = 0; k < 2; ++k) dst[m][k] = *(const PG8_LAS bf16x8*)(lds + PG8_SA(b, h) + aoff + m * 2048 + k * 1024); } while (0)
#define PG8_LDB(dst, b, h) do { _Pragma("unroll") for (int n = 0; n < 2; ++n) _Pragma("unroll") for (int k = 0; k < 2; ++k) dst[n][k] = *(const PG8_LAS bf16x8*)(lds + PG8_SB(b, h) + boff + n * 2048 + k * 1024); } while (0)
#define PG8_MMA(ai, bj, At, Bt) do { __builtin_amdgcn_s_setprio(1); _Pragma("unroll") for (int m = 0; m < 4; ++m) _Pragma("unroll") for (int n = 0; n < 2; ++n) _Pragma("unroll") for (int k = 0; k < 2; ++k) \
        acc[ai][bj][m][n] = __builtin_amdgcn_mfma_f32_16x16x32_bf16(Bt[n][k], At[m][k], acc[ai][bj][m][n], 0, 0, 0); __builtin_amdgcn_s_setprio(0); } while (0)
#define PG8_WAIT_V(n) asm volatile("s_waitcnt vmcnt(" #n ")" ::: "memory")
#define PG8_WAIT_L(n) asm volatile("s_waitcnt lgkmcnt(" #n ")" ::: "memory")
#define PG8_BAR __builtin_amdgcn_s_barrier()
#define PG8_SCHED __builtin_amdgcn_sched_barrier(0)
    Unit cur, nxt; int ui = 0;
    if (!S.next(0, cur)) return;
    f32x4 acc[2][2][4][2];
#pragma unroll
    for (int a = 0; a < 2; ++a)
#pragma unroll
        for (int b = 0; b < 2; ++b)
#pragma unroll
            for (int m = 0; m < 4; ++m)
#pragma unroll
                for (int n = 0; n < 2; ++n) acc[a][b][m][n] = (f32x4){0.f, 0.f, 0.f, 0.f};
    bf16x8 At[4][2], B0[2][2], B1[2][2];
    const char* cA = (const char*)g.A + (size_t)cur.pm * tstep; const char* cB = (const char*)g.Bt + (size_t)cur.pn * tstep;
    S.a_ready(cur);
    if constexpr (SP2) {
        PG8_STAGE(PG8_SB(0, 0), cB, voffB); PG8_STAGE(PG8_SB(0, 1), cB + hstep, voffB); PG8_STAGE(PG8_SA(0, 0), cA, voffA); PG8_STAGE(PG8_SA(0, 1), cA + hstep, voffA);
        if (wr == 1) PG8_BAR;
        PG8_WAIT_V(2); PG8_BAR;
        PG8_STAGE(PG8_SB(1, 0), cB + kstep, voffB); PG8_STAGE(PG8_SA(1, 0), cA + kstep, voffA); PG8_STAGE(PG8_SB(1, 1), cB + hstep + kstep, voffB);
        PG8_WAIT_V(6); PG8_BAR;
    } else {
        PG8_STAGE(PG8_SB(0, 0), cB, voffB); PG8_STAGE(PG8_SA(0, 0), cA, voffA); PG8_STAGE(PG8_SB(0, 1), cB + hstep, voffB); PG8_STAGE(PG8_SA(0, 1), cA + hstep, voffA);
        if (wr == 1) PG8_BAR;
        PG8_WAIT_V(4); PG8_BAR;
        PG8_STAGE(PG8_SB(1, 0), cB + kstep, voffB); PG8_STAGE(PG8_SA(1, 0), cA + kstep, voffA); PG8_STAGE(PG8_SB(1, 1), cB + hstep + kstep, voffB);
        PG8_WAIT_V(6); PG8_BAR;
    }
    for (;;) {
        const bool has_next = S.next(ui + 1, nxt);
        const char* nA = has_next ? (const char*)g.A + (size_t)nxt.pm * tstep : cA; const char* nB = has_next ? (const char*)g.Bt + (size_t)nxt.pn * tstep : cB;
#pragma nounroll
        for (int t = 0; t < nt; t += 2) {
            const bool last = (t == nt - 2);
            const char* a1 = cA + (size_t)(t + 1) * kstep;
            const char* a2 = last ? nA : cA + (size_t)(t + 2) * kstep; const char* b2 = last ? nB : cB + (size_t)(t + 2) * kstep;
            const char* a3 = a2 + kstep; const char* b3 = b2 + kstep;
            if (last && has_next) S.a_ready(nxt);
            if constexpr (SP2) {
            PG8_LDB(B0, 0, 0); PG8_LDB(B1, 0, 1); PG8_SCHED; PG8_LDA(At, 0, 0); PG8_STAGE(PG8_SA(1, 1), a1 + hstep, voffA);
            PG8_WAIT_V(8); PG8_WAIT_L(0); PG8_BAR; PG8_MMA(0, 0, At, B0); PG8_MMA(0, 1, At, B1); PG8_BAR; PG8_SCHED;
            PG8_LDA(At, 0, 1); PG8_STAGE(PG8_SB(0, 0), b2, voffB); PG8_STAGE(PG8_SB(0, 1), b2 + hstep, voffB); PG8_STAGE(PG8_SA(0, 0), a2, voffA);
            PG8_WAIT_V(8); PG8_WAIT_L(0); PG8_BAR; PG8_MMA(1, 0, At, B0); PG8_MMA(1, 1, At, B1); PG8_BAR; PG8_SCHED;
            PG8_LDB(B0, 1, 0); PG8_LDB(B1, 1, 1); PG8_SCHED; PG8_LDA(At, 1, 0); PG8_STAGE(PG8_SA(0, 1), a2 + hstep, voffA);
            PG8_WAIT_V(8); PG8_WAIT_L(0); PG8_BAR; PG8_MMA(0, 0, At, B0); PG8_MMA(0, 1, At, B1); PG8_BAR; PG8_SCHED;
            PG8_LDA(At, 1, 1); PG8_STAGE(PG8_SB(1, 0), b3, voffB); PG8_STAGE(PG8_SB(1, 1), b3 + hstep, voffB); PG8_STAGE(PG8_SA(1, 0), a3, voffA);
            PG8_WAIT_V(8); PG8_WAIT_L(0); PG8_BAR; PG8_MMA(1, 0, At, B0); PG8_MMA(1, 1, At, B1); PG8_BAR; PG8_SCHED;
            } else {
            PG8_LDB(B0, 0, 0); PG8_SCHED; PG8_LDA(At, 0, 0); PG8_STAGE(PG8_SA(1, 1), a1 + hstep, voffA);
            PG8_WAIT_L(8); PG8_BAR; PG8_WAIT_L(0); PG8_MMA(0, 0, At, B0); PG8_BAR; PG8_SCHED;
            PG8_LDB(B1, 0, 1); PG8_STAGE(PG8_SB(0, 0), b2, voffB);
            PG8_BAR; PG8_WAIT_L(0); PG8_MMA(0, 1, At, B1); PG8_BAR;
            PG8_LDA(At, 0, 1); PG8_STAGE(PG8_SA(0, 0), a2, voffA);
            PG8_BAR; PG8_WAIT_L(0); PG8_MMA(1, 0, At, B0); PG8_BAR; PG8_SCHED;
            PG8_STAGE(PG8_SB(0, 1), b2 + hstep, voffB);
            PG8_WAIT_V(6); PG8_BAR; PG8_MMA(1, 1, At, B1); PG8_BAR;
            PG8_LDB(B0, 1, 0); PG8_SCHED; PG8_LDA(At, 1, 0); PG8_STAGE(PG8_SA(0, 1), a2 + hstep, voffA);
            PG8_WAIT_L(8); PG8_BAR; PG8_WAIT_L(0); PG8_MMA(0, 0, At, B0); PG8_BAR; PG8_SCHED;
            PG8_LDB(B1, 1, 1); PG8_STAGE(PG8_SB(1, 0), b3, voffB);
            PG8_BAR; PG8_WAIT_L(0); PG8_MMA(0, 1, At, B1); PG8_BAR;
            PG8_LDA(At, 1, 1); PG8_STAGE(PG8_SA(1, 0), a3, voffA);
            PG8_BAR; PG8_WAIT_L(0); PG8_MMA(1, 0, At, B0); PG8_BAR; PG8_SCHED;
            PG8_STAGE(PG8_SB(1, 1), b3 + hstep, voffB);
            PG8_WAIT_V(6); PG8_BAR; PG8_MMA(1, 1, At, B1); PG8_BAR;
            }
        }
        if constexpr (ALIGN_EPI) { if (wr == 0) PG8_BAR; }
        if constexpr (!Epi::AFTER_DRAIN) { E(acc, cur, wr, wc, fr, fq); S.done(cur); }
        if (!has_next) break;
#pragma unroll
        for (int a = 0; a < 2; ++a)
#pragma unroll
            for (int b = 0; b < 2; ++b)
#pragma unroll
                for (int m = 0; m < 4; ++m)
#pragma unroll
                    for (int n = 0; n < 2; ++n) acc[a][b][m][n] = (f32x4){0.f, 0.f, 0.f, 0.f};
        cur = nxt; cA = nA; cB = nB; ++ui;
        if constexpr (ALIGN_EPI) { if (wr == 1) PG8_BAR; }
    }
    PG8_WAIT_V(0);
    if constexpr (!ALIGN_EPI) { if (wr == 0) PG8_BAR; }
    PG8_BAR;
    if constexpr (Epi::AFTER_DRAIN) { E.fused(acc, cur, wr, wc, fr, fq, lds, wid, lane); S.done(cur); }
#undef PG8_SA
#undef PG8_SB
#undef PG8_STAGE
#undef PG8_LDA
#undef PG8_LDB
#undef PG8_MMA
#undef PG8_WAIT_V
#undef PG8_WAIT_L
#undef PG8_BAR
#undef PG8_SCHED
}
}
typedef unsigned short bf16_t;
using bf16x8 = __attribute__((ext_vector_type(8))) short;
using s16x4  = __attribute__((ext_vector_type(4))) short;
using f32x16 = __attribute__((ext_vector_type(16))) float;
using f32x4  = __attribute__((ext_vector_type(4))) float;
using u32x4  = __attribute__((ext_vector_type(4))) unsigned;
using u32x2  = __attribute__((ext_vector_type(2))) unsigned;

constexpr int DM = 1024, NB = 32, SEQ = 2048, TC = 256, TT = 2304, TALL = NB * TT, NL = 4;
constexpr int CIN = 2336, CINX = 2368, NIN = 2560, DFF = 4096;
constexpr int OFF_R = 416, OFF_K = 928, OFF_V = 1440, OFF_WLO = 1952, OFF_HV = 2336;
constexpr int NPH = 43, LDS_BYTES = 147456;
constexpr size_t MiB = 1u << 20;
constexpr size_t WS_MODS = 0, WS_ROPE = 3 * MiB + 512 * 1024, WS_BAR = 3 * MiB + 768 * 1024, BAR_BYTES = 16384, WS_TAB = 3 * MiB + 800 * 1024, WS_XC = 4 * MiB, WS_VF = 36 * MiB, WS_WT = 108 * MiB, WS_INV = 134 * MiB, TR = 137 * MiB;
constexpr size_t WT_IN = WS_WT, WT_UQ = WS_WT + 5 * MiB, WT_UKV = WS_WT + 5 * MiB + 512 * 1024, WT_L1 = WS_WT + 6 * MiB, WT_L2 = WS_WT + 7 * MiB,
                 WT_OUT = WS_WT + 8 * MiB, WT_M1 = WS_WT + 10 * MiB, WT_M2 = WS_WT + 18 * MiB;
constexpr size_t WS_R = TR, WS_K = TR + 72 * MiB, WS_H = TR, WS_F = TR + 144 * MiB, WS_Q = TR + 144 * MiB, WS_VATT = TR + 252 * MiB, WS_MIX = TR + 324 * MiB,
                 WS_DEC = TR + 144 * MiB, WS_HID = TR + 144 * MiB, WS_A1 = TR + 477 * MiB, WS_A2 = TR + 513 * MiB, WS_YB = TR + 477 * MiB,
                 WS_CQN = TR + 549 * MiB, WS_CKVN = TR + 585 * MiB, WS_KATT = TR + 621 * MiB, WS_AA = TR + 585 * MiB, WS_G = TR + 729 * MiB,
                 WS_V = TR + 801 * MiB, WS_C1 = 1010 * MiB, WS_C2 = 1012 * MiB, WS_GP1 = 1015 * MiB, WS_GP2 = 1016 * MiB, WS_END = 1017 * MiB;
constexpr size_t WS_RSA = 136 * MiB + 256 * 1024, WS_RSB = 136 * MiB + 640 * 1024;

struct Args { const float* in[31]; float* out; unsigned char* ws; int lo, hi; };
enum { I_X = 0, I_C, I_CTX, I_CCTX, I_ADAW, I_ADAB, I_N1G, I_N2G, I_WIN, I_QNG, I_WUQ, I_KVNG, I_WUKV, I_MU, I_W0, I_W2, I_A0, I_A2, I_G2, I_KK, I_KA, I_RK,
       I_LNW, I_LNB, I_V1, I_V2, I_V0, I_WOUT, I_M1, I_M2, I_FG };

DI float bflo(unsigned w) { return __uint_as_float(w << 16); }
DI float bfhi(unsigned w) { return __uint_as_float(w & 0xffff0000u); }
DI unsigned cvtpk(float lo, float hi) { return pg8::cvt_pk_bf16(lo, hi); }
DI bf16_t f2bf(float f) { return (bf16_t)(cvtpk(f, 0.f) & 0xffffu); }
DI void load8(const bf16_t* p, float (&f)[8]) { const u32x4 w = *(const u32x4*)p; f[0] = bflo(w.x); f[1] = bfhi(w.x); f[2] = bflo(w.y); f[3] = bfhi(w.y); f[4] = bflo(w.z); f[5] = bfhi(w.z); f[6] = bflo(w.w); f[7] = bfhi(w.w); }
DI void store8(bf16_t* p, const float (&f)[8]) { u32x4 w; w.x = cvtpk(f[0], f[1]); w.y = cvtpk(f[2], f[3]); w.z = cvtpk(f[4], f[5]); w.w = cvtpk(f[6], f[7]); *(u32x4*)p = w; }
DI void loadf8(const float* p, float (&f)[8]) { const f32x4 a = *(const f32x4*)p, b = *(const f32x4*)(p + 4); f[0] = a[0]; f[1] = a[1]; f[2] = a[2]; f[3] = a[3]; f[4] = b[0]; f[5] = b[1]; f[6] = b[2]; f[7] = b[3]; }
DI float h2f(unsigned b) { return __half2float(__ushort_as_half((unsigned short)b)); }
DI float sigmoidf_(float x) { return __builtin_amdgcn_rcpf(1.f + __expf(-x)); }
DI float tanhf_(float x) { return 1.f - 2.f * __builtin_amdgcn_rcpf(1.f + __expf(2.f * x)); }
DI float xorsum(float v, int mask) { return v + __shfl_xor(v, mask, 64); }
DI float* xrow(float* out, float* xc, int m) { const int b = m / TT, tt = m - b * TT; return tt < TC ? xc + (size_t)(b * TC + tt) * DM : out + (size_t)(b * SEQ + tt - TC) * DM; }

template <class Fn> struct Epi8 {
    static constexpr bool PERM = true, AFTER_DRAIN = false; Fn f;
    DI void operator()(const pg8::f32x4 (&acc)[2][2][4][2], const pg8::Unit& u, int wr, int wc, int fr, int fq) const {
        asm volatile("" : "+v"(fr), "+v"(fq));
#pragma unroll
        for (int ai = 0; ai < 2; ++ai)
#pragma unroll
            for (int m = 0; m < 4; ++m) { const int rit = ai * 128 + wr * 64 + m * 16 + fr;
#pragma unroll
                for (int bj = 0; bj < 2; ++bj) { f(rit, u.pn * 256 + bj * 128 + wc * 32 + 8 * fq, acc[ai][bj][m][0], acc[ai][bj][m][1], u, fq); __builtin_amdgcn_sched_barrier(0); } }
    }
};
DI void st8(bf16_t* p, const pg8::f32x4& v0, const pg8::f32x4& v1) { u32x4 w; w.x = cvtpk(v0[0], v0[1]); w.y = cvtpk(v0[2], v0[3]); w.z = cvtpk(v1[0], v1[1]); w.w = cvtpk(v1[2], v1[3]); *(u32x4*)p = w; }

struct FnF { bf16_t* F; const float* rs; const float* c1;
    DI void operator()(int rit, int col0, const pg8::f32x4& v0, const pg8::f32x4& v1, const pg8::Unit& u, int) const {
        if (col0 < CINX) { const int row = u.pm * 256 + rit, b = u.pm / 9, mrow = (u.pm - b * 9 == 0) ? 32 : b;
            const float rstd = rsqrtf(rs[row] * (1.f / 1024.f) + 1e-6f); const float* c = c1 + (size_t)mrow * NIN + col0;
            const pg8::f32x4 b0 = *(const pg8::f32x4*)c, b1 = *(const pg8::f32x4*)(c + 4);
            st8(F + (size_t)row * CINX + col0, v0 * rstd + b0, v1 * rstd + b1); } } };
struct FnQ { bf16_t* Q; const float* rope;
    DI void operator()(int rit, int col0, const pg8::f32x4& v0, const pg8::f32x4& v1, const pg8::Unit& u, int fq) const {
        const int seg = u.pm % 9; const bool isrope = (seg != 0) && (((col0 >> 5) % 3) == 2);
        float x[8] = {v0[0], v0[1], v0[2], v0[3], v1[0], v1[1], v1[2], v1[3]};
        if (isrope) { const int s = (seg - 1) * 256 + rit, pos = (fq < 2) ? (s >> 6) : (s & 63); float cs[8], sn[8]; loadf8(rope + pos * 8, cs); loadf8(rope + 512 + pos * 8, sn);
            const float sg = (fq & 1) ? 1.f : -1.f;
#pragma unroll
            for (int j = 0; j < 8; ++j) { const float p = __shfl_xor(x[j], 16, 64); x[j] = x[j] * cs[j] + sg * p * sn[j]; } }
        store8(Q + (size_t)(u.pm * 256 + rit) * 768 + col0, x); } };
struct FnKV { bf16_t* KA; bf16_t* VA;
    DI void operator()(int rit, int col0, const pg8::f32x4& v0, const pg8::f32x4& v1, const pg8::Unit& u, int) const {
        const size_t row = (size_t)(u.pm * 256 + rit); const int h = col0 >> 7, c = col0 & 127;
        if (c < 64) st8(KA + row * 768 + h * 96 + c, v0, v1); else st8(VA + row * 512 + h * 64 + (c - 64), v0, v1); } };
struct FnL1 { __half* DEC; bf16_t* AA; const float* w0; const float* a0;
    DI void operator()(int rit, int col0, const pg8::f32x4& v0, const pg8::f32x4& v1, const pg8::Unit& u, int) const {
        const size_t row = (size_t)(u.pm * 256 + rit); float x[8] = {v0[0], v0[1], v0[2], v0[3], v1[0], v1[1], v1[2], v1[3]};
        if (col0 < 1024) { float b[8]; loadf8(w0 + col0, b); u32x4 w; unsigned hh[8];
#pragma unroll
            for (int j = 0; j < 8; ++j) { const float uu = 0.6065306597f * sigmoidf_(x[j] + b[j]); hh[j] = (unsigned)__half_as_ushort(__float2half(-uu * 1.4426950409f)); }
            w.x = hh[0] | (hh[1] << 16); w.y = hh[2] | (hh[3] << 16); w.z = hh[4] | (hh[5] << 16); w.w = hh[6] | (hh[7] << 16);
            *(u32x4*)(DEC + row * 1024 + col0) = w;
        } else { const int c = col0 - 1024; float b[8]; loadf8(a0 + c, b);
#pragma unroll
            for (int j = 0; j < 8; ++j) x[j] = sigmoidf_(x[j] + b[j]);
            store8(AA + row * 1024 + c, x); } } };
struct FnL2 { bf16_t* G; bf16_t* V; const bf16_t* VF; const float* v0p; int dovres;
    DI void operator()(int rit, int col0, const pg8::f32x4& v0, const pg8::f32x4& v1, const pg8::Unit& u, int) const {
        const size_t row = (size_t)(u.pm * 256 + rit);
        if (col0 < 512) st8(G + row * 512 + col0, v0, v1);
        else if (dovres) { const int c = col0 - 512; float x[8] = {v0[0], v0[1], v0[2], v0[3], v1[0], v1[1], v1[2], v1[3]}, b[8], v[8], vf[8]; loadf8(v0p + c, b); load8(V + row * 512 + c, v); load8(VF + row * 512 + c, vf);
#pragma unroll
            for (int j = 0; j < 8; ++j) v[j] = v[j] + (vf[j] - v[j]) * sigmoidf_(b[j] + x[j]);
            store8(V + row * 512 + c, v); } } };
struct FnM1 { bf16_t* HID; const float* rs; const float* c2;
    DI void operator()(int rit, int col0, const pg8::f32x4& v0, const pg8::f32x4& v1, const pg8::Unit& u, int) const {
        const int row = u.pm * 256 + rit, b = u.pm / 9, mrow = (u.pm - b * 9 == 0) ? 32 : b;
        const float rstd = rsqrtf(rs[row] * (1.f / 1024.f) + 1e-6f); const float* c = c2 + (size_t)mrow * DFF + col0;
        const pg8::f32x4 b0 = *(const pg8::f32x4*)c, b1 = *(const pg8::f32x4*)(c + 4);
        const pg8::f32x4 y0 = v0 * rstd + b0, y1 = v1 * rstd + b1;
        float x[8] = {y0[0], y0[1], y0[2], y0[3], y1[0], y1[1], y1[2], y1[3]};
#pragma unroll
        for (int j = 0; j < 8; ++j) { const float r = fmaxf(x[j], 0.f); x[j] = r * r; }
        store8(HID + (size_t)row * DFF + col0, x); } };
struct EpiRes { static constexpr bool PERM = true, AFTER_DRAIN = false;
    float* out; float* xc; const float* sx; const float* sc; const float* mods; int gidx; const float* gp; bf16_t* H; float* rs; int emit;
    DI void operator()(const pg8::f32x4 (&acc)[2][2][4][2], const pg8::Unit& u, int wr, int wc, int fr, int fq) const {
        asm volatile("" : "+v"(fr), "+v"(fq));
        const int b = u.pm / 9, seg = u.pm - b * 9, mrow = seg == 0 ? 32 : b;
        const float* gbase = mods + (size_t)mrow * 6144 + gidx * 1024; const float* gpb = gp + (size_t)mrow * 1024;
#pragma unroll
        for (int ai = 0; ai < 2; ++ai)
#pragma unroll
            for (int m = 0; m < 4; ++m) { const int rit = ai * 128 + wr * 64 + m * 16 + fr; float ss = 0.f;
                const size_t roff = (seg == 0 ? (size_t)(b * TC + rit) * DM : (size_t)(b * SEQ + (seg - 1) * 256 + rit) * DM);
#pragma unroll
                for (int bj = 0; bj < 2; ++bj) { const int col0 = u.pn * 256 + bj * 128 + wc * 32 + 8 * fq;
                    float* p = (seg == 0 ? xc : out) + roff + col0; const float* q = (seg == 0 ? sc : sx) + roff + col0;
                    const pg8::f32x4 g0 = *(const pg8::f32x4*)(gbase + col0), g1 = *(const pg8::f32x4*)(gbase + col0 + 4); pg8::f32x4 x0 = *(const pg8::f32x4*)q, x1 = *(const pg8::f32x4*)(q + 4);
                    x0 += g0 * acc[ai][bj][m][0]; x1 += g1 * acc[ai][bj][m][1]; *(pg8::f32x4*)p = x0; *(pg8::f32x4*)(p + 4) = x1;
                    if (emit) { const pg8::f32x4 p0 = *(const pg8::f32x4*)(gpb + col0), p1 = *(const pg8::f32x4*)(gpb + col0 + 4);
                        ss += x0[0] * x0[0] + x0[1] * x0[1] + x0[2] * x0[2] + x0[3] * x0[3] + x1[0] * x1[0] + x1[1] * x1[1] + x1[2] * x1[2] + x1[3] * x1[3];
                        st8(H + (size_t)(u.pm * 256 + rit) * 1024 + col0, x0 * p0, x1 * p1); }
                    __builtin_amdgcn_sched_barrier(0); }
                if (emit) { ss += __shfl_xor(ss, 16, 64); ss += __shfl_xor(ss, 32, 64); if (fq == 0) atomicAdd(rs + u.pm * 256 + rit, ss); }
            }
    }
};
struct Order { pg8::StaticOrder s; int lat;
    DI void init(int lat_, int N) { lat = lat_; s.init(lat_ ? NB * SEQ : TALL, N, (int)gridDim.x, (int)blockIdx.x); }
    DI bool next(int i, pg8::Unit& u) const { if (!s.next(i, u)) return false; if (lat) u.pm = (u.pm >> 3) * 9 + 1 + (u.pm & 7); return true; }
    DI void a_ready(const pg8::Unit&) const {}
    DI void done(const pg8::Unit&) const {}
};
template <int N, int K, class Fn> DI void run_gemm(unsigned char* lds, const bf16_t* A, const bf16_t* Bt, int lat, const Fn& fn) {
    pg8::Gemm g{A, Bt, lat ? NB * SEQ : TALL, N, K}; Order S; S.init(lat, N); Epi8<Fn> E{fn};
    pg8::gemm_phase<Epi8<Fn>, Order, true, true>((PG8_LAS unsigned char*)lds, g, S, E);
    __syncthreads();
}
template <int N, int K, class Epi> DI void run_gemm_epi(unsigned char* lds, const bf16_t* A, const bf16_t* Bt, int lat, const Epi& E) {
    pg8::Gemm g{A, Bt, lat ? NB * SEQ : TALL, N, K}; Order S; S.init(lat, N);
    pg8::gemm_phase<Epi, Order, true, true>((PG8_LAS unsigned char*)lds, g, S, E);
    __syncthreads();
}
namespace att {
constexpr int NW = 8, QBLK = 32, KVBLK = 64;
constexpr float SCALE = 0.10206207261596577f, THR = 8.f;
constexpr int LDQ = 768, LDKK = 768, LDV = 512, LDO = 1024;
constexpr int SHM_V = KVBLK * 64 * 2, SHM_K = KVBLK * 256, SHM_ATTN = 2 * SHM_V + 2 * SHM_K + NW * 64 * 4;
#define KSWZ(row, colB) ((row) * 256 + ((colB) ^ (((row) & 7) << 4)))
#define SBAR() __builtin_amdgcn_sched_barrier(0)
DI int crow(int r, int hi) { return (r & 3) + 8 * (r >> 2) + 4 * hi; }
DI unsigned cvtpk_(float lo, float hi) { unsigned r; asm volatile("v_cvt_pk_bf16_f32 %0, %1, %2" : "=v"(r) : "v"(lo), "v"(hi)); return r; }
DI void partialSM(f32x16& p0, f32x16& p1, float& m_reg, float& mn, float& alpha) {
  constexpr float C = SCALE * 1.4426950408889634f;
  float pmax = p0[0];
#pragma unroll
  for (int r = 1; r < 16; ++r) pmax = fmaxf(pmax, p0[r]);
#pragma unroll
  for (int r = 0; r < 16; ++r) pmax = fmaxf(pmax, p1[r]);
  { auto rr = __builtin_amdgcn_permlane32_swap(__float_as_uint(pmax), __float_as_uint(pmax), false, false);
    pmax = fmaxf(__uint_as_float(rr[0]), __uint_as_float(rr[1])); }
  if (__builtin_expect(__all(pmax - m_reg <= THR / SCALE), 1)) { mn = m_reg; alpha = 1.f; }
  else { mn = fmaxf(m_reg, pmax); alpha = __builtin_amdgcn_exp2f((m_reg - mn) * C); m_reg = mn; }
  const float mnC = -mn * C;
#pragma unroll
  for (int r = 0; r < 16; ++r) p0[r] = fmaf(p0[r], C, mnC);
#pragma unroll
  for (int r = 0; r < 16; ++r) p1[r] = fmaf(p1[r], C, mnC);
#pragma unroll
  for (int r = 0; r < 16; ++r) p0[r] = __builtin_amdgcn_exp2f(p0[r]);
}
DI void finishSM(f32x16& p0, f32x16& p1, float alpha, float& l_reg, bf16x8& pa0, bf16x8& pa1, bf16x8& pa2, bf16x8& pa3) {
#pragma unroll
  for (int r = 0; r < 16; ++r) p1[r] = __builtin_amdgcn_exp2f(p1[r]);
  float ps = 0;
#pragma unroll
  for (int r = 0; r < 16; ++r) ps += p0[r];
#pragma unroll
  for (int r = 0; r < 16; ++r) ps += p1[r];
  { auto rr = __builtin_amdgcn_permlane32_swap(__float_as_uint(ps), __float_as_uint(ps), false, false);
    ps = __uint_as_float(rr[0]) + __uint_as_float(rr[1]); }
  l_reg = l_reg * alpha + ps;
#define PK4(P, BASE, OUT) do { unsigned a0 = cvtpk_(P[BASE + 0], P[BASE + 1]), a1 = cvtpk_(P[BASE + 2], P[BASE + 3]);   \
    unsigned b0 = cvtpk_(P[BASE + 4], P[BASE + 5]), b1 = cvtpk_(P[BASE + 6], P[BASE + 7]);                              \
    auto r0 = __builtin_amdgcn_permlane32_swap(a0, b0, false, false); auto r1 = __builtin_amdgcn_permlane32_swap(a1, b1, false, false); \
    u32x4 w = {r0[0], r1[0], r0[1], r1[1]}; OUT = *reinterpret_cast<bf16x8*>(&w); } while (0)
  PK4(p0, 0, pa0); PK4(p0, 8, pa1); PK4(p1, 0, pa2); PK4(p1, 8, pa3);
#undef PK4
}
DI void qkt(f32x16& p0, f32x16& p1, const char* Ks, const bf16x8* qr, int r32, int hi) {
  p0 = f32x16{}; p1 = f32x16{};
#pragma unroll
  for (int d0 = 0; d0 < 6; ++d0) { const int cb = (d0 * 16 + hi * 8) * 2;
    bf16x8 b0 = *reinterpret_cast<const bf16x8*>(Ks + KSWZ(r32, cb));
    bf16x8 b1 = *reinterpret_cast<const bf16x8*>(Ks + KSWZ(32 + r32, cb));
    p0 = __builtin_amdgcn_mfma_f32_32x32x16_bf16(b0, qr[d0], p0, 0, 0, 0);
    p1 = __builtin_amdgcn_mfma_f32_32x32x16_bf16(b1, qr[d0], p1, 0, 0, 0); }
}
DI int v_st(int k, int c) { const int kk = (k & ~0xC) | ((k & 4) << 1) | ((k & 8) >> 1); return ((kk >> 3) * 2 + (c >> 5)) * 512 + ((kk & 7) * 32 + (c & 31)) * 2; }
DI int v_rd_base(int lane) { return ((lane & 3) << 3) | (((lane >> 2) & 3) << 6) | (((lane >> 4) & 1) << 5) | (((lane >> 5) & 1) << 8); }
constexpr int v_rd_off(int d0, int ks, int half) { return d0 * 512 + ks * 2048 + half * 1024; }
template <int OFF> DI s16x4 tr_read(int vb) {
  s16x4 r; asm volatile("ds_read_b64_tr_b16 %0, %1 offset:%2" : "=&v"(r) : "v"(vb), "i"(OFF) : "memory"); return r;
}
template <int D0> DI void pv_one(f32x16& od, int vb, bf16x8 pa0, bf16x8 pa1, bf16x8 pa2, bf16x8 pa3) {
  const s16x4 l0 = tr_read<v_rd_off(D0, 0, 0)>(vb), h0 = tr_read<v_rd_off(D0, 0, 1)>(vb), l1 = tr_read<v_rd_off(D0, 1, 0)>(vb), h1 = tr_read<v_rd_off(D0, 1, 1)>(vb);
  const s16x4 l2 = tr_read<v_rd_off(D0, 2, 0)>(vb), h2 = tr_read<v_rd_off(D0, 2, 1)>(vb), l3 = tr_read<v_rd_off(D0, 3, 0)>(vb), h3 = tr_read<v_rd_off(D0, 3, 1)>(vb);
  asm volatile("s_waitcnt lgkmcnt(0)" ::: "memory"); SBAR();
#define PK(L, H) (bf16x8){L[0], L[1], L[2], L[3], H[0], H[1], H[2], H[3]}
  od = __builtin_amdgcn_mfma_f32_32x32x16_bf16(pa0, PK(l0, h0), od, 0, 0, 0);
  od = __builtin_amdgcn_mfma_f32_32x32x16_bf16(pa1, PK(l1, h1), od, 0, 0, 0);
  od = __builtin_amdgcn_mfma_f32_32x32x16_bf16(pa2, PK(l2, h2), od, 0, 0, 0);
  od = __builtin_amdgcn_mfma_f32_32x32x16_bf16(pa3, PK(l3, h3), od, 0, 0, 0);
#undef PK
}
DI void pv_d0(f32x16* o, int vb, bf16x8 pa0, bf16x8 pa1, bf16x8 pa2, bf16x8 pa3) {
  pv_one<0>(o[0], vb, pa0, pa1, pa2, pa3); pv_one<1>(o[1], vb, pa0, pa1, pa2, pa3);
}
DI void attn_body(const bf16_t* __restrict__ Qb, const bf16_t* __restrict__ Kh, const bf16_t* __restrict__ Vh, bf16_t* __restrict__ Ob, int seq, char* lds) {
  const int tid = ltid(), wid = tid >> 6, lane = tid & 63, r32 = lane & 31, hi = lane >> 5;
  char* V_lds = lds; char* K_lds = lds + 2 * SHM_V;
  float* ws = (float*)(lds + 2 * SHM_V + 2 * SHM_K) + wid * 64; float* li_l = ws; float* al_l = ws + 32;
  float m_reg = -1e30f, l_reg = 0; f32x16 o[2] = {}; bf16x8 qr[6];
  const bf16_t* Qw = Qb + (long)(wid * QBLK + r32) * LDQ + hi * 8;
#pragma unroll
  for (int d0 = 0; d0 < 6; ++d0) qr[d0] = *reinterpret_cast<const bf16x8*>(Qw + d0 * 16);
  const int kc2 = 512 + (tid & 255);
  const int kr1 = tid / 12, kch1 = tid - kr1 * 12, kr2 = kc2 / 12, kch2 = kc2 - kr2 * 12, vr = tid >> 3, vch = tid & 7;
  const int vst = v_st(vr, vch * 8), kst1 = KSWZ(kr1, kch1 * 16), kst2 = KSWZ(kr2, kch2 * 16);
  const int vb0 = (int)(uintptr_t)V_lds + v_rd_base(lane);
  struct { bf16x8 v, k1, k2; } sr_[2];
#define SLOAD(i, k0) do { sr_[i].v = *reinterpret_cast<const bf16x8*>(&Vh[(long)((k0) + vr) * LDV + vch * 8]); \
    sr_[i].k1 = *reinterpret_cast<const bf16x8*>(&Kh[(long)((k0) + kr1) * LDKK + kch1 * 8]); sr_[i].k2 = *reinterpret_cast<const bf16x8*>(&Kh[(long)((k0) + kr2) * LDKK + kch2 * 8]); } while (0)
#define SWRITE(b, i) do { *(bf16x8*)(V_lds + (b) * SHM_V + vst) = sr_[i].v; *(bf16x8*)(K_lds + (b) * SHM_K + kst1) = sr_[i].k1; *(bf16x8*)(K_lds + (b) * SHM_K + kst2) = sr_[i].k2; } while (0)
#define RESC(a) do { if (__any((a) < 1.f)) { if (hi == 0) al_l[r32] = (a); asm volatile("s_waitcnt lgkmcnt(0)" ::: "memory"); \
    _Pragma("unroll") for (int d = 0; d < 2; ++d) _Pragma("unroll") for (int r = 0; r < 16; ++r) o[d][r] *= al_l[crow(r, hi)]; } } while (0)
  f32x16 pA0, pA1, pB0, pB1; float mnA, mnB, alA, alB; bf16x8 pa0, pa1, pa2, pa3; const int NT = seq / KVBLK;
  constexpr int SE = 0, SO = 1;
  SLOAD(SE, 0); asm volatile("s_waitcnt vmcnt(0)" ::: "memory"); SWRITE(0, SE); __syncthreads();
  qkt(pA0, pA1, K_lds, qr, r32, hi); partialSM(pA0, pA1, m_reg, mnA, alA);
  SLOAD(SO, KVBLK); if (2 < NT) SLOAD(SE, 2 * KVBLK);
  SWRITE(1, SO); __syncthreads();
  for (int j = 1; j + 1 < NT; j += 2) {
    SBAR(); qkt(pB0, pB1, K_lds + SHM_K, qr, r32, hi);
    finishSM(pA0, pA1, alA, l_reg, pa0, pa1, pa2, pa3); SBAR();
    SLOAD(SO, (j + 2) * KVBLK); SBAR();
    pv_d0(o, vb0, pa0, pa1, pa2, pa3); partialSM(pB0, pB1, m_reg, mnB, alB);
    __syncthreads(); SWRITE(0, SE);
    RESC(alB); __syncthreads();
    SBAR(); qkt(pA0, pA1, K_lds, qr, r32, hi);
    finishSM(pB0, pB1, alB, l_reg, pa0, pa1, pa2, pa3); SBAR();
    if (j + 3 < NT) SLOAD(SE, (j + 3) * KVBLK); SBAR();
    pv_d0(o, vb0 + SHM_V, pa0, pa1, pa2, pa3); partialSM(pA0, pA1, m_reg, mnA, alA);
    __syncthreads(); SWRITE(1, SO);
    RESC(alA); __syncthreads();
  }
  SBAR(); qkt(pB0, pB1, K_lds + SHM_K, qr, r32, hi);
  finishSM(pA0, pA1, alA, l_reg, pa0, pa1, pa2, pa3); SBAR();
  pv_d0(o, vb0, pa0, pa1, pa2, pa3); partialSM(pB0, pB1, m_reg, mnB, alB);
  __syncthreads(); RESC(alB);
  finishSM(pB0, pB1, alB, l_reg, pa0, pa1, pa2, pa3); SBAR();
  pv_d0(o, vb0 + SHM_V, pa0, pa1, pa2, pa3);
  if (hi == 0) li_l[r32] = l_reg; asm volatile("s_waitcnt lgkmcnt(0)" ::: "memory");
  float rli[16];
#pragma unroll
  for (int r = 0; r < 16; ++r) rli[r] = __builtin_amdgcn_rcpf(li_l[crow(r, hi)]);
  bf16_t* Ow = Ob + (long)(wid * QBLK) * LDO;
#pragma unroll
  for (int r = 0; r < 16; ++r) { const int orow = crow(r, hi);
#pragma unroll
    for (int d0 = 0; d0 < 2; ++d0) Ow[(long)orow * LDO + d0 * 32 + r32] = f2bf(o[d0][r] * rli[r]); }
#undef SLOAD
#undef SWRITE
#undef RESC
}
}

DI void phase_attn(const bf16_t* Q, const bf16_t* KA, const bf16_t* VA, bf16_t* MIX, bool last, char* lds) {
    const int c = blockIdx.x, G = gridDim.x, NU = 2048 + (last ? 0 : 256);
    for (int L = c; L < NU; L += G) {
        int bh, seq; long qrow0;
        if (L < 2048) { int qb;
            if (G == 256) { const int i = L >> 8, cc = L & 255, xcd = cc & 7, slot = cc >> 3; bh = i * 32 + xcd * 4 + (slot >> 3); qb = slot & 7; }
            else { bh = L >> 3; qb = L & 7; }
            qrow0 = (long)(bh >> 3) * TT + TC + qb * 256; seq = TT; }
        else { bh = L - 2048; qrow0 = (long)(bh >> 3) * TT; seq = TC; }
        const int b = bh >> 3, h = bh & 7;
        att::attn_body(Q + qrow0 * 768 + h * 96, KA + (long)b * TT * 768 + h * 96, VA + (long)b * TT * 512 + h * 64, MIX + qrow0 * 1024 + h * 64, seq, lds);
        __syncthreads();
    }
}

DI float rowsum16(float x) {
    x += __int_as_float(__builtin_amdgcn_update_dpp(0, __float_as_int(x), 0x128, 0xf, 0xf, false));
    x += __int_as_float(__builtin_amdgcn_update_dpp(0, __float_as_int(x), 0x124, 0xf, 0xf, false));
    x += __int_as_float(__builtin_amdgcn_update_dpp(0, __float_as_int(x), 0x122, 0xf, 0xf, false));
    x += __int_as_float(__builtin_amdgcn_update_dpp(0, __float_as_int(x), 0x121, 0xf, 0xf, false));
    return x;
}
#define RS8_STEP(R) "v_add_f32_dpp %0, %0, %0 " R " row_mask:0xf bank_mask:0xf\n\tv_add_f32_dpp %1, %1, %1 " R " row_mask:0xf bank_mask:0xf\n\t" \
                    "v_add_f32_dpp %2, %2, %2 " R " row_mask:0xf bank_mask:0xf\n\tv_add_f32_dpp %3, %3, %3 " R " row_mask:0xf bank_mask:0xf\n\t" \
                    "v_add_f32_dpp %4, %4, %4 " R " row_mask:0xf bank_mask:0xf\n\tv_add_f32_dpp %5, %5, %5 " R " row_mask:0xf bank_mask:0xf\n\t" \
                    "v_add_f32_dpp %6, %6, %6 " R " row_mask:0xf bank_mask:0xf\n\tv_add_f32_dpp %7, %7, %7 " R " row_mask:0xf bank_mask:0xf\n\t"
DI void sum8x8(float& x0, float& x1, float& x2, float& x3, float& x4, float& x5, float& x6, float& x7) {
    asm volatile("s_nop 1\n\t" RS8_STEP("quad_perm:[1,0,3,2]") RS8_STEP("quad_perm:[2,3,0,1]") RS8_STEP("row_half_mirror")
                 : "+v"(x0), "+v"(x1), "+v"(x2), "+v"(x3), "+v"(x4), "+v"(x5), "+v"(x6), "+v"(x7));
}
typedef float f32x2 __attribute__((ext_vector_type(2)));
DI float dot8(const f32x2 (&s)[4], const f32x4& x0, const f32x4& x1) {
    f32x2 t = s[0] * (f32x2){x0[0], x0[1]};
    t = __builtin_elementwise_fma(s[1], (f32x2){x0[2], x0[3]}, t);
    t = __builtin_elementwise_fma(s[2], (f32x2){x1[0], x1[1]}, t);
    t = __builtin_elementwise_fma(s[3], (f32x2){x1[2], x1[3]}, t);
    return t.x + t.y;
}
DI int scan_row(int d, int b, int n) { const int tt = d == 0 ? n : (n < TC ? TC - 1 - n : TT + TC - 1 - n); return b * TT + tt; }
struct ScanStep { f32x4 a0, a1, w0, w1, b0, b1, k0, k1, q0, q1, v; float br, kr; };
DI void scan_ld(ScanStep& t, const float* p, const float* sc, int cgp, int vrow) {
    t.a0 = *(const f32x4*)(p + 8 * cgp); t.a1 = *(const f32x4*)(p + 8 * cgp + 4); t.w0 = *(const f32x4*)(p + 64 + 8 * cgp); t.w1 = *(const f32x4*)(p + 64 + 8 * cgp + 4);
    t.b0 = *(const f32x4*)(p + 128 + 8 * cgp); t.b1 = *(const f32x4*)(p + 128 + 8 * cgp + 4); t.k0 = *(const f32x4*)(p + 192 + 8 * cgp); t.k1 = *(const f32x4*)(p + 192 + 8 * cgp + 4);
    t.q0 = *(const f32x4*)(p + 256 + 8 * cgp); t.q1 = *(const f32x4*)(p + 256 + 8 * cgp + 4); t.v = *(const f32x4*)(p + 320 + vrow); t.br = sc[0]; t.kr = sc[1];
}
DI void phase_scan(const bf16_t* R, const bf16_t* Kk, const bf16_t* V, const __half* DEC, const bf16_t* AA, const float* INV, const float* kkp, const float* kap,
                   bf16_t* MIX, bf16_t* YB, char* lds) {
    const int tid = ltid(); const bool consumer = tid < 256;
    float* bufA = (float*)lds; float* ybufA = (float*)(lds + 98304); float* sbufA = (float*)(lds + 114688);
    constexpr int NCH = TT / 16;
    for (int s0 = blockIdx.x * 2; s0 < 512; s0 += gridDim.x * 2) {
        const int p_ = tid & 255, pst = p_ >> 4, pj0 = (p_ & 15) * 4;
        const int cw = tid >> 6, cgrp = (cw >> 1) & 1, ws_ = cw & 1, lane = tid & 63, rgl = lane >> 3, cgp = lane & 7, vrow = ws_ * 32 + rgl * 4;
        f32x2 S[4][4];
#pragma unroll
        for (int i = 0; i < 4; ++i)
#pragma unroll
            for (int j = 0; j < 4; ++j) S[i][j] = (f32x2){0.f, 0.f};
#define PRODUCE(c, bsel) do { _Pragma("unroll") for (int gq = 0; gq < 2; ++gq) { \
            const int sid = s0 + gq, d = sid >> 8, b = (sid >> 3) & 31, h = sid & 7, hc = h * 64 + pj0; \
            const size_t m_ = (size_t)scan_row(d, b, (c) * 16 + pst); \
            const u32x2 lr = *(const u32x2*)(R + m_ * 512 + hc), lk = *(const u32x2*)(Kk + m_ * 512 + hc), lv = *(const u32x2*)(V + m_ * 512 + hc), \
                        ld_ = *(const u32x2*)(DEC + m_ * 1024 + d * 512 + hc), la = *(const u32x2*)(AA + m_ * 1024 + d * 512 + hc); const float linv = INV[m_ * 8 + h]; \
            const f32x4 kk4 = *(const f32x4*)(kkp + hc), ka4 = *(const f32x4*)(kap + hc); \
            float* q_ = bufA + gq * 12288 + (bsel) * 6144 + pst * 384 + pj0; float* sd_ = sbufA + gq * 64 + (bsel) * 32; \
            const float k0 = bflo(lk.x), k1 = bfhi(lk.x), k2 = bflo(lk.y), k3 = bfhi(lk.y), a0 = bflo(la.x), a1 = bfhi(la.x), a2 = bflo(la.y), a3 = bfhi(la.y); \
            const float q0 = k0 * kk4[0] * linv, q1 = k1 * kk4[1] * linv, q2 = k2 * kk4[2] * linv, q3 = k3 * kk4[3] * linv; \
            const float w0 = __builtin_amdgcn_exp2f(h2f(ld_.x & 0xffffu)), w1 = __builtin_amdgcn_exp2f(h2f(ld_.x >> 16)), w2 = __builtin_amdgcn_exp2f(h2f(ld_.y & 0xffffu)), w3 = __builtin_amdgcn_exp2f(h2f(ld_.y >> 16)); \
            const float r0 = bflo(lr.x), r1 = bfhi(lr.x), r2 = bflo(lr.y), r3 = bfhi(lr.y); \
            const float b0 = q0 * a0, b1 = q1 * a1, b2 = q2 * a2, b3 = q3 * a3; \
            const float d0 = k0 * (1.f + (a0 - 1.f) * ka4[0]), d1 = k1 * (1.f + (a1 - 1.f) * ka4[1]), d2 = k2 * (1.f + (a2 - 1.f) * ka4[2]), d3 = k3 * (1.f + (a3 - 1.f) * ka4[3]); \
            *(f32x4*)(q_) = (f32x4){-q0, -q1, -q2, -q3}; \
            *(f32x4*)(q_ + 64) = (f32x4){w0, w1, w2, w3}; \
            *(f32x4*)(q_ + 128) = (f32x4){b0, b1, b2, b3}; \
            *(f32x4*)(q_ + 192) = (f32x4){d0, d1, d2, d3}; \
            *(f32x4*)(q_ + 256) = (f32x4){w0 * r0, w1 * r1, w2 * r2, w3 * r3}; \
            *(f32x4*)(q_ + 320) = (f32x4){bflo(lv.x), bfhi(lv.x), bflo(lv.y), bfhi(lv.y)}; \
            const float br_ = rowsum16(b0 * r0 + b1 * r1 + b2 * r2 + b3 * r3), kr_ = rowsum16(d0 * r0 + d1 * r1 + d2 * r2 + d3 * r3); \
            if ((p_ & 15) == 0) { sd_[pst * 2] = br_; sd_[pst * 2 + 1] = kr_; } } } while (0)
#define OUTPUT(c, bsel) do { _Pragma("unroll") for (int gq = 0; gq < 2; ++gq) { \
            const int sid = s0 + gq, d = sid >> 8, b = (sid >> 3) & 31, h = sid & 7, hc = h * 64 + pj0; \
            const f32x4 yv = *(const f32x4*)(ybufA + gq * 2048 + (bsel) * 1024 + pst * 64 + pj0); const size_t m_ = (size_t)scan_row(d, b, (c) * 16 + pst); \
            u32x2 w; w.x = cvtpk(yv[0], yv[1]); w.y = cvtpk(yv[2], yv[3]); \
            if (d == 0) *(u32x2*)(MIX + m_ * 1024 + 512 + hc) = w; else *(u32x2*)(YB + m_ * 512 + hc) = w; } } while (0)
        if (!consumer) PRODUCE(0, 0);
        __syncthreads();
        if (consumer) __builtin_amdgcn_s_setprio(3);
        for (int c = 0; c < NCH; ++c) {
            if (consumer) {
                const float* cur = bufA + cgrp * 12288 + (c & 1) * 6144; float* yb = ybufA + cgrp * 2048 + (c & 1) * 1024; const float* sc = sbufA + cgrp * 64 + (c & 1) * 32;
                ScanStep t; scan_ld(t, cur, sc, cgp, vrow);
#pragma unroll 2
                for (int st = 0; st < 16; ++st) {
                    ScanStep n; scan_ld(n, cur + (st + 1) * 384, sc + (st + 1) * 2, cgp, vrow);
                    float sa0 = dot8(S[0], t.a0, t.a1), sa1 = dot8(S[1], t.a0, t.a1), sa2 = dot8(S[2], t.a0, t.a1), sa3 = dot8(S[3], t.a0, t.a1);
                    float z0 = dot8(S[0], t.q0, t.q1), z1 = dot8(S[1], t.q0, t.q1), z2 = dot8(S[2], t.q0, t.q1), z3 = dot8(S[3], t.q0, t.q1);
                    sum8x8(sa0, sa1, sa2, sa3, z0, z1, z2, z3);
                    const f32x2 w01 = {t.w0[0], t.w0[1]}, w23 = {t.w0[2], t.w0[3]}, w45 = {t.w1[0], t.w1[1]}, w67 = {t.w1[2], t.w1[3]};
                    const f32x2 b01 = {t.b0[0], t.b0[1]}, b23 = {t.b0[2], t.b0[3]}, b45 = {t.b1[0], t.b1[1]}, b67 = {t.b1[2], t.b1[3]};
                    const f32x2 k01 = {t.k0[0], t.k0[1]}, k23 = {t.k0[2], t.k0[3]}, k45 = {t.k1[0], t.k1[1]}, k67 = {t.k1[2], t.k1[3]};
                    const float sa[4] = {sa0, sa1, sa2, sa3};
                    const f32x2 wv[4] = {w01, w23, w45, w67}, bv[4] = {b01, b23, b45, b67}, kv[4] = {k01, k23, k45, k67};
#pragma unroll
                    for (int i = 0; i < 4; ++i)
#pragma unroll
                        for (int j = 0; j < 4; ++j) S[i][j] = S[i][j] * wv[j];
#pragma unroll
                    for (int i = 0; i < 4; ++i) { const f32x2 s2 = {sa[i], sa[i]};
#pragma unroll
                        for (int j = 0; j < 4; ++j) S[i][j] = __builtin_elementwise_fma(s2, bv[j], S[i][j]); }
#pragma unroll
                    for (int i = 0; i < 4; ++i) { const f32x2 v2 = {t.v[i], t.v[i]};
#pragma unroll
                        for (int j = 0; j < 4; ++j) S[i][j] = __builtin_elementwise_fma(v2, kv[j], S[i][j]); }
                    if (cgp == 0) *(f32x4*)(yb + st * 64 + vrow) = (f32x4){z0 + sa0 * t.br + t.v[0] * t.kr, z1 + sa1 * t.br + t.v[1] * t.kr, z2 + sa2 * t.br + t.v[2] * t.kr, z3 + sa3 * t.br + t.v[3] * t.kr};
                    t = n;
                }
            } else {
                if (c + 1 < NCH) PRODUCE(c + 1, (c + 1) & 1);
                if (c > 0) OUTPUT(c - 1, (c - 1) & 1);
            }
            __syncthreads();
        }
        __builtin_amdgcn_s_setprio(0);
        if (!consumer) OUTPUT(NCH - 1, (NCH - 1) & 1);
        __syncthreads();
#undef PRODUCE
#undef OUTPUT
    }
}

DI void phase_prologue(const Args& a, unsigned char* lds) {
    const int tid = ltid(), G = gridDim.x;
    float* out = a.out; float* xc = (float*)(a.ws + WS_XC);
    if (blockIdx.x == 0) {
        float* rope = (float*)(a.ws + WS_ROPE); const int pos = tid >> 3, j = tid & 7;
        const float inv_freq = powf(10000.f, -(float)j / 8.f), ang = (float)pos * inv_freq;
        rope[tid] = cosf(ang); rope[512 + tid] = sinf(ang);
    }
    float* sv = (float*)lds; float* red = sv + 33 * 1024;
    for (int i = tid; i < 33 * 1024; i += 512) { const float v = i < 32 * 1024 ? a.in[I_C][i] : a.in[I_CCTX][i - 32 * 1024]; sv[i] = v / (1.f + __expf(-v)); }
    __syncthreads();
    const int wave = tid >> 6, lane = tid & 63;
    float* mods = (float*)(a.ws + WS_MODS);
    for (int it = blockIdx.x; it < NL * 96; it += G) {
        const int l = it / 96, n0 = (it - l * 96) * 64;
        const float* w = a.in[I_ADAW] + (size_t)l * 1024 * 6144 + n0 + lane;
        float acc[33];
#pragma unroll
        for (int r = 0; r < 33; ++r) acc[r] = 0.f;
        for (int k = wave * 128; k < wave * 128 + 128; k += 8) { float wv[8];
#pragma unroll
            for (int u = 0; u < 8; ++u) wv[u] = w[(size_t)(k + u) * 6144];
#pragma unroll
            for (int u = 0; u < 8; ++u)
#pragma unroll
                for (int r = 0; r < 33; ++r) acc[r] += sv[r * 1024 + k + u] * wv[u]; }
        for (int i = tid; i < 33 * 64; i += 512) red[i] = 0.f;
        __syncthreads();
        for (int ww = 0; ww < 8; ++ww) { if (wave == ww) {
#pragma unroll
                for (int r = 0; r < 33; ++r) red[r * 64 + lane] += acc[r]; }
            __syncthreads(); }
        for (int i = tid; i < 33 * 64; i += 512) { const int r = i >> 6, n = n0 + (i & 63); mods[((size_t)l * 33 + r) * 6144 + n] = red[i] + a.in[I_ADAB][l * 6144 + n]; }
        __syncthreads();
    }
}

DI void phase_vectors(const Args& a, unsigned char* lds) {
    const int tid = ltid(), G = gridDim.x, wave = tid >> 6, lane = tid & 63;
    const float* mods = (const float*)(a.ws + WS_MODS);
    float* gp1 = (float*)(a.ws + WS_GP1); float* gp2 = (float*)(a.ws + WS_GP2);
    for (int i = blockIdx.x * 512 + tid; i < NL * 33 * 1024; i += G * 512) { const int c = i & 1023, lr = i >> 10, l = lr / 33;
        gp1[i] = a.in[I_N1G][l * 1024 + c] * (1.f + mods[(size_t)lr * 6144 + 1024 + c]); gp2[i] = a.in[I_N2G][l * 1024 + c] * (1.f + mods[(size_t)lr * 6144 + 4 * 1024 + c]); }
    float* sv = (float*)lds; float* red = sv + 33 * 1024;
    for (int it = blockIdx.x; it < NL * 101; it += G) {
        const int l = it / 101, ci = it - l * 101, which = ci < 37 ? 0 : 1, n0 = (which ? ci - 37 : ci) * 64, n = n0 + lane;
        __syncthreads();
        for (int i = tid; i < 33 * 1024; i += 512) sv[i] = mods[((size_t)l * 33 + (i >> 10)) * 6144 + (which ? 3 * 1024 : 0) + (i & 1023)];
        for (int i = tid; i < 33 * 64; i += 512) red[i] = 0.f;
        __syncthreads();
        const float* w; int ld; float live = 1.f;
        if (which) { w = a.in[I_M1] + (size_t)l * 1024 * 4096 + n; ld = 4096; }
        else if (n < CIN) { w = a.in[I_WIN] + (size_t)l * 1024 * CIN + n; ld = CIN; }
        else if (n < CINX && l > 0) { w = a.in[I_V1] + (size_t)(l - 1) * 1024 * 32 + (n - CIN); ld = 32; }
        else { w = a.in[I_WIN]; ld = 0; live = 0.f; }
        float acc[33];
#pragma unroll
        for (int r = 0; r < 33; ++r) acc[r] = 0.f;
        for (int k = wave * 128; k < wave * 128 + 128; k += 8) { float wv[8];
#pragma unroll
            for (int u = 0; u < 8; ++u) wv[u] = w[(size_t)(k + u) * ld] * live;
#pragma unroll
            for (int u = 0; u < 8; ++u)
#pragma unroll
                for (int r = 0; r < 33; ++r) acc[r] += sv[r * 1024 + k + u] * wv[u]; }
        for (int ww = 0; ww < 8; ++ww) { if (wave == ww) {
#pragma unroll
                for (int r = 0; r < 33; ++r) red[r * 64 + lane] += acc[r]; }
            __syncthreads(); }
        float* outp = which ? (float*)(a.ws + WS_C2) + (size_t)l * 33 * DFF : (float*)(a.ws + WS_C1) + (size_t)l * 33 * NIN; const int ldo = which ? DFF : NIN;
        for (int i = tid; i < 33 * 64; i += 512) outp[(size_t)(i >> 6) * ldo + n0 + (i & 63)] = red[i];
    }
    {
        const int gw = blockIdx.x * 8 + wave, nw = G * 8; bf16_t* __restrict__ H = (bf16_t*)(a.ws + WS_H); float* __restrict__ rsa = (float*)(a.ws + WS_RSA); const float* __restrict__ gamma = a.in[I_N1G];
        for (int m = gw; m < TALL; m += nw) { const int b = m / TT, tt = m - b * TT; const bool ctx = tt < TC;
            const float* xr = ctx ? a.in[I_CTX] + (size_t)(b * TC + tt) * DM : a.in[I_X] + (size_t)(b * SEQ + tt - TC) * DM; const float* md = mods + (size_t)(ctx ? 32 : b) * 6144 + 1024;
            f32x4 v[4]; float ss = 0.f;
#pragma unroll
            for (int q = 0; q < 4; ++q) { v[q] = *(const f32x4*)(xr + q * 256 + lane * 4); ss += v[q][0] * v[q][0] + v[q][1] * v[q][1] + v[q][2] * v[q][2] + v[q][3] * v[q][3]; }
#pragma unroll
            for (int k = 1; k < 64; k <<= 1) ss = xorsum(ss, k);
            if (lane == 0) rsa[m] = ss;
#pragma unroll
            for (int q = 0; q < 4; ++q) { const int col = q * 256 + lane * 4; const f32x4 g = *(const f32x4*)(gamma + col), sc = *(const f32x4*)(md + col);
                u32x2 w; w.x = cvtpk(v[q][0] * g[0] * (1.f + sc[0]), v[q][1] * g[1] * (1.f + sc[1])); w.y = cvtpk(v[q][2] * g[2] * (1.f + sc[2]), v[q][3] * g[3] * (1.f + sc[3]));
                *(u32x2*)(H + (size_t)m * 1024 + col) = w; } }
    }
}

template <class Gt> DI void cvt_tile(bf16_t* __restrict__ dst, int ldk, int n0, int k0, const Gt& get, float*) {
    const int lane = ltid() & 63, n = n0 + lane;
#pragma unroll
    for (int ch = 0; ch < 4; ++ch) { float v[16];
#pragma unroll
        for (int kk = 0; kk < 16; ++kk) v[kk] = get(n, k0 + ch * 16 + kk);
        u32x4 w0, w1; w0.x = cvtpk(v[0], v[1]); w0.y = cvtpk(v[2], v[3]); w0.z = cvtpk(v[4], v[5]); w0.w = cvtpk(v[6], v[7]);
        w1.x = cvtpk(v[8], v[9]); w1.y = cvtpk(v[10], v[11]); w1.z = cvtpk(v[12], v[13]); w1.w = cvtpk(v[14], v[15]);
        bf16_t* p = dst + (size_t)n * ldk + k0 + ch * 16; *(u32x4*)p = w0; *(u32x4*)(p + 8) = w1; }
}
DI void convert_weights(const Args& a, int l, unsigned char* lds, int group) {
    float* tl = (float*)lds; unsigned char* ws = a.ws;
    const float* w_in = a.in[I_WIN] + (size_t)l * 1024 * CIN; const float* v1 = a.in[I_V1] + (size_t)(l > 0 ? l - 1 : 0) * 1024 * 32;
    const float* w_uq = a.in[I_WUQ] + (size_t)l * 256 * 768; const float* w_ukv = a.in[I_WUKV] + (size_t)l * 128 * 1024;
    const float* w2 = a.in[I_W2] + (size_t)l * 2 * 64 * 512; const float* a2 = a.in[I_A2] + (size_t)l * 2 * 64 * 512;
    const float* g2 = a.in[I_G2] + (size_t)l * 128 * 512; const float* v2 = a.in[I_V2] + (size_t)(l > 0 ? l - 1 : 0) * 32 * 512;
    const float* w_out = a.in[I_WOUT] + (size_t)l * 1024 * 1024; const float* m1 = a.in[I_M1] + (size_t)l * 1024 * 4096; const float* m2 = a.in[I_M2] + (size_t)l * 4096 * 1024;
    constexpr int T0 = 640, T1 = T0 + 48, T2 = T1 + 64, T3 = T2 + 128, T4 = T3 + 64, T5 = T4 + 256, T6 = T5 + 1024, T7 = T6 + 1024;
    const int tb = group == 0 ? 0 : T4, te = group == 0 ? T4 : T7;
    for (int t = tb + blockIdx.x * 8 + (ltid() >> 6); t < te; t += gridDim.x * 8) {
        if (t < T0) { const int nt = t >> 4, kt = t & 15;
            cvt_tile((bf16_t*)(ws + WT_IN), 1024, nt * 64, kt * 64, [&](int n, int k) -> float { return n < CIN ? w_in[(size_t)k * CIN + n] : ((n < CINX && l > 0) ? v1[k * 32 + (n - CIN)] : 0.f); }, tl); }
        else if (t < T1) { const int u = t - T0, nt = u >> 2, kt = u & 3;
            cvt_tile((bf16_t*)(ws + WT_UQ), 256, nt * 64, kt * 64, [&](int n, int k) -> float { return w_uq[k * 768 + n]; }, tl); }
        else if (t < T2) { const int u = t - T1, nt = u >> 2, kt = u & 3;
            cvt_tile((bf16_t*)(ws + WT_UKV), 256, nt * 64, kt * 64, [&](int n, int k) -> float { return k < 128 ? w_ukv[k * 1024 + n] : 0.f; }, tl); }
        else if (t < T3) { const int u = t - T2, nt = u >> 2, kt = u & 3;
            cvt_tile((bf16_t*)(ws + WT_L1), 256, nt * 64, kt * 64, [&](int n, int k) -> float {
                if (n < 1024) { const int d = n >> 9, c = n & 511; return (k < 128 && (k >> 6) == d) ? w2[(d * 64 + (k & 63)) * 512 + c] : 0.f; }
                const int n2 = n - 1024, d = n2 >> 9, c = n2 & 511; return (k >= 128 && ((k - 128) >> 6) == d) ? a2[(d * 64 + ((k - 128) & 63)) * 512 + c] : 0.f; }, tl); }
        else if (t < T4) { const int u = t - T3, nt = u >> 2, kt = u & 3;
            cvt_tile((bf16_t*)(ws + WT_L2), 256, nt * 64, kt * 64, [&](int n, int k) -> float {
                if (n < 512) return k < 128 ? g2[k * 512 + n] : 0.f;
                return (l > 0 && k >= 128 && k < 160) ? v2[(k - 128) * 512 + (n - 512)] : 0.f; }, tl); }
        else if (t < T5) { const int u = t - T4, nt = u >> 4, kt = u & 15;
            cvt_tile((bf16_t*)(ws + WT_OUT), 1024, nt * 64, kt * 64, [&](int n, int k) -> float { return w_out[(size_t)k * 1024 + n]; }, tl); }
        else if (t < T6) { const int u = t - T5, nt = u >> 4, kt = u & 15;
            cvt_tile((bf16_t*)(ws + WT_M1), 1024, nt * 64, kt * 64, [&](int n, int k) -> float { return m1[(size_t)k * 4096 + n]; }, tl); }
        else { const int u = t - T6, nt = u >> 6, kt = u & 63;
            cvt_tile((bf16_t*)(ws + WT_M2), 4096, nt * 64, kt * 64, [&](int n, int k) -> float { return m2[(size_t)k * 1024 + n]; }, tl); }
    }
}

DI void phase_norm(const Args& a, int l, const float* __restrict__ gamma, int shift_idx, int scale_idx, bool latent_only, bool from_input) {
    const int lane = ltid() & 63, gw = blockIdx.x * 8 + (ltid() >> 6), nw = gridDim.x * 8;
    float* xc = from_input ? (float*)a.in[I_CTX] : (float*)(a.ws + WS_XC); float* xo = from_input ? (float*)a.in[I_X] : a.out;
    bf16_t* __restrict__ H = (bf16_t*)(a.ws + WS_H); const float* __restrict__ mods = (const float*)(a.ws + WS_MODS) + (size_t)l * 33 * 6144;
    const int nrows = latent_only ? NB * SEQ : TALL;
    auto rowof = [&](int i) -> int { return latent_only ? (i >> 11) * TT + TC + (i & 2047) : i; };
    f32x4 v[4], nv[4];
    int i = gw;
    if (i < nrows) { const float* xr = xrow(xo, xc, rowof(i));
#pragma unroll
        for (int q = 0; q < 4; ++q) v[q] = *(const f32x4*)(xr + q * 256 + lane * 4); }
    for (; i < nrows; i += nw) {
        const int m = rowof(i), b = m / TT, tt = m - b * TT; const bool ctx = tt < TC;
        const bool hn = i + nw < nrows;
        if (hn) { const float* xn = xrow(xo, xc, rowof(i + nw));
#pragma unroll
            for (int q = 0; q < 4; ++q) nv[q] = *(const f32x4*)(xn + q * 256 + lane * 4); }
        const float* md = mods + (size_t)(ctx ? 32 : b) * 6144;
        float ss = 0.f;
#pragma unroll
        for (int q = 0; q < 4; ++q) ss += v[q][0] * v[q][0] + v[q][1] * v[q][1] + v[q][2] * v[q][2] + v[q][3] * v[q][3];
#pragma unroll
        for (int k = 1; k < 64; k <<= 1) ss = xorsum(ss, k);
        const float rstd = rsqrtf(ss * (1.f / 1024.f) + 1e-6f);
#pragma unroll
        for (int q = 0; q < 4; ++q) { const int col = q * 256 + lane * 4; const f32x4 g = *(const f32x4*)(gamma + col), sc = *(const f32x4*)(md + scale_idx * 1024 + col), sh = *(const f32x4*)(md + shift_idx * 1024 + col);
            float o[4];
#pragma unroll
            for (int j = 0; j < 4; ++j) o[j] = v[q][j] * rstd * g[j] * (1.f + sc[j]) + sh[j];
            u32x2 w; w.x = cvtpk(o[0], o[1]); w.y = cvtpk(o[2], o[3]); *(u32x2*)(H + (size_t)m * 1024 + col) = w; }
#pragma unroll
        for (int q = 0; q < 4; ++q) v[q] = nv[q];
    }
}

DI void unpack8(const u32x4& w, float (&f)[8]) { f[0] = bflo(w.x); f[1] = bfhi(w.x); f[2] = bflo(w.y); f[3] = bfhi(w.y); f[4] = bflo(w.z); f[5] = bfhi(w.z); f[6] = bflo(w.w); f[7] = bfhi(w.w); }
DI void shift8r(const u32x4& c_, const u32x4& p_, const u32x4& n_, const float* __restrict__ mu, int col, float (&o)[8]) {
    float c[8], p[8], n[8], u[8]; unpack8(c_, c); unpack8(p_, p); unpack8(n_, n); loadf8(mu + (col - OFF_R), u);
#pragma unroll
    for (int j = 0; j < 8; ++j) o[j] = c[j] + u[j] * (0.5f * (p[j] + n[j]) - c[j]);
}
DI void phase_split(const Args& a, int l) {
    const int lane = ltid() & 63, gw = blockIdx.x * 8 + (ltid() >> 6), nw = gridDim.x * 8;
    unsigned char* ws = a.ws;
    const bf16_t* __restrict__ F = (const bf16_t*)(ws + WS_F); bf16_t* __restrict__ R = (bf16_t*)(ws + WS_R); bf16_t* __restrict__ Kb = (bf16_t*)(ws + WS_K); bf16_t* __restrict__ Vb = (bf16_t*)(ws + (l == 0 ? WS_VF : WS_V));
    bf16_t* __restrict__ A1 = (bf16_t*)(ws + WS_A1); bf16_t* __restrict__ A2 = (bf16_t*)(ws + WS_A2); bf16_t* __restrict__ CQN = (bf16_t*)(ws + WS_CQN); bf16_t* __restrict__ CKVN = (bf16_t*)(ws + WS_CKVN); bf16_t* __restrict__ KA = (bf16_t*)(ws + WS_KATT);
    float* __restrict__ INV = (float*)(ws + WS_INV); const float* __restrict__ rope = (const float*)(ws + WS_ROPE);
    const float* __restrict__ mu = a.in[I_MU] + (size_t)l * 1920; const float* __restrict__ kkp = a.in[I_KK] + l * 512; const float* __restrict__ qg = a.in[I_QNG] + l * 256; const float* __restrict__ kvg = a.in[I_KVNG] + l * 128;
    const u32x4 zero4 = {0u, 0u, 0u, 0u};
    const int lcol = lane < 48 ? OFF_WLO + lane * 8 : (lane < 52 ? OFF_HV + (lane - 48) * 8 : 0);
    const int mcol = lane < 32 ? lane * 8 : (lane < 48 ? 256 + (lane - 32) * 8 : 384 + ((lane - 48) & 3) * 8);
    const int chunk = (TALL + nw - 1) / nw, m0 = gw * chunk, m1 = (m0 + chunk < TALL) ? m0 + chunk : TALL;
    struct Raw { u32x4 r, k, v, l; };
    auto ld4 = [&](int m) -> Raw { Raw t; if (m >= 0 && m < TALL) { const bf16_t* Fq = F + (size_t)m * CINX; t.r = *(const u32x4*)(Fq + OFF_R + lane * 8); t.k = *(const u32x4*)(Fq + OFF_K + lane * 8);
            t.v = *(const u32x4*)(Fq + OFF_V + lane * 8); t.l = (lane < 52) ? *(const u32x4*)(Fq + lcol) : zero4; } else { t.r = zero4; t.k = zero4; t.v = zero4; t.l = zero4; } return t; };
    auto ldm = [&](int m) -> u32x4 { return (m < TALL) ? *(const u32x4*)(F + (size_t)m * CINX + mcol) : zero4; };
    Raw P = ld4(m0 - 1), C = ld4(m0), N = ld4(m0 + 1); u32x4 M = ldm(m0);
    for (int m = m0; m < m1; ++m) {
        const int b = m / TT, tt = m - b * TT; const bool ctx = tt < TC;
        const bool pok = !(tt == 0 || tt == TC), nok = !(tt == TC - 1 || tt == TT - 1);
        const Raw NN = ld4(m + 2); const u32x4 MN = ldm(m + 1);
        u32x4 rc = C.r, kc = C.k, vc = C.v, lc = C.l, rp = P.r, kp = P.k, vp = P.v, lp = P.l, rn = N.r, kn = N.k, vn = N.v, ln = N.l; const u32x4 mc = M;
        if (!pok) { rp = zero4; kp = zero4; vp = zero4; lp = zero4; }
        if (!nok) { rn = zero4; kn = zero4; vn = zero4; ln = zero4; }
        P = C; C = N; N = NN; M = MN;
        float x[8];
        shift8r(rc, rp, rn, mu, OFF_R + lane * 8, x); store8(R + (size_t)m * 512 + lane * 8, x);
        shift8r(kc, kp, kn, mu, OFF_K + lane * 8, x); store8(Kb + (size_t)m * 512 + lane * 8, x);
        { float kq[8], ss = 0.f; loadf8(kkp + lane * 8, kq);
#pragma unroll
          for (int j = 0; j < 8; ++j) { const float t = x[j] * kq[j]; ss += t * t; }
          ss = xorsum(ss, 1); ss = xorsum(ss, 2); ss = xorsum(ss, 4);
          if ((lane & 7) == 0) INV[(size_t)m * 8 + (lane >> 3)] = rsqrtf(fmaxf(ss, 1e-24f)); }
        shift8r(vc, vp, vn, mu, OFF_V + lane * 8, x); store8(Vb + (size_t)m * 512 + lane * 8, x);
        if (lane < 48) { shift8r(lc, lp, ln, mu, lcol, x);
            if (lane < 16) {
#pragma unroll
                for (int j = 0; j < 8; ++j) x[j] = tanhf_(x[j]); }
            else if (lane >= 32) {
#pragma unroll
                for (int j = 0; j < 8; ++j) x[j] = sigmoidf_(x[j]); }
            if (lane < 32) store8(A1 + (size_t)m * 256 + lane * 8, x); else store8(A2 + (size_t)m * 256 + (lane - 32) * 8, x); }
        else { unpack8(lc, x); store8(A2 + (size_t)m * 256 + 128 + (lane - 48) * 8, x); }
        { unpack8(mc, x); float ss = 0.f;
#pragma unroll
          for (int j = 0; j < 8; ++j) ss += x[j] * x[j];
          ss = xorsum(ss, 1); ss = xorsum(ss, 2); ss = xorsum(ss, 4); ss = xorsum(ss, 8); const float ss32 = xorsum(ss, 16);
          float px[8]; const int q = (lane - 48) & 3;
#pragma unroll
          for (int j = 0; j < 8; ++j) px[j] = __shfl_xor(x[j], 1, 64);
          if (lane < 32) { const float rstd = rsqrtf(ss32 * (1.f / 256.f) + 1e-6f); float g[8]; loadf8(qg + lane * 8, g);
#pragma unroll
              for (int j = 0; j < 8; ++j) x[j] = x[j] * rstd * g[j];
              store8(CQN + (size_t)m * 256 + lane * 8, x); }
          else if (lane < 48) { const float rstd = rsqrtf(ss * (1.f / 128.f) + 1e-6f); float g[8]; loadf8(kvg + (lane - 32) * 8, g);
#pragma unroll
              for (int j = 0; j < 8; ++j) x[j] = x[j] * rstd * g[j];
              store8(CKVN + (size_t)m * 256 + (lane - 32) * 8, x); }
          else { if (lane < 52) {
                  if (!ctx) { const int s = tt - TC, pos = (q < 2) ? (s >> 6) : (s & 63); float cs[8], sn[8]; loadf8(rope + pos * 8, cs); loadf8(rope + 512 + pos * 8, sn); const float sg = (q & 1) ? 1.f : -1.f;
#pragma unroll
                      for (int j = 0; j < 8; ++j) x[j] = x[j] * cs[j] + sg * px[j] * sn[j]; }
#pragma unroll
                  for (int hh = 0; hh < 8; ++hh) store8(KA + (size_t)m * 768 + hh * 96 + 64 + q * 8, x); }
              float z[8];
#pragma unroll
              for (int j = 0; j < 8; ++j) z[j] = 0.f;
              store8(CKVN + (size_t)m * 256 + 128 + (lane - 48) * 8, z); } }
    }
}

DI void phase_rwkv_out(const Args& a, int l, bool latent_only) {
    const int lane = ltid() & 63, gw = blockIdx.x * 8 + (ltid() >> 6), nw = gridDim.x * 8;
    unsigned char* ws = a.ws;
    const bf16_t* R = (const bf16_t*)(ws + WS_R); const bf16_t* Kb = (const bf16_t*)(ws + WS_K); const bf16_t* Vb = (const bf16_t*)(ws + (l == 0 ? WS_VF : WS_V));
    const bf16_t* AA = (const bf16_t*)(ws + WS_AA); const bf16_t* Gb = (const bf16_t*)(ws + WS_G); const bf16_t* YB = (const bf16_t*)(ws + WS_YB); bf16_t* MIX = (bf16_t*)(ws + WS_MIX);
    const int c = lane * 8; float ka[8], rk[8], lw[8], lb[8];
    loadf8(a.in[I_KA] + l * 512 + c, ka); loadf8(a.in[I_RK] + l * 512 + c, rk); loadf8(a.in[I_LNW] + l * 512 + c, lw); loadf8(a.in[I_LNB] + l * 512 + c, lb);
    for (int m = gw; m < TALL; m += nw) {
        const int tt = m % TT; if (latent_only && tt < TC) continue;
        float yf[8], yb[8], r[8], k[8], v[8], a0[8], a1[8], g[8];
        load8(MIX + (size_t)m * 1024 + 512 + c, yf); load8(YB + (size_t)m * 512 + c, yb); load8(R + (size_t)m * 512 + c, r); load8(Kb + (size_t)m * 512 + c, k); load8(Vb + (size_t)m * 512 + c, v);
        load8(AA + (size_t)m * 1024 + c, a0); load8(AA + (size_t)m * 1024 + 512 + c, a1); load8(Gb + (size_t)m * 512 + c, g);
        float s = 0.f, bon = 0.f;
#pragma unroll
        for (int j = 0; j < 8; ++j) { yf[j] += yb[j]; s += yf[j]; bon += r[j] * k[j] * (2.f + (a0[j] + a1[j] - 2.f) * ka[j]) * rk[j]; }
        s = xorsum(s, 1); s = xorsum(s, 2); s = xorsum(s, 4); bon = xorsum(bon, 1); bon = xorsum(bon, 2); bon = xorsum(bon, 4);
        const float mean = s * (1.f / 64.f); float vs = 0.f;
#pragma unroll
        for (int j = 0; j < 8; ++j) { yf[j] -= mean; vs += yf[j] * yf[j]; }
        vs = xorsum(vs, 1); vs = xorsum(vs, 2); vs = xorsum(vs, 4);
        const float rstd = rsqrtf(vs * (1.f / 64.f) + 64e-5f);
#pragma unroll
        for (int j = 0; j < 8; ++j) yf[j] = (yf[j] * rstd * lw[j] + lb[j] + bon * v[j]) * g[j];
        store8(MIX + (size_t)m * 1024 + 512 + c, yf);
    }
}

DI void phase_final(const Args& a) {
    const int lane = ltid() & 63, gw = blockIdx.x * 8 + (ltid() >> 6), nw = gridDim.x * 8; const float* gamma = a.in[I_FG];
    for (int m = gw; m < NB * SEQ; m += nw) {
        float* xr = a.out + (size_t)m * DM; f32x4 v[4]; float ss = 0.f;
#pragma unroll
        for (int i = 0; i < 4; ++i) { v[i] = *(const f32x4*)(xr + i * 256 + lane * 4); ss += v[i][0] * v[i][0] + v[i][1] * v[i][1] + v[i][2] * v[i][2] + v[i][3] * v[i][3]; }
#pragma unroll
        for (int k = 1; k < 64; k <<= 1) ss = xorsum(ss, k);
        const float rstd = rsqrtf(ss * (1.f / 1024.f) + 1e-6f);
#pragma unroll
        for (int i = 0; i < 4; ++i) { const int col = i * 256 + lane * 4; const f32x4 g = *(const f32x4*)(gamma + col); *(f32x4*)(xr + col) = v[i] * rstd * g; }
    }
}

#define LAS __attribute__((address_space(3)))
#define XB_TMO      128
#define XB_XCNT(j)  (256  + 64 * (j))
#define XB_XSUB(j)  (1280 + 64 * (j))
#define XB_XGEN(j)  (2304 + 64 * (j))
#define XB_TOP      3328
#define XB_TOPGEN   3392
#define XCD_BAR_WORDS 3456
#define XB_SPIN_CAP (1u << 18)

__device__ __forceinline__ unsigned xb_ld(unsigned* p)              { return __hip_atomic_load(p, __ATOMIC_RELAXED, __HIP_MEMORY_SCOPE_AGENT); }
__device__ __forceinline__ unsigned xb_add(unsigned* p, unsigned v) { return __hip_atomic_fetch_add(p, v, __ATOMIC_RELAXED, __HIP_MEMORY_SCOPE_AGENT); }
__device__ __forceinline__ unsigned xb_xcc_id() { return (unsigned)__builtin_amdgcn_s_getreg((3 << 11) | 20) & 0xFu; }
#define XB_SPIN(cond, bar) do { unsigned _sp = 0; while (cond) { __builtin_amdgcn_s_sleep(1); \
    if ((++_sp & 255u) == 0u) { if (xb_ld(&(bar)[XB_TMO])) break; if (_sp > XB_SPIN_CAP) { atomicAdd(&(bar)[XB_TMO], 1u); break; } } } } while (0)

struct XcdBarrier {
    unsigned* bar; unsigned x;
    volatile LAS unsigned* st;
};

__device__ __forceinline__ XcdBarrier xcd_barrier_post(unsigned* bar, volatile LAS unsigned* st) {
    XcdBarrier b; b.bar = bar; b.x = xb_xcc_id(); b.st = st;
    if (threadIdx.x == 0) (void)xb_add(&bar[XB_XCNT(b.x)], 1u);
    return b;
}
__device__ __forceinline__ void xcd_barrier_complete(unsigned* bar, unsigned x, unsigned& nloc, unsigned& nx) {
    const unsigned G = gridDim.x * gridDim.y * gridDim.z;
    unsigned sum, cnt, mine, sp = 0u;
    for (;;) {
        sum = 0u; cnt = 0u; mine = 0u;
#pragma unroll
        for (unsigned j = 0; j < 16; ++j) { const unsigned c = xb_ld(&bar[XB_XCNT(j)]); sum += c; cnt += (c > 0u) ? 1u : 0u; mine = (j == x) ? c : mine; }
        if (sum == G) break;
        __builtin_amdgcn_s_sleep(1);
        if ((++sp & 255u) == 0u) { if (xb_ld(&bar[XB_TMO])) break; if (sp > XB_SPIN_CAP) { atomicAdd(&bar[XB_TMO], 1u); break; } }
    }
    nloc = mine > 0u ? mine : 1u; nx = cnt > 0u ? cnt : 1u;
}

__device__ __forceinline__ void xcd_barrier(const XcdBarrier& b) {
    asm volatile("s_waitcnt vmcnt(0)" ::: "memory");
    __syncthreads();
    if (threadIdx.x == 0) {
        unsigned* bar = b.bar;
        __builtin_amdgcn_s_waitcnt(0);
        unsigned nloc = b.st[0], nx = b.st[1];
        if (nloc == 0u) { xcd_barrier_complete(bar, b.x, nloc, nx); b.st[0] = nloc; b.st[1] = nx; }
        const unsigned old = xb_add(&bar[XB_XSUB(b.x)], 1u);
        const unsigned gen = old / nloc;
        if (old + 1u == (gen + 1u) * nloc) {
            __builtin_amdgcn_fence(__ATOMIC_RELEASE, "agent");
            asm volatile("s_waitcnt vmcnt(0)" ::: "memory");
            const unsigned og = xb_add(&bar[XB_TOP], 1u);
            const unsigned tg = og / nx;
            if (og + 1u == (tg + 1u) * nx) xb_add(&bar[XB_TOPGEN], 1u);
            else XB_SPIN(xb_ld(&bar[XB_TOPGEN]) == tg, bar);
            __builtin_amdgcn_fence(__ATOMIC_ACQUIRE, "agent");
            xb_add(&bar[XB_XGEN(b.x)], 1u);
            asm volatile("s_waitcnt vmcnt(0)" ::: "memory");
        } else {
            XB_SPIN(xb_ld(&bar[XB_XGEN(b.x)]) == gen, bar);
            __builtin_amdgcn_fence(__ATOMIC_ACQUIRE, "agent");
            asm volatile("s_waitcnt vmcnt(0)" ::: "memory");
        }
    }
    __syncthreads();
}

#ifndef DUPMASK
#define DUPMASK 0
#endif
#ifndef SUBM
#define SUBM 3
#endif
#ifndef PHMASK
#define PHMASK 0xfff
#endif
__global__ void __launch_bounds__(512, 2) trunk_fwd(Args ka) {
    extern __shared__ __attribute__((aligned(16))) unsigned char lds[];
    cg::grid_group grid = cg::this_grid();
    volatile LAS unsigned* bst = (volatile LAS unsigned*)((LAS unsigned char*)lds + (LDS_BYTES - 16));
    if (threadIdx.x < 4) bst[threadIdx.x] = 0u;
    __syncthreads();
    XcdBarrier xbar = xcd_barrier_post((unsigned*)(ka.ws + WS_BAR), bst);
    const int ph_hi = ka.hi;
    {
        if (blockIdx.x == 0 && threadIdx.x == 0) {
#pragma unroll
            for (int i = 0; i < 31; ++i) ((const float**)(ka.ws + WS_TAB))[i] = ka.in[i]; }
        phase_prologue(ka, lds); convert_weights(ka, 0, lds, 0);
        grid.sync();
    }
    for (int ph = 1; ph < ph_hi; ++ph) {
        Args a; a.ws = ka.ws; a.out = ka.out; asm volatile("" : "+s"(a.ws)); asm volatile("" : "+s"(a.out));
        { const float* const* tab = (const float* const*)(a.ws + WS_TAB);
#define LD4(i) asm volatile("s_load_dwordx2 %0, %4, %5\n\ts_load_dwordx2 %1, %4, %6\n\ts_load_dwordx2 %2, %4, %7\n\ts_load_dwordx2 %3, %4, %8\n\ts_waitcnt lgkmcnt(0)" \
              : "=&s"(a.in[i]), "=&s"(a.in[i + 1]), "=&s"(a.in[i + 2]), "=&s"(a.in[i + 3]) : "s"(tab), "i"((i) * 8), "i"((i) * 8 + 8), "i"((i) * 8 + 16), "i"((i) * 8 + 24))
          LD4(0); LD4(4); LD4(8); LD4(12); LD4(16); LD4(20); LD4(24);
          asm volatile("s_load_dwordx2 %0, %3, %4\n\ts_load_dwordx2 %1, %3, %5\n\ts_load_dwordx2 %2, %3, %6\n\ts_waitcnt lgkmcnt(0)" : "=&s"(a.in[28]), "=&s"(a.in[29]), "=&s"(a.in[30]) : "s"(tab), "i"(224), "i"(232), "i"(240));
#undef LD4
        }
        a.lo = 0; a.hi = 0;
        unsigned char* ws = a.ws;
        if (ph == 1) phase_vectors(a, lds);
        else if (ph == NPH - 1) phase_final(a);
        else {
            const int l = (ph - 2) / 10, s = (ph - 2) % 10; const bool last = (l == NL - 1);
            const float* mods = (const float*)(ws + WS_MODS) + (size_t)l * 33 * 6144;
            float* rsa = (float*)(ws + WS_RSA); float* rsb = (float*)(ws + WS_RSB);
            if (s == 0) { run_gemm<NIN, 1024>(lds, (const bf16_t*)(ws + WS_H), (const bf16_t*)(ws + WT_IN), 0, FnF{(bf16_t*)(ws + WS_F), rsa, (const float*)(ws + WS_C1) + (size_t)l * 33 * NIN}); }
            else if (s == 1) { phase_split(a, l); convert_weights(a, l, lds, 1);
                for (int i = blockIdx.x * 512 + ltid(); i < TALL; i += gridDim.x * 512) { rsa[i] = 0.f; rsb[i] = 0.f; } }
            else if (s == 2) { run_gemm<768, 256>(lds, (const bf16_t*)(ws + WS_CQN), (const bf16_t*)(ws + WT_UQ), 0, FnQ{(bf16_t*)(ws + WS_Q), (const float*)(ws + WS_ROPE)});
                    run_gemm<1024, 256>(lds, (const bf16_t*)(ws + WS_CKVN), (const bf16_t*)(ws + WT_UKV), 0, FnKV{(bf16_t*)(ws + WS_KATT), (bf16_t*)(ws + WS_VATT)}); }
            else if (s == 3) { phase_attn((const bf16_t*)(ws + WS_Q), (const bf16_t*)(ws + WS_KATT), (const bf16_t*)(ws + WS_VATT), (bf16_t*)(ws + WS_MIX), last, (char*)lds); }
            else if (s == 4) { run_gemm<2048, 256>(lds, (const bf16_t*)(ws + WS_A1), (const bf16_t*)(ws + WT_L1), 0, FnL1{(__half*)(ws + WS_DEC), (bf16_t*)(ws + WS_AA), a.in[I_W0] + l * 1024, a.in[I_A0] + l * 1024});
                    run_gemm<1024, 256>(lds, (const bf16_t*)(ws + WS_A2), (const bf16_t*)(ws + WT_L2), 0,
                             FnL2{(bf16_t*)(ws + WS_G), (bf16_t*)(ws + WS_V), (const bf16_t*)(ws + WS_VF), a.in[I_V0] + (l > 0 ? l - 1 : 0) * 512, l > 0 ? 1 : 0}); }
            else if (s == 5) { phase_scan((const bf16_t*)(ws + WS_R), (const bf16_t*)(ws + WS_K), (const bf16_t*)(ws + (l == 0 ? WS_VF : WS_V)), (const __half*)(ws + WS_DEC), (const bf16_t*)(ws + WS_AA),
                               (const float*)(ws + WS_INV), a.in[I_KK] + l * 512, a.in[I_KA] + l * 512, (bf16_t*)(ws + WS_MIX), (bf16_t*)(ws + WS_YB), (char*)lds); }
            else if (s == 6) { phase_rwkv_out(a, l, last); if (!last) convert_weights(a, l + 1, lds, 0); }
            else if (s == 7) { run_gemm_epi<1024, 1024>(lds, (const bf16_t*)(ws + WS_MIX), (const bf16_t*)(ws + WT_OUT), last ? 1 : 0,
                             EpiRes{a.out, (float*)(ws + WS_XC), l == 0 ? a.in[I_X] : a.out, l == 0 ? a.in[I_CTX] : (const float*)(ws + WS_XC), mods, 2,
                                    (const float*)(ws + WS_GP2) + (size_t)l * 33 * 1024, (bf16_t*)(ws + WS_H), rsb, 1}); }
            else if (s == 8) { run_gemm<DFF, 1024>(lds, (const bf16_t*)(ws + WS_H), (const bf16_t*)(ws + WT_M1), last ? 1 : 0, FnM1{(bf16_t*)(ws + WS_HID), rsb, (const float*)(ws + WS_C2) + (size_t)l * 33 * DFF}); }
            else if (s == 9) { run_gemm_epi<1024, DFF>(lds, (const bf16_t*)(ws + WS_HID), (const bf16_t*)(ws + WT_M2), last ? 1 : 0,
                             EpiRes{a.out, (float*)(ws + WS_XC), a.out, (const float*)(ws + WS_XC), mods, 5,
                                    (const float*)(ws + WS_GP1) + (size_t)(last ? l : l + 1) * 33 * 1024, (bf16_t*)(ws + WS_H), rsa, last ? 0 : 1}); }
        }
        if (ph + 1 < ph_hi) { XcdBarrier xb = xbar; asm volatile("" : "+s"(xb.bar)); xcd_barrier(xb); }
    }
}

extern "C" void kernel_launch(void* const* d_in, const int* in_sizes, int n_in, void* d_out, int out_size, void* d_ws, size_t ws_size, hipStream_t stream) {
    static int grid = 0;
    if (grid == 0) {
        if (n_in != 31 || out_size != NB * SEQ * DM || ws_size < WS_END) { fprintf(stderr, "kernel_launch: unexpected shapes: n_in %d out %d ws %zu (need %zu)\n", n_in, out_size, ws_size, (size_t)WS_END); grid = -1; return; }
        int dev = 0, cus = 0, per_cu = 0;
        (void)hipGetDevice(&dev); (void)hipDeviceGetAttribute(&cus, hipDeviceAttributeMultiprocessorCount, dev);
        if (hipFuncSetAttribute((const void*)trunk_fwd, hipFuncAttributeMaxDynamicSharedMemorySize, LDS_BYTES) != hipSuccess) { fprintf(stderr, "kernel_launch: hipFuncSetAttribute failed\n"); grid = -1; return; }
        if (hipOccupancyMaxActiveBlocksPerMultiprocessor(&per_cu, (const void*)trunk_fwd, 512, LDS_BYTES) != hipSuccess || per_cu < 1) { fprintf(stderr, "kernel_launch: occupancy query gave %d\n", per_cu); per_cu = 1; }
        (void)hipGetLastError();
        grid = cus * 1;
    }
    if (grid < 0) return;
    if (hipMemsetAsync((char*)d_ws + WS_BAR, 0, BAR_BYTES, stream) != hipSuccess) { fprintf(stderr, "kernel_launch: hipMemsetAsync failed\n"); return; }
    Args a{};
    for (int i = 0; i < 31; ++i) a.in[i] = (const float*)d_in[i];
    a.out = (float*)d_out; a.ws = (unsigned char*)d_ws; a.lo = 0; a.hi = NPH;
    void* args[] = {&a};
    hipError_t e = hipLaunchCooperativeKernel((const void*)trunk_fwd, dim3(grid), dim3(512), args, LDS_BYTES, stream);
    if (e != hipSuccess) fprintf(stderr, "kernel_launch: cooperative launch failed: %s (grid %d)\n", hipGetErrorString(e), grid);
}
```

```cpp
#include <hip/hip_runtime.h>
#include <hip/hip_cooperative_groups.h>
#include <hip/hip_fp16.h>
#include <cstdio>
#include <cstdint>
namespace cg = cooperative_groups;
#define DI __device__ __forceinline__
DI int ltid() { int t = threadIdx.x; asm volatile("" : "+v"(t)); return t; }
namespace pg8 {
#define PG8_LAS __attribute__((address_space(3)))
typedef unsigned short bf16_t;
typedef short bf16x8 __attribute__((ext_vector_type(8)));
typedef float f32x4 __attribute__((ext_vector_type(4)));
typedef unsigned u32x4 __attribute__((ext_vector_type(4)));
constexpr int BM = 256, BK = 64, HALF = 128, HTB = HALF * BK * 2  , STAGE_BYTES = 8 * HTB, NXCD = 8, WGM = 8;

__host__ __device__ __forceinline__ int lds_byte(int r, int c) { const int st = (r >> 4) * 2 + (c >> 5), rr = r & 15, cc = c & 31, ob = rr * 64 + cc * 2; return st * 1024 + (ob ^ (((ob >> 9) & 1) << 5)); }
__host__ __device__ __forceinline__ void stage_rc(int b, int& R, int& C) { const int st = b / 1024, sb = b % 1024, swz = sb ^ (((sb >> 9) & 1) << 5); R = (st >> 1) * 16 + swz / 64; C = (st & 1) * 32 + (swz % 64) / 2; }
__host__ __device__ __forceinline__ int perm32(int rho) { const int n = rho >> 4, i = rho & 15; return 8 * (i >> 2) + 4 * n + (i & 3); }

struct Unit { int pm, pn; };
struct Gemm { const bf16_t* A; const bf16_t* Bt; int M, N, K; };

struct StaticOrder {
    int nM, nN, nwg, G, c;
    __host__ __device__ void init(int M, int N, int G_, int c_) { nM = M / BM; nN = N / BM; nwg = nM * nN; G = G_; c = c_; }
    __host__ __device__ bool next(int i, Unit& u) const {
        const long L = (long)i * G + c; if (L >= nwg) return false;
        int wgid = (int)L; { const int q = nwg / NXCD, r = nwg % NXCD, xcd = wgid % NXCD, off = wgid / NXCD; wgid = (xcd < r ? xcd * (q + 1) : r * (q + 1) + (xcd - r) * q) + off; }
        const int nig = WGM * nN, gid = wgid / nig, fm = gid * WGM, gsz = (nM - fm) < WGM ? (nM - fm) : WGM;
        u.pm = fm + ((wgid % nig) % gsz); u.pn = (wgid % nig) / gsz; return true;
    }
    __device__ __forceinline__ void a_ready(const Unit&) const {}
    __device__ __forceinline__ void done(const Unit&) const {}
};

__device__ __forceinline__ unsigned cvt_pk_bf16(float lo, float hi) { unsigned r; asm volatile("v_cvt_pk_bf16_f32 %0, %1, %2" : "=v"(r) : "v"(lo), "v"(hi)); return r; }

template <class Epi, class Sched, bool ALIGN_EPI = false, bool SP2 = false>
__device__ __forceinline__ void gemm_phase(PG8_LAS unsigned char* lds, const Gemm g, const Sched& S, const Epi& E) {
    const int tid = ltid(), wid = __builtin_amdgcn_readfirstlane(tid >> 6), lane = tid & 63, wr = wid >> 2, wc = wid & 3, fr = lane & 15, fq = lane >> 4;
    const int K = g.K, nt = K / BK;
    unsigned voffA[2], voffB[2];
#pragma unroll
    for (int i = 0; i < 2; ++i) { int R, C; stage_rc(tid * 16 + i * 8192, R, C); const int Rb = Epi::PERM ? ((R & ~31) + perm32(R & 31)) : R;
        voffA[i] = (unsigned)(R * K + C) * 2u; voffB[i] = (unsigned)(Rb * K + C) * 2u; }
    const size_t kstep = (size_t)(BK * 2);
    const size_t hstep = (size_t)HALF * K * 2;
    const size_t tstep = 2 * hstep;
    const unsigned ldsw = (unsigned)wid * 1024u;
    const int aoff = lds_byte(wr * 64 + fr, fq * 8), boff = lds_byte(wc * 32 + fr, fq * 8);
#define PG8_SA(b, h) (((b) * 2 + (h)) * HTB)
#define PG8_SB(b, h) ((4 + (b) * 2 + (h)) * HTB)
#define PG8_STAGE(bufoff, gbase, voff) do { _Pragma("unroll") for (int _i = 0; _i < 2; ++_i) \
        __builtin_amdgcn_global_load_lds((const unsigned*)((const char*)(gbase) + (voff)[_i]), (PG8_LAS unsigned*)(lds + (bufoff) + ldsw + _i * 8192), 16, 0, 0); } while (0)
#define PG8_LDA(dst, b, h) do { _Pragma("unroll") for (int m = 0; m < 4; ++m) _Pragma("unroll") for (int k = 0; k < 2; ++k) dst[m][k] = *(const PG8_LAS bf16x8*)(lds + PG8_SA(b, h) + aoff + m * 2048 + k * 1024); } while (0)
#define PG8_LDB(dst, b, h) do { _Pragma("unroll") for (int n = 0; n < 2; ++n) _Pragma("unroll") for (int k = 0; k < 2; ++k) dst[n][k] = *(const PG8_LAS bf16x8*)(lds + PG8_SB(b, h) + boff + n * 2048 + k * 1024); } while (0)
#define PG8_MMA(ai, bj, At, Bt) do { __builtin_amdgcn_s_setprio(1); _Pragma("unroll") for (int m = 0; m < 4; ++m) _Pragma("unroll") for (int n = 0; n < 2; ++n) _Pragma("unroll") for (int k = 0; k < 2; ++k) \
        acc[ai][bj][m][n] = __builtin_amdgcn_mfma_f32_16x16x32_bf16(Bt[n][k], At[m][k], acc[ai][bj][m][n], 0, 0, 0); __builtin_amdgcn_s_setprio(0); } while (0)
#define PG8_WAIT_V(n) asm volatile("s_waitcnt vmcnt(" #n ")" ::: "memory")
#define PG8_WAIT_L(n) asm volatile("s_waitcnt lgkmcnt(" #n ")" ::: "memory")
#define PG8_BAR __builtin_amdgcn_s_barrier()
#define PG8_SCHED __builtin_amdgcn_sched_barrier(0)
    Unit cur, nxt; int ui = 0;
    if (!S.next(0, cur)) return;
    f32x4 acc[2][2][4][2];
#pragma unroll
    for (int a = 0; a < 2; ++a)
#pragma unroll
        for (int b = 0; b < 2; ++b)
#pragma unroll
            for (int m = 0; m < 4; ++m)
#pragma unroll
                for (int n = 0; n < 2; ++n) acc[a][b][m][n] = (f32x4){0.f, 0.f, 0.f, 0.f};
    bf16x8 At[4][2], B0[2][2], B1[2][2];
    const char* cA = (const char*)g.A + (size_t)cur.pm * tstep; const char* cB = (const char*)g.Bt + (size_t)cur.pn * tstep;
    S.a_ready(cur);
    if constexpr (SP2) {
        PG8_STAGE(PG8_SB(0, 0), cB, voffB); PG8_STAGE(PG8_SB(0, 1), cB + hstep, voffB); PG8_STAGE(PG8_SA(0, 0), cA, voffA); PG8_STAGE(PG8_SA(0, 1), cA + hstep, voffA);
        if (wr == 1) PG8_BAR;
        PG8_WAIT_V(2); PG8_BAR;
        PG8_STAGE(PG8_SB(1, 0), cB + kstep, voffB); PG8_STAGE(PG8_SA(1, 0), cA + kstep, voffA); PG8_STAGE(PG8_SB(1, 1), cB + hstep + kstep, voffB);
        PG8_WAIT_V(6); PG8_BAR;
    } else {
        PG8_STAGE(PG8_SB(0, 0), cB, voffB); PG8_STAGE(PG8_SA(0, 0), cA, voffA); PG8_STAGE(PG8_SB(0, 1), cB + hstep, voffB); PG8_STAGE(PG8_SA(0, 1), cA + hstep, voffA);
        if (wr == 1) PG8_BAR;
        PG8_WAIT_V(4); PG8_BAR;
        PG8_STAGE(PG8_SB(1, 0), cB + kstep, voffB); PG8_STAGE(PG8_SA(1, 0), cA + kstep, voffA); PG8_STAGE(PG8_SB(1, 1), cB + hstep + kstep, voffB);
        PG8_WAIT_V(6); PG8_BAR;
    }
    for (;;) {
        const bool has_next = S.next(ui + 1, nxt);
        const char* nA = has_next ? (const char*)g.A + (size_t)nxt.pm * tstep : cA; const char* nB = has_next ? (const char*)g.Bt + (size_t)nxt.pn * tstep : cB;
#pragma nounroll
        for (int t = 0; t < nt; t += 2) {
            const bool last = (t == nt - 2);
            const char* a1 = cA + (size_t)(t + 1) * kstep;
            const char* a2 = last ? nA : cA + (size_t)(t + 2) * kstep; const char* b2 = last ? nB : cB + (size_t)(t + 2) * kstep;
            const char* a3 = a2 + kstep; const char* b3 = b2 + kstep;
            if (last && has_next) S.a_ready(nxt);
            if constexpr (SP2) {
            PG8_LDB(B0, 0, 0); PG8_LDB(B1, 0, 1); PG8_SCHED; PG8_LDA(At, 0, 0); PG8_STAGE(PG8_SA(1, 1), a1 + hstep, voffA);
            PG8_WAIT_V(8); PG8_WAIT_L(0); PG8_BAR; PG8_MMA(0, 0, At, B0); PG8_MMA(0, 1, At, B1); PG8_BAR; PG8_SCHED;
            PG8_LDA(At, 0, 1); PG8_STAGE(PG8_SB(0, 0), b2, voffB); PG8_STAGE(PG8_SB(0, 1), b2 + hstep, voffB); PG8_STAGE(PG8_SA(0, 0), a2, voffA);
            PG8_WAIT_V(8); PG8_WAIT_L(0); PG8_BAR; PG8_MMA(1, 0, At, B0); PG8_MMA(1, 1, At, B1); PG8_BAR; PG8_SCHED;
            PG8_LDB(B0, 1, 0); PG8_LDB(B1, 1, 1); PG8_SCHED; PG8_LDA(At, 1, 0); PG8_STAGE(PG8_SA(0, 1), a2 + hstep, voffA);
            PG8_WAIT_V(8); PG8_WAIT_L(0); PG8_BAR; PG8_MMA(0, 0, At, B0); PG8_MMA(0, 1, At, B1); PG8_BAR; PG8_SCHED;
            PG8_LDA(At, 1, 1); PG8_STAGE(PG8_SB(1, 0), b3, voffB); PG8_STAGE(PG8_SB(1, 1), b3 + hstep, voffB); PG8_STAGE(PG8_SA(1, 0), a3, voffA);
            PG8_WAIT_V(8); PG8_WAIT_L(0); PG8_BAR; PG8_MMA(1, 0, At, B0); PG8_MMA(1, 1, At, B1); PG8_BAR; PG8_SCHED;
            } else {
            PG8_LDB(B0, 0, 0); PG8_SCHED; PG8_LDA(At, 0, 0); PG8_STAGE(PG8_SA(1, 1), a1 + hstep, voffA);
            PG8_WAIT_L(8); PG8_BAR; PG8_WAIT_L(0); PG8_MMA(0, 0, At, B0); PG8_BAR; PG8_SCHED;
            PG8_LDB(B1, 0, 1); PG8_STAGE(PG8_SB(0, 0), b2, voffB);
            PG8_BAR; PG8_WAIT_L(0); PG8_MMA(0, 1, At, B1); PG8_BAR;
            PG8_LDA(At, 0, 1); PG8_STAGE(PG8_SA(0, 0), a2, voffA);
            PG8_BAR; PG8_WAIT_L(0); PG8_MMA(1, 0, At, B0); PG8_BAR; PG8_SCHED;
            PG8_STAGE(PG8_SB(0, 1), b2 + hstep, voffB);
            PG8_WAIT_V(6); PG8_BAR; PG8_MMA(1, 1, At, B1); PG8_BAR;
            PG8_LDB(B0, 1, 0); PG8_SCHED; PG8_LDA(At, 1, 0); PG8_STAGE(PG8_SA(0, 1), a2 + hstep, voffA);
            PG8_WAIT_L(8); PG8_BAR; PG8_WAIT_L(0); PG8_MMA(0, 0, At, B0); PG8_BAR; PG8_SCHED;
            PG8_LDB(B1, 1, 1); PG8_STAGE(PG8_SB(1, 0), b3, voffB);
            PG8_BAR; PG8_WAIT_L(0); PG8_MMA(0, 1, At, B1); PG8_BAR;
            PG8_LDA(At, 1, 1); PG8_STAGE(PG8_SA(1, 0), a3, voffA);
            PG8_BAR; PG8_WAIT_L(0); PG8_MMA(1, 0, At, B0); PG8_BAR; PG8_SCHED;
            PG8_STAGE(PG8_SB(1, 1), b3 + hstep, voffB);
            PG8_WAIT_V(6); PG8_BAR; PG8_MMA(1, 1, At, B1); PG8_BAR;
            }
        }
        if constexpr (ALIGN_EPI) { if (wr == 0) PG8_BAR; }
        if constexpr (!Epi::AFTER_DRAIN) { E(acc, cur, wr, wc, fr, fq); S.done(cur); }
        if (!has_next) break;
#pragma unroll
        for (int a = 0; a < 2; ++a)
#pragma unroll
            for (int b = 0; b < 2; ++b)
#pragma unroll
                for (int m = 0; m < 4; ++m)
#pragma unroll
                    for (int n = 0; n < 2; ++n) acc[a][b][m][n] = (f32x4){0.f, 0.f, 0.f, 0.f};
        cur = nxt; cA = nA; cB = nB; ++ui;
        if constexpr (ALIGN_EPI) { if (wr == 1) PG8_BAR; }
    }
    PG8_WAIT_V(0);
    if constexpr (!ALIGN_EPI) { if (wr == 0) PG8_BAR; }
    PG8_BAR;
    if constexpr (Epi::AFTER_DRAIN) { E.fused(acc, cur, wr, wc, fr, fq, lds, wid, lane); S.done(cur); }
#undef PG8_SA
#undef PG8_SB
#undef PG8_STAGE
#undef PG8_LDA
#undef PG8_LDB
#undef PG8_MMA
#undef PG8_WAIT_V
#undef PG8_WAIT_L
#undef PG8_BAR
#undef PG8_SCHED
}
}
typedef unsigned short bf16_t;
using bf16x8 = __attribute__((ext_vector_type(8))) short;
using s16x4  = __attribute__((ext_vector_type(4))) short;
using f32x16 = __attribute__((ext_vector_type(16))) float;
using f32x4  = __attribute__((ext_vector_type(4))) float;
using u32x4  = __attribute__((ext_vector_type(4))) unsigned;
using u32x2  = __attribute__((ext_vector_type(2))) unsigned;

constexpr int DM = 1024, NB = 32, SEQ = 2048, TC = 256, TT = 2304, TALL = NB * TT, NL = 4;
constexpr int CIN = 2336, CINX = 2368, NIN = 2560, DFF = 4096;
constexpr int OFF_R = 416, OFF_K = 928, OFF_V = 1440, OFF_WLO = 1952, OFF_HV = 2336;
constexpr int NPH = 43, LDS_BYTES = 147456;
constexpr size_t MiB = 1u << 20;
constexpr size_t WS_MODS = 0, WS_ROPE = 3 * MiB + 512 * 1024, WS_BAR = 3 * MiB + 768 * 1024, BAR_BYTES = 16384, WS_TAB = 3 * MiB + 800 * 1024, WS_XC = 4 * MiB, WS_VF = 36 * MiB, WS_WT = 108 * MiB, WS_INV = 134 * MiB, TR = 137 * MiB;
constexpr size_t WT_IN = WS_WT, WT_UQ = WS_WT + 5 * MiB, WT_UKV = WS_WT + 5 * MiB + 512 * 1024, WT_L1 = WS_WT + 6 * MiB, WT_L2 = WS_WT + 7 * MiB,
                 WT_OUT = WS_WT + 8 * MiB, WT_M1 = WS_WT + 10 * MiB, WT_M2 = WS_WT + 18 * MiB;
constexpr size_t WS_R = TR, WS_K = TR + 72 * MiB, WS_H = TR, WS_F = TR + 144 * MiB, WS_Q = TR + 144 * MiB, WS_VATT = TR + 252 * MiB, WS_MIX = TR + 324 * MiB,
                 WS_DEC = TR + 144 * MiB, WS_HID = TR + 144 * MiB, WS_A1 = TR + 477 * MiB, WS_A2 = TR + 513 * MiB, WS_YB = TR + 477 * MiB,
                 WS_CQN = TR + 549 * MiB, WS_CKVN = TR + 585 * MiB, WS_KATT = TR + 621 * MiB, WS_AA = TR + 585 * MiB, WS_G = TR + 729 * MiB,
                 WS_V = TR + 801 * MiB, WS_C1 = 1010 * MiB, WS_C2 = 1012 * MiB, WS_GP1 = 1015 * MiB, WS_GP2 = 1016 * MiB, WS_END = 1017 * MiB;
constexpr size_t WS_RSA = 136 * MiB + 256 * 1024, WS_RSB = 136 * MiB + 640 * 1024;

struct Args { const float* in[31]; float* out; unsigned char* ws; int lo, hi; };
enum { I_X = 0, I_C, I_CTX, I_CCTX, I_ADAW, I_ADAB, I_N1G, I_N2G, I_WIN, I_QNG, I_WUQ, I_KVNG, I_WUKV, I_MU, I_W0, I_W2, I_A0, I_A2, I_G2, I_KK, I_KA, I_RK,
       I_LNW, I_LNB, I_V1, I_V2, I_V0, I_WOUT, I_M1, I_M2, I_FG };

DI float bflo(unsigned w) { return __uint_as_float(w << 16); }
DI float bfhi(unsigned w) { return __uint_as_float(w & 0xffff0000u); }
DI unsigned cvtpk(float lo, float hi) { return pg8::cvt_pk_bf16(lo, hi); }
DI bf16_t f2bf(float f) { return (bf16_t)(cvtpk(f, 0.f) & 0xffffu); }
DI void load8(const bf16_t* p, float (&f)[8]) { const u32x4 w = *(const u32x4*)p; f[0] = bflo(w.x); f[1] = bfhi(w.x); f[2] = bflo(w.y); f[3] = bfhi(w.y); f[4] = bflo(w.z); f[5] = bfhi(w.z); f[6] = bflo(w.w); f[7] = bfhi(w.w); }
DI void store8(bf16_t* p, const float (&f)[8]) { u32x4 w; w.x = cvtpk(f[0], f[1]); w.y = cvtpk(f[2], f[3]); w.z = cvtpk(f[4], f[5]); w.w = cvtpk(f[6], f[7]); *(u32x4*)p = w; }
DI void loadf8(const float* p, float (&f)[8]) { const f32x4 a = *(const f32x4*)p, b = *(const f32x4*)(p + 4); f[0] = a[0]; f[1] = a[1]; f[2] = a[2]; f[3] = a[3]; f[4] = b[0]; f[5] = b[1]; f[6] = b[2]; f[7] = b[3]; }
DI float h2f(unsigned b) { return __half2float(__ushort_as_half((unsigned short)b)); }
DI float sigmoidf_(float x) { return __builtin_amdgcn_rcpf(1.f + __expf(-x)); }
DI float tanhf_(float x) { return 1.f - 2.f * __builtin_amdgcn_rcpf(1.f + __expf(2.f * x)); }
DI float xorsum(float v, int mask) { return v + __shfl_xor(v, mask, 64); }
DI float* xrow(float* out, float* xc, int m) { const int b = m / TT, tt = m - b * TT; return tt < TC ? xc + (size_t)(b * TC + tt) * DM : out + (size_t)(b * SEQ + tt - TC) * DM; }

template <class Fn> struct Epi8 {
    static constexpr bool PERM = true, AFTER_DRAIN = false; Fn f;
    DI void operator()(const pg8::f32x4 (&acc)[2][2][4][2], const pg8::Unit& u, int wr, int wc, int fr, int fq) const {
        asm volatile("" : "+v"(fr), "+v"(fq));
#pragma unroll
        for (int ai = 0; ai < 2; ++ai)
#pragma unroll
            for (int m = 0; m < 4; ++m) { const int rit = ai * 128 + wr * 64 + m * 16 + fr;
#pragma unroll
                for (int bj = 0; bj < 2; ++bj) { f(rit, u.pn * 256 + bj * 128 + wc * 32 + 8 * fq, acc[ai][bj][m][0], acc[ai][bj][m][1], u, fq); __builtin_amdgcn_sched_barrier(0); } }
    }
};
DI void st8(bf16_t* p, const pg8::f32x4& v0, const pg8::f32x4& v1) { u32x4 w; w.x = cvtpk(v0[0], v0[1]); w.y = cvtpk(v0[2], v0[3]); w.z = cvtpk(v1[0], v1[1]); w.w = cvtpk(v1[2], v1[3]); *(u32x4*)p = w; }

struct FnF { bf16_t* F; const float* rs; const float* c1;
    DI void operator()(int rit, int col0, const pg8::f32x4& v0, const pg8::f32x4& v1, const pg8::Unit& u, int) const {
        if (col0 < CINX) { const int row = u.pm * 256 + rit, b = u.pm / 9, mrow = (u.pm - b * 9 == 0) ? 32 : b;
            const float rstd = rsqrtf(rs[row] * (1.f / 1024.f) + 1e-6f); const float* c = c1 + (size_t)mrow * NIN + col0;
            const pg8::f32x4 b0 = *(const pg8::f32x4*)c, b1 = *(const pg8::f32x4*)(c + 4);
            st8(F + (size_t)row * CINX + col0, v0 * rstd + b0, v1 * rstd + b1); } } };
struct FnQ { bf16_t* Q; const float* rope;
    DI void operator()(int rit, int col0, const pg8::f32x4& v0, const pg8::f32x4& v1, const pg8::Unit& u, int fq) const {
        const int seg = u.pm % 9; const bool isrope = (seg != 0) && (((col0 >> 5) % 3) == 2);
        float x[8] = {v0[0], v0[1], v0[2], v0[3], v1[0], v1[1], v1[2], v1[3]};
        if (isrope) { const int s = (seg - 1) * 256 + rit, pos = (fq < 2) ? (s >> 6) : (s & 63); float cs[8], sn[8]; loadf8(rope + pos * 8, cs); loadf8(rope + 512 + pos * 8, sn);
            const float sg = (fq & 1) ? 1.f : -1.f;
#pragma unroll
            for (int j = 0; j < 8; ++j) { const float p = __shfl_xor(x[j], 16, 64); x[j] = x[j] * cs[j] + sg * p * sn[j]; } }
        store8(Q + (size_t)(u.pm * 256 + rit) * 768 + col0, x); } };
struct FnKV { bf16_t* KA; bf16_t* VA;
    DI void operator()(int rit, int col0, const pg8::f32x4& v0, const pg8::f32x4& v1, const pg8::Unit& u, int) const {
        const size_t row = (size_t)(u.pm * 256 + rit); const int h = col0 >> 7, c = col0 & 127;
        if (c < 64) st8(KA + row * 768 + h * 96 + c, v0, v1); else st8(VA + row * 512 + h * 64 + (c - 64), v0, v1); } };
struct FnL1 { __half* DEC; bf16_t* AA; const float* w0; const float* a0;
    DI void operator()(int rit, int col0, const pg8::f32x4& v0, const pg8::f32x4& v1, const pg8::Unit& u, int) const {
        const size_t row = (size_t)(u.pm * 256 + rit); float x[8] = {v0[0], v0[1], v0[2], v0[3], v1[0], v1[1], v1[2], v1[3]};
        if (col0 < 1024) { float b[8]; loadf8(w0 + col0, b); u32x4 w; unsigned hh[8];
#pragma unroll
            for (int j = 0; j < 8; ++j) { const float uu = 0.6065306597f * sigmoidf_(x[j] + b[j]); hh[j] = (unsigned)__half_as_ushort(__float2half(-uu * 1.4426950409f)); }
            w.x = hh[0] | (hh[1] << 16); w.y = hh[2] | (hh[3] << 16); w.z = hh[4] | (hh[5] << 16); w.w = hh[6] | (hh[7] << 16);
            *(u32x4*)(DEC + row * 1024 + col0) = w;
        } else { const int c = col0 - 1024; float b[8]; loadf8(a0 + c, b);
#pragma unroll
            for (int j = 0; j < 8; ++j) x[j] = sigmoidf_(x[j] + b[j]);
            store8(AA + row * 1024 + c, x); } } };
struct FnL2 { bf16_t* G; bf16_t* V; const bf16_t* VF; const float* v0p; int dovres;
    DI void operator()(int rit, int col0, const pg8::f32x4& v0, const pg8::f32x4& v1, const pg8::Unit& u, int) const {
        const size_t row = (size_t)(u.pm * 256 + rit);
        if (col0 < 512) st8(G + row * 512 + col0, v0, v1);
        else if (dovres) { const int c = col0 - 512; float x[8] = {v0[0], v0[1], v0[2], v0[3], v1[0], v1[1], v1[2], v1[3]}, b[8], v[8], vf[8]; loadf8(v0p + c, b); load8(V + row * 512 + c, v); load8(VF + row * 512 + c, vf);
#pragma unroll
            for (int j = 0; j < 8; ++j) v[j] = v[j] + (vf[j] - v[j]) * sigmoidf_(b[j] + x[j]);
            store8(V + row * 512 + c, v); } } };
struct FnM1 { bf16_t* HID; const float* rs; const float* c2;
    DI void operator()(int rit, int col0, const pg8::f32x4& v0, const pg8::f32x4& v1, const pg8::Unit& u, int) const {
        const int row = u.pm * 256 + rit, b = u.pm / 9, mrow = (u.pm - b * 9 == 0) ? 32 : b;
        const float rstd = rsqrtf(rs[row] * (1.f / 1024.f) + 1e-6f); const float* c = c2 + (size_t)mrow * DFF + col0;
        const pg8::f32x4 b0 = *(const pg8::f32x4*)c, b1 = *(const pg8::f32x4*)(c + 4);
        const pg8::f32x4 y0 = v0 * rstd + b0, y1 = v1 * rstd + b1;
        float x[8] = {y0[0], y0[1], y0[2], y0[3], y1[0], y1[1], y1[2], y1[3]};
#pragma unroll
        for (int j = 0; j < 8; ++j) { const float r = fmaxf(x[j], 0.f); x[j] = r * r; }
        store8(HID + (size_t)row * DFF + col0, x); } };
struct EpiRes { static constexpr bool PERM = true, AFTER_DRAIN = false;
    float* out; float* xc; const float* sx; const float* sc; const float* mods; int gidx; const float* gp; bf16_t* H; float* rs; int emit;
    DI void operator()(const pg8::f32x4 (&acc)[2][2][4][2], const pg8::Unit& u, int wr, int wc, int fr, int fq) const {
        asm volatile("" : "+v"(fr), "+v"(fq));
        const int b = u.pm / 9, seg = u.pm - b * 9, mrow = seg == 0 ? 32 : b;
        const float* gbase = mods + (size_t)mrow * 6144 + gidx * 1024; const float* gpb = gp + (size_t)mrow * 1024;
#pragma unroll
        for (int ai = 0; ai < 2; ++ai)
#pragma unroll
            for (int m = 0; m < 4; ++m) { const int rit = ai * 128 + wr * 64 + m * 16 + fr; float ss = 0.f;
                const size_t roff = (seg == 0 ? (size_t)(b * TC + rit) * DM : (size_t)(b * SEQ + (seg - 1) * 256 + rit) * DM);
#pragma unroll
                for (int bj = 0; bj < 2; ++bj) { const int col0 = u.pn * 256 + bj * 128 + wc * 32 + 8 * fq;
                    float* p = (seg == 0 ? xc : out) + roff + col0; const float* q = (seg == 0 ? sc : sx) + roff + col0;
                    const pg8::f32x4 g0 = *(const pg8::f32x4*)(gbase + col0), g1 = *(const pg8::f32x4*)(gbase + col0 + 4); pg8::f32x4 x0 = *(const pg8::f32x4*)q, x1 = *(const pg8::f32x4*)(q + 4);
                    x0 += g0 * acc[ai][bj][m][0]; x1 += g1 * acc[ai][bj][m][1]; *(pg8::f32x4*)p = x0; *(pg8::f32x4*)(p + 4) = x1;
                    if (emit) { const pg8::f32x4 p0 = *(const pg8::f32x4*)(gpb + col0), p1 = *(const pg8::f32x4*)(gpb + col0 + 4);
                        ss += x0[0] * x0[0] + x0[1] * x0[1] + x0[2] * x0[2] + x0[3] * x0[3] + x1[0] * x1[0] + x1[1] * x1[1] + x1[2] * x1[2] + x1[3] * x1[3];
                        st8(H + (size_t)(u.pm * 256 + rit) * 1024 + col0, x0 * p0, x1 * p1); }
                    __builtin_amdgcn_sched_barrier(0); }
                if (emit) { ss += __shfl_xor(ss, 16, 64); ss += __shfl_xor(ss, 32, 64); if (fq == 0) atomicAdd(rs + u.pm * 256 + rit, ss); }
            }
    }
};
struct Order { pg8::StaticOrder s; int lat;
    DI void init(int lat_, int N) { lat = lat_; s.init(lat_ ? NB * SEQ : TALL, N, (int)gridDim.x, (int)blockIdx.x); }
    DI bool next(int i, pg8::Unit& u) const { if (!s.next(i, u)) return false; if (lat) u.pm = (u.pm >> 3) * 9 + 1 + (u.pm & 7); return true; }
    DI void a_ready(const pg8::Unit&) const {}
    DI void done(const pg8::Unit&) const {}
};
template <int N, int K, class Fn> DI void run_gemm(unsigned char* lds, const bf16_t* A, const bf16_t* Bt, int lat, const Fn& fn) {
    int Kr = K; if (K == 128) asm volatile("" : "+s"(Kr));
    pg8::Gemm g{A, Bt, lat ? NB * SEQ : TALL, N, Kr}; Order S; S.init(lat, N); Epi8<Fn> E{fn};
    pg8::gemm_phase<Epi8<Fn>, Order, true, true>((PG8_LAS unsigned char*)lds, g, S, E);
    __syncthreads();
}
template <int N, int K, class Epi> DI void run_gemm_epi(unsigned char* lds, const bf16_t* A, const bf16_t* Bt, int lat, const Epi& E) {
    pg8::Gemm g{A, Bt, lat ? NB * SEQ : TALL, N, K}; Order S; S.init(lat, N);
    pg8::gemm_phase<Epi, Order, true, true>((PG8_LAS unsigned char*)lds, g, S, E);
    __syncthreads();
}
namespace att {
constexpr int NW = 8, QBLK = 32, KVBLK = 64;
constexpr float SCALE = 0.10206207261596577f, THR = 8.f;
constexpr int LDQ = 768, LDKK = 768, LDV = 512, LDO = 1024;
constexpr int SHM_V = KVBLK * 64 * 2, SHM_K = KVBLK * 256, SHM_ATTN = 2 * SHM_V + 2 * SHM_K + NW * 64 * 4;
#define KSWZ(row, colB) ((row) * 256 + ((colB) ^ (((row) & 7) << 4)))
#define SBAR() __builtin_amdgcn_sched_barrier(0)
DI int crow(int r, int hi) { return (r & 3) + 8 * (r >> 2) + 4 * hi; }
DI unsigned cvtpk_(float lo, float hi) { unsigned r; asm volatile("v_cvt_pk_bf16_f32 %0, %1, %2" : "=v"(r) : "v"(lo), "v"(hi)); return r; }
DI void partialSM(f32x16& p0, f32x16& p1, float& m_reg, float& mn, float& alpha) {
  constexpr float C = SCALE * 1.4426950408889634f;
  float pmax = p0[0];
#pragma unroll
  for (int r = 1; r < 16; ++r) pmax = fmaxf(pmax, p0[r]);
#pragma unroll
  for (int r = 0; r < 16; ++r) pmax = fmaxf(pmax, p1[r]);
  { auto rr = __builtin_amdgcn_permlane32_swap(__float_as_uint(pmax), __float_as_uint(pmax), false, false);
    pmax = fmaxf(__uint_as_float(rr[0]), __uint_as_float(rr[1])); }
  if (__builtin_expect(__all(pmax - m_reg <= THR / SCALE), 1)) { mn = m_reg; alpha = 1.f; }
  else { mn = fmaxf(m_reg, pmax); alpha = __builtin_amdgcn_exp2f((m_reg - mn) * C); m_reg = mn; }
  const float mnC = -mn * C;
#pragma unroll
  for (int r = 0; r < 16; ++r) p0[r] = fmaf(p0[r], C, mnC);
#pragma unroll
  for (int r = 0; r < 16; ++r) p1[r] = fmaf(p1[r], C, mnC);
#pragma unroll
  for (int r = 0; r < 16; ++r) p0[r] = __builtin_amdgcn_exp2f(p0[r]);
}
DI void finishSM(f32x16& p0, f32x16& p1, float alpha, float& l_reg, bf16x8& pa0, bf16x8& pa1, bf16x8& pa2, bf16x8& pa3) {
#pragma unroll
  for (int r = 0; r < 16; ++r) p1[r] = __builtin_amdgcn_exp2f(p1[r]);
  float ps = 0;
#pragma unroll
  for (int r = 0; r < 16; ++r) ps += p0[r];
#pragma unroll
  for (int r = 0; r < 16; ++r) ps += p1[r];
  { auto rr = __builtin_amdgcn_permlane32_swap(__float_as_uint(ps), __float_as_uint(ps), false, false);
    ps = __uint_as_float(rr[0]) + __uint_as_float(rr[1]); }
  l_reg = l_reg * alpha + ps;
#define PK4(P, BASE, OUT) do { unsigned a0 = cvtpk_(P[BASE + 0], P[BASE + 1]), a1 = cvtpk_(P[BASE + 2], P[BASE + 3]);   \
    unsigned b0 = cvtpk_(P[BASE + 4], P[BASE + 5]), b1 = cvtpk_(P[BASE + 6], P[BASE + 7]);                              \
    auto r0 = __builtin_amdgcn_permlane32_swap(a0, b0, false, false); auto r1 = __builtin_amdgcn_permlane32_swap(a1, b1, false, false); \
    u32x4 w = {r0[0], r1[0], r0[1], r1[1]}; OUT = *reinterpret_cast<bf16x8*>(&w); } while (0)
  PK4(p0, 0, pa0); PK4(p0, 8, pa1); PK4(p1, 0, pa2); PK4(p1, 8, pa3);
#undef PK4
}
DI void qkt(f32x16& p0, f32x16& p1, const char* Ks, const bf16x8* qr, int r32, int hi) {
  p0 = f32x16{}; p1 = f32x16{};
#pragma unroll
  for (int d0 = 0; d0 < 6; ++d0) { const int cb = (d0 * 16 + hi * 8) * 2;
    bf16x8 b0 = *reinterpret_cast<const bf16x8*>(Ks + KSWZ(r32, cb));
    bf16x8 b1 = *reinterpret_cast<const bf16x8*>(Ks + KSWZ(32 + r32, cb));
    p0 = __builtin_amdgcn_mfma_f32_32x32x16_bf16(b0, qr[d0], p0, 0, 0, 0);
    p1 = __builtin_amdgcn_mfma_f32_32x32x16_bf16(b1, qr[d0], p1, 0, 0, 0); }
}
DI int v_st(int k, int c) { const int kk = (k & ~0xC) | ((k & 4) << 1) | ((k & 8) >> 1); return ((kk >> 3) * 2 + (c >> 5)) * 512 + ((kk & 7) * 32 + (c & 31)) * 2; }
DI int v_rd_base(int lane) { return ((lane & 3) << 3) | (((lane >> 2) & 3) << 6) | (((lane >> 4) & 1) << 5) | (((lane >> 5) & 1) << 8); }
constexpr int v_rd_off(int d0, int ks, int half) { return d0 * 512 + ks * 2048 + half * 1024; }
template <int OFF> DI s16x4 tr_read(int vb) {
  s16x4 r; asm volatile("ds_read_b64_tr_b16 %0, %1 offset:%2" : "=&v"(r) : "v"(vb), "i"(OFF) : "memory"); return r;
}
template <int D0> DI void pv_one(f32x16& od, int vb, bf16x8 pa0, bf16x8 pa1, bf16x8 pa2, bf16x8 pa3) {
  const s16x4 l0 = tr_read<v_rd_off(D0, 0, 0)>(vb), h0 = tr_read<v_rd_off(D0, 0, 1)>(vb), l1 = tr_read<v_rd_off(D0, 1, 0)>(vb), h1 = tr_read<v_rd_off(D0, 1, 1)>(vb);
  const s16x4 l2 = tr_read<v_rd_off(D0, 2, 0)>(vb), h2 = tr_read<v_rd_off(D0, 2, 1)>(vb), l3 = tr_read<v_rd_off(D0, 3, 0)>(vb), h3 = tr_read<v_rd_off(D0, 3, 1)>(vb);
  asm volatile("s_waitcnt lgkmcnt(0)" ::: "memory"); SBAR();
#define PK(L, H) (bf16x8){L[0], L[1], L[2], L[3], H[0], H[1], H[2], H[3]}
  od = __builtin_amdgcn_mfma_f32_32x32x16_bf16(pa0, PK(l0, h0), od, 0, 0, 0);
  od = __builtin_amdgcn_mfma_f32_32x32x16_bf16(pa1, PK(l1, h1), od, 0, 0, 0);
  od = __builtin_amdgcn_mfma_f32_32x32x16_bf16(pa2, PK(l2, h2), od, 0, 0, 0);
  od = __builtin_amdgcn_mfma_f32_32x32x16_bf16(pa3, PK(l3, h3), od, 0, 0, 0);
#undef PK
}
DI void pv_d0(f32x16* o, int vb, bf16x8 pa0, bf16x8 pa1, bf16x8 pa2, bf16x8 pa3) {
  pv_one<0>(o[0], vb, pa0, pa1, pa2, pa3); pv_one<1>(o[1], vb, pa0, pa1, pa2, pa3);
}
DI void attn_body(const bf16_t* __restrict__ Qb, const bf16_t* __restrict__ Kh, const bf16_t* __restrict__ Vh, bf16_t* __restrict__ Ob, int seq, char* lds) {
  const int tid = ltid(), wid = tid >> 6, lane = tid & 63, r32 = lane & 31, hi = lane >> 5;
  char* V_lds = lds; char* K_lds = lds + 2 * SHM_V;
  float* ws = (float*)(lds + 2 * SHM_V + 2 * SHM_K) + wid * 64; float* li_l = ws; float* al_l = ws + 32;
  float m_reg = -1e30f, l_reg = 0; f32x16 o[2] = {}; bf16x8 qr[6];
  const bf16_t* Qw = Qb + (long)(wid * QBLK + r32) * LDQ + hi * 8;
#pragma unroll
  for (int d0 = 0; d0 < 6; ++d0) qr[d0] = *reinterpret_cast<const bf16x8*>(Qw + d0 * 16);
  const int kc2 = 512 + (tid & 255);
  const int kr1 = tid / 12, kch1 = tid - kr1 * 12, kr2 = kc2 / 12, kch2 = kc2 - kr2 * 12, vr = tid >> 3, vch = tid & 7;
  const int vst = v_st(vr, vch * 8), kst1 = KSWZ(kr1, kch1 * 16), kst2 = KSWZ(kr2, kch2 * 16);
  const int vb0 = (int)(uintptr_t)V_lds + v_rd_base(lane);
  struct { bf16x8 v, k1, k2; } sr_[2];
#define SLOAD(i, k0) do { sr_[i].v = *reinterpret_cast<const bf16x8*>(&Vh[(long)((k0) + vr) * LDV + vch * 8]); \
    sr_[i].k1 = *reinterpret_cast<const bf16x8*>(&Kh[(long)((k0) + kr1) * LDKK + kch1 * 8]); sr_[i].k2 = *reinterpret_cast<const bf16x8*>(&Kh[(long)((k0) + kr2) * LDKK + kch2 * 8]); } while (0)
#define SWRITE(b, i) do { *(bf16x8*)(V_lds + (b) * SHM_V + vst) = sr_[i].v; *(bf16x8*)(K_lds + (b) * SHM_K + kst1) = sr_[i].k1; *(bf16x8*)(K_lds + (b) * SHM_K + kst2) = sr_[i].k2; } while (0)
#define RESC(a) do { if (__any((a) < 1.f)) { if (hi == 0) al_l[r32] = (a); asm volatile("s_waitcnt lgkmcnt(0)" ::: "memory"); \
    _Pragma("unroll") for (int d = 0; d < 2; ++d) _Pragma("unroll") for (int r = 0; r < 16; ++r) o[d][r] *= al_l[crow(r, hi)]; } } while (0)
  f32x16 pA0, pA1, pB0, pB1; float mnA, mnB, alA, alB; bf16x8 pa0, pa1, pa2, pa3; const int NT = seq / KVBLK;
  constexpr int SE = 0, SO = 1;
  SLOAD(SE, 0); asm volatile("s_waitcnt vmcnt(0)" ::: "memory"); SWRITE(0, SE); __syncthreads();
  qkt(pA0, pA1, K_lds, qr, r32, hi); partialSM(pA0, pA1, m_reg, mnA, alA);
  SLOAD(SO, KVBLK); if (2 < NT) SLOAD(SE, 2 * KVBLK);
  SWRITE(1, SO); __syncthreads();
  for (int j = 1; j + 1 < NT; j += 2) {
    SBAR(); qkt(pB0, pB1, K_lds + SHM_K, qr, r32, hi);
    finishSM(pA0, pA1, alA, l_reg, pa0, pa1, pa2, pa3); SBAR();
    SLOAD(SO, (j + 2) * KVBLK); SBAR();
    pv_d0(o, vb0, pa0, pa1, pa2, pa3); partialSM(pB0, pB1, m_reg, mnB, alB);
    __syncthreads(); SWRITE(0, SE);
    RESC(alB); __syncthreads();
    SBAR(); qkt(pA0, pA1, K_lds, qr, r32, hi);
    finishSM(pB0, pB1, alB, l_reg, pa0, pa1, pa2, pa3); SBAR();
    if (j + 3 < NT) SLOAD(SE, (j + 3) * KVBLK); SBAR();
    pv_d0(o, vb0 + SHM_V, pa0, pa1, pa2, pa3); partialSM(pA0, pA1, m_reg, mnA, alA);
    __syncthreads(); SWRITE(1, SO);
    RESC(alA); __syncthreads();
  }
  SBAR(); qkt(pB0, pB1, K_lds + SHM_K, qr, r32, hi);
  finishSM(pA0, pA1, alA, l_reg, pa0, pa1, pa2, pa3); SBAR();
  pv_d0(o, vb0, pa0, pa1, pa2, pa3); partialSM(pB0, pB1, m_reg, mnB, alB);
  __syncthreads(); RESC(alB);
  finishSM(pB0, pB1, alB, l_reg, pa0, pa1, pa2, pa3); SBAR();
  pv_d0(o, vb0 + SHM_V, pa0, pa1, pa2, pa3);
  if (hi == 0) li_l[r32] = l_reg; asm volatile("s_waitcnt lgkmcnt(0)" ::: "memory");
  float rli[16];
#pragma unroll
  for (int r = 0; r < 16; ++r) rli[r] = __builtin_amdgcn_rcpf(li_l[crow(r, hi)]);
  bf16_t* Ow = Ob + (long)(wid * QBLK) * LDO;
#pragma unroll
  for (int r = 0; r < 16; ++r) { const int orow = crow(r, hi);
#pragma unroll
    for (int d0 = 0; d0 < 2; ++d0) Ow[(long)orow * LDO + d0 * 32 + r32] = f2bf(o[d0][r] * rli[r]); }
#undef SLOAD
#undef SWRITE
#undef RESC
}
}

DI void phase_attn(const bf16_t* Q, const bf16_t* KA, const bf16_t* VA, bf16_t* MIX, bool last, char* lds) {
    const int c = blockIdx.x, G = gridDim.x, NU = 2048 + (last ? 0 : 256);
    for (int L = c; L < NU; L += G) {
        int bh, seq; long qrow0;
        if (L < 2048) { int qb;
            if (G == 256) { const int i = L >> 8, cc = L & 255, xcd = cc & 7, slot = cc >> 3; bh = i * 32 + xcd * 4 + (slot >> 3); qb = slot & 7; }
            else { bh = L >> 3; qb = L & 7; }
            qrow0 = (long)(bh >> 3) * TT + TC + qb * 256; seq = TT; }
        else { bh = L - 2048; qrow0 = (long)(bh >> 3) * TT; seq = TC; }
        const int b = bh >> 3, h = bh & 7;
        att::attn_body(Q + qrow0 * 768 + h * 96, KA + (long)b * TT * 768 + h * 96, VA + (long)b * TT * 512 + h * 64, MIX + qrow0 * 1024 + h * 64, seq, lds);
        __syncthreads();
    }
}

DI float rowsum16(float x) {
    x += __int_as_float(__builtin_amdgcn_update_dpp(0, __float_as_int(x), 0x128, 0xf, 0xf, false));
    x += __int_as_float(__builtin_amdgcn_update_dpp(0, __float_as_int(x), 0x124, 0xf, 0xf, false));
    x += __int_as_float(__builtin_amdgcn_update_dpp(0, __float_as_int(x), 0x122, 0xf, 0xf, false));
    x += __int_as_float(__builtin_amdgcn_update_dpp(0, __float_as_int(x), 0x121, 0xf, 0xf, false));
    return x;
}
#define RS8_STEP(R) "v_add_f32_dpp %0, %0, %0 " R " row_mask:0xf bank_mask:0xf\n\tv_add_f32_dpp %1, %1, %1 " R " row_mask:0xf bank_mask:0xf\n\t" \
                    "v_add_f32_dpp %2, %2, %2 " R " row_mask:0xf bank_mask:0xf\n\tv_add_f32_dpp %3, %3, %3 " R " row_mask:0xf bank_mask:0xf\n\t" \
                    "v_add_f32_dpp %4, %4, %4 " R " row_mask:0xf bank_mask:0xf\n\tv_add_f32_dpp %5, %5, %5 " R " row_mask:0xf bank_mask:0xf\n\t" \
                    "v_add_f32_dpp %6, %6, %6 " R " row_mask:0xf bank_mask:0xf\n\tv_add_f32_dpp %7, %7, %7 " R " row_mask:0xf bank_mask:0xf\n\t"
DI void sum8x8(float& x0, float& x1, float& x2, float& x3, float& x4, float& x5, float& x6, float& x7) {
    asm volatile("s_nop 1\n\t" RS8_STEP("quad_perm:[1,0,3,2]") RS8_STEP("quad_perm:[2,3,0,1]") RS8_STEP("row_half_mirror")
                 : "+v"(x0), "+v"(x1), "+v"(x2), "+v"(x3), "+v"(x4), "+v"(x5), "+v"(x6), "+v"(x7));
}
typedef float f32x2 __attribute__((ext_vector_type(2)));
DI float dot8(const f32x2 (&s)[4], const f32x4& x0, const f32x4& x1) {
    f32x2 t = s[0] * (f32x2){x0[0], x0[1]};
    t = __builtin_elementwise_fma(s[1], (f32x2){x0[2], x0[3]}, t);
    t = __builtin_elementwise_fma(s[2], (f32x2){x1[0], x1[1]}, t);
    t = __builtin_elementwise_fma(s[3], (f32x2){x1[2], x1[3]}, t);
    return t.x + t.y;
}
DI int scan_row(int d, int b, int n) { const int tt = d == 0 ? n : (n < TC ? TC - 1 - n : TT + TC - 1 - n); return b * TT + tt; }
struct ScanStep { f32x4 a0, a1, w0, w1, b0, b1, k0, k1, q0, q1, v; float br, kr; };
DI void scan_ld(ScanStep& t, const float* p, const float* sc, int cgp, int vrow) {
    t.a0 = *(const f32x4*)(p + 8 * cgp); t.a1 = *(const f32x4*)(p + 8 * cgp + 4); t.w0 = *(const f32x4*)(p + 64 + 8 * cgp); t.w1 = *(const f32x4*)(p + 64 + 8 * cgp + 4);
    t.b0 = *(const f32x4*)(p + 128 + 8 * cgp); t.b1 = *(const f32x4*)(p + 128 + 8 * cgp + 4); t.k0 = *(const f32x4*)(p + 192 + 8 * cgp); t.k1 = *(const f32x4*)(p + 192 + 8 * cgp + 4);
    t.q0 = *(const f32x4*)(p + 256 + 8 * cgp); t.q1 = *(const f32x4*)(p + 256 + 8 * cgp + 4); t.v = *(const f32x4*)(p + 320 + vrow); t.br = sc[0]; t.kr = sc[1];
}
DI void phase_scan(const bf16_t* R, const bf16_t* Kk, const bf16_t* V, const __half* DEC, const bf16_t* AA, const float* INV, const float* kkp, const float* kap,
                   bf16_t* MIX, bf16_t* YB, char* lds) {
    const int tid = ltid(); const bool consumer = tid < 256;
    float* bufA = (float*)lds; float* ybufA = (float*)(lds + 98304); float* sbufA = (float*)(lds + 114688);
    constexpr int NCH = TT / 16;
    for (int s0 = blockIdx.x * 2; s0 < 512; s0 += gridDim.x * 2) {
        const int p_ = tid & 255, pst = p_ >> 4, pj0 = (p_ & 15) * 4;
        const int cw = tid >> 6, cgrp = (cw >> 1) & 1, ws_ = cw & 1, lane = tid & 63, rgl = lane >> 3, cgp = lane & 7, vrow = ws_ * 32 + rgl * 4;
        f32x2 S[4][4];
#pragma unroll
        for (int i = 0; i < 4; ++i)
#pragma unroll
            for (int j = 0; j < 4; ++j) S[i][j] = (f32x2){0.f, 0.f};
#define PRODUCE(c, bsel) do { _Pragma("unroll") for (int gq = 0; gq < 2; ++gq) { \
            const int sid = s0 + gq, d = sid >> 8, b = (sid >> 3) & 31, h = sid & 7, hc = h * 64 + pj0; \
            const size_t m_ = (size_t)scan_row(d, b, (c) * 16 + pst); \
            const u32x2 lr = *(const u32x2*)(R + m_ * 512 + hc), lk = *(const u32x2*)(Kk + m_ * 512 + hc), lv = *(const u32x2*)(V + m_ * 512 + hc), \
                        ld_ = *(const u32x2*)(DEC + m_ * 1024 + d * 512 + hc), la = *(const u32x2*)(AA + m_ * 1024 + d * 512 + hc); const float linv = INV[m_ * 8 + h]; \
            const f32x4 kk4 = *(const f32x4*)(kkp + hc), ka4 = *(const f32x4*)(kap + hc); \
            float* q_ = bufA + gq * 12288 + (bsel) * 6144 + pst * 384 + pj0; float* sd_ = sbufA + gq * 64 + (bsel) * 32; \
            const float k0 = bflo(lk.x), k1 = bfhi(lk.x), k2 = bflo(lk.y), k3 = bfhi(lk.y), a0 = bflo(la.x), a1 = bfhi(la.x), a2 = bflo(la.y), a3 = bfhi(la.y); \
            const float q0 = k0 * kk4[0] * linv, q1 = k1 * kk4[1] * linv, q2 = k2 * kk4[2] * linv, q3 = k3 * kk4[3] * linv; \
            const float w0 = __builtin_amdgcn_exp2f(h2f(ld_.x & 0xffffu)), w1 = __builtin_amdgcn_exp2f(h2f(ld_.x >> 16)), w2 = __builtin_amdgcn_exp2f(h2f(ld_.y & 0xffffu)), w3 = __builtin_amdgcn_exp2f(h2f(ld_.y >> 16)); \
            const float r0 = bflo(lr.x), r1 = bfhi(lr.x), r2 = bflo(lr.y), r3 = bfhi(lr.y); \
            const float b0 = q0 * a0, b1 = q1 * a1, b2 = q2 * a2, b3 = q3 * a3; \
            const float d0 = k0 * (1.f + (a0 - 1.f) * ka4[0]), d1 = k1 * (1.f + (a1 - 1.f) * ka4[1]), d2 = k2 * (1.f + (a2 - 1.f) * ka4[2]), d3 = k3 * (1.f + (a3 - 1.f) * ka4[3]); \
            *(f32x4*)(q_) = (f32x4){-q0, -q1, -q2, -q3}; \
            *(f32x4*)(q_ + 64) = (f32x4){w0, w1, w2, w3}; \
            *(f32x4*)(q_ + 128) = (f32x4){b0, b1, b2, b3}; \
            *(f32x4*)(q_ + 192) = (f32x4){d0, d1, d2, d3}; \
            *(f32x4*)(q_ + 256) = (f32x4){w0 * r0, w1 * r1, w2 * r2, w3 * r3}; \
            *(f32x4*)(q_ + 320) = (f32x4){bflo(lv.x), bfhi(lv.x), bflo(lv.y), bfhi(lv.y)}; \
            const float br_ = rowsum16(b0 * r0 + b1 * r1 + b2 * r2 + b3 * r3), kr_ = rowsum16(d0 * r0 + d1 * r1 + d2 * r2 + d3 * r3); \
            if ((p_ & 15) == 0) { sd_[pst * 2] = br_; sd_[pst * 2 + 1] = kr_; } } } while (0)
#define OUTPUT(c, bsel) do { _Pragma("unroll") for (int gq = 0; gq < 2; ++gq) { \
            const int sid = s0 + gq, d = sid >> 8, b = (sid >> 3) & 31, h = sid & 7, hc = h * 64 + pj0; \
            const f32x4 yv = *(const f32x4*)(ybufA + gq * 2048 + (bsel) * 1024 + pst * 64 + pj0); const size_t m_ = (size_t)scan_row(d, b, (c) * 16 + pst); \
            u32x2 w; w.x = cvtpk(yv[0], yv[1]); w.y = cvtpk(yv[2], yv[3]); \
            if (d == 0) *(u32x2*)(MIX + m_ * 1024 + 512 + hc) = w; else *(u32x2*)(YB + m_ * 512 + hc) = w; } } while (0)
        if (!consumer) PRODUCE(0, 0);
        __syncthreads();
        if (consumer) __builtin_amdgcn_s_setprio(3);
        for (int c = 0; c < NCH; ++c) {
            if (consumer) {
                const float* cur = bufA + cgrp * 12288 + (c & 1) * 6144; float* yb = ybufA + cgrp * 2048 + (c & 1) * 1024; const float* sc = sbufA + cgrp * 64 + (c & 1) * 32;
                ScanStep t; scan_ld(t, cur, sc, cgp, vrow);
#pragma unroll 2
                for (int st = 0; st < 16; ++st) {
                    ScanStep n; scan_ld(n, cur + (st + 1) * 384, sc + (st + 1) * 2, cgp, vrow);
                    float sa0 = dot8(S[0], t.a0, t.a1), sa1 = dot8(S[1], t.a0, t.a1), sa2 = dot8(S[2], t.a0, t.a1), sa3 = dot8(S[3], t.a0, t.a1);
                    float z0 = dot8(S[0], t.q0, t.q1), z1 = dot8(S[1], t.q0, t.q1), z2 = dot8(S[2], t.q0, t.q1), z3 = dot8(S[3], t.q0, t.q1);
                    sum8x8(sa0, sa1, sa2, sa3, z0, z1, z2, z3);
                    const f32x2 w01 = {t.w0[0], t.w0[1]}, w23 = {t.w0[2], t.w0[3]}, w45 = {t.w1[0], t.w1[1]}, w67 = {t.w1[2], t.w1[3]};
                    const f32x2 b01 = {t.b0[0], t.b0[1]}, b23 = {t.b0[2], t.b0[3]}, b45 = {t.b1[0], t.b1[1]}, b67 = {t.b1[2], t.b1[3]};
                    const f32x2 k01 = {t.k0[0], t.k0[1]}, k23 = {t.k0[2], t.k0[3]}, k45 = {t.k1[0], t.k1[1]}, k67 = {t.k1[2], t.k1[3]};
                    const float sa[4] = {sa0, sa1, sa2, sa3};
                    const f32x2 wv[4] = {w01, w23, w45, w67}, bv[4] = {b01, b23, b45, b67}, kv[4] = {k01, k23, k45, k67};
#pragma unroll
                    for (int i = 0; i < 4; ++i)
#pragma unroll
                        for (int j = 0; j < 4; ++j) S[i][j] = S[i][j] * wv[j];
#pragma unroll
                    for (int i = 0; i < 4; ++i) { const f32x2 s2 = {sa[i], sa[i]};
#pragma unroll
                        for (int j = 0; j < 4; ++j) S[i][j] = __builtin_elementwise_fma(s2, bv[j], S[i][j]); }
#pragma unroll
                    for (int i = 0; i < 4; ++i) { const f32x2 v2 = {t.v[i], t.v[i]};
#pragma unroll
                        for (int j = 0; j < 4; ++j) S[i][j] = __builtin_elementwise_fma(v2, kv[j], S[i][j]); }
                    if (cgp == 0) *(f32x4*)(yb + st * 64 + vrow) = (f32x4){z0 + sa0 * t.br + t.v[0] * t.kr, z1 + sa1 * t.br + t.v[1] * t.kr, z2 + sa2 * t.br + t.v[2] * t.kr, z3 + sa3 * t.br + t.v[3] * t.kr};
                    t = n;
                }
            } else {
                if (c + 1 < NCH) PRODUCE(c + 1, (c + 1) & 1);
                if (c > 0) OUTPUT(c - 1, (c - 1) & 1);
            }
            __syncthreads();
        }
        __builtin_amdgcn_s_setprio(0);
        if (!consumer) OUTPUT(NCH - 1, (NCH - 1) & 1);
        __syncthreads();
#undef PRODUCE
#undef OUTPUT
    }
}

DI void phase_prologue(const Args& a, unsigned char* lds) {
    const int tid = ltid(), G = gridDim.x;
    float* out = a.out; float* xc = (float*)(a.ws + WS_XC);
    if (blockIdx.x == 0) {
        float* rope = (float*)(a.ws + WS_ROPE); const int pos = tid >> 3, j = tid & 7;
        const float inv_freq = powf(10000.f, -(float)j / 8.f), ang = (float)pos * inv_freq;
        rope[tid] = cosf(ang); rope[512 + tid] = sinf(ang);
    }
    float* sv = (float*)lds; float* red = sv + 33 * 1024;
    for (int i = tid; i < 33 * 1024; i += 512) { const float v = i < 32 * 1024 ? a.in[I_C][i] : a.in[I_CCTX][i - 32 * 1024]; sv[i] = v / (1.f + __expf(-v)); }
    __syncthreads();
    const int wave = tid >> 6, lane = tid & 63;
    float* mods = (float*)(a.ws + WS_MODS);
    for (int it = blockIdx.x; it < NL * 96; it += G) {
        const int l = it / 96, n0 = (it - l * 96) * 64;
        const float* w = a.in[I_ADAW] + (size_t)l * 1024 * 6144 + n0 + lane;
        float acc[33];
#pragma unroll
        for (int r = 0; r < 33; ++r) acc[r] = 0.f;
        for (int k = wave * 128; k < wave * 128 + 128; k += 8) { float wv[8];
#pragma unroll
            for (int u = 0; u < 8; ++u) wv[u] = w[(size_t)(k + u) * 6144];
#pragma unroll
            for (int u = 0; u < 8; ++u)
#pragma unroll
                for (int r = 0; r < 33; ++r) acc[r] += sv[r * 1024 + k + u] * wv[u]; }
        for (int i = tid; i < 33 * 64; i += 512) red[i] = 0.f;
        __syncthreads();
        for (int ww = 0; ww < 8; ++ww) { if (wave == ww) {
#pragma unroll
                for (int r = 0; r < 33; ++r) red[r * 64 + lane] += acc[r]; }
            __syncthreads(); }
        for (int i = tid; i < 33 * 64; i += 512) { const int r = i >> 6, n = n0 + (i & 63); mods[((size_t)l * 33 + r) * 6144 + n] = red[i] + a.in[I_ADAB][l * 6144 + n]; }
        __syncthreads();
    }
}

DI void phase_vectors(const Args& a, unsigned char* lds) {
    const int tid = ltid(), G = gridDim.x, wave = tid >> 6, lane = tid & 63;
    const float* mods = (const float*)(a.ws + WS_MODS);
    float* gp1 = (float*)(a.ws + WS_GP1); float* gp2 = (float*)(a.ws + WS_GP2);
    for (int i = blockIdx.x * 512 + tid; i < NL * 33 * 1024; i += G * 512) { const int c = i & 1023, lr = i >> 10, l = lr / 33;
        gp1[i] = a.in[I_N1G][l * 1024 + c] * (1.f + mods[(size_t)lr * 6144 + 1024 + c]); gp2[i] = a.in[I_N2G][l * 1024 + c] * (1.f + mods[(size_t)lr * 6144 + 4 * 1024 + c]); }
    float* sv = (float*)lds; float* red = sv + 33 * 1024;
    for (int it = blockIdx.x; it < NL * 101; it += G) {
        const int l = it / 101, ci = it - l * 101, which = ci < 37 ? 0 : 1, n0 = (which ? ci - 37 : ci) * 64, n = n0 + lane;
        __syncthreads();
        for (int i = tid; i < 33 * 1024; i += 512) sv[i] = mods[((size_t)l * 33 + (i >> 10)) * 6144 + (which ? 3 * 1024 : 0) + (i & 1023)];
        for (int i = tid; i < 33 * 64; i += 512) red[i] = 0.f;
        __syncthreads();
        const float* w; int ld; float live = 1.f;
        if (which) { w = a.in[I_M1] + (size_t)l * 1024 * 4096 + n; ld = 4096; }
        else if (n < CIN) { w = a.in[I_WIN] + (size_t)l * 1024 * CIN + n; ld = CIN; }
        else if (n < CINX && l > 0) { w = a.in[I_V1] + (size_t)(l - 1) * 1024 * 32 + (n - CIN); ld = 32; }
        else { w = a.in[I_WIN]; ld = 0; live = 0.f; }
        float acc[33];
#pragma unroll
        for (int r = 0; r < 33; ++r) acc[r] = 0.f;
        for (int k = wave * 128; k < wave * 128 + 128; k += 8) { float wv[8];
#pragma unroll
            for (int u = 0; u < 8; ++u) wv[u] = w[(size_t)(k + u) * ld] * live;
#pragma unroll
            for (int u = 0; u < 8; ++u)
#pragma unroll
                for (int r = 0; r < 33; ++r) acc[r] += sv[r * 1024 + k + u] * wv[u]; }
        for (int ww = 0; ww < 8; ++ww) { if (wave == ww) {
#pragma unroll
                for (int r = 0; r < 33; ++r) red[r * 64 + lane] += acc[r]; }
            __syncthreads(); }
        float* outp = which ? (float*)(a.ws + WS_C2) + (size_t)l * 33 * DFF : (float*)(a.ws + WS_C1) + (size_t)l * 33 * NIN; const int ldo = which ? DFF : NIN;
        for (int i = tid; i < 33 * 64; i += 512) outp[(size_t)(i >> 6) * ldo + n0 + (i & 63)] = red[i];
    }
    {
        const int gw = blockIdx.x * 8 + wave, nw = G * 8; bf16_t* __restrict__ H = (bf16_t*)(a.ws + WS_H); float* __restrict__ rsa = (float*)(a.ws + WS_RSA); const float* __restrict__ gamma = a.in[I_N1G];
        for (int m = gw; m < TALL; m += nw) { const int b = m / TT, tt = m - b * TT; const bool ctx = tt < TC;
            const float* xr = ctx ? a.in[I_CTX] + (size_t)(b * TC + tt) * DM : a.in[I_X] + (size_t)(b * SEQ + tt - TC) * DM; const float* md = mods + (size_t)(ctx ? 32 : b) * 6144 + 1024;
            f32x4 v[4]; float ss = 0.f;
#pragma unroll
            for (int q = 0; q < 4; ++q) { v[q] = *(const f32x4*)(xr + q * 256 + lane * 4); ss += v[q][0] * v[q][0] + v[q][1] * v[q][1] + v[q][2] * v[q][2] + v[q][3] * v[q][3]; }
#pragma unroll
            for (int k = 1; k < 64; k <<= 1) ss = xorsum(ss, k);
            if (lane == 0) rsa[m] = ss;
#pragma unroll
            for (int q = 0; q < 4; ++q) { const int col = q * 256 + lane * 4; const f32x4 g = *(const f32x4*)(gamma + col), sc = *(const f32x4*)(md + col);
                u32x2 w; w.x = cvtpk(v[q][0] * g[0] * (1.f + sc[0]), v[q][1] * g[1] * (1.f + sc[1])); w.y = cvtpk(v[q][2] * g[2] * (1.f + sc[2]), v[q][3] * g[3] * (1.f + sc[3]));
                *(u32x2*)(H + (size_t)m * 1024 + col) = w; } }
    }
}

template <class Gt> DI void cvt_tile(bf16_t* __restrict__ dst, int ldk, int n0, int k0, const Gt& get, float*) {
    const int lane = ltid() & 63, n = n0 + lane;
#pragma unroll
    for (int ch = 0; ch < 4; ++ch) { float v[16];
#pragma unroll
        for (int kk = 0; kk < 16; ++kk) v[kk] = get(n, k0 + ch * 16 + kk);
        u32x4 w0, w1; w0.x = cvtpk(v[0], v[1]); w0.y = cvtpk(v[2], v[3]); w0.z = cvtpk(v[4], v[5]); w0.w = cvtpk(v[6], v[7]);
        w1.x = cvtpk(v[8], v[9]); w1.y = cvtpk(v[10], v[11]); w1.z = cvtpk(v[12], v[13]); w1.w = cvtpk(v[14], v[15]);
        bf16_t* p = dst + (size_t)n * ldk + k0 + ch * 16; *(u32x4*)p = w0; *(u32x4*)(p + 8) = w1; }
}
DI void convert_weights(const Args& a, int l, unsigned char* lds, int group) {
    float* tl = (float*)lds; unsigned char* ws = a.ws;
    const float* w_in = a.in[I_WIN] + (size_t)l * 1024 * CIN; const float* v1 = a.in[I_V1] + (size_t)(l > 0 ? l - 1 : 0) * 1024 * 32;
    const float* w_uq = a.in[I_WUQ] + (size_t)l * 256 * 768; const float* w_ukv = a.in[I_WUKV] + (size_t)l * 128 * 1024;
    const float* w2 = a.in[I_W2] + (size_t)l * 2 * 64 * 512; const float* a2 = a.in[I_A2] + (size_t)l * 2 * 64 * 512;
    const float* g2 = a.in[I_G2] + (size_t)l * 128 * 512; const float* v2 = a.in[I_V2] + (size_t)(l > 0 ? l - 1 : 0) * 32 * 512;
    const float* w_out = a.in[I_WOUT] + (size_t)l * 1024 * 1024; const float* m1 = a.in[I_M1] + (size_t)l * 1024 * 4096; const float* m2 = a.in[I_M2] + (size_t)l * 4096 * 1024;
    constexpr int T0 = 640, T1 = T0 + 48, T2 = T1 + 64, T3 = T2 + 128, T4 = T3 + 64, T5 = T4 + 256, T6 = T5 + 1024, T7 = T6 + 1024;
    const int tb = group == 0 ? 0 : T4, te = group == 0 ? T4 : T7;
    for (int t = tb + blockIdx.x * 8 + (ltid() >> 6); t < te; t += gridDim.x * 8) {
        if (t < T0) { const int nt = t >> 4, kt = t & 15;
            cvt_tile((bf16_t*)(ws + WT_IN), 1024, nt * 64, kt * 64, [&](int n, int k) -> float { return n < CIN ? w_in[(size_t)k * CIN + n] : ((n < CINX && l > 0) ? v1[k * 32 + (n - CIN)] : 0.f); }, tl); }
        else if (t < T1) { const int u = t - T0, nt = u >> 2, kt = u & 3;
            cvt_tile((bf16_t*)(ws + WT_UQ), 256, nt * 64, kt * 64, [&](int n, int k) -> float { return w_uq[k * 768 + n]; }, tl); }
        else if (t < T2) { const int u = t - T1, nt = u >> 2, kt = u & 3;
            if (kt < 2) cvt_tile((bf16_t*)(ws + WT_UKV), 128, nt * 64, kt * 64, [&](int n, int k) -> float { return w_ukv[k * 1024 + n]; }, tl); }
        else if (t < T3) { const int u = t - T2, nt = u >> 2, kt = u & 3;
            cvt_tile((bf16_t*)(ws + WT_L1), 256, nt * 64, kt * 64, [&](int n, int k) -> float {
                if (n < 1024) { const int d = n >> 9, c = n & 511; return (k < 128 && (k >> 6) == d) ? w2[(d * 64 + (k & 63)) * 512 + c] : 0.f; }
                const int n2 = n - 1024, d = n2 >> 9, c = n2 & 511; return (k >= 128 && ((k - 128) >> 6) == d) ? a2[(d * 64 + ((k - 128) & 63)) * 512 + c] : 0.f; }, tl); }
        else if (t < T4) { const int u = t - T3, nt = u >> 2, kt = u & 3;
            cvt_tile((bf16_t*)(ws + WT_L2), 256, nt * 64, kt * 64, [&](int n, int k) -> float {
                if (n < 512) return k < 128 ? g2[k * 512 + n] : 0.f;
                return (l > 0 && k >= 128 && k < 160) ? v2[(k - 128) * 512 + (n - 512)] : 0.f; }, tl); }
        else if (t < T5) { const int u = t - T4, nt = u >> 4, kt = u & 15;
            cvt_tile((bf16_t*)(ws + WT_OUT), 1024, nt * 64, kt * 64, [&](int n, int k) -> float { return w_out[(size_t)k * 1024 + n]; }, tl); }
        else if (t < T6) { const int u = t - T5, nt = u >> 4, kt = u & 15;
            cvt_tile((bf16_t*)(ws + WT_M1), 1024, nt * 64, kt * 64, [&](int n, int k) -> float { return m1[(size_t)k * 4096 + n]; }, tl); }
        else { const int u = t - T6, nt = u >> 6, kt = u & 63;
            cvt_tile((bf16_t*)(ws + WT_M2), 4096, nt * 64, kt * 64, [&](int n, int k) -> float { return m2[(size_t)k * 1024 + n]; }, tl); }
    }
}

DI void phase_norm(const Args& a, int l, const float* __restrict__ gamma, int shift_idx, int scale_idx, bool latent_only, bool from_input) {
    const int lane = ltid() & 63, gw = blockIdx.x * 8 + (ltid() >> 6), nw = gridDim.x * 8;
    float* xc = from_input ? (float*)a.in[I_CTX] : (float*)(a.ws + WS_XC); float* xo = from_input ? (float*)a.in[I_X] : a.out;
    bf16_t* __restrict__ H = (bf16_t*)(a.ws + WS_H); const float* __restrict__ mods = (const float*)(a.ws + WS_MODS) + (size_t)l * 33 * 6144;
    const int nrows = latent_only ? NB * SEQ : TALL;
    auto rowof = [&](int i) -> int { return latent_only ? (i >> 11) * TT + TC + (i & 2047) : i; };
    f32x4 v[4], nv[4];
    int i = gw;
    if (i < nrows) { const float* xr = xrow(xo, xc, rowof(i));
#pragma unroll
        for (int q = 0; q < 4; ++q) v[q] = *(const f32x4*)(xr + q * 256 + lane * 4); }
    for (; i < nrows; i += nw) {
        const int m = rowof(i), b = m / TT, tt = m - b * TT; const bool ctx = tt < TC;
        const bool hn = i + nw < nrows;
        if (hn) { const float* xn = xrow(xo, xc, rowof(i + nw));
#pragma unroll
            for (int q = 0; q < 4; ++q) nv[q] = *(const f32x4*)(xn + q * 256 + lane * 4); }
        const float* md = mods + (size_t)(ctx ? 32 : b) * 6144;
        float ss = 0.f;
#pragma unroll
        for (int q = 0; q < 4; ++q) ss += v[q][0] * v[q][0] + v[q][1] * v[q][1] + v[q][2] * v[q][2] + v[q][3] * v[q][3];
#pragma unroll
        for (int k = 1; k < 64; k <<= 1) ss = xorsum(ss, k);
        const float rstd = rsqrtf(ss * (1.f / 1024.f) + 1e-6f);
#pragma unroll
        for (int q = 0; q < 4; ++q) { const int col = q * 256 + lane * 4; const f32x4 g = *(const f32x4*)(gamma + col), sc = *(const f32x4*)(md + scale_idx * 1024 + col), sh = *(const f32x4*)(md + shift_idx * 1024 + col);
            float o[4];
#pragma unroll
            for (int j = 0; j < 4; ++j) o[j] = v[q][j] * rstd * g[j] * (1.f + sc[j]) + sh[j];
            u32x2 w; w.x = cvtpk(o[0], o[1]); w.y = cvtpk(o[2], o[3]); *(u32x2*)(H + (size_t)m * 1024 + col) = w; }
#pragma unroll
        for (int q = 0; q < 4; ++q) v[q] = nv[q];
    }
}

DI void unpack8(const u32x4& w, float (&f)[8]) { f[0] = bflo(w.x); f[1] = bfhi(w.x); f[2] = bflo(w.y); f[3] = bfhi(w.y); f[4] = bflo(w.z); f[5] = bfhi(w.z); f[6] = bflo(w.w); f[7] = bfhi(w.w); }
DI void shift8r(const u32x4& c_, const u32x4& p_, const u32x4& n_, const float* __restrict__ mu, int col, float (&o)[8]) {
    float c[8], p[8], n[8], u[8]; unpack8(c_, c); unpack8(p_, p); unpack8(n_, n); loadf8(mu + (col - OFF_R), u);
#pragma unroll
    for (int j = 0; j < 8; ++j) o[j] = c[j] + u[j] * (0.5f * (p[j] + n[j]) - c[j]);
}
DI void phase_split(const Args& a, int l) {
    const int lane = ltid() & 63, gw = blockIdx.x * 8 + (ltid() >> 6), nw = gridDim.x * 8;
    unsigned char* ws = a.ws;
    const bf16_t* __restrict__ F = (const bf16_t*)(ws + WS_F); bf16_t* __restrict__ R = (bf16_t*)(ws + WS_R); bf16_t* __restrict__ Kb = (bf16_t*)(ws + WS_K); bf16_t* __restrict__ Vb = (bf16_t*)(ws + (l == 0 ? WS_VF : WS_V));
    bf16_t* __restrict__ A1 = (bf16_t*)(ws + WS_A1); bf16_t* __restrict__ A2 = (bf16_t*)(ws + WS_A2); bf16_t* __restrict__ CQN = (bf16_t*)(ws + WS_CQN); bf16_t* __restrict__ CKVN = (bf16_t*)(ws + WS_CKVN); bf16_t* __restrict__ KA = (bf16_t*)(ws + WS_KATT);
    float* __restrict__ INV = (float*)(ws + WS_INV); const float* __restrict__ rope = (const float*)(ws + WS_ROPE);
    const float* __restrict__ mu = a.in[I_MU] + (size_t)l * 1920; const float* __restrict__ kkp = a.in[I_KK] + l * 512; const float* __restrict__ qg = a.in[I_QNG] + l * 256; const float* __restrict__ kvg = a.in[I_KVNG] + l * 128;
    const u32x4 zero4 = {0u, 0u, 0u, 0u};
    const int lcol = lane < 48 ? OFF_WLO + lane * 8 : (lane < 52 ? OFF_HV + (lane - 48) * 8 : 0);
    const int mcol = lane < 32 ? lane * 8 : (lane < 48 ? 256 + (lane - 32) * 8 : 384 + ((lane - 48) & 3) * 8);
    const int chunk = (TALL + nw - 1) / nw, m0 = gw * chunk, m1 = (m0 + chunk < TALL) ? m0 + chunk : TALL;
    struct Raw { u32x4 r, k, v, l; };
    auto ld4 = [&](int m) -> Raw { Raw t; if (m >= 0 && m < TALL) { const bf16_t* Fq = F + (size_t)m * CINX; t.r = *(const u32x4*)(Fq + OFF_R + lane * 8); t.k = *(const u32x4*)(Fq + OFF_K + lane * 8);
            t.v = *(const u32x4*)(Fq + OFF_V + lane * 8); t.l = (lane < 52) ? *(const u32x4*)(Fq + lcol) : zero4; } else { t.r = zero4; t.k = zero4; t.v = zero4; t.l = zero4; } return t; };
    auto ldm = [&](int m) -> u32x4 { return (m < TALL) ? *(const u32x4*)(F + (size_t)m * CINX + mcol) : zero4; };
    Raw P = ld4(m0 - 1), C = ld4(m0), N = ld4(m0 + 1); u32x4 M = ldm(m0);
    for (int m = m0; m < m1; ++m) {
        const int b = m / TT, tt = m - b * TT; const bool ctx = tt < TC;
        const bool pok = !(tt == 0 || tt == TC), nok = !(tt == TC - 1 || tt == TT - 1);
        const Raw NN = ld4(m + 2); const u32x4 MN = ldm(m + 1);
        u32x4 rc = C.r, kc = C.k, vc = C.v, lc = C.l, rp = P.r, kp = P.k, vp = P.v, lp = P.l, rn = N.r, kn = N.k, vn = N.v, ln = N.l; const u32x4 mc = M;
        if (!pok) { rp = zero4; kp = zero4; vp = zero4; lp = zero4; }
        if (!nok) { rn = zero4; kn = zero4; vn = zero4; ln = zero4; }
        P = C; C = N; N = NN; M = MN;
        float x[8];
        shift8r(rc, rp, rn, mu, OFF_R + lane * 8, x); store8(R + (size_t)m * 512 + lane * 8, x);
        shift8r(kc, kp, kn, mu, OFF_K + lane * 8, x); store8(Kb + (size_t)m * 512 + lane * 8, x);
        { float kq[8], ss = 0.f; loadf8(kkp + lane * 8, kq);
#pragma unroll
          for (int j = 0; j < 8; ++j) { const float t = x[j] * kq[j]; ss += t * t; }
          ss = xorsum(ss, 1); ss = xorsum(ss, 2); ss = xorsum(ss, 4);
          if ((lane & 7) == 0) INV[(size_t)m * 8 + (lane >> 3)] = rsqrtf(fmaxf(ss, 1e-24f)); }
        shift8r(vc, vp, vn, mu, OFF_V + lane * 8, x); store8(Vb + (size_t)m * 512 + lane * 8, x);
        if (lane < 48) { shift8r(lc, lp, ln, mu, lcol, x);
            if (lane < 16) {
#pragma unroll
                for (int j = 0; j < 8; ++j) x[j] = tanhf_(x[j]); }
            else if (lane >= 32) {
#pragma unroll
                for (int j = 0; j < 8; ++j) x[j] = sigmoidf_(x[j]); }
            if (lane < 32) store8(A1 + (size_t)m * 256 + lane * 8, x); else store8(A2 + (size_t)m * 256 + (lane - 32) * 8, x); }
        else { unpack8(lc, x); store8(A2 + (size_t)m * 256 + 128 + (lane - 48) * 8, x); }
        { unpack8(mc, x); float ss = 0.f;
#pragma unroll
          for (int j = 0; j < 8; ++j) ss += x[j] * x[j];
          ss = xorsum(ss, 1); ss = xorsum(ss, 2); ss = xorsum(ss, 4); ss = xorsum(ss, 8); const float ss32 = xorsum(ss, 16);
          float px[8]; const int q = (lane - 48) & 3;
#pragma unroll
          for (int j = 0; j < 8; ++j) px[j] = __shfl_xor(x[j], 1, 64);
          if (lane < 32) { const float rstd = rsqrtf(ss32 * (1.f / 256.f) + 1e-6f); float g[8]; loadf8(qg + lane * 8, g);
#pragma unroll
              for (int j = 0; j < 8; ++j) x[j] = x[j] * rstd * g[j];
              store8(CQN + (size_t)m * 256 + lane * 8, x); }
          else if (lane < 48) { const float rstd = rsqrtf(ss * (1.f / 128.f) + 1e-6f); float g[8]; loadf8(kvg + (lane - 32) * 8, g);
#pragma unroll
              for (int j = 0; j < 8; ++j) x[j] = x[j] * rstd * g[j];
              store8(CKVN + (size_t)m * 128 + (lane - 32) * 8, x); }
          else { if (lane < 52) {
                  if (!ctx) { const int s = tt - TC, pos = (q < 2) ? (s >> 6) : (s & 63); float cs[8], sn[8]; loadf8(rope + pos * 8, cs); loadf8(rope + 512 + pos * 8, sn); const float sg = (q & 1) ? 1.f : -1.f;
#pragma unroll
                      for (int j = 0; j < 8; ++j) x[j] = x[j] * cs[j] + sg * px[j] * sn[j]; }
#pragma unroll
                  for (int hh = 0; hh < 8; ++hh) store8(KA + (size_t)m * 768 + hh * 96 + 64 + q * 8, x); }
          } }
    }
}

DI void phase_rwkv_out(const Args& a, int l, bool latent_only) {
    const int lane = ltid() & 63, gw = blockIdx.x * 8 + (ltid() >> 6), nw = gridDim.x * 8;
    unsigned char* ws = a.ws;
    const bf16_t* R = (const bf16_t*)(ws + WS_R); const bf16_t* Kb = (const bf16_t*)(ws + WS_K); const bf16_t* Vb = (const bf16_t*)(ws + (l == 0 ? WS_VF : WS_V));
    const bf16_t* AA = (const bf16_t*)(ws + WS_AA); const bf16_t* Gb = (const bf16_t*)(ws + WS_G); const bf16_t* YB = (const bf16_t*)(ws + WS_YB); bf16_t* MIX = (bf16_t*)(ws + WS_MIX);
    const int c = lane * 8; float ka[8], rk[8], lw[8], lb[8];
    loadf8(a.in[I_KA] + l * 512 + c, ka); loadf8(a.in[I_RK] + l * 512 + c, rk); loadf8(a.in[I_LNW] + l * 512 + c, lw); loadf8(a.in[I_LNB] + l * 512 + c, lb);
    for (int m = gw; m < TALL; m += nw) {
        const int tt = m % TT; if (latent_only && tt < TC) continue;
        float yf[8], yb[8], r[8], k[8], v[8], a0[8], a1[8], g[8];
        load8(MIX + (size_t)m * 1024 + 512 + c, yf); load8(YB + (size_t)m * 512 + c, yb); load8(R + (size_t)m * 512 + c, r); load8(Kb + (size_t)m * 512 + c, k); load8(Vb + (size_t)m * 512 + c, v);
        load8(AA + (size_t)m * 1024 + c, a0); load8(AA + (size_t)m * 1024 + 512 + c, a1); load8(Gb + (size_t)m * 512 + c, g);
        float s = 0.f, bon = 0.f;
#pragma unroll
        for (int j = 0; j < 8; ++j) { yf[j] += yb[j]; s += yf[j]; bon += r[j] * k[j] * (2.f + (a0[j] + a1[j] - 2.f) * ka[j]) * rk[j]; }
        s = xorsum(s, 1); s = xorsum(s, 2); s = xorsum(s, 4); bon = xorsum(bon, 1); bon = xorsum(bon, 2); bon = xorsum(bon, 4);
        const float mean = s * (1.f / 64.f); float vs = 0.f;
#pragma unroll
        for (int j = 0; j < 8; ++j) { yf[j] -= mean; vs += yf[j] * yf[j]; }
        vs = xorsum(vs, 1); vs = xorsum(vs, 2); vs = xorsum(vs, 4);
        const float rstd = rsqrtf(vs * (1.f / 64.f) + 64e-5f);
#pragma unroll
        for (int j = 0; j < 8; ++j) yf[j] = (yf[j] * rstd * lw[j] + lb[j] + bon * v[j]) * g[j];
        store8(MIX + (size_t)m * 1024 + 512 + c, yf);
    }
}

DI void phase_final(const Args& a) {
    const int lane = ltid() & 63, gw = blockIdx.x * 8 + (ltid() >> 6), nw = gridDim.x * 8; const float* gamma = a.in[I_FG];
    for (int m = gw; m < NB * SEQ; m += nw) {
        float* xr = a.out + (size_t)m * DM; f32x4 v[4]; float ss = 0.f;
#pragma unroll
        for (int i = 0; i < 4; ++i) { v[i] = *(const f32x4*)(xr + i * 256 + lane * 4); ss += v[i][0] * v[i][0] + v[i][1] * v[i][1] + v[i][2] * v[i][2] + v[i][3] * v[i][3]; }
#pragma unroll
        for (int k = 1; k < 64; k <<= 1) ss = xorsum(ss, k);
        const float rstd = rsqrtf(ss * (1.f / 1024.f) + 1e-6f);
#pragma unroll
        for (int i = 0; i < 4; ++i) { const int col = i * 256 + lane * 4; const f32x4 g = *(const f32x4*)(gamma + col); *(f32x4*)(xr + col) = v[i] * rstd * g; }
    }
}

#define LAS __attribute__((address_space(3)))
#define XB_TMO      128
#define XB_XCNT(j)  (256  + 64 * (j))
#define XB_XSUB(j)  (1280 + 64 * (j))
#define XB_XGEN(j)  (2304 + 64 * (j))
#define XB_TOP      3328
#define XB_TOPGEN   3392
#define XCD_BAR_WORDS 3456
#define XB_SPIN_CAP (1u << 18)

__device__ __forceinline__ unsigned xb_ld(unsigned* p)              { return __hip_atomic_load(p, __ATOMIC_RELAXED, __HIP_MEMORY_SCOPE_AGENT); }
__device__ __forceinline__ unsigned xb_add(unsigned* p, unsigned v) { return __hip_atomic_fetch_add(p, v, __ATOMIC_RELAXED, __HIP_MEMORY_SCOPE_AGENT); }
__device__ __forceinline__ unsigned xb_xcc_id() { return (unsigned)__builtin_amdgcn_s_getreg((3 << 11) | 20) & 0xFu; }
#define XB_SPIN(cond, bar) do { unsigned _sp = 0; while (cond) { __builtin_amdgcn_s_sleep(1); \
    if ((++_sp & 255u) == 0u) { if (xb_ld(&(bar)[XB_TMO])) break; if (_sp > XB_SPIN_CAP) { atomicAdd(&(bar)[XB_TMO], 1u); break; } } } } while (0)

struct XcdBarrier {
    unsigned* bar; unsigned x;
    volatile LAS unsigned* st;
};

__device__ __forceinline__ XcdBarrier xcd_barrier_post(unsigned* bar, volatile LAS unsigned* st) {
    XcdBarrier b; b.bar = bar; b.x = xb_xcc_id(); b.st = st;
    if (threadIdx.x == 0) (void)xb_add(&bar[XB_XCNT(b.x)], 1u);
    return b;
}
__device__ __forceinline__ void xcd_barrier_complete(unsigned* bar, unsigned x, unsigned& nloc, unsigned& nx) {
    const unsigned G = gridDim.x * gridDim.y * gridDim.z;
    unsigned sum, cnt, mine, sp = 0u;
    for (;;) {
        sum = 0u; cnt = 0u; mine = 0u;
#pragma unroll
        for (unsigned j = 0; j < 16; ++j) { const unsigned c = xb_ld(&bar[XB_XCNT(j)]); sum += c; cnt += (c > 0u) ? 1u : 0u; mine = (j == x) ? c : mine; }
        if (sum == G) break;
        __builtin_amdgcn_s_sleep(1);
        if ((++sp & 255u) == 0u) { if (xb_ld(&bar[XB_TMO])) break; if (sp > XB_SPIN_CAP) { atomicAdd(&bar[XB_TMO], 1u); break; } }
    }
    nloc = mine > 0u ? mine : 1u; nx = cnt > 0u ? cnt : 1u;
}

__device__ __forceinline__ void xcd_barrier(const XcdBarrier& b) {
    asm volatile("s_waitcnt vmcnt(0)" ::: "memory");
    __syncthreads();
    if (threadIdx.x == 0) {
        unsigned* bar = b.bar;
        __builtin_amdgcn_s_waitcnt(0);
        unsigned nloc = b.st[0], nx = b.st[1];
        if (nloc == 0u) { xcd_barrier_complete(bar, b.x, nloc, nx); b.st[0] = nloc; b.st[1] = nx; }
        const unsigned old = xb_add(&bar[XB_XSUB(b.x)], 1u);
        const unsigned gen = old / nloc;
        if (old + 1u == (gen + 1u) * nloc) {
            __builtin_amdgcn_fence(__ATOMIC_RELEASE, "agent");
            asm volatile("s_waitcnt vmcnt(0)" ::: "memory");
            const unsigned og = xb_add(&bar[XB_TOP], 1u);
            const unsigned tg = og / nx;
            if (og + 1u == (tg + 1u) * nx) xb_add(&bar[XB_TOPGEN], 1u);
            else XB_SPIN(xb_ld(&bar[XB_TOPGEN]) == tg, bar);
            __builtin_amdgcn_fence(__ATOMIC_ACQUIRE, "agent");
            xb_add(&bar[XB_XGEN(b.x)], 1u);
            asm volatile("s_waitcnt vmcnt(0)" ::: "memory");
        } else {
            XB_SPIN(xb_ld(&bar[XB_XGEN(b.x)]) == gen, bar);
            __builtin_amdgcn_fence(__ATOMIC_ACQUIRE, "agent");
            asm volatile("s_waitcnt vmcnt(0)" ::: "memory");
        }
    }
    __syncthreads();
}

#ifndef DUPMASK
#define DUPMASK 0
#endif
#ifndef SUBM
#define SUBM 3
#endif
#ifndef PHMASK
#define PHMASK 0xfff
#endif
__global__ void __launch_bounds__(512, 2) trunk_fwd(Args ka) {
    extern __shared__ __attribute__((aligned(16))) unsigned char lds[];
    cg::grid_group grid = cg::this_grid();
    volatile LAS unsigned* bst = (volatile LAS unsigned*)((LAS unsigned char*)lds + (LDS_BYTES - 16));
    if (threadIdx.x < 4) bst[threadIdx.x] = 0u;
    __syncthreads();
    XcdBarrier xbar = xcd_barrier_post((unsigned*)(ka.ws + WS_BAR), bst);
    const int ph_hi = ka.hi;
    {
        if (blockIdx.x == 0 && threadIdx.x == 0) {
#pragma unroll
            for (int i = 0; i < 31; ++i) ((const float**)(ka.ws + WS_TAB))[i] = ka.in[i]; }
        phase_prologue(ka, lds); convert_weights(ka, 0, lds, 0);
        grid.sync();
    }
    for (int ph = 1; ph < ph_hi; ++ph) {
        Args a; a.ws = ka.ws; a.out = ka.out; asm volatile("" : "+s"(a.ws)); asm volatile("" : "+s"(a.out));
        { const float* const* tab = (const float* const*)(a.ws + WS_TAB);
#define LD4(i) asm volatile("s_load_dwordx2 %0, %4, %5\n\ts_load_dwordx2 %1, %4, %6\n\ts_load_dwordx2 %2, %4, %7\n\ts_load_dwordx2 %3, %4, %8\n\ts_waitcnt lgkmcnt(0)" \
              : "=&s"(a.in[i]), "=&s"(a.in[i + 1]), "=&s"(a.in[i + 2]), "=&s"(a.in[i + 3]) : "s"(tab), "i"((i) * 8), "i"((i) * 8 + 8), "i"((i) * 8 + 16), "i"((i) * 8 + 24))
          LD4(0); LD4(4); LD4(8); LD4(12); LD4(16); LD4(20); LD4(24);
          asm volatile("s_load_dwordx2 %0, %3, %4\n\ts_load_dwordx2 %1, %3, %5\n\ts_load_dwordx2 %2, %3, %6\n\ts_waitcnt lgkmcnt(0)" : "=&s"(a.in[28]), "=&s"(a.in[29]), "=&s"(a.in[30]) : "s"(tab), "i"(224), "i"(232), "i"(240));
#undef LD4
        }
        a.lo = 0; a.hi = 0;
        unsigned char* ws = a.ws;
        if (ph == 1) phase_vectors(a, lds);
        else if (ph == NPH - 1) phase_final(a);
        else {
            const int l = (ph - 2) / 10, s = (ph - 2) % 10; const bool last = (l == NL - 1);
            const float* mods = (const float*)(ws + WS_MODS) + (size_t)l * 33 * 6144;
            float* rsa = (float*)(ws + WS_RSA); float* rsb = (float*)(ws + WS_RSB);
            if (s == 0) { run_gemm<NIN, 1024>(lds, (const bf16_t*)(ws + WS_H), (const bf16_t*)(ws + WT_IN), 0, FnF{(bf16_t*)(ws + WS_F), rsa, (const float*)(ws + WS_C1) + (size_t)l * 33 * NIN}); }
            else if (s == 1) { phase_split(a, l); convert_weights(a, l, lds, 1);
                for (int i = blockIdx.x * 512 + ltid(); i < TALL; i += gridDim.x * 512) { rsa[i] = 0.f; rsb[i] = 0.f; } }
            else if (s == 2) { run_gemm<768, 256>(lds, (const bf16_t*)(ws + WS_CQN), (const bf16_t*)(ws + WT_UQ), 0, FnQ{(bf16_t*)(ws + WS_Q), (const float*)(ws + WS_ROPE)});
                    run_gemm<1024, 128>(lds, (const bf16_t*)(ws + WS_CKVN), (const bf16_t*)(ws + WT_UKV), 0, FnKV{(bf16_t*)(ws + WS_KATT), (bf16_t*)(ws + WS_VATT)}); }
            else if (s == 3) { phase_attn((const bf16_t*)(ws + WS_Q), (const bf16_t*)(ws + WS_KATT), (const bf16_t*)(ws + WS_VATT), (bf16_t*)(ws + WS_MIX), last, (char*)lds); }
            else if (s == 4) { run_gemm<2048, 256>(lds, (const bf16_t*)(ws + WS_A1), (const bf16_t*)(ws + WT_L1), 0, FnL1{(__half*)(ws + WS_DEC), (bf16_t*)(ws + WS_AA), a.in[I_W0] + l * 1024, a.in[I_A0] + l * 1024});
                    run_gemm<1024, 256>(lds, (const bf16_t*)(ws + WS_A2), (const bf16_t*)(ws + WT_L2), 0,
                             FnL2{(bf16_t*)(ws + WS_G), (bf16_t*)(ws + WS_V), (const bf16_t*)(ws + WS_VF), a.in[I_V0] + (l > 0 ? l - 1 : 0) * 512, l > 0 ? 1 : 0}); }
            else if (s == 5) { phase_scan((const bf16_t*)(ws + WS_R), (const bf16_t*)(ws + WS_K), (const bf16_t*)(ws + (l == 0 ? WS_VF : WS_V)), (const __half*)(ws + WS_DEC), (const bf16_t*)(ws + WS_AA),
                               (const float*)(ws + WS_INV), a.in[I_KK] + l * 512, a.in[I_KA] + l * 512, (bf16_t*)(ws + WS_MIX), (bf16_t*)(ws + WS_YB), (char*)lds); }
            else if (s == 6) { phase_rwkv_out(a, l, last); if (!last) convert_weights(a, l + 1, lds, 0); }
            else if (s == 7) { run_gemm_epi<1024, 1024>(lds, (const bf16_t*)(ws + WS_MIX), (const bf16_t*)(ws + WT_OUT), last ? 1 : 0,
                             EpiRes{a.out, (float*)(ws + WS_XC), l == 0 ? a.in[I_X] : a.out, l == 0 ? a.in[I_CTX] : (const float*)(ws + WS_XC), mods, 2,
                                    (const float*)(ws + WS_GP2) + (size_t)l * 33 * 1024, (bf16_t*)(ws + WS_H), rsb, 1}); }
            else if (s == 8) { run_gemm<DFF, 1024>(lds, (const bf16_t*)(ws + WS_H), (const bf16_t*)(ws + WT_M1), last ? 1 : 0, FnM1{(bf16_t*)(ws + WS_HID), rsb, (const float*)(ws + WS_C2) + (size_t)l * 33 * DFF}); }
            else if (s == 9) { run_gemm_epi<1024, DFF>(lds, (const bf16_t*)(ws + WS_HID), (const bf16_t*)(ws + WT_M2), last ? 1 : 0,
                             EpiRes{a.out, (float*)(ws + WS_XC), a.out, (const float*)(ws + WS_XC), mods, 5,
                                    (const float*)(ws + WS_GP1) + (size_t)(last ? l : l + 1) * 33 * 1024, (bf16_t*)(ws + WS_H), rsa, last ? 0 : 1}); }
        }
        if (ph + 1 < ph_hi) { XcdBarrier xb = xbar; asm volatile("" : "+s"(xb.bar)); xcd_barrier(xb); }
    }
}

extern "C" void kernel_launch(void* const* d_in, const int* in_sizes, int n_in, void* d_out, int out_size, void* d_ws, size_t ws_size, hipStream_t stream) {
    static int grid = 0;
    if (grid == 0) {
        if (n_in != 31 || out_size != NB * SEQ * DM || ws_size < WS_END) { fprintf(stderr, "kernel_launch: unexpected shapes: n_in %d out %d ws %zu (need %zu)\n", n_in, out_size, ws_size, (size_t)WS_END); grid = -1; return; }
        int dev = 0, cus = 0, per_cu = 0;
        (void)hipGetDevice(&dev); (void)hipDeviceGetAttribute(&cus, hipDeviceAttributeMultiprocessorCount, dev);
        if (hipFuncSetAttribute((const void*)trunk_fwd, hipFuncAttributeMaxDynamicSharedMemorySize, LDS_BYTES) != hipSuccess) { fprintf(stderr, "kernel_launch: hipFuncSetAttribute failed\n"); grid = -1; return; }
        if (hipOccupancyMaxActiveBlocksPerMultiprocessor(&per_cu, (const void*)trunk_fwd, 512, LDS_BYTES) != hipSuccess || per_cu < 1) { fprintf(stderr, "kernel_launch: occupancy query gave %d\n", per_cu); per_cu = 1; }
        (void)hipGetLastError();
        grid = cus * 1;
    }
    if (grid < 0) return;
    if (hipMemsetAsync((char*)d_ws + WS_BAR, 0, BAR_BYTES, stream) != hipSuccess) { fprintf(stderr, "kernel_launch: hipMemsetAsync failed\n"); return; }
    Args a{};
    for (int i = 0; i < 31; ++i) a.in[i] = (const float*)d_in[i];
    a.out = (float*)d_out; a.ws = (unsigned char*)d_ws; a.lo = 0; a.hi = NPH;
    void* args[] = {&a};
    hipError_t e = hipLaunchCooperativeKernel((const void*)trunk_fwd, dim3(grid), dim3(512), args, LDS_BYTES, stream);
    if (e != hipSuccess) fprintf(stderr, "kernel_launch: cooperative launch failed: %s (grid %d)\n", hipGetErrorString(e), grid);
}
```

```cpp
#include <hip/hip_runtime.h>
#include <hip/hip_cooperative_groups.h>
#include <hip/hip_fp16.h>
#include <cstdio>
#include <cstdint>
namespace cg = cooperative_groups;
#define DI __device__ __forceinline__
DI int ltid() { int t = threadIdx.x; asm volatile("" : "+v"(t)); return t; }
namespace pg8 {
#define PG8_LAS __attribute__((address_space(3)))
typedef unsigned short bf16_t;
typedef short bf16x8 __attribute__((ext_vector_type(8)));
typedef float f32x4 __attribute__((ext_vector_type(4)));
typedef unsigned u32x4 __attribute__((ext_vector_type(4)));
constexpr int BM = 256, BK = 64, HALF = 128, HTB = HALF * BK * 2  , STAGE_BYTES = 8 * HTB, NXCD = 8, WGM = 8;

__host__ __device__ __forceinline__ int lds_byte(int r, int c) { const int st = (r >> 4) * 2 + (c >> 5), rr = r & 15, cc = c & 31, ob = rr * 64 + cc * 2; return st * 1024 + (ob ^ (((ob >> 9) & 1) << 5)); }
__host__ __device__ __forceinline__ void stage_rc(int b, int& R, int& C) { const int st = b / 1024, sb = b % 1024, swz = sb ^ (((sb >> 9) & 1) << 5); R = (st >> 1) * 16 + swz / 64; C = (st & 1) * 32 + (swz % 64) / 2; }
__host__ __device__ __forceinline__ int perm32(int rho) { const int n = rho >> 4, i = rho & 15; return 8 * (i >> 2) + 4 * n + (i & 3); }

struct Unit { int pm, pn; };
struct Gemm { const bf16_t* A; const bf16_t* Bt; int M, N, K; };

struct StaticOrder {
    int nM, nN, nwg, G, c;
    __host__ __device__ void init(int M, int N, int G_, int c_) { nM = M / BM; nN = N / BM; nwg = nM * nN; G = G_; c = c_; }
    __host__ __device__ bool next(int i, Unit& u) const {
        const long L = (long)i * G + c; if (L >= nwg) return false;
        int wgid = (int)L; { const int q = nwg / NXCD, r = nwg % NXCD, xcd = wgid % NXCD, off = wgid / NXCD; wgid = (xcd < r ? xcd * (q + 1) : r * (q + 1) + (xcd - r) * q) + off; }
        const int nig = WGM * nN, gid = wgid / nig, fm = gid * WGM, gsz = (nM - fm) < WGM ? (nM - fm) : WGM;
        u.pm = fm + ((wgid % nig) % gsz); u.pn = (wgid % nig) / gsz; return true;
    }
    __device__ __forceinline__ void a_ready(const Unit&) const {}
    __device__ __forceinline__ void done(const Unit&) const {}
};

__device__ __forceinline__ unsigned cvt_pk_bf16(float lo, float hi) { unsigned r; asm volatile("v_cvt_pk_bf16_f32 %0, %1, %2" : "=v"(r) : "v"(lo), "v"(hi)); return r; }

template <class Epi, class Sched, bool ALIGN_EPI = false, bool SP2 = false>
__device__ __forceinline__ void gemm_phase(PG8_LAS unsigned char* lds, const Gemm g, const Sched& S, const Epi& E) {
    const int tid = ltid(), wid = __builtin_amdgcn_readfirstlane(tid >> 6), lane = tid & 63, wr = wid >> 2, wc = wid & 3, fr = lane & 15, fq = lane >> 4;
    const int K = g.K, nt = K / BK;
    unsigned voffA[2], voffB[2];
#pragma unroll
    for (int i = 0; i < 2; ++i) { int R, C; stage_rc(tid * 16 + i * 8192, R, C); const int Rb = Epi::PERM ? ((R & ~31) + perm32(R & 31)) : R;
        voffA[i] = (unsigned)(R * K + C) * 2u; voffB[i] = (unsigned)(Rb * K + C) * 2u; }
    const size_t kstep = (size_t)(BK * 2);
    const size_t hstep = (size_t)HALF * K * 2;
    const size_t tstep = 2 * hstep;
    const unsigned ldsw = (unsigned)wid * 1024u;
    const int aoff = lds_byte(wr * 64 + fr, fq * 8), boff = lds_byte(wc * 32 + fr, fq * 8);
#define PG8_SA(b, h) (((b) * 2 + (h)) * HTB)
#define PG8_SB(b, h) ((4 + (b) * 2 + (h)) * HTB)
#define PG8_STAGE(bufoff, gbase, voff) do { _Pragma("unroll") for (int _i = 0; _i < 2; ++_i) \
        __builtin_amdgcn_global_load_lds((const unsigned*)((const char*)(gbase) + (voff)[_i]), (PG8_LAS unsigned*)(lds + (bufoff) + ldsw + _i * 8192), 16, 0, 0); } while (0)
#define PG8_LDA(dst, b, h) do { _Pragma("unroll") for (int m = 0; m < 4; ++m) _Pragma("unroll") for (int k = 0; k < 2; ++k) dst[m][k] = *(const PG8_LAS bf16x8*)(lds + PG8_SA(b, h) + aoff + m * 2048 + k * 1024); } while (0)
#define PG8_LDB(dst, b, h) do { _Pragma("unroll") for (int n = 0; n < 2; ++n) _Pragma("unroll") for (int k = 0; k < 2; ++k) dst[n][k] = *(const PG8_LAS bf16x8*)(lds + PG8_SB(b, h) + boff + n * 2048 + k * 1024); } while (0)
#define PG8_MMA(ai, bj, At, Bt) do { __builtin_amdgcn_s_setprio(1); _Pragma("unroll") for (int m = 0; m < 4; ++m) _Pragma("unroll") for (int n = 0; n < 2; ++n) _Pragma("unroll") for (int k = 0; k < 2; ++k) \
        acc[ai][bj][m][n] = __builtin_amdgcn_mfma_f32_16x16x32_bf16(Bt[n][k], At[m][k], acc[ai][bj][m][n], 0, 0, 0); __builtin_amdgcn_s_setprio(0); } while (0)
#define PG8_WAIT_V(n) asm volatile("s_waitcnt vmcnt(" #n ")" ::: "memory")
#define PG8_WAIT_L(n) asm volatile("s_waitcnt lgkmcnt(" #n ")" ::: "memory")
#define PG8_BAR __builtin_amdgcn_s_barrier()
#define PG8_SCHED __builtin_amdgcn_sched_barrier(0)
    Unit cur, nxt; int ui = 0;
    if (!S.next(0, cur)) return;
    f32x4 acc[2][2][4][2];
#pragma unroll
    for (int a = 0; a < 2; ++a)
#pragma unroll
        for (int b = 0; b < 2; ++b)
#pragma unroll
            for (int m = 0; m < 4; ++m)
#pragma unroll
                for (int n = 0; n < 2; ++n) acc[a][b][m][n] = (f32x4){0.f, 0.f, 0.f, 0.f};
    bf16x8 At[4][2], B0[2][2], B1[2][2];
    const char* cA = (const char*)g.A + (size_t)cur.pm * tstep; const char* cB = (const char*)g.Bt + (size_t)cur.pn * tstep;
    S.a_ready(cur);
    if constexpr (SP2) {
        PG8_STAGE(PG8_SB(0, 0), cB, voffB); PG8_STAGE(PG8_SB(0, 1), cB + hstep, voffB); PG8_STAGE(PG8_SA(0, 0), cA, voffA); PG8_STAGE(PG8_SA(0, 1), cA + hstep, voffA);
        if (wr == 1) PG8_BAR;
        PG8_WAIT_V(2); PG8_BAR;
        PG8_STAGE(PG8_SB(1, 0), cB + kstep, voffB); PG8_STAGE(PG8_SA(1, 0), cA + kstep, voffA); PG8_STAGE(PG8_SB(1, 1), cB + hstep + kstep, voffB);
        PG8_WAIT_V(6); PG8_BAR;
    } else {
        PG8_STAGE(PG8_SB(0, 0), cB, voffB); PG8_STAGE(PG8_SA(0, 0), cA, voffA); PG8_STAGE(PG8_SB(0, 1), cB + hstep, voffB); PG8_STAGE(PG8_SA(0, 1), cA + hstep, voffA);
        if (wr == 1) PG8_BAR;
        PG8_WAIT_V(4); PG8_BAR;
        PG8_STAGE(PG8_SB(1, 0), cB + kstep, voffB); PG8_STAGE(PG8_SA(1, 0), cA + kstep, voffA); PG8_STAGE(PG8_SB(1, 1), cB + hstep + kstep, voffB);
        PG8_WAIT_V(6); PG8_BAR;
    }
    for (;;) {
        const bool has_next = S.next(ui + 1, nxt);
        const char* nA = has_next ? (const char*)g.A + (size_t)nxt.pm * tstep : cA; const char* nB = has_next ? (const char*)g.Bt + (size_t)nxt.pn * tstep : cB;
#pragma nounroll
        for (int t = 0; t < nt; t += 2) {
            const bool last = (t == nt - 2);
            const char* a1 = cA + (size_t)(t + 1) * kstep;
            const char* a2 = last ? nA : cA + (size_t)(t + 2) * kstep; const char* b2 = last ? nB : cB + (size_t)(t + 2) * kstep;
            const char* a3 = a2 + kstep; const char* b3 = b2 + kstep;
            if (last && has_next) S.a_ready(nxt);
            if constexpr (SP2) {
            PG8_LDB(B0, 0, 0); PG8_LDB(B1, 0, 1); PG8_SCHED; PG8_LDA(At, 0, 0); PG8_STAGE(PG8_SA(1, 1), a1 + hstep, voffA);
            PG8_WAIT_V(8); PG8_WAIT_L(0); PG8_BAR; PG8_MMA(0, 0, At, B0); PG8_MMA(0, 1, At, B1); PG8_BAR; PG8_SCHED;
            PG8_LDA(At, 0, 1); PG8_STAGE(PG8_SB(0, 0), b2, voffB); PG8_STAGE(PG8_SB(0, 1), b2 + hstep, voffB); PG8_STAGE(PG8_SA(0, 0), a2, voffA);
            PG8_WAIT_V(8); PG8_WAIT_L(0); PG8_BAR; PG8_MMA(1, 0, At, B0); PG8_MMA(1, 1, At, B1); PG8_BAR; PG8_SCHED;
            PG8_LDB(B0, 1, 0); PG8_LDB(B1, 1, 1); PG8_SCHED; PG8_LDA(At, 1, 0); PG8_STAGE(PG8_SA(0, 1), a2 + hstep, voffA);
            PG8_WAIT_V(8); PG8_WAIT_L(0); PG8_BAR; PG8_MMA(0, 0, At, B0); PG8_MMA(0, 1, At, B1); PG8_BAR; PG8_SCHED;
            PG8_LDA(At, 1, 1); PG8_STAGE(PG8_SB(1, 0), b3, voffB); PG8_STAGE(PG8_SB(1, 1), b3 + hstep, voffB); PG8_STAGE(PG8_SA(1, 0), a3, voffA);
            PG8_WAIT_V(8); PG8_WAIT_L(0); PG8_BAR; PG8_MMA(1, 0, At, B0); PG8_MMA(1, 1, At, B1); PG8_BAR; PG8_SCHED;
            } else {
            PG8_LDB(B0, 0, 0); PG8_SCHED; PG8_LDA(At, 0, 0); PG8_STAGE(PG8_SA(1, 1), a1 + hstep, voffA);
            PG8_WAIT_L(8); PG8_BAR; PG8_WAIT_L(0); PG8_MMA(0, 0, At, B0); PG8_BAR; PG8_SCHED;
            PG8_LDB(B1, 0, 1); PG8_STAGE(PG8_SB(0, 0), b2, voffB);
            PG8_BAR; PG8_WAIT_L(0); PG8_MMA(0, 1, At, B1); PG8_BAR;
            PG8_LDA(At, 0, 1); PG8_STAGE(PG8_SA(0, 0), a2, voffA);
            PG8_BAR; PG8_WAIT_L(0); PG8_MMA(1, 0, At, B0); PG8_BAR; PG8_SCHED;
            PG8_STAGE(PG8_SB(0, 1), b2 + hstep, voffB);
            PG8_WAIT_V(6); PG8_BAR; PG8_MMA(1, 1, At, B1); PG8_BAR;
            PG8_LDB(B0, 1, 0); PG8_SCHED; PG8_LDA(At, 1, 0); PG8_STAGE(PG8_SA(0, 1), a2 + hstep, voffA);
            PG8_WAIT_L(8); PG8_BAR; PG8_WAIT_L(0); PG8_MMA(0, 0, At, B0); PG8_BAR; PG8_SCHED;
            PG8_LDB(B1, 1, 1); PG8_STAGE(PG8_SB(1, 0), b3, voffB);
            PG8_BAR; PG8_WAIT_L(0); PG8_MMA(0, 1, At, B1); PG8_BAR;
            PG8_LDA(At, 1, 1); PG8_STAGE(PG8_SA(1, 0), a3, voffA);
            PG8_BAR; PG8_WAIT_L(0); PG8_MMA(1, 0, At, B0); PG8_BAR; PG8_SCHED;
            PG8_STAGE(PG8_SB(1, 1), b3 + hstep, voffB);
            PG8_WAIT_V(6); PG8_BAR; PG8_MMA(1, 1, At, B1); PG8_BAR;
            }
        }
        if constexpr (ALIGN_EPI) { if (wr == 0) PG8_BAR; }
        if constexpr (!Epi::AFTER_DRAIN) { E(acc, cur, wr, wc, fr, fq); S.done(cur); }
        if (!has_next) break;
#pragma unroll
        for (int a = 0; a < 2; ++a)
#pragma unroll
            for (int b = 0; b < 2; ++b)
#pragma unroll
                for (int m = 0; m < 4; ++m)
#pragma unroll
                    for (int n = 0; n < 2; ++n) acc[a][b][m][n] = (f32x4){0.f, 0.f, 0.f, 0.f};
        cur = nxt; cA = nA; cB = nB; ++ui;
        if constexpr (ALIGN_EPI) { if (wr == 1) PG8_BAR; }
    }
    PG8_WAIT_V(0);
    if constexpr (!ALIGN_EPI) { if (wr == 0) PG8_BAR; }
    PG8_BAR;
    if constexpr (Epi::AFTER_DRAIN) { E.fused(acc, cur, wr, wc, fr, fq, lds, wid, lane); S.done(cur); }
#undef PG8_SA
#undef PG8_SB
#undef PG8_STAGE
#undef PG8_LDA
#undef PG8_LDB
#undef PG8_MMA
#undef PG8_WAIT_V
#undef PG8_WAIT_L
#undef PG8_BAR
#undef PG8_SCHED
}
}
typedef unsigned short bf16_t;
using bf16x8 = __attribute__((ext_vector_type(8))) short;
using s16x4  = __attribute__((ext_vector_type(4))) short;
using f32x16 = __attribute__((ext_vector_type(16))) float;
using f32x4  = __attribute__((ext_vector_type(4))) float;
using u32x4  = __attribute__((ext_vector_type(4))) unsigned;
using u32x2  = __attribute__((ext_vector_type(2))) unsigned;

constexpr int DM = 1024, NB = 32, SEQ = 2048, TC = 256, TT = 2304, TALL = NB * TT, NL = 4;
constexpr int CIN = 2336, CINX = 2368, NIN = 2560, DFF = 4096;
constexpr int OFF_R = 416, OFF_K = 928, OFF_V = 1440, OFF_WLO = 1952, OFF_HV = 2336;
constexpr int NPH = 43, LDS_BYTES = 147456;
constexpr size_t MiB = 1u << 20;
constexpr size_t WS_MODS = 0, WS_ROPE = 3 * MiB + 512 * 1024, WS_BAR = 3 * MiB + 768 * 1024, BAR_BYTES = 16384, WS_TAB = 3 * MiB + 800 * 1024, WS_XC = 4 * MiB, WS_VF = 36 * MiB, WS_WT = 108 * MiB, WS_INV = 134 * MiB, TR = 137 * MiB;
constexpr size_t WT_IN = WS_WT, WT_UQ = WS_WT + 5 * MiB, WT_UKV = WS_WT + 5 * MiB + 512 * 1024, WT_L1 = WS_WT + 6 * MiB, WT_L2 = WS_WT + 7 * MiB,
                 WT_OUT = WS_WT + 8 * MiB, WT_M1 = WS_WT + 10 * MiB, WT_M2 = WS_WT + 18 * MiB;
constexpr size_t WS_R = TR, WS_K = TR + 72 * MiB, WS_H = TR, WS_F = TR + 144 * MiB, WS_Q = TR + 144 * MiB, WS_VATT = TR + 252 * MiB, WS_MIX = TR + 324 * MiB,
                 WS_DEC = TR + 144 * MiB, WS_HID = TR + 144 * MiB, WS_A1 = TR + 477 * MiB, WS_A2 = TR + 513 * MiB, WS_YB = TR + 477 * MiB,
                 WS_CQN = TR + 549 * MiB, WS_CKVN = TR + 585 * MiB, WS_KATT = TR + 621 * MiB, WS_AA = TR + 585 * MiB, WS_G = TR + 729 * MiB,
                 WS_V = TR + 801 * MiB, WS_C1 = 1010 * MiB, WS_C2 = 1012 * MiB, WS_GP1 = 1015 * MiB, WS_GP2 = 1016 * MiB, WS_END = 1017 * MiB;
constexpr size_t WS_RSA = 136 * MiB + 256 * 1024, WS_RSB = 136 * MiB + 640 * 1024;

struct Args { const float* in[31]; float* out; unsigned char* ws; int lo, hi; };
enum { I_X = 0, I_C, I_CTX, I_CCTX, I_ADAW, I_ADAB, I_N1G, I_N2G, I_WIN, I_QNG, I_WUQ, I_KVNG, I_WUKV, I_MU, I_W0, I_W2, I_A0, I_A2, I_G2, I_KK, I_KA, I_RK,
       I_LNW, I_LNB, I_V1, I_V2, I_V0, I_WOUT, I_M1, I_M2, I_FG };

DI float bflo(unsigned w) { return __uint_as_float(w << 16); }
DI float bfhi(unsigned w) { return __uint_as_float(w & 0xffff0000u); }
DI unsigned cvtpk(float lo, float hi) { return pg8::cvt_pk_bf16(lo, hi); }
DI bf16_t f2bf(float f) { return (bf16_t)(cvtpk(f, 0.f) & 0xffffu); }
DI void load8(const bf16_t* p, float (&f)[8]) { const u32x4 w = *(const u32x4*)p; f[0] = bflo(w.x); f[1] = bfhi(w.x); f[2] = bflo(w.y); f[3] = bfhi(w.y); f[4] = bflo(w.z); f[5] = bfhi(w.z); f[6] = bflo(w.w); f[7] = bfhi(w.w); }
DI void store8(bf16_t* p, const float (&f)[8]) { u32x4 w; w.x = cvtpk(f[0], f[1]); w.y = cvtpk(f[2], f[3]); w.z = cvtpk(f[4], f[5]); w.w = cvtpk(f[6], f[7]); *(u32x4*)p = w; }
DI void loadf8(const float* p, float (&f)[8]) { const f32x4 a = *(const f32x4*)p, b = *(const f32x4*)(p + 4); f[0] = a[0]; f[1] = a[1]; f[2] = a[2]; f[3] = a[3]; f[4] = b[0]; f[5] = b[1]; f[6] = b[2]; f[7] = b[3]; }
DI float h2f(unsigned b) { return __half2float(__ushort_as_half((unsigned short)b)); }
DI float sigmoidf_(float x) { return __builtin_amdgcn_rcpf(1.f + __expf(-x)); }
DI float tanhf_(float x) { return 1.f - 2.f * __builtin_amdgcn_rcpf(1.f + __expf(2.f * x)); }
DI float xorsum(float v, int mask) { return v + __shfl_xor(v, mask, 64); }
DI float* xrow(float* out, float* xc, int m) { const int b = m / TT, tt = m - b * TT; return tt < TC ? xc + (size_t)(b * TC + tt) * DM : out + (size_t)(b * SEQ + tt - TC) * DM; }

template <class Fn> struct Epi8 {
    static constexpr bool PERM = true, AFTER_DRAIN = false; Fn f;
    DI void operator()(const pg8::f32x4 (&acc)[2][2][4][2], const pg8::Unit& u, int wr, int wc, int fr, int fq) const {
        asm volatile("" : "+v"(fr), "+v"(fq));
#pragma unroll
        for (int ai = 0; ai < 2; ++ai)
#pragma unroll
            for (int m = 0; m < 4; ++m) { const int rit = ai * 128 + wr * 64 + m * 16 + fr;
#pragma unroll
                for (int bj = 0; bj < 2; ++bj) { f(rit, u.pn * 256 + bj * 128 + wc * 32 + 8 * fq, acc[ai][bj][m][0], acc[ai][bj][m][1], u, fq); __builtin_amdgcn_sched_barrier(0); } }
    }
};
DI void st8(bf16_t* p, const pg8::f32x4& v0, const pg8::f32x4& v1) { u32x4 w; w.x = cvtpk(v0[0], v0[1]); w.y = cvtpk(v0[2], v0[3]); w.z = cvtpk(v1[0], v1[1]); w.w = cvtpk(v1[2], v1[3]); *(u32x4*)p = w; }

struct FnF { bf16_t* F; const float* rs; const float* c1;
    DI void operator()(int rit, int col0, const pg8::f32x4& v0, const pg8::f32x4& v1, const pg8::Unit& u, int) const {
        if (col0 < CINX) { const int row = u.pm * 256 + rit, b = u.pm / 9, mrow = (u.pm - b * 9 == 0) ? 32 : b;
            const float rstd = rsqrtf(rs[row] * (1.f / 1024.f) + 1e-6f); const float* c = c1 + (size_t)mrow * NIN + col0;
            const pg8::f32x4 b0 = *(const pg8::f32x4*)c, b1 = *(const pg8::f32x4*)(c + 4);
            st8(F + (size_t)row * CINX + col0, v0 * rstd + b0, v1 * rstd + b1); } } };
struct FnQ { bf16_t* Q; const float* rope;
    DI void operator()(int rit, int col0, const pg8::f32x4& v0, const pg8::f32x4& v1, const pg8::Unit& u, int fq) const {
        const int seg = u.pm % 9; const bool isrope = (seg != 0) && (((col0 >> 5) % 3) == 2);
        float x[8] = {v0[0], v0[1], v0[2], v0[3], v1[0], v1[1], v1[2], v1[3]};
        if (isrope) { const int s = (seg - 1) * 256 + rit, pos = (fq < 2) ? (s >> 6) : (s & 63); float cs[8], sn[8]; loadf8(rope + pos * 8, cs); loadf8(rope + 512 + pos * 8, sn);
            const float sg = (fq & 1) ? 1.f : -1.f;
#pragma unroll
            for (int j = 0; j < 8; ++j) { const float p = __shfl_xor(x[j], 16, 64); x[j] = x[j] * cs[j] + sg * p * sn[j]; } }
        store8(Q + (size_t)(u.pm * 256 + rit) * 768 + col0, x); } };
struct FnKV { bf16_t* KA; bf16_t* VA;
    DI void operator()(int rit, int col0, const pg8::f32x4& v0, const pg8::f32x4& v1, const pg8::Unit& u, int) const {
        const size_t row = (size_t)(u.pm * 256 + rit); const int h = col0 >> 7, c = col0 & 127;
        if (c < 64) st8(KA + row * 768 + h * 96 + c, v0, v1); else st8(VA + row * 512 + h * 64 + (c - 64), v0, v1); } };
struct FnL1 { __half* DEC; bf16_t* AA; const float* w0; const float* a0;
    DI void operator()(int rit, int col0, const pg8::f32x4& v0, const pg8::f32x4& v1, const pg8::Unit& u, int) const {
        const size_t row = (size_t)(u.pm * 256 + rit); float x[8] = {v0[0], v0[1], v0[2], v0[3], v1[0], v1[1], v1[2], v1[3]};
        if (col0 < 1024) { float b[8]; loadf8(w0 + col0, b); u32x4 w; unsigned hh[8];
#pragma unroll
            for (int j = 0; j < 8; ++j) { const float uu = 0.6065306597f * sigmoidf_(x[j] + b[j]); hh[j] = (unsigned)__half_as_ushort(__float2half(-uu * 1.4426950409f)); }
            w.x = hh[0] | (hh[1] << 16); w.y = hh[2] | (hh[3] << 16); w.z = hh[4] | (hh[5] << 16); w.w = hh[6] | (hh[7] << 16);
            *(u32x4*)(DEC + row * 1024 + col0) = w;
        } else { const int c = col0 - 1024; float b[8]; loadf8(a0 + c, b);
#pragma unroll
            for (int j = 0; j < 8; ++j) x[j] = sigmoidf_(x[j] + b[j]);
            store8(AA + row * 1024 + c, x); } } };
struct FnL2 { bf16_t* G; bf16_t* V; const bf16_t* VF; const float* v0p; int dovres;
    DI void operator()(int rit, int col0, const pg8::f32x4& v0, const pg8::f32x4& v1, const pg8::Unit& u, int) const {
        const size_t row = (size_t)(u.pm * 256 + rit);
        if (col0 < 512) st8(G + row * 512 + col0, v0, v1);
        else if (dovres) { const int c = col0 - 512; float x[8] = {v0[0], v0[1], v0[2], v0[3], v1[0], v1[1], v1[2], v1[3]}, b[8], v[8], vf[8]; loadf8(v0p + c, b); load8(V + row * 512 + c, v); load8(VF + row * 512 + c, vf);
#pragma unroll
            for (int j = 0; j < 8; ++j) v[j] = v[j] + (vf[j] - v[j]) * sigmoidf_(b[j] + x[j]);
            store8(V + row * 512 + c, v); } } };
struct FnM1 { bf16_t* HID; const float* rs; const float* c2;
    DI void operator()(int rit, int col0, const pg8::f32x4& v0, const pg8::f32x4& v1, const pg8::Unit& u, int) const {
        const int row = u.pm * 256 + rit, b = u.pm / 9, mrow = (u.pm - b * 9 == 0) ? 32 : b;
        const float rstd = rsqrtf(rs[row] * (1.f / 1024.f) + 1e-6f); const float* c = c2 + (size_t)mrow * DFF + col0;
        const pg8::f32x4 b0 = *(const pg8::f32x4*)c, b1 = *(const pg8::f32x4*)(c + 4);
        const pg8::f32x4 y0 = v0 * rstd + b0, y1 = v1 * rstd + b1;
        float x[8] = {y0[0], y0[1], y0[2], y0[3], y1[0], y1[1], y1[2], y1[3]};
#pragma unroll
        for (int j = 0; j < 8; ++j) { const float r = fmaxf(x[j], 0.f); x[j] = r * r; }
        store8(HID + (size_t)row * DFF + col0, x); } };
struct EpiRes { static constexpr bool PERM = true, AFTER_DRAIN = false;
    float* out; float* xc; const float* sx; const float* sc; const float* mods; int gidx; const float* gp; bf16_t* H; float* rs; int emit;
    DI void operator()(const pg8::f32x4 (&acc)[2][2][4][2], const pg8::Unit& u, int wr, int wc, int fr, int fq) const {
        asm volatile("" : "+v"(fr), "+v"(fq));
        const int b = u.pm / 9, seg = u.pm - b * 9, mrow = seg == 0 ? 32 : b;
        const float* gbase = mods + (size_t)mrow * 6144 + gidx * 1024; const float* gpb = gp + (size_t)mrow * 1024;
#pragma unroll
        for (int ai = 0; ai < 2; ++ai)
#pragma unroll
            for (int m = 0; m < 4; ++m) { const int rit = ai * 128 + wr * 64 + m * 16 + fr; float ss = 0.f;
                const size_t roff = (seg == 0 ? (size_t)(b * TC + rit) * DM : (size_t)(b * SEQ + (seg - 1) * 256 + rit) * DM);
#pragma unroll
                for (int bj = 0; bj < 2; ++bj) { const int col0 = u.pn * 256 + bj * 128 + wc * 32 + 8 * fq;
                    float* p = (seg == 0 ? xc : out) + roff + col0; const float* q = (seg == 0 ? sc : sx) + roff + col0;
                    const pg8::f32x4 g0 = *(const pg8::f32x4*)(gbase + col0), g1 = *(const pg8::f32x4*)(gbase + col0 + 4); pg8::f32x4 x0 = *(const pg8::f32x4*)q, x1 = *(const pg8::f32x4*)(q + 4);
                    x0 += g0 * acc[ai][bj][m][0]; x1 += g1 * acc[ai][bj][m][1]; *(pg8::f32x4*)p = x0; *(pg8::f32x4*)(p + 4) = x1;
                    if (emit) { const pg8::f32x4 p0 = *(const pg8::f32x4*)(gpb + col0), p1 = *(const pg8::f32x4*)(gpb + col0 + 4);
                        ss += x0[0] * x0[0] + x0[1] * x0[1] + x0[2] * x0[2] + x0[3] * x0[3] + x1[0] * x1[0] + x1[1] * x1[1] + x1[2] * x1[2] + x1[3] * x1[3];
                        st8(H + (size_t)(u.pm * 256 + rit) * 1024 + col0, x0 * p0, x1 * p1); }
                    __builtin_amdgcn_sched_barrier(0); }
                if (emit) { ss += __shfl_xor(ss, 16, 64); ss += __shfl_xor(ss, 32, 64); if (fq == 0) atomicAdd(rs + u.pm * 256 + rit, ss); }
            }
    }
};
struct Order { pg8::StaticOrder s; int lat;
    DI void init(int lat_, int N) { lat = lat_; s.init(lat_ ? NB * SEQ : TALL, N, (int)gridDim.x, (int)blockIdx.x); }
    DI bool next(int i, pg8::Unit& u) const { if (!s.next(i, u)) return false; if (lat) u.pm = (u.pm >> 3) * 9 + 1 + (u.pm & 7); return true; }
    DI void a_ready(const pg8::Unit&) const {}
    DI void done(const pg8::Unit&) const {}
};
template <int N, int K, class Fn> DI void run_gemm(unsigned char* lds, const bf16_t* A, const bf16_t* Bt, int lat, const Fn& fn) {
    int Kr = K; if (K == 128) asm volatile("" : "+s"(Kr));
    pg8::Gemm g{A, Bt, lat ? NB * SEQ : TALL, N, Kr}; Order S; S.init(lat, N); Epi8<Fn> E{fn};
    pg8::gemm_phase<Epi8<Fn>, Order, true, true>((PG8_LAS unsigned char*)lds, g, S, E);
    __syncthreads();
}
template <int N, int K, class Epi> DI void run_gemm_epi(unsigned char* lds, const bf16_t* A, const bf16_t* Bt, int lat, const Epi& E) {
    pg8::Gemm g{A, Bt, lat ? NB * SEQ : TALL, N, K}; Order S; S.init(lat, N);
    pg8::gemm_phase<Epi, Order, true, true>((PG8_LAS unsigned char*)lds, g, S, E);
    __syncthreads();
}
namespace att {
constexpr int NW = 8, QBLK = 32, KVBLK = 64;
constexpr float SCALE = 0.10206207261596577f, THR = 8.f;
constexpr int LDQ = 768, LDKK = 768, LDV = 512, LDO = 1024;
constexpr int SHM_V = KVBLK * 64 * 2, SHM_K = KVBLK * 256, SHM_ATTN = 2 * SHM_V + 2 * SHM_K + NW * 64 * 4;
#define KSWZ(row, colB) ((row) * 256 + ((colB) ^ (((row) & 7) << 4)))
#define SBAR() __builtin_amdgcn_sched_barrier(0)
DI int crow(int r, int hi) { return (r & 3) + 8 * (r >> 2) + 4 * hi; }
DI unsigned cvtpk_(float lo, float hi) { unsigned r; asm volatile("v_cvt_pk_bf16_f32 %0, %1, %2" : "=v"(r) : "v"(lo), "v"(hi)); return r; }
DI void partialSM(f32x16& p0, f32x16& p1, float& m_reg, float& mn, float& alpha) {
  constexpr float C = SCALE * 1.4426950408889634f;
  float pmax = p0[0];
#pragma unroll
  for (int r = 1; r < 16; ++r) pmax = fmaxf(pmax, p0[r]);
#pragma unroll
  for (int r = 0; r < 16; ++r) pmax = fmaxf(pmax, p1[r]);
  { auto rr = __builtin_amdgcn_permlane32_swap(__float_as_uint(pmax), __float_as_uint(pmax), false, false);
    pmax = fmaxf(__uint_as_float(rr[0]), __uint_as_float(rr[1])); }
  if (__builtin_expect(__all(pmax - m_reg <= THR / SCALE), 1)) { mn = m_reg; alpha = 1.f; }
  else { mn = fmaxf(m_reg, pmax); alpha = __builtin_amdgcn_exp2f((m_reg - mn) * C); m_reg = mn; }
  const float mnC = -mn * C;
#pragma unroll
  for (int r = 0; r < 16; ++r) p0[r] = fmaf(p0[r], C, mnC);
#pragma unroll
  for (int r = 0; r < 16; ++r) p1[r] = fmaf(p1[r], C, mnC);
#pragma unroll
  for (int r = 0; r < 16; ++r) p0[r] = __builtin_amdgcn_exp2f(p0[r]);
}
DI void finishSM(f32x16& p0, f32x16& p1, float alpha, float& l_reg, bf16x8& pa0, bf16x8& pa1, bf16x8& pa2, bf16x8& pa3) {
#pragma unroll
  for (int r = 0; r < 16; ++r) p1[r] = __builtin_amdgcn_exp2f(p1[r]);
  float ps = 0;
#pragma unroll
  for (int r = 0; r < 16; ++r) ps += p0[r];
#pragma unroll
  for (int r = 0; r < 16; ++r) ps += p1[r];
  { auto rr = __builtin_amdgcn_permlane32_swap(__float_as_uint(ps), __float_as_uint(ps), false, false);
    ps = __uint_as_float(rr[0]) + __uint_as_float(rr[1]); }
  l_reg = l_reg * alpha + ps;
#define PK4(P, BASE, OUT) do { unsigned a0 = cvtpk_(P[BASE + 0], P[BASE + 1]), a1 = cvtpk_(P[BASE + 2], P[BASE + 3]);   \
    unsigned b0 = cvtpk_(P[BASE + 4], P[BASE + 5]), b1 = cvtpk_(P[BASE + 6], P[BASE + 7]);                              \
    auto r0 = __builtin_amdgcn_permlane32_swap(a0, b0, false, false); auto r1 = __builtin_amdgcn_permlane32_swap(a1, b1, false, false); \
    u32x4 w = {r0[0], r1[0], r0[1], r1[1]}; OUT = *reinterpret_cast<bf16x8*>(&w); } while (0)
  PK4(p0, 0, pa0); PK4(p0, 8, pa1); PK4(p1, 0, pa2); PK4(p1, 8, pa3);
#undef PK4
}
DI void qkt(f32x16& p0, f32x16& p1, const char* Ks, const bf16x8* qr, int r32, int hi) {
  p0 = f32x16{}; p1 = f32x16{};
#pragma unroll
  for (int d0 = 0; d0 < 6; ++d0) { const int cb = (d0 * 16 + hi * 8) * 2;
    bf16x8 b0 = *reinterpret_cast<const bf16x8*>(Ks + KSWZ(r32, cb));
    bf16x8 b1 = *reinterpret_cast<const bf16x8*>(Ks + KSWZ(32 + r32, cb));
    p0 = __builtin_amdgcn_mfma_f32_32x32x16_bf16(b0, qr[d0], p0, 0, 0, 0);
    p1 = __builtin_amdgcn_mfma_f32_32x32x16_bf16(b1, qr[d0], p1, 0, 0, 0); }
}
DI int v_st(int k, int c) { const int kk = (k & ~0xC) | ((k & 4) << 1) | ((k & 8) >> 1); return ((kk >> 3) * 2 + (c >> 5)) * 512 + ((kk & 7) * 32 + (c & 31)) * 2; }
DI int v_rd_base(int lane) { return ((lane & 3) << 3) | (((lane >> 2) & 3) << 6) | (((lane >> 4) & 1) << 5) | (((lane >> 5) & 1) << 8); }
constexpr int v_rd_off(int d0, int ks, int half) { return d0 * 512 + ks * 2048 + half * 1024; }
template <int OFF> DI s16x4 tr_read(int vb) {
  s16x4 r; asm volatile("ds_read_b64_tr_b16 %0, %1 offset:%2" : "=&v"(r) : "v"(vb), "i"(OFF) : "memory"); return r;
}
template <int D0> DI void pv_one(f32x16& od, int vb, bf16x8 pa0, bf16x8 pa1, bf16x8 pa2, bf16x8 pa3) {
  const s16x4 l0 = tr_read<v_rd_off(D0, 0, 0)>(vb), h0 = tr_read<v_rd_off(D0, 0, 1)>(vb), l1 = tr_read<v_rd_off(D0, 1, 0)>(vb), h1 = tr_read<v_rd_off(D0, 1, 1)>(vb);
  const s16x4 l2 = tr_read<v_rd_off(D0, 2, 0)>(vb), h2 = tr_read<v_rd_off(D0, 2, 1)>(vb), l3 = tr_read<v_rd_off(D0, 3, 0)>(vb), h3 = tr_read<v_rd_off(D0, 3, 1)>(vb);
  asm volatile("s_waitcnt lgkmcnt(0)" ::: "memory"); SBAR();
#define PK(L, H) (bf16x8){L[0], L[1], L[2], L[3], H[0], H[1], H[2], H[3]}
  od = __builtin_amdgcn_mfma_f32_32x32x16_bf16(pa0, PK(l0, h0), od, 0, 0, 0);
  od = __builtin_amdgcn_mfma_f32_32x32x16_bf16(pa1, PK(l1, h1), od, 0, 0, 0);
  od = __builtin_amdgcn_mfma_f32_32x32x16_bf16(pa2, PK(l2, h2), od, 0, 0, 0);
  od = __builtin_amdgcn_mfma_f32_32x32x16_bf16(pa3, PK(l3, h3), od, 0, 0, 0);
#undef PK
}
DI void pv_d0(f32x16* o, int vb, bf16x8 pa0, bf16x8 pa1, bf16x8 pa2, bf16x8 pa3) {
  pv_one<0>(o[0], vb, pa0, pa1, pa2, pa3); pv_one<1>(o[1], vb, pa0, pa1, pa2, pa3);
}
DI void attn_body(const bf16_t* __restrict__ Qb, const bf16_t* __restrict__ Kh, const bf16_t* __restrict__ Vh, bf16_t* __restrict__ Ob, int seq, char* lds) {
  const int tid = ltid(), wid = tid >> 6, lane = tid & 63, r32 = lane & 31, hi = lane >> 5;
  char* V_lds = lds; char* K_lds = lds + 2 * SHM_V;
  float* ws = (float*)(lds + 2 * SHM_V + 2 * SHM_K) + wid * 64; float* li_l = ws; float* al_l = ws + 32;
  float m_reg = -1e30f, l_reg = 0; f32x16 o[2] = {}; bf16x8 qr[6];
  const bf16_t* Qw = Qb + (long)(wid * QBLK + r32) * LDQ + hi * 8;
#pragma unroll
  for (int d0 = 0; d0 < 6; ++d0) qr[d0] = *reinterpret_cast<const bf16x8*>(Qw + d0 * 16);
  const int kc2 = 512 + (tid & 255);
  const int kr1 = tid / 12, kch1 = tid - kr1 * 12, kr2 = kc2 / 12, kch2 = kc2 - kr2 * 12, vr = tid >> 3, vch = tid & 7;
  const int vst = v_st(vr, vch * 8), kst1 = KSWZ(kr1, kch1 * 16), kst2 = KSWZ(kr2, kch2 * 16);
  const int vb0 = (int)(uintptr_t)V_lds + v_rd_base(lane);
  struct { bf16x8 v, k1, k2; } sr_[2];
#define SLOAD(i, k0) do { sr_[i].v = *reinterpret_cast<const bf16x8*>(&Vh[(long)((k0) + vr) * LDV + vch * 8]); \
    sr_[i].k1 = *reinterpret_cast<const bf16x8*>(&Kh[(long)((k0) + kr1) * LDKK + kch1 * 8]); sr_[i].k2 = *reinterpret_cast<const bf16x8*>(&Kh[(long)((k0) + kr2) * LDKK + kch2 * 8]); } while (0)
#define SWRITE(b, i) do { *(bf16x8*)(V_lds + (b) * SHM_V + vst) = sr_[i].v; *(bf16x8*)(K_lds + (b) * SHM_K + kst1) = sr_[i].k1; *(bf16x8*)(K_lds + (b) * SHM_K + kst2) = sr_[i].k2; } while (0)
#define RESC(a) do { if (__any((a) < 1.f)) { if (hi == 0) al_l[r32] = (a); asm volatile("s_waitcnt lgkmcnt(0)" ::: "memory"); \
    _Pragma("unroll") for (int d = 0; d < 2; ++d) _Pragma("unroll") for (int r = 0; r < 16; ++r) o[d][r] *= al_l[crow(r, hi)]; } } while (0)
  f32x16 pA0, pA1, pB0, pB1; float mnA, mnB, alA, alB; bf16x8 pa0, pa1, pa2, pa3; const int NT = seq / KVBLK;
  constexpr int SE = 0, SO = 1;
  SLOAD(SE, 0); asm volatile("s_waitcnt vmcnt(0)" ::: "memory"); SWRITE(0, SE); __syncthreads();
  qkt(pA0, pA1, K_lds, qr, r32, hi); partialSM(pA0, pA1, m_reg, mnA, alA);
  SLOAD(SO, KVBLK); if (2 < NT) SLOAD(SE, 2 * KVBLK);
  SWRITE(1, SO); __syncthreads();
  for (int j = 1; j + 1 < NT; j += 2) {
    SBAR(); qkt(pB0, pB1, K_lds + SHM_K, qr, r32, hi);
    finishSM(pA0, pA1, alA, l_reg, pa0, pa1, pa2, pa3); SBAR();
    SLOAD(SO, (j + 2) * KVBLK); SBAR();
    pv_d0(o, vb0, pa0, pa1, pa2, pa3); partialSM(pB0, pB1, m_reg, mnB, alB);
    __syncthreads(); SWRITE(0, SE);
    RESC(alB); __syncthreads();
    SBAR(); qkt(pA0, pA1, K_lds, qr, r32, hi);
    finishSM(pB0, pB1, alB, l_reg, pa0, pa1, pa2, pa3); SBAR();
    if (j + 3 < NT) SLOAD(SE, (j + 3) * KVBLK); SBAR();
    pv_d0(o, vb0 + SHM_V, pa0, pa1, pa2, pa3); partialSM(pA0, pA1, m_reg, mnA, alA);
    __syncthreads(); SWRITE(1, SO);
    RESC(alA); __syncthreads();
  }
  SBAR(); qkt(pB0, pB1, K_lds + SHM_K, qr, r32, hi);
  finishSM(pA0, pA1, alA, l_reg, pa0, pa1, pa2, pa3); SBAR();
  pv_d0(o, vb0, pa0, pa1, pa2, pa3); partialSM(pB0, pB1, m_reg, mnB, alB);
  __syncthreads(); RESC(alB);
  finishSM(pB0, pB1, alB, l_reg, pa0, pa1, pa2, pa3); SBAR();
  pv_d0(o, vb0 + SHM_V, pa0, pa1, pa2, pa3);
  if (hi == 0) li_l[r32] = l_reg; asm volatile("s_waitcnt lgkmcnt(0)" ::: "memory");
  float rli[16];
#pragma unroll
  for (int r = 0; r < 16; ++r) rli[r] = __builtin_amdgcn_rcpf(li_l[crow(r, hi)]);
  bf16_t* Ow = Ob + (long)(wid * QBLK) * LDO;
#pragma unroll
  for (int r = 0; r < 16; ++r) { const int orow = crow(r, hi);
#pragma unroll
    for (int d0 = 0; d0 < 2; ++d0) Ow[(long)orow * LDO + d0 * 32 + r32] = f2bf(o[d0][r] * rli[r]); }
#undef SLOAD
#undef SWRITE
#undef RESC
}
}

DI void phase_attn(const bf16_t* Q, const bf16_t* KA, const bf16_t* VA, bf16_t* MIX, bool last, char* lds) {
    const int c = blockIdx.x, G = gridDim.x, NU = 2048 + (last ? 0 : 256);
    for (int L = c; L < NU; L += G) {
        int bh, seq; long qrow0;
        if (L < 2048) { int qb;
            if (G == 256) { const int i = L >> 8, cc = L & 255, xcd = cc & 7, slot = cc >> 3; bh = i * 32 + xcd * 4 + (slot >> 3); qb = slot & 7; }
            else { bh = L >> 3; qb = L & 7; }
            qrow0 = (long)(bh >> 3) * TT + TC + qb * 256; seq = TT; }
        else { bh = L - 2048; qrow0 = (long)(bh >> 3) * TT; seq = TC; }
        const int b = bh >> 3, h = bh & 7;
        att::attn_body(Q + qrow0 * 768 + h * 96, KA + (long)b * TT * 768 + h * 96, VA + (long)b * TT * 512 + h * 64, MIX + qrow0 * 1024 + h * 64, seq, lds);
        __syncthreads();
    }
}

DI float rowsum16(float x) {
    x += __int_as_float(__builtin_amdgcn_update_dpp(0, __float_as_int(x), 0x128, 0xf, 0xf, false));
    x += __int_as_float(__builtin_amdgcn_update_dpp(0, __float_as_int(x), 0x124, 0xf, 0xf, false));
    x += __int_as_float(__builtin_amdgcn_update_dpp(0, __float_as_int(x), 0x122, 0xf, 0xf, false));
    x += __int_as_float(__builtin_amdgcn_update_dpp(0, __float_as_int(x), 0x121, 0xf, 0xf, false));
    return x;
}
#define RS8_STEP(R) "v_add_f32_dpp %0, %0, %0 " R " row_mask:0xf bank_mask:0xf\n\tv_add_f32_dpp %1, %1, %1 " R " row_mask:0xf bank_mask:0xf\n\t" \
                    "v_add_f32_dpp %2, %2, %2 " R " row_mask:0xf bank_mask:0xf\n\tv_add_f32_dpp %3, %3, %3 " R " row_mask:0xf bank_mask:0xf\n\t" \
                    "v_add_f32_dpp %4, %4, %4 " R " row_mask:0xf bank_mask:0xf\n\tv_add_f32_dpp %5, %5, %5 " R " row_mask:0xf bank_mask:0xf\n\t" \
                    "v_add_f32_dpp %6, %6, %6 " R " row_mask:0xf bank_mask:0xf\n\tv_add_f32_dpp %7, %7, %7 " R " row_mask:0xf bank_mask:0xf\n\t"
DI void sum8x8(float& x0, float& x1, float& x2, float& x3, float& x4, float& x5, float& x6, float& x7) {
    asm volatile("s_nop 1\n\t" RS8_STEP("quad_perm:[1,0,3,2]") RS8_STEP("quad_perm:[2,3,0,1]") RS8_STEP("row_half_mirror")
                 : "+v"(x0), "+v"(x1), "+v"(x2), "+v"(x3), "+v"(x4), "+v"(x5), "+v"(x6), "+v"(x7));
}
typedef float f32x2 __attribute__((ext_vector_type(2)));
DI float dot8(const f32x2 (&s)[4], const f32x4& x0, const f32x4& x1) {
    f32x2 t = s[0] * (f32x2){x0[0], x0[1]};
    t = __builtin_elementwise_fma(s[1], (f32x2){x0[2], x0[3]}, t);
    t = __builtin_elementwise_fma(s[2], (f32x2){x1[0], x1[1]}, t);
    t = __builtin_elementwise_fma(s[3], (f32x2){x1[2], x1[3]}, t);
    return t.x + t.y;
}
DI int scan_row(int d, int b, int n) { const int tt = d == 0 ? n : (n < TC ? TC - 1 - n : TT + TC - 1 - n); return b * TT + tt; }
struct ScanStep { f32x4 a0, a1, w0, w1, b0, b1, k0, k1, q0, q1, v; float br, kr; };
DI void scan_ld(ScanStep& t, const float* p, const float* sc, int cgp, int vrow) {
    t.a0 = *(const f32x4*)(p + 8 * cgp); t.a1 = *(const f32x4*)(p + 8 * cgp + 4); t.w0 = *(const f32x4*)(p + 64 + 8 * cgp); t.w1 = *(const f32x4*)(p + 64 + 8 * cgp + 4);
    t.b0 = *(const f32x4*)(p + 128 + 8 * cgp); t.b1 = *(const f32x4*)(p + 128 + 8 * cgp + 4); t.k0 = *(const f32x4*)(p + 192 + 8 * cgp); t.k1 = *(const f32x4*)(p + 192 + 8 * cgp + 4);
    t.q0 = *(const f32x4*)(p + 256 + 8 * cgp); t.q1 = *(const f32x4*)(p + 256 + 8 * cgp + 4); t.v = *(const f32x4*)(p + 320 + vrow); t.br = sc[0]; t.kr = sc[1];
}
DI void phase_scan(const bf16_t* R, const bf16_t* Kk, const bf16_t* V, const __half* DEC, const bf16_t* AA, const float* INV, const float* kkp, const float* kap,
                   bf16_t* MIX, bf16_t* YB, char* lds) {
    const int tid = ltid(); const bool consumer = tid < 256;
    float* bufA = (float*)lds; float* ybufA = (float*)(lds + 98304); float* sbufA = (float*)(lds + 114688);
    constexpr int NCH = TT / 16;
    for (int s0 = blockIdx.x * 2; s0 < 512; s0 += gridDim.x * 2) {
        const int p_ = tid & 255, pst = p_ >> 4, pj0 = (p_ & 15) * 4;
        const int cw = tid >> 6, cgrp = (cw >> 1) & 1, ws_ = cw & 1, lane = tid & 63, rgl = lane >> 3, cgp = lane & 7, vrow = ws_ * 32 + rgl * 4;
        f32x2 S[4][4];
#pragma unroll
        for (int i = 0; i < 4; ++i)
#pragma unroll
            for (int j = 0; j < 4; ++j) S[i][j] = (f32x2){0.f, 0.f};
#define PRODUCE(c, bsel) do { _Pragma("unroll") for (int gq = 0; gq < 2; ++gq) { \
            const int sid = s0 + gq, d = sid >> 8, b = (sid >> 3) & 31, h = sid & 7, hc = h * 64 + pj0; \
            const size_t m_ = (size_t)scan_row(d, b, (c) * 16 + pst); \
            const u32x2 lr = *(const u32x2*)(R + m_ * 512 + hc), lk = *(const u32x2*)(Kk + m_ * 512 + hc), lv = *(const u32x2*)(V + m_ * 512 + hc), \
                        ld_ = *(const u32x2*)(DEC + m_ * 1024 + d * 512 + hc), la = *(const u32x2*)(AA + m_ * 1024 + d * 512 + hc); const float linv = INV[m_ * 8 + h]; \
            const f32x4 kk4 = *(const f32x4*)(kkp + hc), ka4 = *(const f32x4*)(kap + hc); \
            float* q_ = bufA + gq * 12288 + (bsel) * 6144 + pst * 384 + pj0; float* sd_ = sbufA + gq * 64 + (bsel) * 32; \
            const float k0 = bflo(lk.x), k1 = bfhi(lk.x), k2 = bflo(lk.y), k3 = bfhi(lk.y), a0 = bflo(la.x), a1 = bfhi(la.x), a2 = bflo(la.y), a3 = bfhi(la.y); \
            const float q0 = k0 * kk4[0] * linv, q1 = k1 * kk4[1] * linv, q2 = k2 * kk4[2] * linv, q3 = k3 * kk4[3] * linv; \
            const float w0 = __builtin_amdgcn_exp2f(h2f(ld_.x & 0xffffu)), w1 = __builtin_amdgcn_exp2f(h2f(ld_.x >> 16)), w2 = __builtin_amdgcn_exp2f(h2f(ld_.y & 0xffffu)), w3 = __builtin_amdgcn_exp2f(h2f(ld_.y >> 16)); \
            const float r0 = bflo(lr.x), r1 = bfhi(lr.x), r2 = bflo(lr.y), r3 = bfhi(lr.y); \
            const float b0 = q0 * a0, b1 = q1 * a1, b2 = q2 * a2, b3 = q3 * a3; \
            const float d0 = k0 * (1.f + (a0 - 1.f) * ka4[0]), d1 = k1 * (1.f + (a1 - 1.f) * ka4[1]), d2 = k2 * (1.f + (a2 - 1.f) * ka4[2]), d3 = k3 * (1.f + (a3 - 1.f) * ka4[3]); \
            *(f32x4*)(q_) = (f32x4){-q0, -q1, -q2, -q3}; \
            *(f32x4*)(q_ + 64) = (f32x4){w0, w1, w2, w3}; \
            *(f32x4*)(q_ + 128) = (f32x4){b0, b1, b2, b3}; \
            *(f32x4*)(q_ + 192) = (f32x4){d0, d1, d2, d3}; \
            *(f32x4*)(q_ + 256) = (f32x4){w0 * r0, w1 * r1, w2 * r2, w3 * r3}; \
            *(f32x4*)(q_ + 320) = (f32x4){bflo(lv.x), bfhi(lv.x), bflo(lv.y), bfhi(lv.y)}; \
            const float br_ = rowsum16(b0 * r0 + b1 * r1 + b2 * r2 + b3 * r3), kr_ = rowsum16(d0 * r0 + d1 * r1 + d2 * r2 + d3 * r3); \
            if ((p_ & 15) == 0) { sd_[pst * 2] = br_; sd_[pst * 2 + 1] = kr_; } } } while (0)
#define OUTPUT(c, bsel) do { _Pragma("unroll") for (int gq = 0; gq < 2; ++gq) { \
            const int sid = s0 + gq, d = sid >> 8, b = (sid >> 3) & 31, h = sid & 7, hc = h * 64 + pj0; \
            const f32x4 yv = *(const f32x4*)(ybufA + gq * 2048 + (bsel) * 1024 + pst * 64 + pj0); const size_t m_ = (size_t)scan_row(d, b, (c) * 16 + pst); \
            u32x2 w; w.x = cvtpk(yv[0], yv[1]); w.y = cvtpk(yv[2], yv[3]); \
            if (d == 0) *(u32x2*)(MIX + m_ * 1024 + 512 + hc) = w; else *(u32x2*)(YB + m_ * 512 + hc) = w; } } while (0)
        if (!consumer) PRODUCE(0, 0);
        __syncthreads();
        if (consumer) __builtin_amdgcn_s_setprio(3);
        for (int c = 0; c < NCH; ++c) {
            if (consumer) {
                const float* cur = bufA + cgrp * 12288 + (c & 1) * 6144; float* yb = ybufA + cgrp * 2048 + (c & 1) * 1024; const float* sc = sbufA + cgrp * 64 + (c & 1) * 32;
                ScanStep t; scan_ld(t, cur, sc, cgp, vrow);
#pragma unroll 2
                for (int st = 0; st < 16; ++st) {
                    ScanStep n; scan_ld(n, cur + (st + 1) * 384, sc + (st + 1) * 2, cgp, vrow);
                    float sa0 = dot8(S[0], t.a0, t.a1), sa1 = dot8(S[1], t.a0, t.a1), sa2 = dot8(S[2], t.a0, t.a1), sa3 = dot8(S[3], t.a0, t.a1);
                    float z0 = dot8(S[0], t.q0, t.q1), z1 = dot8(S[1], t.q0, t.q1), z2 = dot8(S[2], t.q0, t.q1), z3 = dot8(S[3], t.q0, t.q1);
                    sum8x8(sa0, sa1, sa2, sa3, z0, z1, z2, z3);
                    const f32x2 w01 = {t.w0[0], t.w0[1]}, w23 = {t.w0[2], t.w0[3]}, w45 = {t.w1[0], t.w1[1]}, w67 = {t.w1[2], t.w1[3]};
                    const f32x2 b01 = {t.b0[0], t.b0[1]}, b23 = {t.b0[2], t.b0[3]}, b45 = {t.b1[0], t.b1[1]}, b67 = {t.b1[2], t.b1[3]};
                    const f32x2 k01 = {t.k0[0], t.k0[1]}, k23 = {t.k0[2], t.k0[3]}, k45 = {t.k1[0], t.k1[1]}, k67 = {t.k1[2], t.k1[3]};
                    const float sa[4] = {sa0, sa1, sa2, sa3};
                    const f32x2 wv[4] = {w01, w23, w45, w67}, bv[4] = {b01, b23, b45, b67}, kv[4] = {k01, k23, k45, k67};
#pragma unroll
                    for (int i = 0; i < 4; ++i)
#pragma unroll
                        for (int j = 0; j < 4; ++j) S[i][j] = S[i][j] * wv[j];
#pragma unroll
                    for (int i = 0; i < 4; ++i) { const f32x2 s2 = {sa[i], sa[i]};
#pragma unroll
                        for (int j = 0; j < 4; ++j) S[i][j] = __builtin_elementwise_fma(s2, bv[j], S[i][j]); }
#pragma unroll
                    for (int i = 0; i < 4; ++i) { const f32x2 v2 = {t.v[i], t.v[i]};
#pragma unroll
                        for (int j = 0; j < 4; ++j) S[i][j] = __builtin_elementwise_fma(v2, kv[j], S[i][j]); }
                    if (cgp == 0) *(f32x4*)(yb + st * 64 + vrow) = (f32x4){z0 + sa0 * t.br + t.v[0] * t.kr, z1 + sa1 * t.br + t.v[1] * t.kr, z2 + sa2 * t.br + t.v[2] * t.kr, z3 + sa3 * t.br + t.v[3] * t.kr};
                    t = n;
                }
            } else {
                if (c + 1 < NCH) PRODUCE(c + 1, (c + 1) & 1);
                if (c > 0) OUTPUT(c - 1, (c - 1) & 1);
            }
            __syncthreads();
        }
        __builtin_amdgcn_s_setprio(0);
        if (!consumer) OUTPUT(NCH - 1, (NCH - 1) & 1);
        __syncthreads();
#undef PRODUCE
#undef OUTPUT
    }
}

DI void phase_prologue(const Args& a, unsigned char* lds) {
    const int tid = ltid(), G = gridDim.x;
    float* out = a.out; float* xc = (float*)(a.ws + WS_XC);
    if (blockIdx.x == 0) {
        float* rope = (float*)(a.ws + WS_ROPE); const int pos = tid >> 3, j = tid & 7;
        const float inv_freq = powf(10000.f, -(float)j / 8.f), ang = (float)pos * inv_freq;
        rope[tid] = cosf(ang); rope[512 + tid] = sinf(ang);
    }
    float* sv = (float*)lds; float* red = sv + 33 * 1024;
    for (int i = tid; i < 33 * 1024; i += 512) { const float v = i < 32 * 1024 ? a.in[I_C][i] : a.in[I_CCTX][i - 32 * 1024]; sv[i] = v / (1.f + __expf(-v)); }
    __syncthreads();
    const int wave = tid >> 6, lane = tid & 63;
    float* mods = (float*)(a.ws + WS_MODS);
    for (int it = blockIdx.x; it < NL * 96; it += G) {
        const int l = it / 96, n0 = (it - l * 96) * 64;
        const float* w = a.in[I_ADAW] + (size_t)l * 1024 * 6144 + n0 + lane;
        float acc[33];
#pragma unroll
        for (int r = 0; r < 33; ++r) acc[r] = 0.f;
        for (int k = wave * 128; k < wave * 128 + 128; k += 8) { float wv[8];
#pragma unroll
            for (int u = 0; u < 8; ++u) wv[u] = w[(size_t)(k + u) * 6144];
#pragma unroll
            for (int u = 0; u < 8; ++u)
#pragma unroll
                for (int r = 0; r < 33; ++r) acc[r] += sv[r * 1024 + k + u] * wv[u]; }
        for (int i = tid; i < 33 * 64; i += 512) red[i] = 0.f;
        __syncthreads();
        for (int ww = 0; ww < 8; ++ww) { if (wave == ww) {
#pragma unroll
                for (int r = 0; r < 33; ++r) red[r * 64 + lane] += acc[r]; }
            __syncthreads(); }
        for (int i = tid; i < 33 * 64; i += 512) { const int r = i >> 6, n = n0 + (i & 63); mods[((size_t)l * 33 + r) * 6144 + n] = red[i] + a.in[I_ADAB][l * 6144 + n]; }
        __syncthreads();
    }
}

DI void phase_vectors(const Args& a, unsigned char* lds) {
    const int tid = ltid(), G = gridDim.x, wave = tid >> 6, lane = tid & 63;
    const float* mods = (const float*)(a.ws + WS_MODS);
    float* gp1 = (float*)(a.ws + WS_GP1); float* gp2 = (float*)(a.ws + WS_GP2);
    for (int i = blockIdx.x * 512 + tid; i < NL * 33 * 1024; i += G * 512) { const int c = i & 1023, lr = i >> 10, l = lr / 33;
        gp1[i] = a.in[I_N1G][l * 1024 + c] * (1.f + mods[(size_t)lr * 6144 + 1024 + c]); gp2[i] = a.in[I_N2G][l * 1024 + c] * (1.f + mods[(size_t)lr * 6144 + 4 * 1024 + c]); }
    float* sv = (float*)lds; float* red = sv + 33 * 1024;
    for (int it = blockIdx.x; it < NL * 101; it += G) {
        const int l = it / 101, ci = it - l * 101, which = ci < 37 ? 0 : 1, n0 = (which ? ci - 37 : ci) * 64, n = n0 + lane;
        __syncthreads();
        for (int i = tid; i < 33 * 1024; i += 512) sv[i] = mods[((size_t)l * 33 + (i >> 10)) * 6144 + (which ? 3 * 1024 : 0) + (i & 1023)];
        for (int i = tid; i < 33 * 64; i += 512) red[i] = 0.f;
        __syncthreads();
        const float* w; int ld; float live = 1.f;
        if (which) { w = a.in[I_M1] + (size_t)l * 1024 * 4096 + n; ld = 4096; }
        else if (n < CIN) { w = a.in[I_WIN] + (size_t)l * 1024 * CIN + n; ld = CIN; }
        else if (n < CINX && l > 0) { w = a.in[I_V1] + (size_t)(l - 1) * 1024 * 32 + (n - CIN); ld = 32; }
        else { w = a.in[I_WIN]; ld = 0; live = 0.f; }
        float acc[33];
#pragma unroll
        for (int r = 0; r < 33; ++r) acc[r] = 0.f;
        for (int k = wave * 128; k < wave * 128 + 128; k += 8) { float wv[8];
#pragma unroll
            for (int u = 0; u < 8; ++u) wv[u] = w[(size_t)(k + u) * ld] * live;
#pragma unroll
            for (int u = 0; u < 8; ++u)
#pragma unroll
                for (int r = 0; r < 33; ++r) acc[r] += sv[r * 1024 + k + u] * wv[u]; }
        for (int ww = 0; ww < 8; ++ww) { if (wave == ww) {
#pragma unroll
                for (int r = 0; r < 33; ++r) red[r * 64 + lane] += acc[r]; }
            __syncthreads(); }
        float* outp = which ? (float*)(a.ws + WS_C2) + (size_t)l * 33 * DFF : (float*)(a.ws + WS_C1) + (size_t)l * 33 * NIN; const int ldo = which ? DFF : NIN;
        for (int i = tid; i < 33 * 64; i += 512) outp[(size_t)(i >> 6) * ldo + n0 + (i & 63)] = red[i];
    }
    {
        const int gw = blockIdx.x * 8 + wave, nw = G * 8; bf16_t* __restrict__ H = (bf16_t*)(a.ws + WS_H); float* __restrict__ rsa = (float*)(a.ws + WS_RSA); const float* __restrict__ gamma = a.in[I_N1G];
        for (int m = gw; m < TALL; m += nw) { const int b = m / TT, tt = m - b * TT; const bool ctx = tt < TC;
            const float* xr = ctx ? a.in[I_CTX] + (size_t)(b * TC + tt) * DM : a.in[I_X] + (size_t)(b * SEQ + tt - TC) * DM; const float* md = mods + (size_t)(ctx ? 32 : b) * 6144 + 1024;
            f32x4 v[4]; float ss = 0.f;
#pragma unroll
            for (int q = 0; q < 4; ++q) { v[q] = *(const f32x4*)(xr + q * 256 + lane * 4); ss += v[q][0] * v[q][0] + v[q][1] * v[q][1] + v[q][2] * v[q][2] + v[q][3] * v[q][3]; }
#pragma unroll
            for (int k = 1; k < 64; k <<= 1) ss = xorsum(ss, k);
            if (lane == 0) rsa[m] = ss;
#pragma unroll
            for (int q = 0; q < 4; ++q) { const int col = q * 256 + lane * 4; const f32x4 g = *(const f32x4*)(gamma + col), sc = *(const f32x4*)(md + col);
                u32x2 w; w.x = cvtpk(v[q][0] * g[0] * (1.f + sc[0]), v[q][1] * g[1] * (1.f + sc[1])); w.y = cvtpk(v[q][2] * g[2] * (1.f + sc[2]), v[q][3] * g[3] * (1.f + sc[3]));
                *(u32x2*)(H + (size_t)m * 1024 + col) = w; } }
    }
}

template <class Gt> DI void cvt_tile(bf16_t* __restrict__ dst, int ldk, int n0, int k0, const Gt& get, float*) {
    const int lane = ltid() & 63, n = n0 + lane;
#pragma unroll
    for (int ch = 0; ch < 4; ++ch) { float v[16];
#pragma unroll
        for (int kk = 0; kk < 16; ++kk) v[kk] = get(n, k0 + ch * 16 + kk);
        u32x4 w0, w1; w0.x = cvtpk(v[0], v[1]); w0.y = cvtpk(v[2], v[3]); w0.z = cvtpk(v[4], v[5]); w0.w = cvtpk(v[6], v[7]);
        w1.x = cvtpk(v[8], v[9]); w1.y = cvtpk(v[10], v[11]); w1.z = cvtpk(v[12], v[13]); w1.w = cvtpk(v[14], v[15]);
        bf16_t* p = dst + (size_t)n * ldk + k0 + ch * 16; *(u32x4*)p = w0; *(u32x4*)(p + 8) = w1; }
}
DI void convert_weights(const Args& a, int l, unsigned char* lds, int group) {
    float* tl = (float*)lds; unsigned char* ws = a.ws;
    const float* w_in = a.in[I_WIN] + (size_t)l * 1024 * CIN; const float* v1 = a.in[I_V1] + (size_t)(l > 0 ? l - 1 : 0) * 1024 * 32;
    const float* w_uq = a.in[I_WUQ] + (size_t)l * 256 * 768; const float* w_ukv = a.in[I_WUKV] + (size_t)l * 128 * 1024;
    const float* w2 = a.in[I_W2] + (size_t)l * 2 * 64 * 512; const float* a2 = a.in[I_A2] + (size_t)l * 2 * 64 * 512;
    const float* g2 = a.in[I_G2] + (size_t)l * 128 * 512; const float* v2 = a.in[I_V2] + (size_t)(l > 0 ? l - 1 : 0) * 32 * 512;
    const float* w_out = a.in[I_WOUT] + (size_t)l * 1024 * 1024; const float* m1 = a.in[I_M1] + (size_t)l * 1024 * 4096; const float* m2 = a.in[I_M2] + (size_t)l * 4096 * 1024;
    constexpr int T0 = 640, T1 = T0 + 48, T2 = T1 + 64, T3 = T2 + 128, T4 = T3 + 64, T5 = T4 + 256, T6 = T5 + 1024, T7 = T6 + 1024;
    const int tb = group == 0 ? 0 : T4, te = group == 0 ? T4 : T7;
    for (int t = tb + blockIdx.x * 8 + (ltid() >> 6); t < te; t += gridDim.x * 8) {
        if (t < T0) { const int nt = t >> 4, kt = t & 15;
            cvt_tile((bf16_t*)(ws + WT_IN), 1024, nt * 64, kt * 64, [&](int n, int k) -> float { return n < CIN ? w_in[(size_t)k * CIN + n] : ((n < CINX && l > 0) ? v1[k * 32 + (n - CIN)] : 0.f); }, tl); }
        else if (t < T1) { const int u = t - T0, nt = u >> 2, kt = u & 3;
            cvt_tile((bf16_t*)(ws + WT_UQ), 256, nt * 64, kt * 64, [&](int n, int k) -> float { return w_uq[k * 768 + n]; }, tl); }
        else if (t < T2) { const int u = t - T1, nt = u >> 2, kt = u & 3;
            if (kt < 2) cvt_tile((bf16_t*)(ws + WT_UKV), 128, nt * 64, kt * 64, [&](int n, int k) -> float { return w_ukv[k * 1024 + n]; }, tl); }
        else if (t < T3) { const int u = t - T2, nt = u >> 2, kt = u & 3;
            cvt_tile((bf16_t*)(ws + WT_L1), 256, nt * 64, kt * 64, [&](int n, int k) -> float {
                if (n < 1024) { const int d = n >> 9, c = n & 511; return (k < 128 && (k >> 6) == d) ? w2[(d * 64 + (k & 63)) * 512 + c] : 0.f; }
                const int n2 = n - 1024, d = n2 >> 9, c = n2 & 511; return (k >= 128 && ((k - 128) >> 6) == d) ? a2[(d * 64 + ((k - 128) & 63)) * 512 + c] : 0.f; }, tl); }
        else if (t < T4) { const int u = t - T3, nt = u >> 2, kt = u & 3;
            cvt_tile((bf16_t*)(ws + WT_L2), 256, nt * 64, kt * 64, [&](int n, int k) -> float {
                if (n < 512) return k < 128 ? g2[k * 512 + n] : 0.f;
                return (l > 0 && k >= 128 && k < 160) ? v2[(k - 128) * 512 + (n - 512)] : 0.f; }, tl); }
        else if (t < T5) { const int u = t - T4, nt = u >> 4, kt = u & 15;
            cvt_tile((bf16_t*)(ws + WT_OUT), 1024, nt * 64, kt * 64, [&](int n, int k) -> float { return w_out[(size_t)k * 1024 + n]; }, tl); }
        else if (t < T6) { const int u = t - T5, nt = u >> 4, kt = u & 15;
            cvt_tile((bf16_t*)(ws + WT_M1), 1024, nt * 64, kt * 64, [&](int n, int k) -> float { return m1[(size_t)k * 4096 + n]; }, tl); }
        else { const int u = t - T6, nt = u >> 6, kt = u & 63;
            cvt_tile((bf16_t*)(ws + WT_M2), 4096, nt * 64, kt * 64, [&](int n, int k) -> float { return m2[(size_t)k * 1024 + n]; }, tl); }
    }
}

DI void unpack8(const u32x4& w, float (&f)[8]) { f[0] = bflo(w.x); f[1] = bfhi(w.x); f[2] = bflo(w.y); f[3] = bfhi(w.y); f[4] = bflo(w.z); f[5] = bfhi(w.z); f[6] = bflo(w.w); f[7] = bfhi(w.w); }
DI void shift8r(const u32x4& c_, const u32x4& p_, const u32x4& n_, const float* __restrict__ mu, int col, float (&o)[8]) {
    float c[8], p[8], n[8], u[8]; unpack8(c_, c); unpack8(p_, p); unpack8(n_, n); loadf8(mu + (col - OFF_R), u);
#pragma unroll
    for (int j = 0; j < 8; ++j) o[j] = c[j] + u[j] * (0.5f * (p[j] + n[j]) - c[j]);
}
DI void phase_split(const Args& a, int l) {
    const int lane = ltid() & 63, gw = blockIdx.x * 8 + (ltid() >> 6), nw = gridDim.x * 8;
    unsigned char* ws = a.ws;
    const bf16_t* __restrict__ F = (const bf16_t*)(ws + WS_F); bf16_t* __restrict__ R = (bf16_t*)(ws + WS_R); bf16_t* __restrict__ Kb = (bf16_t*)(ws + WS_K); bf16_t* __restrict__ Vb = (bf16_t*)(ws + (l == 0 ? WS_VF : WS_V));
    bf16_t* __restrict__ A1 = (bf16_t*)(ws + WS_A1); bf16_t* __restrict__ A2 = (bf16_t*)(ws + WS_A2); bf16_t* __restrict__ CQN = (bf16_t*)(ws + WS_CQN); bf16_t* __restrict__ CKVN = (bf16_t*)(ws + WS_CKVN); bf16_t* __restrict__ KA = (bf16_t*)(ws + WS_KATT);
    float* __restrict__ INV = (float*)(ws + WS_INV); const float* __restrict__ rope = (const float*)(ws + WS_ROPE);
    const float* __restrict__ mu = a.in[I_MU] + (size_t)l * 1920; const float* __restrict__ kkp = a.in[I_KK] + l * 512; const float* __restrict__ qg = a.in[I_QNG] + l * 256; const float* __restrict__ kvg = a.in[I_KVNG] + l * 128;
    const u32x4 zero4 = {0u, 0u, 0u, 0u};
    const int lcol = lane < 48 ? OFF_WLO + lane * 8 : (lane < 52 ? OFF_HV + (lane - 48) * 8 : 0);
    const int mcol = lane < 32 ? lane * 8 : (lane < 48 ? 256 + (lane - 32) * 8 : 384 + ((lane - 48) & 3) * 8);
    const int chunk = (TALL + nw - 1) / nw, m0 = gw * chunk, m1 = (m0 + chunk < TALL) ? m0 + chunk : TALL;
    struct Raw { u32x4 r, k, v, l; };
    auto ld4 = [&](int m) -> Raw { Raw t; if (m >= 0 && m < TALL) { const bf16_t* Fq = F + (size_t)m * CINX; t.r = *(const u32x4*)(Fq + OFF_R + lane * 8); t.k = *(const u32x4*)(Fq + OFF_K + lane * 8);
            t.v = *(const u32x4*)(Fq + OFF_V + lane * 8); t.l = (lane < 52) ? *(const u32x4*)(Fq + lcol) : zero4; } else { t.r = zero4; t.k = zero4; t.v = zero4; t.l = zero4; } return t; };
    auto ldm = [&](int m) -> u32x4 { return (m < TALL) ? *(const u32x4*)(F + (size_t)m * CINX + mcol) : zero4; };
    Raw P = ld4(m0 - 1), C = ld4(m0), N = ld4(m0 + 1); u32x4 M = ldm(m0);
    for (int m = m0; m < m1; ++m) {
        const int b = m / TT, tt = m - b * TT; const bool ctx = tt < TC;
        const bool pok = !(tt == 0 || tt == TC), nok = !(tt == TC - 1 || tt == TT - 1);
        const Raw NN = ld4(m + 2); const u32x4 MN = ldm(m + 1);
        u32x4 rc = C.r, kc = C.k, vc = C.v, lc = C.l, rp = P.r, kp = P.k, vp = P.v, lp = P.l, rn = N.r, kn = N.k, vn = N.v, ln = N.l; const u32x4 mc = M;
        if (!pok) { rp = zero4; kp = zero4; vp = zero4; lp = zero4; }
        if (!nok) { rn = zero4; kn = zero4; vn = zero4; ln = zero4; }
        P = C; C = N; N = NN; M = MN;
        float x[8];
        shift8r(rc, rp, rn, mu, OFF_R + lane * 8, x); store8(R + (size_t)m * 512 + lane * 8, x);
        shift8r(kc, kp, kn, mu, OFF_K + lane * 8, x); store8(Kb + (size_t)m * 512 + lane * 8, x);
        { float kq[8], ss = 0.f; loadf8(kkp + lane * 8, kq);
#pragma unroll
          for (int j = 0; j < 8; ++j) { const float t = x[j] * kq[j]; ss += t * t; }
          ss = xorsum(ss, 1); ss = xorsum(ss, 2); ss = xorsum(ss, 4);
          if ((lane & 7) == 0) INV[(size_t)m * 8 + (lane >> 3)] = rsqrtf(fmaxf(ss, 1e-24f)); }
        shift8r(vc, vp, vn, mu, OFF_V + lane * 8, x); store8(Vb + (size_t)m * 512 + lane * 8, x);
        if (lane < 48) { shift8r(lc, lp, ln, mu, lcol, x);
            if (lane < 16) {
#pragma unroll
                for (int j = 0; j < 8; ++j) x[j] = tanhf_(x[j]); }
            else if (lane >= 32) {
#pragma unroll
                for (int j = 0; j < 8; ++j) x[j] = sigmoidf_(x[j]); }
            if (lane < 32) store8(A1 + (size_t)m * 256 + lane * 8, x); else store8(A2 + (size_t)m * 256 + (lane - 32) * 8, x); }
        else { unpack8(lc, x); store8(A2 + (size_t)m * 256 + 128 + (lane - 48) * 8, x); }
        { unpack8(mc, x); float ss = 0.f;
#pragma unroll
          for (int j = 0; j < 8; ++j) ss += x[j] * x[j];
          ss = xorsum(ss, 1); ss = xorsum(ss, 2); ss = xorsum(ss, 4); ss = xorsum(ss, 8); const float ss32 = xorsum(ss, 16);
          float px[8]; const int q = (lane - 48) & 3;
#pragma unroll
          for (int j = 0; j < 8; ++j) px[j] = __shfl_xor(x[j], 1, 64);
          if (lane < 32) { const float rstd = rsqrtf(ss32 * (1.f / 256.f) + 1e-6f); float g[8]; loadf8(qg + lane * 8, g);
#pragma unroll
              for (int j = 0; j < 8; ++j) x[j] = x[j] * rstd * g[j];
              store8(CQN + (size_t)m * 256 + lane * 8, x); }
          else if (lane < 48) { const float rstd = rsqrtf(ss * (1.f / 128.f) + 1e-6f); float g[8]; loadf8(kvg + (lane - 32) * 8, g);
#pragma unroll
              for (int j = 0; j < 8; ++j) x[j] = x[j] * rstd * g[j];
              store8(CKVN + (size_t)m * 128 + (lane - 32) * 8, x); }
          else { if (lane < 52) {
                  if (!ctx) { const int s = tt - TC, pos = (q < 2) ? (s >> 6) : (s & 63); float cs[8], sn[8]; loadf8(rope + pos * 8, cs); loadf8(rope + 512 + pos * 8, sn); const float sg = (q & 1) ? 1.f : -1.f;
#pragma unroll
                      for (int j = 0; j < 8; ++j) x[j] = x[j] * cs[j] + sg * px[j] * sn[j]; }
#pragma unroll
                  for (int hh = 0; hh < 8; ++hh) store8(KA + (size_t)m * 768 + hh * 96 + 64 + q * 8, x); }
          } }
    }
}

DI void phase_rwkv_out(const Args& a, int l, bool latent_only) {
    const int lane = ltid() & 63, gw = blockIdx.x * 8 + (ltid() >> 6), nw = gridDim.x * 8;
    unsigned char* ws = a.ws;
    const bf16_t* R = (const bf16_t*)(ws + WS_R); const bf16_t* Kb = (const bf16_t*)(ws + WS_K); const bf16_t* Vb = (const bf16_t*)(ws + (l == 0 ? WS_VF : WS_V));
    const bf16_t* AA = (const bf16_t*)(ws + WS_AA); const bf16_t* Gb = (const bf16_t*)(ws + WS_G); const bf16_t* YB = (const bf16_t*)(ws + WS_YB); bf16_t* MIX = (bf16_t*)(ws + WS_MIX);
    const int c = lane * 8; float ka[8], rk[8], lw[8], lb[8];
    loadf8(a.in[I_KA] + l * 512 + c, ka); loadf8(a.in[I_RK] + l * 512 + c, rk); loadf8(a.in[I_LNW] + l * 512 + c, lw); loadf8(a.in[I_LNB] + l * 512 + c, lb);
    for (int m = gw; m < TALL; m += nw) {
        const int tt = m % TT; if (latent_only && tt < TC) continue;
        float yf[8], yb[8], r[8], k[8], v[8], a0[8], a1[8], g[8];
        load8(MIX + (size_t)m * 1024 + 512 + c, yf); load8(YB + (size_t)m * 512 + c, yb); load8(R + (size_t)m * 512 + c, r); load8(Kb + (size_t)m * 512 + c, k); load8(Vb + (size_t)m * 512 + c, v);
        load8(AA + (size_t)m * 1024 + c, a0); load8(AA + (size_t)m * 1024 + 512 + c, a1); load8(Gb + (size_t)m * 512 + c, g);
        float s = 0.f, bon = 0.f;
#pragma unroll
        for (int j = 0; j < 8; ++j) { yf[j] += yb[j]; s += yf[j]; bon += r[j] * k[j] * (2.f + (a0[j] + a1[j] - 2.f) * ka[j]) * rk[j]; }
        s = xorsum(s, 1); s = xorsum(s, 2); s = xorsum(s, 4); bon = xorsum(bon, 1); bon = xorsum(bon, 2); bon = xorsum(bon, 4);
        const float mean = s * (1.f / 64.f); float vs = 0.f;
#pragma unroll
        for (int j = 0; j < 8; ++j) { yf[j] -= mean; vs += yf[j] * yf[j]; }
        vs = xorsum(vs, 1); vs = xorsum(vs, 2); vs = xorsum(vs, 4);
        const float rstd = rsqrtf(vs * (1.f / 64.f) + 64e-5f);
#pragma unroll
        for (int j = 0; j < 8; ++j) yf[j] = (yf[j] * rstd * lw[j] + lb[j] + bon * v[j]) * g[j];
        store8(MIX + (size_t)m * 1024 + 512 + c, yf);
    }
}

DI void phase_final(const Args& a) {
    const int lane = ltid() & 63, gw = blockIdx.x * 8 + (ltid() >> 6), nw = gridDim.x * 8; const float* gamma = a.in[I_FG];
    for (int m = gw; m < NB * SEQ; m += nw) {
        float* xr = a.out + (size_t)m * DM; f32x4 v[4]; float ss = 0.f;
#pragma unroll
        for (int i = 0; i < 4; ++i) { v[i] = *(const f32x4*)(xr + i * 256 + lane * 4); ss += v[i][0] * v[i][0] + v[i][1] * v[i][1] + v[i][2] * v[i][2] + v[i][3] * v[i][3]; }
#pragma unroll
        for (int k = 1; k < 64; k <<= 1) ss = xorsum(ss, k);
        const float rstd = rsqrtf(ss * (1.f / 1024.f) + 1e-6f);
#pragma unroll
        for (int i = 0; i < 4; ++i) { const int col = i * 256 + lane * 4; const f32x4 g = *(const f32x4*)(gamma + col); *(f32x4*)(xr + col) = v[i] * rstd * g; }
    }
}

#define LAS __attribute__((address_space(3)))
#define XB_TMO      128
#define XB_XCNT(j)  (256  + 64 * (j))
#define XB_XSUB(j)  (1280 + 64 * (j))
#define XB_XGEN(j)  (2304 + 64 * (j))
#define XB_TOP      3328
#define XB_TOPGEN   3392
#define XCD_BAR_WORDS 3456
#define XB_SPIN_CAP (1u << 18)

__device__ __forceinline__ unsigned xb_ld(unsigned* p)              { return __hip_atomic_load(p, __ATOMIC_RELAXED, __HIP_MEMORY_SCOPE_AGENT); }
__device__ __forceinline__ unsigned xb_add(unsigned* p, unsigned v) { return __hip_atomic_fetch_add(p, v, __ATOMIC_RELAXED, __HIP_MEMORY_SCOPE_AGENT); }
__device__ __forceinline__ unsigned xb_xcc_id() { return (unsigned)__builtin_amdgcn_s_getreg((3 << 11) | 20) & 0xFu; }
#define XB_SPIN(cond, bar) do { unsigned _sp = 0; while (cond) { __builtin_amdgcn_s_sleep(1); \
    if ((++_sp & 255u) == 0u) { if (xb_ld(&(bar)[XB_TMO])) break; if (_sp > XB_SPIN_CAP) { atomicAdd(&(bar)[XB_TMO], 1u); break; } } } } while (0)

struct XcdBarrier {
    unsigned* bar; unsigned x;
    volatile LAS unsigned* st;
};

__device__ __forceinline__ XcdBarrier xcd_barrier_post(unsigned* bar, volatile LAS unsigned* st) {
    XcdBarrier b; b.bar = bar; b.x = xb_xcc_id(); b.st = st;
    if (threadIdx.x == 0) (void)xb_add(&bar[XB_XCNT(b.x)], 1u);
    return b;
}
__device__ __forceinline__ void xcd_barrier_complete(unsigned* bar, unsigned x, unsigned& nloc, unsigned& nx) {
    const unsigned G = gridDim.x * gridDim.y * gridDim.z;
    unsigned sum, cnt, mine, sp = 0u;
    for (;;) {
        sum = 0u; cnt = 0u; mine = 0u;
#pragma unroll
        for (unsigned j = 0; j < 16; ++j) { const unsigned c = xb_ld(&bar[XB_XCNT(j)]); sum += c; cnt += (c > 0u) ? 1u : 0u; mine = (j == x) ? c : mine; }
        if (sum == G) break;
        __builtin_amdgcn_s_sleep(1);
        if ((++sp & 255u) == 0u) { if (xb_ld(&bar[XB_TMO])) break; if (sp > XB_SPIN_CAP) { atomicAdd(&bar[XB_TMO], 1u); break; } }
    }
    nloc = mine > 0u ? mine : 1u; nx = cnt > 0u ? cnt : 1u;
}

__device__ __forceinline__ void xcd_barrier(const XcdBarrier& b) {
    asm volatile("s_waitcnt vmcnt(0)" ::: "memory");
    __syncthreads();
    if (threadIdx.x == 0) {
        unsigned* bar = b.bar;
        __builtin_amdgcn_s_waitcnt(0);
        unsigned nloc = b.st[0], nx = b.st[1];
        if (nloc == 0u) { xcd_barrier_complete(bar, b.x, nloc, nx); b.st[0] = nloc; b.st[1] = nx; }
        const unsigned old = xb_add(&bar[XB_XSUB(b.x)], 1u);
        const unsigned gen = old / nloc;
        if (old + 1u == (gen + 1u) * nloc) {
            __builtin_amdgcn_fence(__ATOMIC_RELEASE, "agent");
            asm volatile("s_waitcnt vmcnt(0)" ::: "memory");
            const unsigned og = xb_add(&bar[XB_TOP], 1u);
            const unsigned tg = og / nx;
            if (og + 1u == (tg + 1u) * nx) xb_add(&bar[XB_TOPGEN], 1u);
            else XB_SPIN(xb_ld(&bar[XB_TOPGEN]) == tg, bar);
            __builtin_amdgcn_fence(__ATOMIC_ACQUIRE, "agent");
            xb_add(&bar[XB_XGEN(b.x)], 1u);
            asm volatile("s_waitcnt vmcnt(0)" ::: "memory");
        } else {
            XB_SPIN(xb_ld(&bar[XB_XGEN(b.x)]) == gen, bar);
            __builtin_amdgcn_fence(__ATOMIC_ACQUIRE, "agent");
            asm volatile("s_waitcnt vmcnt(0)" ::: "memory");
        }
    }
    __syncthreads();
}

__global__ void __launch_bounds__(512, 2) trunk_fwd(Args ka) {
    extern __shared__ __attribute__((aligned(16))) unsigned char lds[];
    cg::grid_group grid = cg::this_grid();
    volatile LAS unsigned* bst = (volatile LAS unsigned*)((LAS unsigned char*)lds + (LDS_BYTES - 16));
    if (threadIdx.x < 4) bst[threadIdx.x] = 0u;
    __syncthreads();
    XcdBarrier xbar = xcd_barrier_post((unsigned*)(ka.ws + WS_BAR), bst);
    const int ph_hi = ka.hi;
    {
        if (blockIdx.x == 0 && threadIdx.x == 0) {
#pragma unroll
            for (int i = 0; i < 31; ++i) ((const float**)(ka.ws + WS_TAB))[i] = ka.in[i]; }
        phase_prologue(ka, lds); convert_weights(ka, 0, lds, 0);
        grid.sync();
    }
    for (int ph = 1; ph < ph_hi; ++ph) {
        Args a; a.ws = ka.ws; a.out = ka.out; asm volatile("" : "+s"(a.ws)); asm volatile("" : "+s"(a.out));
        { const float* const* tab = (const float* const*)(a.ws + WS_TAB);
#define LD4(i) asm volatile("s_load_dwordx2 %0, %4, %5\n\ts_load_dwordx2 %1, %4, %6\n\ts_load_dwordx2 %2, %4, %7\n\ts_load_dwordx2 %3, %4, %8\n\ts_waitcnt lgkmcnt(0)" \
              : "=&s"(a.in[i]), "=&s"(a.in[i + 1]), "=&s"(a.in[i + 2]), "=&s"(a.in[i + 3]) : "s"(tab), "i"((i) * 8), "i"((i) * 8 + 8), "i"((i) * 8 + 16), "i"((i) * 8 + 24))
          LD4(0); LD4(4); LD4(8); LD4(12); LD4(16); LD4(20); LD4(24);
          asm volatile("s_load_dwordx2 %0, %3, %4\n\ts_load_dwordx2 %1, %3, %5\n\ts_load_dwordx2 %2, %3, %6\n\ts_waitcnt lgkmcnt(0)" : "=&s"(a.in[28]), "=&s"(a.in[29]), "=&s"(a.in[30]) : "s"(tab), "i"(224), "i"(232), "i"(240));
#undef LD4
        }
        a.lo = 0; a.hi = 0;
        unsigned char* ws = a.ws;
        if (ph == 1) phase_vectors(a, lds);
        else if (ph == NPH - 1) phase_final(a);
        else {
            const int l = (ph - 2) / 10, s = (ph - 2) % 10; const bool last = (l == NL - 1);
            const float* mods = (const float*)(ws + WS_MODS) + (size_t)l * 33 * 6144;
            float* rsa = (float*)(ws + WS_RSA); float* rsb = (float*)(ws + WS_RSB);
            if (s == 0) { run_gemm<NIN, 1024>(lds, (const bf16_t*)(ws + WS_H), (const bf16_t*)(ws + WT_IN), 0, FnF{(bf16_t*)(ws + WS_F), rsa, (const float*)(ws + WS_C1) + (size_t)l * 33 * NIN}); }
            else if (s == 1) { phase_split(a, l); convert_weights(a, l, lds, 1);
                for (int i = blockIdx.x * 512 + ltid(); i < TALL; i += gridDim.x * 512) { rsa[i] = 0.f; rsb[i] = 0.f; } }
            else if (s == 2) { run_gemm<768, 256>(lds, (const bf16_t*)(ws + WS_CQN), (const bf16_t*)(ws + WT_UQ), 0, FnQ{(bf16_t*)(ws + WS_Q), (const float*)(ws + WS_ROPE)});
                    run_gemm<1024, 128>(lds, (const bf16_t*)(ws + WS_CKVN), (const bf16_t*)(ws + WT_UKV), 0, FnKV{(bf16_t*)(ws + WS_KATT), (bf16_t*)(ws + WS_VATT)}); }
            else if (s == 3) { phase_attn((const bf16_t*)(ws + WS_Q), (const bf16_t*)(ws + WS_KATT), (const bf16_t*)(ws + WS_VATT), (bf16_t*)(ws + WS_MIX), last, (char*)lds); }
            else if (s == 4) { run_gemm<2048, 256>(lds, (const bf16_t*)(ws + WS_A1), (const bf16_t*)(ws + WT_L1), 0, FnL1{(__half*)(ws + WS_DEC), (bf16_t*)(ws + WS_AA), a.in[I_W0] + l * 1024, a.in[I_A0] + l * 1024});
                    run_gemm<1024, 256>(lds, (const bf16_t*)(ws + WS_A2), (const bf16_t*)(ws + WT_L2), 0,
                             FnL2{(bf16_t*)(ws + WS_G), (bf16_t*)(ws + WS_V), (const bf16_t*)(ws + WS_VF), a.in[I_V0] + (l > 0 ? l - 1 : 0) * 512, l > 0 ? 1 : 0}); }
            else if (s == 5) { phase_scan((const bf16_t*)(ws + WS_R), (const bf16_t*)(ws + WS_K), (const bf16_t*)(ws + (l == 0 ? WS_VF : WS_V)), (const __half*)(ws + WS_DEC), (const bf16_t*)(ws + WS_AA),
                               (const float*)(ws + WS_INV), a.in[I_KK] + l * 512, a.in[I_KA] + l * 512, (bf16_t*)(ws + WS_MIX), (bf16_t*)(ws + WS_YB), (char*)lds); }
            else if (s == 6) { phase_rwkv_out(a, l, last); if (!last) convert_weights(a, l + 1, lds, 0); }
            else if (s == 7) { run_gemm_epi<1024, 1024>(lds, (const bf16_t*)(ws + WS_MIX), (const bf16_t*)(ws + WT_OUT), last ? 1 : 0,
                             EpiRes{a.out, (float*)(ws + WS_XC), l == 0 ? a.in[I_X] : a.out, l == 0 ? a.in[I_CTX] : (const float*)(ws + WS_XC), mods, 2,
                                    (const float*)(ws + WS_GP2) + (size_t)l * 33 * 1024, (bf16_t*)(ws + WS_H), rsb, 1}); }
            else if (s == 8) { run_gemm<DFF, 1024>(lds, (const bf16_t*)(ws + WS_H), (const bf16_t*)(ws + WT_M1), last ? 1 : 0, FnM1{(bf16_t*)(ws + WS_HID), rsb, (const float*)(ws + WS_C2) + (size_t)l * 33 * DFF}); }
            else if (s == 9) { run_gemm_epi<1024, DFF>(lds, (const bf16_t*)(ws + WS_HID), (const bf16_t*)(ws + WT_M2), last ? 1 : 0,
                             EpiRes{a.out, (float*)(ws + WS_XC), a.out, (const float*)(ws + WS_XC), mods, 5,
                                    (const float*)(ws + WS_GP1) + (size_t)(last ? l : l + 1) * 33 * 1024, (bf16_t*)(ws + WS_H), rsa, last ? 0 : 1}); }
        }
        if (ph + 1 < ph_hi) { XcdBarrier xb = xbar; asm volatile("" : "+s"(xb.bar)); xcd_barrier(xb); }
    }
}

extern "C" void kernel_launch(void* const* d_in, const int* in_sizes, int n_in, void* d_out, int out_size, void* d_ws, size_t ws_size, hipStream_t stream) {
    static int grid = 0;
    if (grid == 0) {
        if (n_in != 31 || out_size != NB * SEQ * DM || ws_size < WS_END) { fprintf(stderr, "kernel_launch: unexpected shapes: n_in %d out %d ws %zu (need %zu)\n", n_in, out_size, ws_size, (size_t)WS_END); grid = -1; return; }
        int dev = 0, cus = 0, per_cu = 0;
        (void)hipGetDevice(&dev); (void)hipDeviceGetAttribute(&cus, hipDeviceAttributeMultiprocessorCount, dev);
        if (hipFuncSetAttribute((const void*)trunk_fwd, hipFuncAttributeMaxDynamicSharedMemorySize, LDS_BYTES) != hipSuccess) { fprintf(stderr, "kernel_launch: hipFuncSetAttribute failed\n"); grid = -1; return; }
        if (hipOccupancyMaxActiveBlocksPerMultiprocessor(&per_cu, (const void*)trunk_fwd, 512, LDS_BYTES) != hipSuccess || per_cu < 1) { fprintf(stderr, "kernel_launch: occupancy query gave %d\n", per_cu); per_cu = 1; }
        (void)hipGetLastError();
        grid = cus * 1;
    }
    if (grid < 0) return;
    if (hipMemsetAsync((char*)d_ws + WS_BAR, 0, BAR_BYTES, stream) != hipSuccess) { fprintf(stderr, "kernel_launch: hipMemsetAsync failed\n"); return; }
    Args a{};
    for (int i = 0; i < 31; ++i) a.in[i] = (const float*)d_in[i];
    a.out = (float*)d_out; a.ws = (unsigned char*)d_ws; a.lo = 0; a.hi = NPH;
    void* args[] = {&a};
    hipError_t e = hipLaunchCooperativeKernel((const void*)trunk_fwd, dim3(grid), dim3(512), args, LDS_BYTES, stream);
    if (e != hipSuccess) fprintf(stderr, "kernel_launch: cooperative launch failed: %s (grid %d)\n", hipGetErrorString(e), grid);
}
```

```cpp
#include <hip/hip_runtime.h>
#include <hip/hip_cooperative_groups.h>
#include <hip/hip_fp16.h>
#include <cstdio>
#include <cstdint>
namespace cg = cooperative_groups;
#define DI __device__ __forceinline__
DI int ltid() { int t = threadIdx.x; asm volatile("" : "+v"(t)); return t; }
namespace pg8 {
#define PG8_LAS __attribute__((address_space(3)))
typedef unsigned short bf16_t;
typedef short bf16x8 __attribute__((ext_vector_type(8)));
typedef float f32x4 __attribute__((ext_vector_type(4)));
typedef unsigned u32x4 __attribute__((ext_vector_type(4)));
constexpr int BM = 256, BK = 64, HALF = 128, HTB = HALF * BK * 2  , STAGE_BYTES = 8 * HTB, NXCD = 8, WGM = 8;

__host__ __device__ __forceinline__ int lds_byte(int r, int c) { const int st = (r >> 4) * 2 + (c >> 5), rr = r & 15, cc = c & 31, ob = rr * 64 + cc * 2; return st * 1024 + (ob ^ (((ob >> 9) & 1) << 5)); }
__host__ __device__ __forceinline__ void stage_rc(int b, int& R, int& C) { const int st = b / 1024, sb = b % 1024, swz = sb ^ (((sb >> 9) & 1) << 5); R = (st >> 1) * 16 + swz / 64; C = (st & 1) * 32 + (swz % 64) / 2; }
__host__ __device__ __forceinline__ int perm32(int rho) { const int n = rho >> 4, i = rho & 15; return 8 * (i >> 2) + 4 * n + (i & 3); }

struct Unit { int pm, pn; };
struct Gemm { const bf16_t* A; const bf16_t* Bt; int M, N, K; };

struct StaticOrder {
    int nM, nN, nwg, G, c;
    __host__ __device__ void init(int M, int N, int G_, int c_) { nM = M / BM; nN = N / BM; nwg = nM * nN; G = G_; c = c_; }
    __host__ __device__ bool next(int i, Unit& u) const {
        const long L = (long)i * G + c; if (L >= nwg) return false;
        int wgid = (int)L; { const int q = nwg / NXCD, r = nwg % NXCD, xcd = wgid % NXCD, off = wgid / NXCD; wgid = (xcd < r ? xcd * (q + 1) : r * (q + 1) + (xcd - r) * q) + off; }
        const int nig = WGM * nN, gid = wgid / nig, fm = gid * WGM, gsz = (nM - fm) < WGM ? (nM - fm) : WGM;
        u.pm = fm + ((wgid % nig) % gsz); u.pn = (wgid % nig) / gsz; return true;
    }
    __device__ __forceinline__ void a_ready(const Unit&) const {}
    __device__ __forceinline__ void done(const Unit&) const {}
};

__device__ __forceinline__ unsigned cvt_pk_bf16(float lo, float hi) { unsigned r; asm volatile("v_cvt_pk_bf16_f32 %0, %1, %2" : "=v"(r) : "v"(lo), "v"(hi)); return r; }

template <class Epi, class Sched, bool ALIGN_EPI = false, bool SP2 = false>
__device__ __forceinline__ void gemm_phase(PG8_LAS unsigned char* lds, const Gemm g, const Sched& S, const Epi& E) {
    const int tid = ltid(), wid = __builtin_amdgcn_readfirstlane(tid >> 6), lane = tid & 63, wr = wid >> 2, wc = wid & 3, fr = lane & 15, fq = lane >> 4;
    const int K = g.K, nt = K / BK;
    unsigned voffA[2], voffB[2];
#pragma unroll
    for (int i = 0; i < 2; ++i) { int R, C; stage_rc(tid * 16 + i * 8192, R, C); const int Rb = Epi::PERM ? ((R & ~31) + perm32(R & 31)) : R;
        voffA[i] = (unsigned)(R * K + C) * 2u; voffB[i] = (unsigned)(Rb * K + C) * 2u; }
    const size_t kstep = (size_t)(BK * 2);
    const size_t hstep = (size_t)HALF * K * 2;
    const size_t tstep = 2 * hstep;
    const unsigned ldsw = (unsigned)wid * 1024u;
    const int aoff = lds_byte(wr * 64 + fr, fq * 8), boff = lds_byte(wc * 32 + fr, fq * 8);
#define PG8_SA(b, h) (((b) * 2 + (h)) * HTB)
#define PG8_SB(b, h) ((4 + (b) * 2 + (h)) * HTB)
#define PG8_STAGE(bufoff, gbase, voff) do { _Pragma("unroll") for (int _i = 0; _i < 2; ++_i) \
        __builtin_amdgcn_global_load_lds((const unsigned*)((const char*)(gbase) + (voff)[_i]), (PG8_LAS unsigned*)(lds + (bufoff) + ldsw + _i * 8192), 16, 0, 0); } while (0)
#define PG8_LDA(dst, b, h) do { _Pragma("unroll") for (int m = 0; m < 4; ++m) _Pragma("unroll") for (int k = 0; k < 2; ++k) dst[m][k] = *(const PG8_LAS bf16x8*)(lds + PG8_SA(b, h) + aoff + m * 2048 + k * 1024); } while (0)
#define PG8_LDB(dst, b, h) do { _Pragma("unroll") for (int n = 0; n < 2; ++n) _Pragma("unroll") for (int k = 0; k < 2; ++k) dst[n][k] = *(const PG8_LAS bf16x8*)(lds + PG8_SB(b, h) + boff + n * 2048 + k * 1024); } while (0)
#define PG8_MMA(ai, bj, At, Bt) do { __builtin_amdgcn_s_setprio(1); _Pragma("unroll") for (int m = 0; m < 4; ++m) _Pragma("unroll") for (int n = 0; n < 2; ++n) _Pragma("unroll") for (int k = 0; k < 2; ++k) \
        acc[ai][bj][m][n] = __builtin_amdgcn_mfma_f32_16x16x32_bf16(Bt[n][k], At[m][k], acc[ai][bj][m][n], 0, 0, 0); __builtin_amdgcn_s_setprio(0); } while (0)
#define PG8_WAIT_V(n) asm volatile("s_waitcnt vmcnt(" #n ")" ::: "memory")
#define PG8_WAIT_L(n) asm volatile("s_waitcnt lgkmcnt(" #n ")" ::: "memory")
#define PG8_BAR __builtin_amdgcn_s_barrier()
#define PG8_SCHED __builtin_amdgcn_sched_barrier(0)
    Unit cur, nxt; int ui = 0;
    if (!S.next(0, cur)) return;
    f32x4 acc[2][2][4][2];
#pragma unroll
    for (int a = 0; a < 2; ++a)
#pragma unroll
        for (int b = 0; b < 2; ++b)
#pragma unroll
            for (int m = 0; m < 4; ++m)
#pragma unroll
                for (int n = 0; n < 2; ++n) acc[a][b][m][n] = (f32x4){0.f, 0.f, 0.f, 0.f};
    bf16x8 At[4][2], B0[2][2], B1[2][2];
    const char* cA = (const char*)g.A + (size_t)cur.pm * tstep; const char* cB = (const char*)g.Bt + (size_t)cur.pn * tstep;
    S.a_ready(cur);
    if constexpr (SP2) {
        PG8_STAGE(PG8_SB(0, 0), cB, voffB); PG8_STAGE(PG8_SB(0, 1), cB + hstep, voffB); PG8_STAGE(PG8_SA(0, 0), cA, voffA); PG8_STAGE(PG8_SA(0, 1), cA + hstep, voffA);
        if (wr == 1) PG8_BAR;
        PG8_WAIT_V(2); PG8_BAR;
        PG8_STAGE(PG8_SB(1, 0), cB + kstep, voffB); PG8_STAGE(PG8_SA(1, 0), cA + kstep, voffA); PG8_STAGE(PG8_SB(1, 1), cB + hstep + kstep, voffB);
        PG8_WAIT_V(6); PG8_BAR;
    } else {
        PG8_STAGE(PG8_SB(0, 0), cB, voffB); PG8_STAGE(PG8_SA(0, 0), cA, voffA); PG8_STAGE(PG8_SB(0, 1), cB + hstep, voffB); PG8_STAGE(PG8_SA(0, 1), cA + hstep, voffA);
        if (wr == 1) PG8_BAR;
        PG8_WAIT_V(4); PG8_BAR;
        PG8_STAGE(PG8_SB(1, 0), cB + kstep, voffB); PG8_STAGE(PG8_SA(1, 0), cA + kstep, voffA); PG8_STAGE(PG8_SB(1, 1), cB + hstep + kstep, voffB);
        PG8_WAIT_V(6); PG8_BAR;
    }
    for (;;) {
        const bool has_next = S.next(ui + 1, nxt);
        const char* nA = has_next ? (const char*)g.A + (size_t)nxt.pm * tstep : cA; const char* nB = has_next ? (const char*)g.Bt + (size_t)nxt.pn * tstep : cB;
#pragma nounroll
        for (int t = 0; t < nt; t += 2) {
            const bool last = (t == nt - 2);
            const char* a1 = cA + (size_t)(t + 1) * kstep;
            const char* a2 = last ? nA : cA + (size_t)(t + 2) * kstep; const char* b2 = last ? nB : cB + (size_t)(t + 2) * kstep;
            const char* a3 = a2 + kstep; const char* b3 = b2 + kstep;
            if (last && has_next) S.a_ready(nxt);
            if constexpr (SP2) {
            PG8_LDB(B0, 0, 0); PG8_LDB(B1, 0, 1); PG8_SCHED; PG8_LDA(At, 0, 0); PG8_STAGE(PG8_SA(1, 1), a1 + hstep, voffA);
            PG8_WAIT_V(8); PG8_WAIT_L(0); PG8_BAR; PG8_MMA(0, 0, At, B0); PG8_MMA(0, 1, At, B1); PG8_BAR; PG8_SCHED;
            PG8_LDA(At, 0, 1); PG8_STAGE(PG8_SB(0, 0), b2, voffB); PG8_STAGE(PG8_SB(0, 1), b2 + hstep, voffB); PG8_STAGE(PG8_SA(0, 0), a2, voffA);
            PG8_WAIT_V(8); PG8_WAIT_L(0); PG8_BAR; PG8_MMA(1, 0, At, B0); PG8_MMA(1, 1, At, B1); PG8_BAR; PG8_SCHED;
            PG8_LDB(B0, 1, 0); PG8_LDB(B1, 1, 1); PG8_SCHED; PG8_LDA(At, 1, 0); PG8_STAGE(PG8_SA(0, 1), a2 + hstep, voffA);
            PG8_WAIT_V(8); PG8_WAIT_L(0); PG8_BAR; PG8_MMA(0, 0, At, B0); PG8_MMA(0, 1, At, B1); PG8_BAR; PG8_SCHED;
            PG8_LDA(At, 1, 1); PG8_STAGE(PG8_SB(1, 0), b3, voffB); PG8_STAGE(PG8_SB(1, 1), b3 + hstep, voffB); PG8_STAGE(PG8_SA(1, 0), a3, voffA);
            PG8_WAIT_V(8); PG8_WAIT_L(0); PG8_BAR; PG8_MMA(1, 0, At, B0); PG8_MMA(1, 1, At, B1); PG8_BAR; PG8_SCHED;
            } else {
            PG8_LDB(B0, 0, 0); PG8_SCHED; PG8_LDA(At, 0, 0); PG8_STAGE(PG8_SA(1, 1), a1 + hstep, voffA);
            PG8_WAIT_L(8); PG8_BAR; PG8_WAIT_L(0); PG8_MMA(0, 0, At, B0); PG8_BAR; PG8_SCHED;
            PG8_LDB(B1, 0, 1); PG8_STAGE(PG8_SB(0, 0), b2, voffB);
            PG8_BAR; PG8_WAIT_L(0); PG8_MMA(0, 1, At, B1); PG8_BAR;
            PG8_LDA(At, 0, 1); PG8_STAGE(PG8_SA(0, 0), a2, voffA);
            PG8_BAR; PG8_WAIT_L(0); PG8_MMA(1, 0, At, B0); PG8_BAR; PG8_SCHED;
            PG8_STAGE(PG8_SB(0, 1), b2 + hstep, voffB);
            PG8_WAIT_V(6); PG8_BAR; PG8_MMA(1, 1, At, B1); PG8_BAR;
            PG8_LDB(B0, 1, 0); PG8_SCHED; PG8_LDA(At, 1, 0); PG8_STAGE(PG8_SA(0, 1), a2 + hstep, voffA);
            PG8_WAIT_L(8); PG8_BAR; PG8_WAIT_L(0); PG8_MMA(0, 0, At, B0); PG8_BAR; PG8_SCHED;
            PG8_LDB(B1, 1, 1); PG8_STAGE(PG8_SB(1, 0), b3, voffB);
            PG8_BAR; PG8_WAIT_L(0); PG8_MMA(0, 1, At, B1); PG8_BAR;
            PG8_LDA(At, 1, 1); PG8_STAGE(PG8_SA(1, 0), a3, voffA);
            PG8_BAR; PG8_WAIT_L(0); PG8_MMA(1, 0, At, B0); PG8_BAR; PG8_SCHED;
            PG8_STAGE(PG8_SB(1, 1), b3 + hstep, voffB);
            PG8_WAIT_V(6); PG8_BAR; PG8_MMA(1, 1, At, B1); PG8_BAR;
            }
        }
        if constexpr (ALIGN_EPI) { if (wr == 0) PG8_BAR; }
        if constexpr (!Epi::AFTER_DRAIN) { E(acc, cur, wr, wc, fr, fq); S.done(cur); }
        if (!has_next) break;
#pragma unroll
        for (int a = 0; a < 2; ++a)
#pragma unroll
            for (int b = 0; b < 2; ++b)
#pragma unroll
                for (int m = 0; m < 4; ++m)
#pragma unroll
                    for (int n = 0; n < 2; ++n) acc[a][b][m][n] = (f32x4){0.f, 0.f, 0.f, 0.f};
        cur = nxt; cA = nA; cB = nB; ++ui;
        if constexpr (ALIGN_EPI) { if (wr == 1) PG8_BAR; }
    }
    PG8_WAIT_V(0);
    if constexpr (!ALIGN_EPI) { if (wr == 0) PG8_BAR; }
    PG8_BAR;
    if constexpr (Epi::AFTER_DRAIN) { E.fused(acc, cur, wr, wc, fr, fq, lds, wid, lane); S.done(cur); }
#undef PG8_SA
#undef PG8_SB
#undef PG8_STAGE
#undef PG8_LDA
#undef PG8_LDB
#undef PG8_MMA
#undef PG8_WAIT_V
#undef PG8_WAIT_L
#undef PG8_BAR
#undef PG8_SCHED
}
}
typedef unsigned short bf16_t;
using bf16x8 = __attribute__((ext_vector_type(8))) short;
using s16x4  = __attribute__((ext_vector_type(4))) short;
using f32x16 = __attribute__((ext_vector_type(16))) float;
using f32x4  = __attribute__((ext_vector_type(4))) float;
using u32x4  = __attribute__((ext_vector_type(4))) unsigned;
using u32x2  = __attribute__((ext_vector_type(2))) unsigned;

constexpr int DM = 1024, NB = 32, SEQ = 2048, TC = 256, TT = 2304, TALL = NB * TT, NL = 4;
constexpr int CIN = 2336, CINX = 2368, NIN = 2560, DFF = 4096;
constexpr int OFF_R = 416, OFF_K = 928, OFF_V = 1440, OFF_WLO = 1952, OFF_HV = 2336;
constexpr int NPH = 43, LDS_BYTES = 147456;
constexpr size_t MiB = 1u << 20;
constexpr size_t WS_MODS = 0, WS_ROPE = 3 * MiB + 512 * 1024, WS_BAR = 3 * MiB + 768 * 1024, BAR_BYTES = 16384, WS_TAB = 3 * MiB + 800 * 1024, WS_XC = 4 * MiB, WS_VF = 36 * MiB, WS_WT = 108 * MiB, WS_INV = 134 * MiB, TR = 137 * MiB;
constexpr size_t WT_IN = WS_WT, WT_UQ = WS_WT + 5 * MiB, WT_UKV = WS_WT + 5 * MiB + 512 * 1024, WT_L1 = WS_WT + 6 * MiB, WT_L2 = WS_WT + 7 * MiB,
                 WT_OUT = WS_WT + 8 * MiB, WT_M1 = WS_WT + 10 * MiB, WT_M2 = WS_WT + 18 * MiB;
constexpr size_t WS_R = TR, WS_K = TR + 72 * MiB, WS_H = TR, WS_F = TR + 144 * MiB, WS_Q = TR + 144 * MiB, WS_VATT = TR + 252 * MiB, WS_MIX = TR + 324 * MiB,
                 WS_DEC = TR + 144 * MiB, WS_HID = TR + 144 * MiB, WS_A1 = TR + 477 * MiB, WS_A2 = TR + 513 * MiB, WS_YB = TR + 477 * MiB,
                 WS_CQN = TR + 549 * MiB, WS_CKVN = TR + 585 * MiB, WS_KATT = TR + 621 * MiB, WS_AA = TR + 585 * MiB, WS_G = TR + 729 * MiB,
                 WS_V = TR + 801 * MiB, WS_C1 = 1010 * MiB, WS_C2 = 1012 * MiB, WS_GP1 = 1015 * MiB, WS_GP2 = 1016 * MiB, WS_END = 1017 * MiB;
constexpr size_t WS_RSA = 136 * MiB + 256 * 1024, WS_RSB = 136 * MiB + 640 * 1024;

struct Args { const float* in[31]; float* out; unsigned char* ws; int lo, hi; };
enum { I_X = 0, I_C, I_CTX, I_CCTX, I_ADAW, I_ADAB, I_N1G, I_N2G, I_WIN, I_QNG, I_WUQ, I_KVNG, I_WUKV, I_MU, I_W0, I_W2, I_A0, I_A2, I_G2, I_KK, I_KA, I_RK,
       I_LNW, I_LNB, I_V1, I_V2, I_V0, I_WOUT, I_M1, I_M2, I_FG };

DI float bflo(unsigned w) { return __uint_as_float(w << 16); }
DI float bfhi(unsigned w) { return __uint_as_float(w & 0xffff0000u); }
DI unsigned cvtpk(float lo, float hi) { return pg8::cvt_pk_bf16(lo, hi); }
DI bf16_t f2bf(float f) { return (bf16_t)(cvtpk(f, 0.f) & 0xffffu); }
DI void load8(const bf16_t* p, float (&f)[8]) { const u32x4 w = *(const u32x4*)p; f[0] = bflo(w.x); f[1] = bfhi(w.x); f[2] = bflo(w.y); f[3] = bfhi(w.y); f[4] = bflo(w.z); f[5] = bfhi(w.z); f[6] = bflo(w.w); f[7] = bfhi(w.w); }
DI void store8(bf16_t* p, const float (&f)[8]) { u32x4 w; w.x = cvtpk(f[0], f[1]); w.y = cvtpk(f[2], f[3]); w.z = cvtpk(f[4], f[5]); w.w = cvtpk(f[6], f[7]); *(u32x4*)p = w; }
DI void loadf8(const float* p, float (&f)[8]) { const f32x4 a = *(const f32x4*)p, b = *(const f32x4*)(p + 4); f[0] = a[0]; f[1] = a[1]; f[2] = a[2]; f[3] = a[3]; f[4] = b[0]; f[5] = b[1]; f[6] = b[2]; f[7] = b[3]; }
DI float h2f(unsigned b) { return __half2float(__ushort_as_half((unsigned short)b)); }
DI float sigmoidf_(float x) { return __builtin_amdgcn_rcpf(1.f + __expf(-x)); }
DI float tanhf_(float x) { return 1.f - 2.f * __builtin_amdgcn_rcpf(1.f + __expf(2.f * x)); }
DI float xorsum(float v, int mask) { return v + __shfl_xor(v, mask, 64); }
DI float* xrow(float* out, float* xc, int m) { const int b = m / TT, tt = m - b * TT; return tt < TC ? xc + (size_t)(b * TC + tt) * DM : out + (size_t)(b * SEQ + tt - TC) * DM; }

template <class Fn> struct Epi8 {
    static constexpr bool PERM = true, AFTER_DRAIN = false; Fn f;
    DI void operator()(const pg8::f32x4 (&acc)[2][2][4][2], const pg8::Unit& u, int wr, int wc, int fr, int fq) const {
        asm volatile("" : "+v"(fr), "+v"(fq));
#pragma unroll
        for (int ai = 0; ai < 2; ++ai)
#pragma unroll
            for (int m = 0; m < 4; ++m) { const int rit = ai * 128 + wr * 64 + m * 16 + fr;
#pragma unroll
                for (int bj = 0; bj < 2; ++bj) { f(rit, u.pn * 256 + bj * 128 + wc * 32 + 8 * fq, acc[ai][bj][m][0], acc[ai][bj][m][1], u, fq); __builtin_amdgcn_sched_barrier(0); } }
    }
};
DI void st8(bf16_t* p, const pg8::f32x4& v0, const pg8::f32x4& v1) { u32x4 w; w.x = cvtpk(v0[0], v0[1]); w.y = cvtpk(v0[2], v0[3]); w.z = cvtpk(v1[0], v1[1]); w.w = cvtpk(v1[2], v1[3]); *(u32x4*)p = w; }

struct FnF { bf16_t* F; const float* rs; const float* c1;
    DI void operator()(int rit, int col0, const pg8::f32x4& v0, const pg8::f32x4& v1, const pg8::Unit& u, int) const {
        if (col0 < CINX) { const int row = u.pm * 256 + rit, b = u.pm / 9, mrow = (u.pm - b * 9 == 0) ? 32 : b;
            const float rstd = rsqrtf(rs[row] * (1.f / 1024.f) + 1e-6f); const float* c = c1 + (size_t)mrow * NIN + col0;
            const pg8::f32x4 b0 = *(const pg8::f32x4*)c, b1 = *(const pg8::f32x4*)(c + 4);
            st8(F + (size_t)row * CINX + col0, v0 * rstd + b0, v1 * rstd + b1); } } };
struct FnQ { bf16_t* Q; const float* rope;
    DI void operator()(int rit, int col0, const pg8::f32x4& v0, const pg8::f32x4& v1, const pg8::Unit& u, int fq) const {
        const int seg = u.pm % 9; const bool isrope = (seg != 0) && (((col0 >> 5) % 3) == 2);
        float x[8] = {v0[0], v0[1], v0[2], v0[3], v1[0], v1[1], v1[2], v1[3]};
        if (isrope) { const int s = (seg - 1) * 256 + rit, pos = (fq < 2) ? (s >> 6) : (s & 63); float cs[8], sn[8]; loadf8(rope + pos * 8, cs); loadf8(rope + 512 + pos * 8, sn);
            const float sg = (fq & 1) ? 1.f : -1.f;
#pragma unroll
            for (int j = 0; j < 8; ++j) { const float p = __shfl_xor(x[j], 16, 64); x[j] = x[j] * cs[j] + sg * p * sn[j]; } }
        store8(Q + (size_t)(u.pm * 256 + rit) * 768 + col0, x); } };
struct FnKV { bf16_t* KA; bf16_t* VA;
    DI void operator()(int rit, int col0, const pg8::f32x4& v0, const pg8::f32x4& v1, const pg8::Unit& u, int) const {
        const size_t row = (size_t)(u.pm * 256 + rit); const int h = col0 >> 7, c = col0 & 127;
        if (c < 64) st8(KA + row * 768 + h * 96 + c, v0, v1); else st8(VA + row * 512 + h * 64 + (c - 64), v0, v1); } };
struct FnL1 { __half* DEC; bf16_t* AA; const float* w0; const float* a0;
    DI void operator()(int rit, int col0, const pg8::f32x4& v0, const pg8::f32x4& v1, const pg8::Unit& u, int) const {
        const size_t row = (size_t)(u.pm * 256 + rit); float x[8] = {v0[0], v0[1], v0[2], v0[3], v1[0], v1[1], v1[2], v1[3]};
        if (col0 < 1024) { float b[8]; loadf8(w0 + col0, b); u32x4 w; unsigned hh[8];
#pragma unroll
            for (int j = 0; j < 8; ++j) { const float uu = 0.6065306597f * sigmoidf_(x[j] + b[j]); hh[j] = (unsigned)__half_as_ushort(__float2half(-uu * 1.4426950409f)); }
            w.x = hh[0] | (hh[1] << 16); w.y = hh[2] | (hh[3] << 16); w.z = hh[4] | (hh[5] << 16); w.w = hh[6] | (hh[7] << 16);
            *(u32x4*)(DEC + row * 1024 + col0) = w;
        } else { const int c = col0 - 1024; float b[8]; loadf8(a0 + c, b);
#pragma unroll
            for (int j = 0; j < 8; ++j) x[j] = sigmoidf_(x[j] + b[j]);
            store8(AA + row * 1024 + c, x); } } };
struct FnL2 { bf16_t* G; bf16_t* V; const bf16_t* VF; const float* v0p; int dovres;
    DI void operator()(int rit, int col0, const pg8::f32x4& v0, const pg8::f32x4& v1, const pg8::Unit& u, int) const {
        const size_t row = (size_t)(u.pm * 256 + rit);
        if (col0 < 512) st8(G + row * 512 + col0, v0, v1);
        else if (dovres) { const int c = col0 - 512; float x[8] = {v0[0], v0[1], v0[2], v0[3], v1[0], v1[1], v1[2], v1[3]}, b[8], v[8], vf[8]; loadf8(v0p + c, b); load8(V + row * 512 + c, v); load8(VF + row * 512 + c, vf);
#pragma unroll
            for (int j = 0; j < 8; ++j) v[j] = v[j] + (vf[j] - v[j]) * sigmoidf_(b[j] + x[j]);
            store8(V + row * 512 + c, v); } } };
struct FnM1 { bf16_t* HID; const float* rs; const float* c2;
    DI void operator()(int rit, int col0, const pg8::f32x4& v0, const pg8::f32x4& v1, const pg8::Unit& u, int) const {
        const int row = u.pm * 256 + rit, b = u.pm / 9, mrow = (u.pm - b * 9 == 0) ? 32 : b;
        const float rstd = rsqrtf(rs[row] * (1.f / 1024.f) + 1e-6f); const float* c = c2 + (size_t)mrow * DFF + col0;
        const pg8::f32x4 b0 = *(const pg8::f32x4*)c, b1 = *(const pg8::f32x4*)(c + 4);
        const pg8::f32x4 y0 = v0 * rstd + b0, y1 = v1 * rstd + b1;
        float x[8] = {y0[0], y0[1], y0[2], y0[3], y1[0], y1[1], y1[2], y1[3]};
#pragma unroll
        for (int j = 0; j < 8; ++j) { const float r = fmaxf(x[j], 0.f); x[j] = r * r; }
        store8(HID + (size_t)row * DFF + col0, x); } };
struct EpiRes { static constexpr bool PERM = true, AFTER_DRAIN = false;
    float* out; float* xc; const float* sx; const float* sc; const float* mods; int gidx; const float* gp; bf16_t* H; float* rs; int emit;
    DI void operator()(const pg8::f32x4 (&acc)[2][2][4][2], const pg8::Unit& u, int wr, int wc, int fr, int fq) const {
        asm volatile("" : "+v"(fr), "+v"(fq));
        const int b = u.pm / 9, seg = u.pm - b * 9, mrow = seg == 0 ? 32 : b;
        const float* gbase = mods + (size_t)mrow * 6144 + gidx * 1024; const float* gpb = gp + (size_t)mrow * 1024;
#pragma unroll
        for (int ai = 0; ai < 2; ++ai)
#pragma unroll
            for (int m = 0; m < 4; ++m) { const int rit = ai * 128 + wr * 64 + m * 16 + fr; float ss = 0.f;
                const size_t roff = (seg == 0 ? (size_t)(b * TC + rit) * DM : (size_t)(b * SEQ + (seg - 1) * 256 + rit) * DM);
#pragma unroll
                for (int bj = 0; bj < 2; ++bj) { const int col0 = u.pn * 256 + bj * 128 + wc * 32 + 8 * fq;
                    float* p = (seg == 0 ? xc : out) + roff + col0; const float* q = (seg == 0 ? sc : sx) + roff + col0;
                    const pg8::f32x4 g0 = *(const pg8::f32x4*)(gbase + col0), g1 = *(const pg8::f32x4*)(gbase + col0 + 4); pg8::f32x4 x0 = *(const pg8::f32x4*)q, x1 = *(const pg8::f32x4*)(q + 4);
                    x0 += g0 * acc[ai][bj][m][0]; x1 += g1 * acc[ai][bj][m][1]; *(pg8::f32x4*)p = x0; *(pg8::f32x4*)(p + 4) = x1;
                    if (emit) { const pg8::f32x4 p0 = *(const pg8::f32x4*)(gpb + col0), p1 = *(const pg8::f32x4*)(gpb + col0 + 4);
                        ss += x0[0] * x0[0] + x0[1] * x0[1] + x0[2] * x0[2] + x0[3] * x0[3] + x1[0] * x1[0] + x1[1] * x1[1] + x1[2] * x1[2] + x1[3] * x1[3];
                        st8(H + (size_t)(u.pm * 256 + rit) * 1024 + col0, x0 * p0, x1 * p1); }
                    __builtin_amdgcn_sched_barrier(0); }
                if (emit) { ss += __shfl_xor(ss, 16, 64); ss += __shfl_xor(ss, 32, 64); if (fq == 0) atomicAdd(rs + u.pm * 256 + rit, ss); }
            }
    }
};
struct Order { pg8::StaticOrder s; int lat;
    DI void init(int lat_, int N) { lat = lat_; s.init(lat_ ? NB * SEQ : TALL, N, (int)gridDim.x, (int)blockIdx.x); }
    DI bool next(int i, pg8::Unit& u) const { if (!s.next(i, u)) return false; if (lat) u.pm = (u.pm >> 3) * 9 + 1 + (u.pm & 7); return true; }
    DI void a_ready(const pg8::Unit&) const {}
    DI void done(const pg8::Unit&) const {}
};
template <int N, int K, class Fn> DI void run_gemm(unsigned char* lds, const bf16_t* A, const bf16_t* Bt, int lat, const Fn& fn) {
    int Kr = K; if (K == 128) asm volatile("" : "+s"(Kr));
    pg8::Gemm g{A, Bt, lat ? NB * SEQ : TALL, N, Kr}; Order S; S.init(lat, N); Epi8<Fn> E{fn};
    pg8::gemm_phase<Epi8<Fn>, Order, true, true>((PG8_LAS unsigned char*)lds, g, S, E);
    __syncthreads();
}
template <int N, int K, class Epi> DI void run_gemm_epi(unsigned char* lds, const bf16_t* A, const bf16_t* Bt, int lat, const Epi& E) {
    pg8::Gemm g{A, Bt, lat ? NB * SEQ : TALL, N, K}; Order S; S.init(lat, N);
    pg8::gemm_phase<Epi, Order, true, true>((PG8_LAS unsigned char*)lds, g, S, E);
    __syncthreads();
}
namespace att {
constexpr int NW = 8, QBLK = 32, KVBLK = 64;
constexpr float SCALE = 0.10206207261596577f, THR = 8.f;
constexpr int LDQ = 768, LDKK = 768, LDV = 512, LDO = 1024;
constexpr int SHM_V = KVBLK * 64 * 2, SHM_K = KVBLK * 256, SHM_ATTN = 2 * SHM_V + 2 * SHM_K + NW * 64 * 4;
#define KSWZ(row, colB) ((row) * 256 + ((colB) ^ (((row) & 7) << 4)))
#define SBAR() __builtin_amdgcn_sched_barrier(0)
DI int crow(int r, int hi) { return (r & 3) + 8 * (r >> 2) + 4 * hi; }
DI unsigned cvtpk_(float lo, float hi) { unsigned r; asm volatile("v_cvt_pk_bf16_f32 %0, %1, %2" : "=v"(r) : "v"(lo), "v"(hi)); return r; }
DI void partialSM(f32x16& p0, f32x16& p1, float& m_reg, float& mn, float& alpha) {
  constexpr float C = SCALE * 1.4426950408889634f;
  float pmax = p0[0];
#pragma unroll
  for (int r = 1; r < 16; ++r) pmax = fmaxf(pmax, p0[r]);
#pragma unroll
  for (int r = 0; r < 16; ++r) pmax = fmaxf(pmax, p1[r]);
  { auto rr = __builtin_amdgcn_permlane32_swap(__float_as_uint(pmax), __float_as_uint(pmax), false, false);
    pmax = fmaxf(__uint_as_float(rr[0]), __uint_as_float(rr[1])); }
  if (__builtin_expect(__all(pmax - m_reg <= THR / SCALE), 1)) { mn = m_reg; alpha = 1.f; }
  else { mn = fmaxf(m_reg, pmax); alpha = __builtin_amdgcn_exp2f((m_reg - mn) * C); m_reg = mn; }
  const float mnC = -mn * C;
#pragma unroll
  for (int r = 0; r < 16; ++r) p0[r] = fmaf(p0[r], C, mnC);
#pragma unroll
  for (int r = 0; r < 16; ++r) p1[r] = fmaf(p1[r], C, mnC);
#pragma unroll
  for (int r = 0; r < 16; ++r) p0[r] = __builtin_amdgcn_exp2f(p0[r]);
}
DI void finishSM(f32x16& p0, f32x16& p1, float alpha, float& l_reg, bf16x8& pa0, bf16x8& pa1, bf16x8& pa2, bf16x8& pa3) {
#pragma unroll
  for (int r = 0; r < 16; ++r) p1[r] = __builtin_amdgcn_exp2f(p1[r]);
  float ps = 0;
#pragma unroll
  for (int r = 0; r < 16; ++r) ps += p0[r];
#pragma unroll
  for (int r = 0; r < 16; ++r) ps += p1[r];
  { auto rr = __builtin_amdgcn_permlane32_swap(__float_as_uint(ps), __float_as_uint(ps), false, false);
    ps = __uint_as_float(rr[0]) + __uint_as_float(rr[1]); }
  l_reg = l_reg * alpha + ps;
#define PK4(P, BASE, OUT) do { unsigned a0 = cvtpk_(P[BASE + 0], P[BASE + 1]), a1 = cvtpk_(P[BASE + 2], P[BASE + 3]);   \
    unsigned b0 = cvtpk_(P[BASE + 4], P[BASE + 5]), b1 = cvtpk_(P[BASE + 6], P[BASE + 7]);                              \
    auto r0 = __builtin_amdgcn_permlane32_swap(a0, b0, false, false); auto r1 = __builtin_amdgcn_permlane32_swap(a1, b1, false, false); \
    u32x4 w = {r0[0], r1[0], r0[1], r1[1]}; OUT = *reinterpret_cast<bf16x8*>(&w); } while (0)
  PK4(p0, 0, pa0); PK4(p0, 8, pa1); PK4(p1, 0, pa2); PK4(p1, 8, pa3);
#undef PK4
}
DI void qkt(f32x16& p0, f32x16& p1, const char* Ks, const bf16x8* qr, int r32, int hi) {
  p0 = f32x16{}; p1 = f32x16{};
#pragma unroll
  for (int d0 = 0; d0 < 6; ++d0) { const int cb = (d0 * 16 + hi * 8) * 2;
    bf16x8 b0 = *reinterpret_cast<const bf16x8*>(Ks + KSWZ(r32, cb));
    bf16x8 b1 = *reinterpret_cast<const bf16x8*>(Ks + KSWZ(32 + r32, cb));
    p0 = __builtin_amdgcn_mfma_f32_32x32x16_bf16(b0, qr[d0], p0, 0, 0, 0);
    p1 = __builtin_amdgcn_mfma_f32_32x32x16_bf16(b1, qr[d0], p1, 0, 0, 0); }
}
DI int v_st(int k, int c) { const int kk = (k & ~0xC) | ((k & 4) << 1) | ((k & 8) >> 1); return ((kk >> 3) * 2 + (c >> 5)) * 512 + ((kk & 7) * 32 + (c & 31)) * 2; }
DI int v_rd_base(int lane) { return ((lane & 3) << 3) | (((lane >> 2) & 3) << 6) | (((lane >> 4) & 1) << 5) | (((lane >> 5) & 1) << 8); }
constexpr int v_rd_off(int d0, int ks, int half) { return d0 * 512 + ks * 2048 + half * 1024; }
template <int OFF> DI s16x4 tr_read(int vb) {
  s16x4 r; asm volatile("ds_read_b64_tr_b16 %0, %1 offset:%2" : "=&v"(r) : "v"(vb), "i"(OFF) : "memory"); return r;
}
template <int D0> DI void pv_one(f32x16& od, int vb, bf16x8 pa0, bf16x8 pa1, bf16x8 pa2, bf16x8 pa3) {
  const s16x4 l0 = tr_read<v_rd_off(D0, 0, 0)>(vb), h0 = tr_read<v_rd_off(D0, 0, 1)>(vb), l1 = tr_read<v_rd_off(D0, 1, 0)>(vb), h1 = tr_read<v_rd_off(D0, 1, 1)>(vb);
  const s16x4 l2 = tr_read<v_rd_off(D0, 2, 0)>(vb), h2 = tr_read<v_rd_off(D0, 2, 1)>(vb), l3 = tr_read<v_rd_off(D0, 3, 0)>(vb), h3 = tr_read<v_rd_off(D0, 3, 1)>(vb);
  asm volatile("s_waitcnt lgkmcnt(0)" ::: "memory"); SBAR();
#define PK(L, H) (bf16x8){L[0], L[1], L[2], L[3], H[0], H[1], H[2], H[3]}
  od = __builtin_amdgcn_mfma_f32_32x32x16_bf16(pa0, PK(l0, h0), od, 0, 0, 0);
  od = __builtin_amdgcn_mfma_f32_32x32x16_bf16(pa1, PK(l1, h1), od, 0, 0, 0);
  od = __builtin_amdgcn_mfma_f32_32x32x16_bf16(pa2, PK(l2, h2), od, 0, 0, 0);
  od = __builtin_amdgcn_mfma_f32_32x32x16_bf16(pa3, PK(l3, h3), od, 0, 0, 0);
#undef PK
}
DI void pv_d0(f32x16* o, int vb, bf16x8 pa0, bf16x8 pa1, bf16x8 pa2, bf16x8 pa3) {
  pv_one<0>(o[0], vb, pa0, pa1, pa2, pa3); pv_one<1>(o[1], vb, pa0, pa1, pa2, pa3);
}
DI void attn_body(const bf16_t* __restrict__ Qb, const bf16_t* __restrict__ Kh, const bf16_t* __restrict__ Vh, bf16_t* __restrict__ Ob, int seq, char* lds) {
  const int tid = ltid(), wid = tid >> 6, lane = tid & 63, r32 = lane & 31, hi = lane >> 5;
  char* V_lds = lds; char* K_lds = lds + 2 * SHM_V;
  float* ws = (float*)(lds + 2 * SHM_V + 2 * SHM_K) + wid * 64; float* li_l = ws; float* al_l = ws + 32;
  float m_reg = -1e30f, l_reg = 0; f32x16 o[2] = {}; bf16x8 qr[6];
  const bf16_t* Qw = Qb + (long)(wid * QBLK + r32) * LDQ + hi * 8;
#pragma unroll
  for (int d0 = 0; d0 < 6; ++d0) qr[d0] = *reinterpret_cast<const bf16x8*>(Qw + d0 * 16);
  const int kc2 = 512 + (tid & 255);
  const int kr1 = tid / 12, kch1 = tid - kr1 * 12, kr2 = kc2 / 12, kch2 = kc2 - kr2 * 12, vr = tid >> 3, vch = tid & 7;
  const int vst = v_st(vr, vch * 8), kst1 = KSWZ(kr1, kch1 * 16), kst2 = KSWZ(kr2, kch2 * 16);
  const int vb0 = (int)(uintptr_t)V_lds + v_rd_base(lane);
  struct { bf16x8 v, k1, k2; } sr_[2];
#define SLOAD(i, k0) do { sr_[i].v = *reinterpret_cast<const bf16x8*>(&Vh[(long)((k0) + vr) * LDV + vch * 8]); \
    sr_[i].k1 = *reinterpret_cast<const bf16x8*>(&Kh[(long)((k0) + kr1) * LDKK + kch1 * 8]); sr_[i].k2 = *reinterpret_cast<const bf16x8*>(&Kh[(long)((k0) + kr2) * LDKK + kch2 * 8]); } while (0)
#define SWRITE(b, i) do { *(bf16x8*)(V_lds + (b) * SHM_V + vst) = sr_[i].v; *(bf16x8*)(K_lds + (b) * SHM_K + kst1) = sr_[i].k1; *(bf16x8*)(K_lds + (b) * SHM_K + kst2) = sr_[i].k2; } while (0)
#define RESC(a) do { if (__any((a) < 1.f)) { if (hi == 0) al_l[r32] = (a); asm volatile("s_waitcnt lgkmcnt(0)" ::: "memory"); \
    _Pragma("unroll") for (int d = 0; d < 2; ++d) _Pragma("unroll") for (int r = 0; r < 16; ++r) o[d][r] *= al_l[crow(r, hi)]; } } while (0)
  f32x16 pA0, pA1, pB0, pB1; float mnA, mnB, alA, alB; bf16x8 pa0, pa1, pa2, pa3; const int NT = seq / KVBLK;
  constexpr int SE = 0, SO = 1;
  SLOAD(SE, 0); asm volatile("s_waitcnt vmcnt(0)" ::: "memory"); SWRITE(0, SE); __syncthreads();
  qkt(pA0, pA1, K_lds, qr, r32, hi); partialSM(pA0, pA1, m_reg, mnA, alA);
  SLOAD(SO, KVBLK); if (2 < NT) SLOAD(SE, 2 * KVBLK);
  SWRITE(1, SO); __syncthreads();
  for (int j = 1; j + 1 < NT; j += 2) {
    SBAR(); qkt(pB0, pB1, K_lds + SHM_K, qr, r32, hi);
    finishSM(pA0, pA1, alA, l_reg, pa0, pa1, pa2, pa3); SBAR();
    SLOAD(SO, (j + 2) * KVBLK); SBAR();
    pv_d0(o, vb0, pa0, pa1, pa2, pa3); partialSM(pB0, pB1, m_reg, mnB, alB);
    __syncthreads(); SWRITE(0, SE);
    RESC(alB); __syncthreads();
    SBAR(); qkt(pA0, pA1, K_lds, qr, r32, hi);
    finishSM(pB0, pB1, alB, l_reg, pa0, pa1, pa2, pa3); SBAR();
    if (j + 3 < NT) SLOAD(SE, (j + 3) * KVBLK); SBAR();
    pv_d0(o, vb0 + SHM_V, pa0, pa1, pa2, pa3); partialSM(pA0, pA1, m_reg, mnA, alA);
    __syncthreads(); SWRITE(1, SO);
    RESC(alA); __syncthreads();
  }
  SBAR(); qkt(pB0, pB1, K_lds + SHM_K, qr, r32, hi);
  finishSM(pA0, pA1, alA, l_reg, pa0, pa1, pa2, pa3); SBAR();
  pv_d0(o, vb0, pa0, pa1, pa2, pa3); partialSM(pB0, pB1, m_reg, mnB, alB);
  __syncthreads(); RESC(alB);
  finishSM(pB0, pB1, alB, l_reg, pa0, pa1, pa2, pa3); SBAR();
  pv_d0(o, vb0 + SHM_V, pa0, pa1, pa2, pa3);
  if (hi == 0) li_l[r32] = l_reg; asm volatile("s_waitcnt lgkmcnt(0)" ::: "memory");
  float rli[16];
#pragma unroll
  for (int r = 0; r < 16; ++r) rli[r] = __builtin_amdgcn_rcpf(li_l[crow(r, hi)]);
  bf16_t* Ow = Ob + (long)(wid * QBLK) * LDO;
#pragma unroll
  for (int r = 0; r < 16; ++r) { const int orow = crow(r, hi);
#pragma unroll
    for (int d0 = 0; d0 < 2; ++d0) Ow[(long)orow * LDO + d0 * 32 + r32] = f2bf(o[d0][r] * rli[r]); }
#undef SLOAD
#undef SWRITE
#undef RESC
}
}

DI void phase_attn(const bf16_t* Q, const bf16_t* KA, const bf16_t* VA, bf16_t* MIX, bool last, char* lds) {
    const int c = blockIdx.x, G = gridDim.x, NU = 2048 + (last ? 0 : 256);
    for (int L = c; L < NU; L += G) {
        int bh, seq; long qrow0;
        if (L < 2048) { int qb;
            if (G == 256) { const int i = L >> 8, cc = L & 255, xcd = cc & 7, slot = cc >> 3; bh = i * 32 + xcd * 4 + (slot >> 3); qb = slot & 7; }
            else { bh = L >> 3; qb = L & 7; }
            qrow0 = (long)(bh >> 3) * TT + TC + qb * 256; seq = TT; }
        else { bh = L - 2048; qrow0 = (long)(bh >> 3) * TT; seq = TC; }
        const int b = bh >> 3, h = bh & 7;
        att::attn_body(Q + qrow0 * 768 + h * 96, KA + (long)b * TT * 768 + h * 96, VA + (long)b * TT * 512 + h * 64, MIX + qrow0 * 1024 + h * 64, seq, lds);
        __syncthreads();
    }
}

DI float rowsum16(float x) {
    x += __int_as_float(__builtin_amdgcn_update_dpp(0, __float_as_int(x), 0x128, 0xf, 0xf, false));
    x += __int_as_float(__builtin_amdgcn_update_dpp(0, __float_as_int(x), 0x124, 0xf, 0xf, false));
    x += __int_as_float(__builtin_amdgcn_update_dpp(0, __float_as_int(x), 0x122, 0xf, 0xf, false));
    x += __int_as_float(__builtin_amdgcn_update_dpp(0, __float_as_int(x), 0x121, 0xf, 0xf, false));
    return x;
}
#define RS8_STEP(R) "v_add_f32_dpp %0, %0, %0 " R " row_mask:0xf bank_mask:0xf\n\tv_add_f32_dpp %1, %1, %1 " R " row_mask:0xf bank_mask:0xf\n\t" \
                    "v_add_f32_dpp %2, %2, %2 " R " row_mask:0xf bank_mask:0xf\n\tv_add_f32_dpp %3, %3, %3 " R " row_mask:0xf bank_mask:0xf\n\t" \
                    "v_add_f32_dpp %4, %4, %4 " R " row_mask:0xf bank_mask:0xf\n\tv_add_f32_dpp %5, %5, %5 " R " row_mask:0xf bank_mask:0xf\n\t" \
                    "v_add_f32_dpp %6, %6, %6 " R " row_mask:0xf bank_mask:0xf\n\tv_add_f32_dpp %7, %7, %7 " R " row_mask:0xf bank_mask:0xf\n\t"
DI void sum8x8(float& x0, float& x1, float& x2, float& x3, float& x4, float& x5, float& x6, float& x7) {
    asm volatile("s_nop 1\n\t" RS8_STEP("quad_perm:[1,0,3,2]") RS8_STEP("quad_perm:[2,3,0,1]") RS8_STEP("row_half_mirror")
                 : "+v"(x0), "+v"(x1), "+v"(x2), "+v"(x3), "+v"(x4), "+v"(x5), "+v"(x6), "+v"(x7));
}
typedef float f32x2 __attribute__((ext_vector_type(2)));
DI float dot8(const f32x2 (&s)[4], const f32x4& x0, const f32x4& x1) {
    f32x2 t = s[0] * (f32x2){x0[0], x0[1]};
    t = __builtin_elementwise_fma(s[1], (f32x2){x0[2], x0[3]}, t);
    t = __builtin_elementwise_fma(s[2], (f32x2){x1[0], x1[1]}, t);
    t = __builtin_elementwise_fma(s[3], (f32x2){x1[2], x1[3]}, t);
    return t.x + t.y;
}
DI int scan_row(int d, int b, int n) { const int tt = d == 0 ? n : (n < TC ? TC - 1 - n : TT + TC - 1 - n); return b * TT + tt; }
typedef __bf16 bf16x2n __attribute__((ext_vector_type(2)));
DI unsigned cvtpk_n(float lo, float hi) { f32x2 v = {lo, hi}; bf16x2n b = __builtin_convertvector(v, bf16x2n); return __builtin_bit_cast(unsigned, b); }
DI bf16x8 pack_acc(const f32x16& x, int s) {
    u32x4 w; w.x = cvtpk_n(x[8 * s], x[8 * s + 1]); w.y = cvtpk_n(x[8 * s + 2], x[8 * s + 3]); w.z = cvtpk_n(x[8 * s + 4], x[8 * s + 5]); w.w = cvtpk_n(x[8 * s + 6], x[8 * s + 7]);
    return __builtin_bit_cast(bf16x8, w);
}
constexpr int SREC = 260;
struct ScanStep { bf16x8 f[4]; float bk0, bk1, v, br, kr; };
DI void scan_ld(ScanStep& t, const float* rec, const char* zimg, int fragoff, bool isaq, int h, int m, int vrow) {
    const char* fp = isaq ? (const char*)(rec + fragoff) + h * 16 : zimg + h * 16;
#pragma unroll
    for (int q = 0; q < 4; ++q) t.f[q] = *(const bf16x8*)(fp + q * 32);
    t.bk0 = rec[64 + h * 64 + m]; t.bk1 = rec[64 + h * 64 + 32 + m]; t.v = rec[192 + vrow]; t.br = rec[256]; t.kr = rec[257];
}
DI void phase_scan(const bf16_t* R, const bf16_t* Kk, const bf16_t* V, const __half* DEC, const bf16_t* AA, const float* INV, const float* kkp, const float* kap,
                   bf16_t* MIX, bf16_t* YB, char* lds) {
    const int tid = ltid(); const bool consumer = tid < 256;
    float* bufA = (float*)lds; float* ybufA = (float*)(lds + 98304); char* zimg = lds + 114688;
    if (tid < 32) ((float*)zimg)[tid] = 0.f;
    constexpr int NCH = TT / 16;
    for (int s0 = blockIdx.x * 2; s0 < 512; s0 += gridDim.x * 2) {
        const int p_ = tid & 255, pst = p_ >> 4, pj0 = (p_ & 15) * 4;
        const int cw = tid >> 6, cgrp = (cw >> 1) & 1, ws_ = cw & 1, lane = tid & 63, m = lane & 31, h = lane >> 5, vrow = ws_ * 32 + m;
        const bool isaq = (m & ~5) == 0;
        const int fragoff = (m & 1) ? 32 : 0;
        f32x16 acc0, acc1, zero16;
#pragma unroll
        for (int r = 0; r < 16; ++r) { acc0[r] = 0.f; acc1[r] = 0.f; zero16[r] = 0.f; }
        const int jl_ = pj0 & 31, rem_ = jl_ & 15, imgoff = ((((pj0 >> 5) * 2 + (jl_ >> 4)) * 2 + ((rem_ >> 2) & 1)) * 16 + ((rem_ >> 3) << 2) * 2) >> 2;
        const int sub = pst & 3, pw = pst >> 2;
        u32x2 lr[2], lk[2], lv[2], la[2], ld0[2], le[2][3]; float linv[2];
#define PLOAD(c) do { _Pragma("unroll") for (int gq = 0; gq < 2; ++gq) { \
            const int sid = s0 + gq, d = sid >> 8, b = (sid >> 3) & 31, hh = sid & 7, hc = hh * 64 + pj0; \
            const size_t m_ = (size_t)scan_row(d, b, (c) * 16 + pst); \
            lr[gq] = *(const u32x2*)(R + m_ * 512 + hc); lk[gq] = *(const u32x2*)(Kk + m_ * 512 + hc); lv[gq] = *(const u32x2*)(V + m_ * 512 + hc); \
            la[gq] = *(const u32x2*)(AA + m_ * 1024 + d * 512 + hc); linv[gq] = INV[m_ * 8 + hh]; ld0[gq] = *(const u32x2*)(DEC + m_ * 1024 + d * 512 + hc); \
            _Pragma("unroll") for (int w_ = 0; w_ < 3; ++w_) { le[gq][w_] = (u32x2){0u, 0u}; \
                if (w_ < pw) le[gq][w_] = *(const u32x2*)(DEC + (size_t)scan_row(d, b, (c) * 16 + 4 * w_ + sub) * 1024 + d * 512 + hc); } } } while (0)
#define PFX(L, e) do { float t_ = __shfl_up(e, 16, 64); L = e + (sub >= 1 ? t_ : 0.f); t_ = __shfl_up(L, 32, 64); L += (sub >= 2 ? t_ : 0.f); } while (0)
#define WSUM(L, x) do { float f_ = (x); f_ += __shfl_xor(f_, 16, 64); f_ += __shfl_xor(f_, 32, 64); L += f_; } while (0)
#define PWRITE(bsel) do { _Pragma("unroll") for (int gq = 0; gq < 2; ++gq) { \
            const int sid = s0 + gq, hh = sid & 7, hc = hh * 64 + pj0; \
            const float l0 = h2f(ld0[gq].x & 0xffffu), l1 = h2f(ld0[gq].x >> 16), l2 = h2f(ld0[gq].y & 0xffffu), l3 = h2f(ld0[gq].y >> 16); \
            float L0, L1, L2, L3; PFX(L0, l0); PFX(L1, l1); PFX(L2, l2); PFX(L3, l3); \
            _Pragma("unroll") for (int w_ = 0; w_ < 3; ++w_) { const u32x2 ev = le[gq][w_]; \
                WSUM(L0, h2f(ev.x & 0xffffu)); WSUM(L1, h2f(ev.x >> 16)); WSUM(L2, h2f(ev.y & 0xffffu)); WSUM(L3, h2f(ev.y >> 16)); } \
            const f32x4 kk4 = *(const f32x4*)(kkp + hc), ka4 = *(const f32x4*)(kap + hc); \
            float* rec_ = bufA + gq * 12288 + (bsel) * 6144 + pst * SREC; \
            const float k0 = bflo(lk[gq].x), k1 = bfhi(lk[gq].x), k2 = bflo(lk[gq].y), k3 = bfhi(lk[gq].y), a0 = bflo(la[gq].x), a1 = bfhi(la[gq].x), a2 = bflo(la[gq].y), a3 = bfhi(la[gq].y); \
            const float q0 = k0 * kk4[0] * linv[gq], q1 = k1 * kk4[1] * linv[gq], q2 = k2 * kk4[2] * linv[gq], q3 = k3 * kk4[3] * linv[gq]; \
            const float W0 = __builtin_amdgcn_exp2f(L0), W1 = __builtin_amdgcn_exp2f(L1), W2 = __builtin_amdgcn_exp2f(L2), W3 = __builtin_amdgcn_exp2f(L3); \
            const float P0 = __builtin_amdgcn_exp2f(L0 - l0), P1 = __builtin_amdgcn_exp2f(L1 - l1), P2 = __builtin_amdgcn_exp2f(L2 - l2), P3 = __builtin_amdgcn_exp2f(L3 - l3); \
            const float I0 = __builtin_amdgcn_exp2f(-L0), I1 = __builtin_amdgcn_exp2f(-L1), I2 = __builtin_amdgcn_exp2f(-L2), I3 = __builtin_amdgcn_exp2f(-L3); \
            const float r0 = bflo(lr[gq].x), r1 = bfhi(lr[gq].x), r2 = bflo(lr[gq].y), r3 = bfhi(lr[gq].y); \
            const float b0 = q0 * a0, b1 = q1 * a1, b2 = q2 * a2, b3 = q3 * a3; \
            const float d0 = k0 * (1.f + (a0 - 1.f) * ka4[0]), d1 = k1 * (1.f + (a1 - 1.f) * ka4[1]), d2 = k2 * (1.f + (a2 - 1.f) * ka4[2]), d3 = k3 * (1.f + (a3 - 1.f) * ka4[3]); \
            { u32x2 w_; w_.x = cvtpk_n(-q0 * P0, -q1 * P1); w_.y = cvtpk_n(-q2 * P2, -q3 * P3); *(u32x2*)(rec_ + imgoff) = w_; } \
            { u32x2 w_; w_.x = cvtpk_n(r0 * W0, r1 * W1); w_.y = cvtpk_n(r2 * W2, r3 * W3); *(u32x2*)(rec_ + 32 + imgoff) = w_; } \
            *(f32x4*)(rec_ + 64 + pj0) = (f32x4){b0 * I0, b1 * I1, b2 * I2, b3 * I3}; \
            *(f32x4*)(rec_ + 128 + pj0) = (f32x4){d0 * I0, d1 * I1, d2 * I2, d3 * I3}; \
            *(f32x4*)(rec_ + 192 + pj0) = (f32x4){bflo(lv[gq].x), bfhi(lv[gq].x), bflo(lv[gq].y), bfhi(lv[gq].y)}; \
            const float br_ = rowsum16(b0 * r0 + b1 * r1 + b2 * r2 + b3 * r3), kr_ = rowsum16(d0 * r0 + d1 * r1 + d2 * r2 + d3 * r3); \
            if ((p_ & 15) == 0) { rec_[256] = br_; rec_[257] = kr_; } \
            if (pst == 15) *(f32x4*)(bufA + gq * 12288 + (bsel) * 6144 + 16 * SREC + pj0) = (f32x4){W0, W1, W2, W3}; } } while (0)
#define OUTPUT(c, bsel) do { _Pragma("unroll") for (int gq = 0; gq < 2; ++gq) { \
            const int sid = s0 + gq, d = sid >> 8, b = (sid >> 3) & 31, hh = sid & 7, hc = hh * 64 + pj0; \
            const f32x4 yv = *(const f32x4*)(ybufA + gq * 2048 + (bsel) * 1024 + pst * 64 + pj0); const size_t m_ = (size_t)scan_row(d, b, (c) * 16 + pst); \
            u32x2 w; w.x = cvtpk(yv[0], yv[1]); w.y = cvtpk(yv[2], yv[3]); \
            if (d == 0) *(u32x2*)(MIX + m_ * 1024 + 512 + hc) = w; else *(u32x2*)(YB + m_ * 512 + hc) = w; } } while (0)
        if (!consumer) { PLOAD(0); PWRITE(0); PLOAD(1); }
        __syncthreads();
        if (consumer) __builtin_amdgcn_s_setprio(3);
        for (int c = 0; c < NCH; ++c) {
            if (consumer) {
                const float* cur = bufA + cgrp * 12288 + (c & 1) * 6144; float* yb = ybufA + cgrp * 2048 + (c & 1) * 1024;
                ScanStep t; scan_ld(t, cur, zimg, fragoff, isaq, h, m, vrow);
#pragma unroll 2
                for (int st = 0; st < 16; ++st) {
                    ScanStep n; scan_ld(n, cur + (st + 1) * SREC, zimg, fragoff, isaq, h, m, vrow);
                    f32x16 d0 = __builtin_amdgcn_mfma_f32_32x32x16_bf16(t.f[0], pack_acc(acc0, 0), zero16, 0, 0, 0);
                    f32x16 d1 = __builtin_amdgcn_mfma_f32_32x32x16_bf16(t.f[2], pack_acc(acc1, 0), zero16, 0, 0, 0);
                    d0 = __builtin_amdgcn_mfma_f32_32x32x16_bf16(t.f[1], pack_acc(acc0, 1), d0, 0, 0, 0);
                    d1 = __builtin_amdgcn_mfma_f32_32x32x16_bf16(t.f[3], pack_acc(acc1, 1), d1, 0, 0, 0);
                    const float sa = d0[0] + d1[0], z = d0[1] + d1[1];
                    yb[st * 64 + vrow] = z + sa * t.br + t.v * t.kr;
                    const float bval = h ? t.v : sa;
                    acc0 = __builtin_amdgcn_mfma_f32_32x32x2f32(t.bk0, bval, acc0, 0, 0, 0);
                    acc1 = __builtin_amdgcn_mfma_f32_32x32x2f32(t.bk1, bval, acc1, 0, 0, 0);
                    t = n;
                }
                const float* wc = cur + 16 * SREC;
#pragma unroll
                for (int g_ = 0; g_ < 4; ++g_) { const f32x4 w0 = *(const f32x4*)(wc + 8 * g_ + 4 * h), w1 = *(const f32x4*)(wc + 32 + 8 * g_ + 4 * h);
#pragma unroll
                    for (int e = 0; e < 4; ++e) { acc0[4 * g_ + e] *= w0[e]; acc1[4 * g_ + e] *= w1[e]; } }
            } else {
                if (c + 1 < NCH) PWRITE((c + 1) & 1);
                if (c + 2 < NCH) PLOAD(c + 2);
                if (c > 0) OUTPUT(c - 1, (c - 1) & 1);
            }
            __syncthreads();
        }
        __builtin_amdgcn_s_setprio(0);
        if (!consumer) OUTPUT(NCH - 1, (NCH - 1) & 1);
        __syncthreads();
#undef PLOAD
#undef PWRITE
#undef PFX
#undef WSUM
#undef OUTPUT
    }
}

DI void phase_prologue(const Args& a, unsigned char* lds) {
    const int tid = ltid(), G = gridDim.x;
    float* out = a.out; float* xc = (float*)(a.ws + WS_XC);
    if (blockIdx.x == 0) {
        float* rope = (float*)(a.ws + WS_ROPE); const int pos = tid >> 3, j = tid & 7;
        const float inv_freq = powf(10000.f, -(float)j / 8.f), ang = (float)pos * inv_freq;
        rope[tid] = cosf(ang); rope[512 + tid] = sinf(ang);
    }
    float* sv = (float*)lds; float* red = sv + 33 * 1024;
    for (int i = tid; i < 33 * 1024; i += 512) { const float v = i < 32 * 1024 ? a.in[I_C][i] : a.in[I_CCTX][i - 32 * 1024]; sv[i] = v / (1.f + __expf(-v)); }
    __syncthreads();
    const int wave = tid >> 6, lane = tid & 63;
    float* mods = (float*)(a.ws + WS_MODS);
    for (int it = blockIdx.x; it < NL * 96; it += G) {
        const int l = it / 96, n0 = (it - l * 96) * 64;
        const float* w = a.in[I_ADAW] + (size_t)l * 1024 * 6144 + n0 + lane;
        float acc[33];
#pragma unroll
        for (int r = 0; r < 33; ++r) acc[r] = 0.f;
        for (int k = wave * 128; k < wave * 128 + 128; k += 8) { float wv[8];
#pragma unroll
            for (int u = 0; u < 8; ++u) wv[u] = w[(size_t)(k + u) * 6144];
#pragma unroll
            for (int u = 0; u < 8; ++u)
#pragma unroll
                for (int r = 0; r < 33; ++r) acc[r] += sv[r * 1024 + k + u] * wv[u]; }
        for (int i = tid; i < 33 * 64; i += 512) red[i] = 0.f;
        __syncthreads();
        for (int ww = 0; ww < 8; ++ww) { if (wave == ww) {
#pragma unroll
                for (int r = 0; r < 33; ++r) red[r * 64 + lane] += acc[r]; }
            __syncthreads(); }
        for (int i = tid; i < 33 * 64; i += 512) { const int r = i >> 6, n = n0 + (i & 63); mods[((size_t)l * 33 + r) * 6144 + n] = red[i] + a.in[I_ADAB][l * 6144 + n]; }
        __syncthreads();
    }
}

DI void phase_vectors(const Args& a, unsigned char* lds) {
    const int tid = ltid(), G = gridDim.x, wave = tid >> 6, lane = tid & 63;
    const float* mods = (const float*)(a.ws + WS_MODS);
    float* gp1 = (float*)(a.ws + WS_GP1); float* gp2 = (float*)(a.ws + WS_GP2);
    for (int i = blockIdx.x * 512 + tid; i < NL * 33 * 1024; i += G * 512) { const int c = i & 1023, lr = i >> 10, l = lr / 33;
        gp1[i] = a.in[I_N1G][l * 1024 + c] * (1.f + mods[(size_t)lr * 6144 + 1024 + c]); gp2[i] = a.in[I_N2G][l * 1024 + c] * (1.f + mods[(size_t)lr * 6144 + 4 * 1024 + c]); }
    float* sv = (float*)lds; float* red = sv + 33 * 1024;
    for (int it = blockIdx.x; it < NL * 101; it += G) {
        const int l = it / 101, ci = it - l * 101, which = ci < 37 ? 0 : 1, n0 = (which ? ci - 37 : ci) * 64, n = n0 + lane;
        __syncthreads();
        for (int i = tid; i < 33 * 1024; i += 512) sv[i] = mods[((size_t)l * 33 + (i >> 10)) * 6144 + (which ? 3 * 1024 : 0) + (i & 1023)];
        for (int i = tid; i < 33 * 64; i += 512) red[i] = 0.f;
        __syncthreads();
        const float* w; int ld; float live = 1.f;
        if (which) { w = a.in[I_M1] + (size_t)l * 1024 * 4096 + n; ld = 4096; }
        else if (n < CIN) { w = a.in[I_WIN] + (size_t)l * 1024 * CIN + n; ld = CIN; }
        else if (n < CINX && l > 0) { w = a.in[I_V1] + (size_t)(l - 1) * 1024 * 32 + (n - CIN); ld = 32; }
        else { w = a.in[I_WIN]; ld = 0; live = 0.f; }
        float acc[33];
#pragma unroll
        for (int r = 0; r < 33; ++r) acc[r] = 0.f;
        for (int k = wave * 128; k < wave * 128 + 128; k += 8) { float wv[8];
#pragma unroll
            for (int u = 0; u < 8; ++u) wv[u] = w[(size_t)(k + u) * ld] * live;
#pragma unroll
            for (int u = 0; u < 8; ++u)
#pragma unroll
                for (int r = 0; r < 33; ++r) acc[r] += sv[r * 1024 + k + u] * wv[u]; }
        for (int ww = 0; ww < 8; ++ww) { if (wave == ww) {
#pragma unroll
                for (int r = 0; r < 33; ++r) red[r * 64 + lane] += acc[r]; }
            __syncthreads(); }
        float* outp = which ? (float*)(a.ws + WS_C2) + (size_t)l * 33 * DFF : (float*)(a.ws + WS_C1) + (size_t)l * 33 * NIN; const int ldo = which ? DFF : NIN;
        for (int i = tid; i < 33 * 64; i += 512) outp[(size_t)(i >> 6) * ldo + n0 + (i & 63)] = red[i];
    }
    {
        const int gw = blockIdx.x * 8 + wave, nw = G * 8; bf16_t* __restrict__ H = (bf16_t*)(a.ws + WS_H); float* __restrict__ rsa = (float*)(a.ws + WS_RSA); const float* __restrict__ gamma = a.in[I_N1G];
        for (int m = gw; m < TALL; m += nw) { const int b = m / TT, tt = m - b * TT; const bool ctx = tt < TC;
            const float* xr = ctx ? a.in[I_CTX] + (size_t)(b * TC + tt) * DM : a.in[I_X] + (size_t)(b * SEQ + tt - TC) * DM; const float* md = mods + (size_t)(ctx ? 32 : b) * 6144 + 1024;
            f32x4 v[4]; float ss = 0.f;
#pragma unroll
            for (int q = 0; q < 4; ++q) { v[q] = *(const f32x4*)(xr + q * 256 + lane * 4); ss += v[q][0] * v[q][0] + v[q][1] * v[q][1] + v[q][2] * v[q][2] + v[q][3] * v[q][3]; }
#pragma unroll
            for (int k = 1; k < 64; k <<= 1) ss = xorsum(ss, k);
            if (lane == 0) rsa[m] = ss;
#pragma unroll
            for (int q = 0; q < 4; ++q) { const int col = q * 256 + lane * 4; const f32x4 g = *(const f32x4*)(gamma + col), sc = *(const f32x4*)(md + col);
                u32x2 w; w.x = cvtpk(v[q][0] * g[0] * (1.f + sc[0]), v[q][1] * g[1] * (1.f + sc[1])); w.y = cvtpk(v[q][2] * g[2] * (1.f + sc[2]), v[q][3] * g[3] * (1.f + sc[3]));
                *(u32x2*)(H + (size_t)m * 1024 + col) = w; } }
    }
}

template <class Gt> DI void cvt_tile(bf16_t* __restrict__ dst, int ldk, int n0, int k0, const Gt& get, float*) {
    const int lane = ltid() & 63, n = n0 + lane;
#pragma unroll
    for (int ch = 0; ch < 4; ++ch) { float v[16];
#pragma unroll
        for (int kk = 0; kk < 16; ++kk) v[kk] = get(n, k0 + ch * 16 + kk);
        u32x4 w0, w1; w0.x = cvtpk(v[0], v[1]); w0.y = cvtpk(v[2], v[3]); w0.z = cvtpk(v[4], v[5]); w0.w = cvtpk(v[6], v[7]);
        w1.x = cvtpk(v[8], v[9]); w1.y = cvtpk(v[10], v[11]); w1.z = cvtpk(v[12], v[13]); w1.w = cvtpk(v[14], v[15]);
        bf16_t* p = dst + (size_t)n * ldk + k0 + ch * 16; *(u32x4*)p = w0; *(u32x4*)(p + 8) = w1; }
}
DI void convert_weights(const Args& a, int l, unsigned char* lds, int group) {
    float* tl = (float*)lds; unsigned char* ws = a.ws;
    const float* w_in = a.in[I_WIN] + (size_t)l * 1024 * CIN; const float* v1 = a.in[I_V1] + (size_t)(l > 0 ? l - 1 : 0) * 1024 * 32;
    const float* w_uq = a.in[I_WUQ] + (size_t)l * 256 * 768; const float* w_ukv = a.in[I_WUKV] + (size_t)l * 128 * 1024;
    const float* w2 = a.in[I_W2] + (size_t)l * 2 * 64 * 512; const float* a2 = a.in[I_A2] + (size_t)l * 2 * 64 * 512;
    const float* g2 = a.in[I_G2] + (size_t)l * 128 * 512; const float* v2 = a.in[I_V2] + (size_t)(l > 0 ? l - 1 : 0) * 32 * 512;
    const float* w_out = a.in[I_WOUT] + (size_t)l * 1024 * 1024; const float* m1 = a.in[I_M1] + (size_t)l * 1024 * 4096; const float* m2 = a.in[I_M2] + (size_t)l * 4096 * 1024;
    constexpr int T0 = 640, T1 = T0 + 48, T2 = T1 + 64, T3 = T2 + 128, T4 = T3 + 64, T5 = T4 + 256, T6 = T5 + 1024, T7 = T6 + 1024;
    const int tb = group == 0 ? 0 : T4, te = group == 0 ? T4 : T7;
    for (int t = tb + blockIdx.x * 8 + (ltid() >> 6); t < te; t += gridDim.x * 8) {
        if (t < T0) { const int nt = t >> 4, kt = t & 15;
            cvt_tile((bf16_t*)(ws + WT_IN), 1024, nt * 64, kt * 64, [&](int n, int k) -> float { return n < CIN ? w_in[(size_t)k * CIN + n] : ((n < CINX && l > 0) ? v1[k * 32 + (n - CIN)] : 0.f); }, tl); }
        else if (t < T1) { const int u = t - T0, nt = u >> 2, kt = u & 3;
            cvt_tile((bf16_t*)(ws + WT_UQ), 256, nt * 64, kt * 64, [&](int n, int k) -> float { return w_uq[k * 768 + n]; }, tl); }
        else if (t < T2) { const int u = t - T1, nt = u >> 2, kt = u & 3;
            if (kt < 2) cvt_tile((bf16_t*)(ws + WT_UKV), 128, nt * 64, kt * 64, [&](int n, int k) -> float { return w_ukv[k * 1024 + n]; }, tl); }
        else if (t < T3) { const int u = t - T2, nt = u >> 2, kt = u & 3;
            cvt_tile((bf16_t*)(ws + WT_L1), 256, nt * 64, kt * 64, [&](int n, int k) -> float {
                if (n < 1024) { const int d = n >> 9, c = n & 511; return (k < 128 && (k >> 6) == d) ? w2[(d * 64 + (k & 63)) * 512 + c] : 0.f; }
                const int n2 = n - 1024, d = n2 >> 9, c = n2 & 511; return (k >= 128 && ((k - 128) >> 6) == d) ? a2[(d * 64 + ((k - 128) & 63)) * 512 + c] : 0.f; }, tl); }
        else if (t < T4) { const int u = t - T3, nt = u >> 2, kt = u & 3;
            cvt_tile((bf16_t*)(ws + WT_L2), 256, nt * 64, kt * 64, [&](int n, int k) -> float {
                if (n < 512) return k < 128 ? g2[k * 512 + n] : 0.f;
                return (l > 0 && k >= 128 && k < 160) ? v2[(k - 128) * 512 + (n - 512)] : 0.f; }, tl); }
        else if (t < T5) { const int u = t - T4, nt = u >> 4, kt = u & 15;
            cvt_tile((bf16_t*)(ws + WT_OUT), 1024, nt * 64, kt * 64, [&](int n, int k) -> float { return w_out[(size_t)k * 1024 + n]; }, tl); }
        else if (t < T6) { const int u = t - T5, nt = u >> 4, kt = u & 15;
            cvt_tile((bf16_t*)(ws + WT_M1), 1024, nt * 64, kt * 64, [&](int n, int k) -> float { return m1[(size_t)k * 4096 + n]; }, tl); }
        else { const int u = t - T6, nt = u >> 6, kt = u & 63;
            cvt_tile((bf16_t*)(ws + WT_M2), 4096, nt * 64, kt * 64, [&](int n, int k) -> float { return m2[(size_t)k * 1024 + n]; }, tl); }
    }
}

DI void unpack8(const u32x4& w, float (&f)[8]) { f[0] = bflo(w.x); f[1] = bfhi(w.x); f[2] = bflo(w.y); f[3] = bfhi(w.y); f[4] = bflo(w.z); f[5] = bfhi(w.z); f[6] = bflo(w.w); f[7] = bfhi(w.w); }
DI void shift8r(const u32x4& c_, const u32x4& p_, const u32x4& n_, const float* __restrict__ mu, int col, float (&o)[8]) {
    float c[8], p[8], n[8], u[8]; unpack8(c_, c); unpack8(p_, p); unpack8(n_, n); loadf8(mu + (col - OFF_R), u);
#pragma unroll
    for (int j = 0; j < 8; ++j) o[j] = c[j] + u[j] * (0.5f * (p[j] + n[j]) - c[j]);
}
DI void phase_split(const Args& a, int l) {
    const int lane = ltid() & 63, gw = blockIdx.x * 8 + (ltid() >> 6), nw = gridDim.x * 8;
    unsigned char* ws = a.ws;
    const bf16_t* __restrict__ F = (const bf16_t*)(ws + WS_F); bf16_t* __restrict__ R = (bf16_t*)(ws + WS_R); bf16_t* __restrict__ Kb = (bf16_t*)(ws + WS_K); bf16_t* __restrict__ Vb = (bf16_t*)(ws + (l == 0 ? WS_VF : WS_V));
    bf16_t* __restrict__ A1 = (bf16_t*)(ws + WS_A1); bf16_t* __restrict__ A2 = (bf16_t*)(ws + WS_A2); bf16_t* __restrict__ CQN = (bf16_t*)(ws + WS_CQN); bf16_t* __restrict__ CKVN = (bf16_t*)(ws + WS_CKVN); bf16_t* __restrict__ KA = (bf16_t*)(ws + WS_KATT);
    float* __restrict__ INV = (float*)(ws + WS_INV); const float* __restrict__ rope = (const float*)(ws + WS_ROPE);
    const float* __restrict__ mu = a.in[I_MU] + (size_t)l * 1920; const float* __restrict__ kkp = a.in[I_KK] + l * 512; const float* __restrict__ qg = a.in[I_QNG] + l * 256; const float* __restrict__ kvg = a.in[I_KVNG] + l * 128;
    const u32x4 zero4 = {0u, 0u, 0u, 0u};
    const int lcol = lane < 48 ? OFF_WLO + lane * 8 : (lane < 52 ? OFF_HV + (lane - 48) * 8 : 0);
    const int mcol = lane < 32 ? lane * 8 : (lane < 48 ? 256 + (lane - 32) * 8 : 384 + ((lane - 48) & 3) * 8);
    const int chunk = (TALL + nw - 1) / nw, m0 = gw * chunk, m1 = (m0 + chunk < TALL) ? m0 + chunk : TALL;
    struct Raw { u32x4 r, k, v, l; };
    auto ld4 = [&](int m) -> Raw { Raw t; if (m >= 0 && m < TALL) { const bf16_t* Fq = F + (size_t)m * CINX; t.r = *(const u32x4*)(Fq + OFF_R + lane * 8); t.k = *(const u32x4*)(Fq + OFF_K + lane * 8);
            t.v = *(const u32x4*)(Fq + OFF_V + lane * 8); t.l = (lane < 52) ? *(const u32x4*)(Fq + lcol) : zero4; } else { t.r = zero4; t.k = zero4; t.v = zero4; t.l = zero4; } return t; };
    auto ldm = [&](int m) -> u32x4 { return (m < TALL) ? *(const u32x4*)(F + (size_t)m * CINX + mcol) : zero4; };
    Raw P = ld4(m0 - 1), C = ld4(m0), N = ld4(m0 + 1); u32x4 M = ldm(m0);
    for (int m = m0; m < m1; ++m) {
        const int b = m / TT, tt = m - b * TT; const bool ctx = tt < TC;
        const bool pok = !(tt == 0 || tt == TC), nok = !(tt == TC - 1 || tt == TT - 1);
        const Raw NN = ld4(m + 2); const u32x4 MN = ldm(m + 1);
        u32x4 rc = C.r, kc = C.k, vc = C.v, lc = C.l, rp = P.r, kp = P.k, vp = P.v, lp = P.l, rn = N.r, kn = N.k, vn = N.v, ln = N.l; const u32x4 mc = M;
        if (!pok) { rp = zero4; kp = zero4; vp = zero4; lp = zero4; }
        if (!nok) { rn = zero4; kn = zero4; vn = zero4; ln = zero4; }
        P = C; C = N; N = NN; M = MN;
        float x[8];
        shift8r(rc, rp, rn, mu, OFF_R + lane * 8, x); store8(R + (size_t)m * 512 + lane * 8, x);
        shift8r(kc, kp, kn, mu, OFF_K + lane * 8, x); store8(Kb + (size_t)m * 512 + lane * 8, x);
        { float kq[8], ss = 0.f; loadf8(kkp + lane * 8, kq);
#pragma unroll
          for (int j = 0; j < 8; ++j) { const float t = x[j] * kq[j]; ss += t * t; }
          ss = xorsum(ss, 1); ss = xorsum(ss, 2); ss = xorsum(ss, 4);
          if ((lane & 7) == 0) INV[(size_t)m * 8 + (lane >> 3)] = rsqrtf(fmaxf(ss, 1e-24f)); }
        shift8r(vc, vp, vn, mu, OFF_V + lane * 8, x); store8(Vb + (size_t)m * 512 + lane * 8, x);
        if (lane < 48) { shift8r(lc, lp, ln, mu, lcol, x);
            if (lane < 16) {
#pragma unroll
                for (int j = 0; j < 8; ++j) x[j] = tanhf_(x[j]); }
            else if (lane >= 32) {
#pragma unroll
                for (int j = 0; j < 8; ++j) x[j] = sigmoidf_(x[j]); }
            if (lane < 32) store8(A1 + (size_t)m * 256 + lane * 8, x); else store8(A2 + (size_t)m * 256 + (lane - 32) * 8, x); }
        else { unpack8(lc, x); store8(A2 + (size_t)m * 256 + 128 + (lane - 48) * 8, x); }
        { unpack8(mc, x); float ss = 0.f;
#pragma unroll
          for (int j = 0; j < 8; ++j) ss += x[j] * x[j];
          ss = xorsum(ss, 1); ss = xorsum(ss, 2); ss = xorsum(ss, 4); ss = xorsum(ss, 8); const float ss32 = xorsum(ss, 16);
          float px[8]; const int q = (lane - 48) & 3;
#pragma unroll
          for (int j = 0; j < 8; ++j) px[j] = __shfl_xor(x[j], 1, 64);
          if (lane < 32) { const float rstd = rsqrtf(ss32 * (1.f / 256.f) + 1e-6f); float g[8]; loadf8(qg + lane * 8, g);
#pragma unroll
              for (int j = 0; j < 8; ++j) x[j] = x[j] * rstd * g[j];
              store8(CQN + (size_t)m * 256 + lane * 8, x); }
          else if (lane < 48) { const float rstd = rsqrtf(ss * (1.f / 128.f) + 1e-6f); float g[8]; loadf8(kvg + (lane - 32) * 8, g);
#pragma unroll
              for (int j = 0; j < 8; ++j) x[j] = x[j] * rstd * g[j];
              store8(CKVN + (size_t)m * 128 + (lane - 32) * 8, x); }
          else { if (lane < 52) {
                  if (!ctx) { const int s = tt - TC, pos = (q < 2) ? (s >> 6) : (s & 63); float cs[8], sn[8]; loadf8(rope + pos * 8, cs); loadf8(rope + 512 + pos * 8, sn); const float sg = (q & 1) ? 1.f : -1.f;
#pragma unroll
                      for (int j = 0; j < 8; ++j) x[j] = x[j] * cs[j] + sg * px[j] * sn[j]; }
#pragma unroll
                  for (int hh = 0; hh < 8; ++hh) store8(KA + (size_t)m * 768 + hh * 96 + 64 + q * 8, x); }
          } }
    }
}

DI void phase_rwkv_out(const Args& a, int l, bool latent_only) {
    const int lane = ltid() & 63, gw = blockIdx.x * 8 + (ltid() >> 6), nw = gridDim.x * 8;
    unsigned char* ws = a.ws;
    const bf16_t* R = (const bf16_t*)(ws + WS_R); const bf16_t* Kb = (const bf16_t*)(ws + WS_K); const bf16_t* Vb = (const bf16_t*)(ws + (l == 0 ? WS_VF : WS_V));
    const bf16_t* AA = (const bf16_t*)(ws + WS_AA); const bf16_t* Gb = (const bf16_t*)(ws + WS_G); const bf16_t* YB = (const bf16_t*)(ws + WS_YB); bf16_t* MIX = (bf16_t*)(ws + WS_MIX);
    const int c = lane * 8; float ka[8], rk[8], lw[8], lb[8];
    loadf8(a.in[I_KA] + l * 512 + c, ka); loadf8(a.in[I_RK] + l * 512 + c, rk); loadf8(a.in[I_LNW] + l * 512 + c, lw); loadf8(a.in[I_LNB] + l * 512 + c, lb);
    for (int m = gw; m < TALL; m += nw) {
        const int tt = m % TT; if (latent_only && tt < TC) continue;
        float yf[8], yb[8], r[8], k[8], v[8], a0[8], a1[8], g[8];
        load8(MIX + (size_t)m * 1024 + 512 + c, yf); load8(YB + (size_t)m * 512 + c, yb); load8(R + (size_t)m * 512 + c, r); load8(Kb + (size_t)m * 512 + c, k); load8(Vb + (size_t)m * 512 + c, v);
        load8(AA + (size_t)m * 1024 + c, a0); load8(AA + (size_t)m * 1024 + 512 + c, a1); load8(Gb + (size_t)m * 512 + c, g);
        float s = 0.f, bon = 0.f;
#pragma unroll
        for (int j = 0; j < 8; ++j) { yf[j] += yb[j]; s += yf[j]; bon += r[j] * k[j] * (2.f + (a0[j] + a1[j] - 2.f) * ka[j]) * rk[j]; }
        s = xorsum(s, 1); s = xorsum(s, 2); s = xorsum(s, 4); bon = xorsum(bon, 1); bon = xorsum(bon, 2); bon = xorsum(bon, 4);
        const float mean = s * (1.f / 64.f); float vs = 0.f;
#pragma unroll
        for (int j = 0; j < 8; ++j) { yf[j] -= mean; vs += yf[j] * yf[j]; }
        vs = xorsum(vs, 1); vs = xorsum(vs, 2); vs = xorsum(vs, 4);
        const float rstd = rsqrtf(vs * (1.f / 64.f) + 64e-5f);
#pragma unroll
        for (int j = 0; j < 8; ++j) yf[j] = (yf[j] * rstd * lw[j] + lb[j] + bon * v[j]) * g[j];
        store8(MIX + (size_t)m * 1024 + 512 + c, yf);
    }
}

DI void phase_final(const Args& a) {
    const int lane = ltid() & 63, gw = blockIdx.x * 8 + (ltid() >> 6), nw = gridDim.x * 8; const float* gamma = a.in[I_FG];
    for (int m = gw; m < NB * SEQ; m += nw) {
        float* xr = a.out + (size_t)m * DM; f32x4 v[4]; float ss = 0.f;
#pragma unroll
        for (int i = 0; i < 4; ++i) { v[i] = *(const f32x4*)(xr + i * 256 + lane * 4); ss += v[i][0] * v[i][0] + v[i][1] * v[i][1] + v[i][2] * v[i][2] + v[i][3] * v[i][3]; }
#pragma unroll
        for (int k = 1; k < 64; k <<= 1) ss = xorsum(ss, k);
        const float rstd = rsqrtf(ss * (1.f / 1024.f) + 1e-6f);
#pragma unroll
        for (int i = 0; i < 4; ++i) { const int col = i * 256 + lane * 4; const f32x4 g = *(const f32x4*)(gamma + col); *(f32x4*)(xr + col) = v[i] * rstd * g; }
    }
}

#define LAS __attribute__((address_space(3)))
#define XB_TMO      128
#define XB_XCNT(j)  (256  + 64 * (j))
#define XB_XSUB(j)  (1280 + 64 * (j))
#define XB_XGEN(j)  (2304 + 64 * (j))
#define XB_TOP      3328
#define XB_TOPGEN   3392
#define XCD_BAR_WORDS 3456
#define XB_SPIN_CAP (1u << 18)

__device__ __forceinline__ unsigned xb_ld(unsigned* p)              { return __hip_atomic_load(p, __ATOMIC_RELAXED, __HIP_MEMORY_SCOPE_AGENT); }
__device__ __forceinline__ unsigned xb_add(unsigned* p, unsigned v) { return __hip_atomic_fetch_add(p, v, __ATOMIC_RELAXED, __HIP_MEMORY_SCOPE_AGENT); }
__device__ __forceinline__ unsigned xb_xcc_id() { return (unsigned)__builtin_amdgcn_s_getreg((3 << 11) | 20) & 0xFu; }
#define XB_SPIN(cond, bar) do { unsigned _sp = 0; while (cond) { __builtin_amdgcn_s_sleep(1); \
    if ((++_sp & 255u) == 0u) { if (xb_ld(&(bar)[XB_TMO])) break; if (_sp > XB_SPIN_CAP) { atomicAdd(&(bar)[XB_TMO], 1u); break; } } } } while (0)

struct XcdBarrier {
    unsigned* bar; unsigned x;
    volatile LAS unsigned* st;
};

__device__ __forceinline__ XcdBarrier xcd_barrier_post(unsigned* bar, volatile LAS unsigned* st) {
    XcdBarrier b; b.bar = bar; b.x = xb_xcc_id(); b.st = st;
    if (threadIdx.x == 0) (void)xb_add(&bar[XB_XCNT(b.x)], 1u);
    return b;
}
__device__ __forceinline__ void xcd_barrier_complete(unsigned* bar, unsigned x, unsigned& nloc, unsigned& nx) {
    const unsigned G = gridDim.x * gridDim.y * gridDim.z;
    unsigned sum, cnt, mine, sp = 0u;
    for (;;) {
        sum = 0u; cnt = 0u; mine = 0u;
#pragma unroll
        for (unsigned j = 0; j < 16; ++j) { const unsigned c = xb_ld(&bar[XB_XCNT(j)]); sum += c; cnt += (c > 0u) ? 1u : 0u; mine = (j == x) ? c : mine; }
        if (sum == G) break;
        __builtin_amdgcn_s_sleep(1);
        if ((++sp & 255u) == 0u) { if (xb_ld(&bar[XB_TMO])) break; if (sp > XB_SPIN_CAP) { atomicAdd(&bar[XB_TMO], 1u); break; } }
    }
    nloc = mine > 0u ? mine : 1u; nx = cnt > 0u ? cnt : 1u;
}

__device__ __forceinline__ void xcd_barrier(const XcdBarrier& b) {
    asm volatile("s_waitcnt vmcnt(0)" ::: "memory");
    __syncthreads();
    if (threadIdx.x == 0) {
        unsigned* bar = b.bar;
        __builtin_amdgcn_s_waitcnt(0);
        unsigned nloc = b.st[0], nx = b.st[1];
        if (nloc == 0u) { xcd_barrier_complete(bar, b.x, nloc, nx); b.st[0] = nloc; b.st[1] = nx; }
        const unsigned old = xb_add(&bar[XB_XSUB(b.x)], 1u);
        const unsigned gen = old / nloc;
        if (old + 1u == (gen + 1u) * nloc) {
            __builtin_amdgcn_fence(__ATOMIC_RELEASE, "agent");
            asm volatile("s_waitcnt vmcnt(0)" ::: "memory");
            const unsigned og = xb_add(&bar[XB_TOP], 1u);
            const unsigned tg = og / nx;
            if (og + 1u == (tg + 1u) * nx) xb_add(&bar[XB_TOPGEN], 1u);
            else XB_SPIN(xb_ld(&bar[XB_TOPGEN]) == tg, bar);
            __builtin_amdgcn_fence(__ATOMIC_ACQUIRE, "agent");
            xb_add(&bar[XB_XGEN(b.x)], 1u);
            asm volatile("s_waitcnt vmcnt(0)" ::: "memory");
        } else {
            XB_SPIN(xb_ld(&bar[XB_XGEN(b.x)]) == gen, bar);
            __builtin_amdgcn_fence(__ATOMIC_ACQUIRE, "agent");
            asm volatile("s_waitcnt vmcnt(0)" ::: "memory");
        }
    }
    __syncthreads();
}

__global__ void __launch_bounds__(512, 2) trunk_fwd(Args ka) {
    extern __shared__ __attribute__((aligned(16))) unsigned char lds[];
    cg::grid_group grid = cg::this_grid();
    volatile LAS unsigned* bst = (volatile LAS unsigned*)((LAS unsigned char*)lds + (LDS_BYTES - 16));
    if (threadIdx.x < 4) bst[threadIdx.x] = 0u;
    __syncthreads();
    XcdBarrier xbar = xcd_barrier_post((unsigned*)(ka.ws + WS_BAR), bst);
    const int ph_hi = ka.hi;
    {
        if (blockIdx.x == 0 && threadIdx.x == 0) {
#pragma unroll
            for (int i = 0; i < 31; ++i) ((const float**)(ka.ws + WS_TAB))[i] = ka.in[i]; }
        phase_prologue(ka, lds); convert_weights(ka, 0, lds, 0);
        grid.sync();
    }
    for (int ph = 1; ph < ph_hi; ++ph) {
        Args a; a.ws = ka.ws; a.out = ka.out; asm volatile("" : "+s"(a.ws)); asm volatile("" : "+s"(a.out));
        { const float* const* tab = (const float* const*)(a.ws + WS_TAB);
#define LD4(i) asm volatile("s_load_dwordx2 %0, %4, %5\n\ts_load_dwordx2 %1, %4, %6\n\ts_load_dwordx2 %2, %4, %7\n\ts_load_dwordx2 %3, %4, %8\n\ts_waitcnt lgkmcnt(0)" \
              : "=&s"(a.in[i]), "=&s"(a.in[i + 1]), "=&s"(a.in[i + 2]), "=&s"(a.in[i + 3]) : "s"(tab), "i"((i) * 8), "i"((i) * 8 + 8), "i"((i) * 8 + 16), "i"((i) * 8 + 24))
          LD4(0); LD4(4); LD4(8); LD4(12); LD4(16); LD4(20); LD4(24);
          asm volatile("s_load_dwordx2 %0, %3, %4\n\ts_load_dwordx2 %1, %3, %5\n\ts_load_dwordx2 %2, %3, %6\n\ts_waitcnt lgkmcnt(0)" : "=&s"(a.in[28]), "=&s"(a.in[29]), "=&s"(a.in[30]) : "s"(tab), "i"(224), "i"(232), "i"(240));
#undef LD4
        }
        a.lo = 0; a.hi = 0;
        unsigned char* ws = a.ws;
        if (ph == 1) phase_vectors(a, lds);
        else if (ph == NPH - 1) phase_final(a);
        else {
            const int l = (ph - 2) / 10, s = (ph - 2) % 10; const bool last = (l == NL - 1);
            const float* mods = (const float*)(ws + WS_MODS) + (size_t)l * 33 * 6144;
            float* rsa = (float*)(ws + WS_RSA); float* rsb = (float*)(ws + WS_RSB);
            if (s == 0) { run_gemm<NIN, 1024>(lds, (const bf16_t*)(ws + WS_H), (const bf16_t*)(ws + WT_IN), 0, FnF{(bf16_t*)(ws + WS_F), rsa, (const float*)(ws + WS_C1) + (size_t)l * 33 * NIN}); }
            else if (s == 1) { phase_split(a, l); convert_weights(a, l, lds, 1);
                for (int i = blockIdx.x * 512 + ltid(); i < TALL; i += gridDim.x * 512) { rsa[i] = 0.f; rsb[i] = 0.f; } }
            else if (s == 2) { run_gemm<768, 256>(lds, (const bf16_t*)(ws + WS_CQN), (const bf16_t*)(ws + WT_UQ), 0, FnQ{(bf16_t*)(ws + WS_Q), (const float*)(ws + WS_ROPE)});
                    run_gemm<1024, 128>(lds, (const bf16_t*)(ws + WS_CKVN), (const bf16_t*)(ws + WT_UKV), 0, FnKV{(bf16_t*)(ws + WS_KATT), (bf16_t*)(ws + WS_VATT)}); }
            else if (s == 3) { phase_attn((const bf16_t*)(ws + WS_Q), (const bf16_t*)(ws + WS_KATT), (const bf16_t*)(ws + WS_VATT), (bf16_t*)(ws + WS_MIX), last, (char*)lds); }
            else if (s == 4) { run_gemm<2048, 256>(lds, (const bf16_t*)(ws + WS_A1), (const bf16_t*)(ws + WT_L1), 0, FnL1{(__half*)(ws + WS_DEC), (bf16_t*)(ws + WS_AA), a.in[I_W0] + l * 1024, a.in[I_A0] + l * 1024});
                    run_gemm<1024, 256>(lds, (const bf16_t*)(ws + WS_A2), (const bf16_t*)(ws + WT_L2), 0,
                             FnL2{(bf16_t*)(ws + WS_G), (bf16_t*)(ws + WS_V), (const bf16_t*)(ws + WS_VF), a.in[I_V0] + (l > 0 ? l - 1 : 0) * 512, l > 0 ? 1 : 0}); }
            else if (s == 5) { phase_scan((const bf16_t*)(ws + WS_R), (const bf16_t*)(ws + WS_K), (const bf16_t*)(ws + (l == 0 ? WS_VF : WS_V)), (const __half*)(ws + WS_DEC), (const bf16_t*)(ws + WS_AA),
                               (const float*)(ws + WS_INV), a.in[I_KK] + l * 512, a.in[I_KA] + l * 512, (bf16_t*)(ws + WS_MIX), (bf16_t*)(ws + WS_YB), (char*)lds); }
            else if (s == 6) { phase_rwkv_out(a, l, last); if (!last) convert_weights(a, l + 1, lds, 0); }
            else if (s == 7) { run_gemm_epi<1024, 1024>(lds, (const bf16_t*)(ws + WS_MIX), (const bf16_t*)(ws + WT_OUT), last ? 1 : 0,
                             EpiRes{a.out, (float*)(ws + WS_XC), l == 0 ? a.in[I_X] : a.out, l == 0 ? a.in[I_CTX] : (const float*)(ws + WS_XC), mods, 2,
                                    (const float*)(ws + WS_GP2) + (size_t)l * 33 * 1024, (bf16_t*)(ws + WS_H), rsb, 1}); }
            else if (s == 8) { run_gemm<DFF, 1024>(lds, (const bf16_t*)(ws + WS_H), (const bf16_t*)(ws + WT_M1), last ? 1 : 0, FnM1{(bf16_t*)(ws + WS_HID), rsb, (const float*)(ws + WS_C2) + (size_t)l * 33 * DFF}); }
            else if (s == 9) { run_gemm_epi<1024, DFF>(lds, (const bf16_t*)(ws + WS_HID), (const bf16_t*)(ws + WT_M2), last ? 1 : 0,
                             EpiRes{a.out, (float*)(ws + WS_XC), a.out, (const float*)(ws + WS_XC), mods, 5,
                                    (const float*)(ws + WS_GP1) + (size_t)(last ? l : l + 1) * 33 * 1024, (bf16_t*)(ws + WS_H), rsa, last ? 0 : 1}); }
        }
        if (ph + 1 < ph_hi) { XcdBarrier xb = xbar; asm volatile("" : "+s"(xb.bar)); xcd_barrier(xb); }
    }
}

extern "C" void kernel_launch(void* const* d_in, const int* in_sizes, int n_in, void* d_out, int out_size, void* d_ws, size_t ws_size, hipStream_t stream) {
    static int grid = 0;
    if (grid == 0) {
        if (n_in != 31 || out_size != NB * SEQ * DM || ws_size < WS_END) { fprintf(stderr, "kernel_launch: unexpected shapes: n_in %d out %d ws %zu (need %zu)\n", n_in, out_size, ws_size, (size_t)WS_END); grid = -1; return; }
        int dev = 0, cus = 0, per_cu = 0;
        (void)hipGetDevice(&dev); (void)hipDeviceGetAttribute(&cus, hipDeviceAttributeMultiprocessorCount, dev);
        if (hipFuncSetAttribute((const void*)trunk_fwd, hipFuncAttributeMaxDynamicSharedMemorySize, LDS_BYTES) != hipSuccess) { fprintf(stderr, "kernel_launch: hipFuncSetAttribute failed\n"); grid = -1; return; }
        if (hipOccupancyMaxActiveBlocksPerMultiprocessor(&per_cu, (const void*)trunk_fwd, 512, LDS_BYTES) != hipSuccess || per_cu < 1) { fprintf(stderr, "kernel_launch: occupancy query gave %d\n", per_cu); per_cu = 1; }
        (void)hipGetLastError();
        grid = cus * 1;
    }
    if (grid < 0) return;
    if (hipMemsetAsync((char*)d_ws + WS_BAR, 0, BAR_BYTES, stream) != hipSuccess) { fprintf(stderr, "kernel_launch: hipMemsetAsync failed\n"); return; }
    Args a{};
    for (int i = 0; i < 31; ++i) a.in[i] = (const float*)d_in[i];
    a.out = (float*)d_out; a.ws = (unsigned char*)d_ws; a.lo = 0; a.hi = NPH;
    void* args[] = {&a};
    hipError_t e = hipLaunchCooperativeKernel((const void*)trunk_fwd, dim3(grid), dim3(512), args, LDS_BYTES, stream);
    if (e != hipSuccess) fprintf(stderr, "kernel_launch: cooperative launch failed: %s (grid %d)\n", hipGetErrorString(e), grid);
}
```

```cpp
#include <hip/hip_runtime.h>
#include <hip/hip_cooperative_groups.h>
#include <hip/hip_fp16.h>
#include <cstdio>
#include <cstdint>
namespace cg = cooperative_groups;
#define DI __device__ __forceinline__
DI int ltid() { int t = threadIdx.x; asm volatile("" : "+v"(t)); return t; }
namespace pg8 {
#define PG8_LAS __attribute__((address_space(3)))
typedef unsigned short bf16_t;
typedef short bf16x8 __attribute__((ext_vector_type(8)));
typedef float f32x4 __attribute__((ext_vector_type(4)));
typedef unsigned u32x4 __attribute__((ext_vector_type(4)));
constexpr int BM = 256, BK = 64, HALF = 128, HTB = HALF * BK * 2  , STAGE_BYTES = 8 * HTB, NXCD = 8, WGM = 8;

__host__ __device__ __forceinline__ int lds_byte(int r, int c) { const int st = (r >> 4) * 2 + (c >> 5), rr = r & 15, cc = c & 31, ob = rr * 64 + cc * 2; return st * 1024 + (ob ^ (((ob >> 9) & 1) << 5)); }
__host__ __device__ __forceinline__ void stage_rc(int b, int& R, int& C) { const int st = b / 1024, sb = b % 1024, swz = sb ^ (((sb >> 9) & 1) << 5); R = (st >> 1) * 16 + swz / 64; C = (st & 1) * 32 + (swz % 64) / 2; }
__host__ __device__ __forceinline__ int perm32(int rho) { const int n = rho >> 4, i = rho & 15; return 8 * (i >> 2) + 4 * n + (i & 3); }

struct Unit { int pm, pn; };
struct Gemm { const bf16_t* A; const bf16_t* Bt; int M, N, K; };

struct StaticOrder {
    int nM, nN, nwg, G, c;
    __host__ __device__ void init(int M, int N, int G_, int c_) { nM = M / BM; nN = N / BM; nwg = nM * nN; G = G_; c = c_; }
    __host__ __device__ bool next(int i, Unit& u) const {
        const long L = (long)i * G + c; if (L >= nwg) return false;
        int wgid = (int)L; { const int q = nwg / NXCD, r = nwg % NXCD, xcd = wgid % NXCD, off = wgid / NXCD; wgid = (xcd < r ? xcd * (q + 1) : r * (q + 1) + (xcd - r) * q) + off; }
        const int nig = WGM * nN, gid = wgid / nig, fm = gid * WGM, gsz = (nM - fm) < WGM ? (nM - fm) : WGM;
        u.pm = fm + ((wgid % nig) % gsz); u.pn = (wgid % nig) / gsz; return true;
    }
    __device__ __forceinline__ void a_ready(const Unit&) const {}
    __device__ __forceinline__ void done(const Unit&) const {}
};

__device__ __forceinline__ unsigned cvt_pk_bf16(float lo, float hi) { unsigned r; asm volatile("v_cvt_pk_bf16_f32 %0, %1, %2" : "=v"(r) : "v"(lo), "v"(hi)); return r; }

template <class Epi, class Sched, bool ALIGN_EPI = false, bool SP2 = false>
__device__ __forceinline__ void gemm_phase(PG8_LAS unsigned char* lds, const Gemm g, const Sched& S, const Epi& E) {
    const int tid = ltid(), wid = __builtin_amdgcn_readfirstlane(tid >> 6), lane = tid & 63, wr = wid >> 2, wc = wid & 3, fr = lane & 15, fq = lane >> 4;
    const int K = g.K, nt = K / BK;
    unsigned voffA[2], voffB[2];
#pragma unroll
    for (int i = 0; i < 2; ++i) { int R, C; stage_rc(tid * 16 + i * 8192, R, C); const int Rb = Epi::PERM ? ((R & ~31) + perm32(R & 31)) : R;
        voffA[i] = (unsigned)(R * K + C) * 2u; voffB[i] = (unsigned)(Rb * K + C) * 2u; }
    const size_t kstep = (size_t)(BK * 2);
    const size_t hstep = (size_t)HALF * K * 2;
    const size_t tstep = 2 * hstep;
    const unsigned ldsw = (unsigned)wid * 1024u;
    const int aoff = lds_byte(wr * 64 + fr, fq * 8), boff = lds_byte(wc * 32 + fr, fq * 8);
#define PG8_SA(b, h) (((b) * 2 + (h)) * HTB)
#define PG8_SB(b, h) ((4 + (b) * 2 + (h)) * HTB)
#define PG8_STAGE(bufoff, gbase, voff) do { _Pragma("unroll") for (int _i = 0; _i < 2; ++_i) \
        __builtin_amdgcn_global_load_lds((const unsigned*)((const char*)(gbase) + (voff)[_i]), (PG8_LAS unsigned*)(lds + (bufoff) + ldsw + _i * 8192), 16, 0, 0); } while (0)
#define PG8_LDA(dst, b, h) do { _Pragma("unroll") for (int m = 0; m < 4; ++m) _Pragma("unroll") for (int k = 0; k < 2; ++k) dst[m][k] = *(const PG8_LAS bf16x8*)(lds + PG8_SA(b, h) + aoff + m * 2048 + k * 1024); } while (0)
#define PG8_LDB(dst, b, h) do { _Pragma("unroll") for (int n = 0; n < 2; ++n) _Pragma("unroll") for (int k = 0; k < 2; ++k) dst[n][k] = *(const PG8_LAS bf16x8*)(lds + PG8_SB(b, h) + boff + n * 2048 + k * 1024); } while (0)
#define PG8_MMA(ai, bj, At, Bt) do { __builtin_amdgcn_s_setprio(1); _Pragma("unroll") for (int m = 0; m < 4; ++m) _Pragma("unroll") for (int n = 0; n < 2; ++n) _Pragma("unroll") for (int k = 0; k < 2; ++k) \
        acc[ai][bj][m][n] = __builtin_amdgcn_mfma_f32_16x16x32_bf16(Bt[n][k], At[m][k], acc[ai][bj][m][n], 0, 0, 0); __builtin_amdgcn_s_setprio(0); } while (0)
#define PG8_WAIT_V(n) asm volatile("s_waitcnt vmcnt(" #n ")" ::: "memory")
#define PG8_WAIT_L(n) asm volatile("s_waitcnt lgkmcnt(" #n ")" ::: "memory")
#define PG8_BAR __builtin_amdgcn_s_barrier()
#define PG8_SCHED __builtin_amdgcn_sched_barrier(0)
    Unit cur, nxt; int ui = 0;
    if (!S.next(0, cur)) return;
    f32x4 acc[2][2][4][2];
#pragma unroll
    for (int a = 0; a < 2; ++a)
#pragma unroll
        for (int b = 0; b < 2; ++b)
#pragma unroll
            for (int m = 0; m < 4; ++m)
#pragma unroll
                for (int n = 0; n < 2; ++n) acc[a][b][m][n] = (f32x4){0.f, 0.f, 0.f, 0.f};
    bf16x8 At[4][2], B0[2][2], B1[2][2];
    const char* cA = (const char*)g.A + (size_t)cur.pm * tstep; const char* cB = (const char*)g.Bt + (size_t)cur.pn * tstep;
    S.a_ready(cur);
    if constexpr (SP2) {
        PG8_STAGE(PG8_SB(0, 0), cB, voffB); PG8_STAGE(PG8_SB(0, 1), cB + hstep, voffB); PG8_STAGE(PG8_SA(0, 0), cA, voffA); PG8_STAGE(PG8_SA(0, 1), cA + hstep, voffA);
        if (wr == 1) PG8_BAR;
        PG8_WAIT_V(2); PG8_BAR;
        PG8_STAGE(PG8_SB(1, 0), cB + kstep, voffB); PG8_STAGE(PG8_SA(1, 0), cA + kstep, voffA); PG8_STAGE(PG8_SB(1, 1), cB + hstep + kstep, voffB);
        PG8_WAIT_V(6); PG8_BAR;
    } else {
        PG8_STAGE(PG8_SB(0, 0), cB, voffB); PG8_STAGE(PG8_SA(0, 0), cA, voffA); PG8_STAGE(PG8_SB(0, 1), cB + hstep, voffB); PG8_STAGE(PG8_SA(0, 1), cA + hstep, voffA);
        if (wr == 1) PG8_BAR;
        PG8_WAIT_V(4); PG8_BAR;
        PG8_STAGE(PG8_SB(1, 0), cB + kstep, voffB); PG8_STAGE(PG8_SA(1, 0), cA + kstep, voffA); PG8_STAGE(PG8_SB(1, 1), cB + hstep + kstep, voffB);
        PG8_WAIT_V(6); PG8_BAR;
    }
    for (;;) {
        const bool has_next = S.next(ui + 1, nxt);
        const char* nA = has_next ? (const char*)g.A + (size_t)nxt.pm * tstep : cA; const char* nB = has_next ? (const char*)g.Bt + (size_t)nxt.pn * tstep : cB;
#pragma nounroll
        for (int t = 0; t < nt; t += 2) {
            const bool last = (t == nt - 2);
            const char* a1 = cA + (size_t)(t + 1) * kstep;
            const char* a2 = last ? nA : cA + (size_t)(t + 2) * kstep; const char* b2 = last ? nB : cB + (size_t)(t + 2) * kstep;
            const char* a3 = a2 + kstep; const char* b3 = b2 + kstep;
            if (last && has_next) S.a_ready(nxt);
            if constexpr (SP2) {
            PG8_LDB(B0, 0, 0); PG8_LDB(B1, 0, 1); PG8_SCHED; PG8_LDA(At, 0, 0); PG8_STAGE(PG8_SA(1, 1), a1 + hstep, voffA);
            PG8_WAIT_V(8); PG8_WAIT_L(0); PG8_BAR; PG8_MMA(0, 0, At, B0); PG8_MMA(0, 1, At, B1); PG8_BAR; PG8_SCHED;
            PG8_LDA(At, 0, 1); PG8_STAGE(PG8_SB(0, 0), b2, voffB); PG8_STAGE(PG8_SB(0, 1), b2 + hstep, voffB); PG8_STAGE(PG8_SA(0, 0), a2, voffA);
            PG8_WAIT_V(8); PG8_WAIT_L(0); PG8_BAR; PG8_MMA(1, 0, At, B0); PG8_MMA(1, 1, At, B1); PG8_BAR; PG8_SCHED;
            PG8_LDB(B0, 1, 0); PG8_LDB(B1, 1, 1); PG8_SCHED; PG8_LDA(At, 1, 0); PG8_STAGE(PG8_SA(0, 1), a2 + hstep, voffA);
            PG8_WAIT_V(8); PG8_WAIT_L(0); PG8_BAR; PG8_MMA(0, 0, At, B0); PG8_MMA(0, 1, At, B1); PG8_BAR; PG8_SCHED;
            PG8_LDA(At, 1, 1); PG8_STAGE(PG8_SB(1, 0), b3, voffB); PG8_STAGE(PG8_SB(1, 1), b3 + hstep, voffB); PG8_STAGE(PG8_SA(1, 0), a3, voffA);
            PG8_WAIT_V(8); PG8_WAIT_L(0); PG8_BAR; PG8_MMA(1, 0, At, B0); PG8_MMA(1, 1, At, B1); PG8_BAR; PG8_SCHED;
            } else {
            PG8_LDB(B0, 0, 0); PG8_SCHED; PG8_LDA(At, 0, 0); PG8_STAGE(PG8_SA(1, 1), a1 + hstep, voffA);
            PG8_WAIT_L(8); PG8_BAR; PG8_WAIT_L(0); PG8_MMA(0, 0, At, B0); PG8_BAR; PG8_SCHED;
            PG8_LDB(B1, 0, 1); PG8_STAGE(PG8_SB(0, 0), b2, voffB);
            PG8_BAR; PG8_WAIT_L(0); PG8_MMA(0, 1, At, B1); PG8_BAR;
            PG8_LDA(At, 0, 1); PG8_STAGE(PG8_SA(0, 0), a2, voffA);
            PG8_BAR; PG8_WAIT_L(0); PG8_MMA(1, 0, At, B0); PG8_BAR; PG8_SCHED;
            PG8_STAGE(PG8_SB(0, 1), b2 + hstep, voffB);
            PG8_WAIT_V(6); PG8_BAR; PG8_MMA(1, 1, At, B1); PG8_BAR;
            PG8_LDB(B0, 1, 0); PG8_SCHED; PG8_LDA(At, 1, 0); PG8_STAGE(PG8_SA(0, 1), a2 + hstep, voffA);
            PG8_WAIT_L(8); PG8_BAR; PG8_WAIT_L(0); PG8_MMA(0, 0, At, B0); PG8_BAR; PG8_SCHED;
            PG8_LDB(B1, 1, 1); PG8_STAGE(PG8_SB(1, 0), b3, voffB);
            PG8_BAR; PG8_WAIT_L(0); PG8_MMA(0, 1, At, B1); PG8_BAR;
            PG8_LDA(At, 1, 1); PG8_STAGE(PG8_SA(1, 0), a3, voffA);
            PG8_BAR; PG8_WAIT_L(0); PG8_MMA(1, 0, At, B0); PG8_BAR; PG8_SCHED;
            PG8_STAGE(PG8_SB(1, 1), b3 + hstep, voffB);
            PG8_WAIT_V(6); PG8_BAR; PG8_MMA(1, 1, At, B1); PG8_BAR;
            }
        }
        if constexpr (ALIGN_EPI) { if (wr == 0) PG8_BAR; }
        if constexpr (!Epi::AFTER_DRAIN) { E(acc, cur, wr, wc, fr, fq); S.done(cur); }
        if (!has_next) break;
#pragma unroll
        for (int a = 0; a < 2; ++a)
#pragma unroll
            for (int b = 0; b < 2; ++b)
#pragma unroll
                for (int m = 0; m < 4; ++m)
#pragma unroll
                    for (int n = 0; n < 2; ++n) acc[a][b][m][n] = (f32x4){0.f, 0.f, 0.f, 0.f};
        cur = nxt; cA = nA; cB = nB; ++ui;
        if constexpr (ALIGN_EPI) { if (wr == 1) PG8_BAR; }
    }
    PG8_WAIT_V(0);
    if constexpr (!ALIGN_EPI) { if (wr == 0) PG8_BAR; }
    PG8_BAR;
    if constexpr (Epi::AFTER_DRAIN) { E.fused(acc, cur, wr, wc, fr, fq, lds, wid, lane); S.done(cur); }
#undef PG8_SA
#undef PG8_SB
#undef PG8_STAGE
#undef PG8_LDA
#undef PG8_LDB
#undef PG8_MMA
#undef PG8_WAIT_V
#undef PG8_WAIT_L
#undef PG8_BAR
#undef PG8_SCHED
}
}
typedef unsigned short bf16_t;
using bf16x8 = __attribute__((ext_vector_type(8))) short;
using s16x4  = __attribute__((ext_vector_type(4))) short;
using f32x16 = __attribute__((ext_vector_type(16))) float;
using f32x4  = __attribute__((ext_vector_type(4))) float;
using u32x4  = __attribute__((ext_vector_type(4))) unsigned;
using u32x2  = __attribute__((ext_vector_type(2))) unsigned;

constexpr int DM = 1024, NB = 32, SEQ = 2048, TC = 256, TT = 2304, TALL = NB * TT, NL = 4;
constexpr int CIN = 2336, CINX = 2368, NIN = 2560, DFF = 4096;
constexpr int OFF_R = 416, OFF_K = 928, OFF_V = 1440, OFF_WLO = 1952, OFF_HV = 2336;
constexpr int NPH = 43, LDS_BYTES = 147456;
constexpr size_t MiB = 1u << 20;
constexpr size_t WS_MODS = 0, WS_ROPE = 3 * MiB + 512 * 1024, WS_BAR = 3 * MiB + 768 * 1024, BAR_BYTES = 16384, WS_TAB = 3 * MiB + 800 * 1024, WS_XC = 4 * MiB, WS_VF = 36 * MiB, WS_WT = 108 * MiB, WS_INV = 134 * MiB, TR = 137 * MiB;
constexpr size_t WT_IN = WS_WT, WT_UQ = WS_WT + 5 * MiB, WT_UKV = WS_WT + 5 * MiB + 512 * 1024, WT_L1 = WS_WT + 6 * MiB, WT_L2 = WS_WT + 7 * MiB,
                 WT_OUT = WS_WT + 8 * MiB, WT_M1 = WS_WT + 10 * MiB, WT_M2 = WS_WT + 18 * MiB;
constexpr size_t WS_R = TR, WS_K = TR + 72 * MiB, WS_H = TR, WS_F = TR + 144 * MiB, WS_Q = TR + 144 * MiB, WS_VATT = TR + 252 * MiB, WS_MIX = TR + 324 * MiB,
                 WS_DEC = TR + 144 * MiB, WS_HID = TR + 144 * MiB, WS_A1 = TR + 477 * MiB, WS_A2 = TR + 513 * MiB, WS_YB = TR + 477 * MiB,
                 WS_CQN = TR + 549 * MiB, WS_CKVN = TR + 585 * MiB, WS_KATT = TR + 621 * MiB, WS_AA = TR + 585 * MiB, WS_G = TR + 729 * MiB,
                 WS_V = TR + 801 * MiB, WS_C1 = 1010 * MiB, WS_C2 = 1012 * MiB, WS_GP1 = 1015 * MiB, WS_GP2 = 1016 * MiB, WS_END = 1017 * MiB;
constexpr size_t WS_RSA = 136 * MiB + 256 * 1024, WS_RSB = 136 * MiB + 640 * 1024;

struct Args { const float* in[31]; float* out; unsigned char* ws; int lo, hi; };
enum { I_X = 0, I_C, I_CTX, I_CCTX, I_ADAW, I_ADAB, I_N1G, I_N2G, I_WIN, I_QNG, I_WUQ, I_KVNG, I_WUKV, I_MU, I_W0, I_W2, I_A0, I_A2, I_G2, I_KK, I_KA, I_RK,
       I_LNW, I_LNB, I_V1, I_V2, I_V0, I_WOUT, I_M1, I_M2, I_FG };

DI float bflo(unsigned w) { return __uint_as_float(w << 16); }
DI float bfhi(unsigned w) { return __uint_as_float(w & 0xffff0000u); }
DI unsigned cvtpk(float lo, float hi) { return pg8::cvt_pk_bf16(lo, hi); }
DI bf16_t f2bf(float f) { return (bf16_t)(cvtpk(f, 0.f) & 0xffffu); }
DI void load8(const bf16_t* p, float (&f)[8]) { const u32x4 w = *(const u32x4*)p; f[0] = bflo(w.x); f[1] = bfhi(w.x); f[2] = bflo(w.y); f[3] = bfhi(w.y); f[4] = bflo(w.z); f[5] = bfhi(w.z); f[6] = bflo(w.w); f[7] = bfhi(w.w); }
DI void store8(bf16_t* p, const float (&f)[8]) { u32x4 w; w.x = cvtpk(f[0], f[1]); w.y = cvtpk(f[2], f[3]); w.z = cvtpk(f[4], f[5]); w.w = cvtpk(f[6], f[7]); *(u32x4*)p = w; }
DI void loadf8(const float* p, float (&f)[8]) { const f32x4 a = *(const f32x4*)p, b = *(const f32x4*)(p + 4); f[0] = a[0]; f[1] = a[1]; f[2] = a[2]; f[3] = a[3]; f[4] = b[0]; f[5] = b[1]; f[6] = b[2]; f[7] = b[3]; }
DI float h2f(unsigned b) { return __half2float(__ushort_as_half((unsigned short)b)); }
DI float sigmoidf_(float x) { return __builtin_amdgcn_rcpf(1.f + __expf(-x)); }
DI float tanhf_(float x) { return 1.f - 2.f * __builtin_amdgcn_rcpf(1.f + __expf(2.f * x)); }
DI float xorsum(float v, int mask) { return v + __shfl_xor(v, mask, 64); }
DI float* xrow(float* out, float* xc, int m) { const int b = m / TT, tt = m - b * TT; return tt < TC ? xc + (size_t)(b * TC + tt) * DM : out + (size_t)(b * SEQ + tt - TC) * DM; }

template <class Fn> struct Epi8 {
    static constexpr bool PERM = true, AFTER_DRAIN = false; Fn f;
    DI void operator()(const pg8::f32x4 (&acc)[2][2][4][2], const pg8::Unit& u, int wr, int wc, int fr, int fq) const {
        asm volatile("" : "+v"(fr), "+v"(fq));
#pragma unroll
        for (int ai = 0; ai < 2; ++ai)
#pragma unroll
            for (int m = 0; m < 4; ++m) { const int rit = ai * 128 + wr * 64 + m * 16 + fr;
#pragma unroll
                for (int bj = 0; bj < 2; ++bj) { f(rit, u.pn * 256 + bj * 128 + wc * 32 + 8 * fq, acc[ai][bj][m][0], acc[ai][bj][m][1], u, fq); __builtin_amdgcn_sched_barrier(0); } }
    }
};
DI void st8(bf16_t* p, const pg8::f32x4& v0, const pg8::f32x4& v1) { u32x4 w; w.x = cvtpk(v0[0], v0[1]); w.y = cvtpk(v0[2], v0[3]); w.z = cvtpk(v1[0], v1[1]); w.w = cvtpk(v1[2], v1[3]); *(u32x4*)p = w; }

struct FnF { bf16_t* F; const float* rs; const float* c1;
    DI void operator()(int rit, int col0, const pg8::f32x4& v0, const pg8::f32x4& v1, const pg8::Unit& u, int) const {
        if (col0 < CINX) { const int row = u.pm * 256 + rit, b = u.pm / 9, mrow = (u.pm - b * 9 == 0) ? 32 : b;
            const float rstd = rsqrtf(rs[row] * (1.f / 1024.f) + 1e-6f); const float* c = c1 + (size_t)mrow * NIN + col0;
            const pg8::f32x4 b0 = *(const pg8::f32x4*)c, b1 = *(const pg8::f32x4*)(c + 4);
            st8(F + (size_t)row * CINX + col0, v0 * rstd + b0, v1 * rstd + b1); } } };
struct FnQ { bf16_t* Q; const float* rope;
    DI void operator()(int rit, int col0, const pg8::f32x4& v0, const pg8::f32x4& v1, const pg8::Unit& u, int fq) const {
        const int seg = u.pm % 9; const bool isrope = (seg != 0) && (((col0 >> 5) % 3) == 2);
        float x[8] = {v0[0], v0[1], v0[2], v0[3], v1[0], v1[1], v1[2], v1[3]};
        if (isrope) { const int s = (seg - 1) * 256 + rit, pos = (fq < 2) ? (s >> 6) : (s & 63); float cs[8], sn[8]; loadf8(rope + pos * 8, cs); loadf8(rope + 512 + pos * 8, sn);
            const float sg = (fq & 1) ? 1.f : -1.f;
#pragma unroll
            for (int j = 0; j < 8; ++j) { const float p = __shfl_xor(x[j], 16, 64); x[j] = x[j] * cs[j] + sg * p * sn[j]; } }
        store8(Q + (size_t)(u.pm * 256 + rit) * 768 + col0, x); } };
struct FnKV { bf16_t* KA; bf16_t* VA;
    DI void operator()(int rit, int col0, const pg8::f32x4& v0, const pg8::f32x4& v1, const pg8::Unit& u, int) const {
        const size_t row = (size_t)(u.pm * 256 + rit); const int h = col0 >> 7, c = col0 & 127;
        if (c < 64) st8(KA + row * 768 + h * 96 + c, v0, v1); else st8(VA + row * 512 + h * 64 + (c - 64), v0, v1); } };
struct FnL1 { __half* DEC; bf16_t* AA; const float* w0; const float* a0;
    DI void operator()(int rit, int col0, const pg8::f32x4& v0, const pg8::f32x4& v1, const pg8::Unit& u, int) const {
        const size_t row = (size_t)(u.pm * 256 + rit); float x[8] = {v0[0], v0[1], v0[2], v0[3], v1[0], v1[1], v1[2], v1[3]};
        if (col0 < 1024) { float b[8]; loadf8(w0 + col0, b); u32x4 w; unsigned hh[8];
#pragma unroll
            for (int j = 0; j < 8; ++j) { const float uu = 0.6065306597f * sigmoidf_(x[j] + b[j]); hh[j] = (unsigned)__half_as_ushort(__float2half(-uu * 1.4426950409f)); }
            w.x = hh[0] | (hh[1] << 16); w.y = hh[2] | (hh[3] << 16); w.z = hh[4] | (hh[5] << 16); w.w = hh[6] | (hh[7] << 16);
            *(u32x4*)(DEC + row * 1024 + col0) = w;
        } else { const int c = col0 - 1024; float b[8]; loadf8(a0 + c, b);
#pragma unroll
            for (int j = 0; j < 8; ++j) x[j] = sigmoidf_(x[j] + b[j]);
            store8(AA + row * 1024 + c, x); } } };
struct FnL2 { bf16_t* G; bf16_t* V; const bf16_t* VF; const float* v0p; int dovres;
    DI void operator()(int rit, int col0, const pg8::f32x4& v0, const pg8::f32x4& v1, const pg8::Unit& u, int) const {
        const size_t row = (size_t)(u.pm * 256 + rit);
        if (col0 < 512) st8(G + row * 512 + col0, v0, v1);
        else if (dovres) { const int c = col0 - 512; float x[8] = {v0[0], v0[1], v0[2], v0[3], v1[0], v1[1], v1[2], v1[3]}, b[8], v[8], vf[8]; loadf8(v0p + c, b); load8(V + row * 512 + c, v); load8(VF + row * 512 + c, vf);
#pragma unroll
            for (int j = 0; j < 8; ++j) v[j] = v[j] + (vf[j] - v[j]) * sigmoidf_(b[j] + x[j]);
            store8(V + row * 512 + c, v); } } };
struct FnM1 { bf16_t* HID; const float* rs; const float* c2;
    DI void operator()(int rit, int col0, const pg8::f32x4& v0, const pg8::f32x4& v1, const pg8::Unit& u, int) const {
        const int row = u.pm * 256 + rit, b = u.pm / 9, mrow = (u.pm - b * 9 == 0) ? 32 : b;
        const float rstd = rsqrtf(rs[row] * (1.f / 1024.f) + 1e-6f); const float* c = c2 + (size_t)mrow * DFF + col0;
        const pg8::f32x4 b0 = *(const pg8::f32x4*)c, b1 = *(const pg8::f32x4*)(c + 4);
        const pg8::f32x4 y0 = v0 * rstd + b0, y1 = v1 * rstd + b1;
        float x[8] = {y0[0], y0[1], y0[2], y0[3], y1[0], y1[1], y1[2], y1[3]};
#pragma unroll
        for (int j = 0; j < 8; ++j) { const float r = fmaxf(x[j], 0.f); x[j] = r * r; }
        store8(HID + (size_t)row * DFF + col0, x); } };
struct EpiRes { static constexpr bool PERM = true, AFTER_DRAIN = false;
    float* out; float* xc; const float* sx; const float* sc; const float* mods; int gidx; const float* gp; bf16_t* H; float* rs; int emit;
    DI void operator()(const pg8::f32x4 (&acc)[2][2][4][2], const pg8::Unit& u, int wr, int wc, int fr, int fq) const {
        asm volatile("" : "+v"(fr), "+v"(fq));
        const int b = u.pm / 9, seg = u.pm - b * 9, mrow = seg == 0 ? 32 : b;
        const float* gbase = mods + (size_t)mrow * 6144 + gidx * 1024; const float* gpb = gp + (size_t)mrow * 1024;
#pragma unroll
        for (int ai = 0; ai < 2; ++ai)
#pragma unroll
            for (int m = 0; m < 4; ++m) { const int rit = ai * 128 + wr * 64 + m * 16 + fr; float ss = 0.f;
                const size_t roff = (seg == 0 ? (size_t)(b * TC + rit) * DM : (size_t)(b * SEQ + (seg - 1) * 256 + rit) * DM);
#pragma unroll
                for (int bj = 0; bj < 2; ++bj) { const int col0 = u.pn * 256 + bj * 128 + wc * 32 + 8 * fq;
                    float* p = (seg == 0 ? xc : out) + roff + col0; const float* q = (seg == 0 ? sc : sx) + roff + col0;
                    const pg8::f32x4 g0 = *(const pg8::f32x4*)(gbase + col0), g1 = *(const pg8::f32x4*)(gbase + col0 + 4); pg8::f32x4 x0 = *(const pg8::f32x4*)q, x1 = *(const pg8::f32x4*)(q + 4);
                    x0 += g0 * acc[ai][bj][m][0]; x1 += g1 * acc[ai][bj][m][1]; *(pg8::f32x4*)p = x0; *(pg8::f32x4*)(p + 4) = x1;
                    if (emit) { const pg8::f32x4 p0 = *(const pg8::f32x4*)(gpb + col0), p1 = *(const pg8::f32x4*)(gpb + col0 + 4);
                        ss += x0[0] * x0[0] + x0[1] * x0[1] + x0[2] * x0[2] + x0[3] * x0[3] + x1[0] * x1[0] + x1[1] * x1[1] + x1[2] * x1[2] + x1[3] * x1[3];
                        st8(H + (size_t)(u.pm * 256 + rit) * 1024 + col0, x0 * p0, x1 * p1); }
                    __builtin_amdgcn_sched_barrier(0); }
                if (emit) { ss += __shfl_xor(ss, 16, 64); ss += __shfl_xor(ss, 32, 64); if (fq == 0) atomicAdd(rs + u.pm * 256 + rit, ss); }
            }
    }
};
struct Order { pg8::StaticOrder s; int lat;
    DI void init(int lat_, int N) { lat = lat_; s.init(lat_ ? NB * SEQ : TALL, N, (int)gridDim.x, (int)blockIdx.x); }
    DI bool next(int i, pg8::Unit& u) const { if (!s.next(i, u)) return false; if (lat) u.pm = (u.pm >> 3) * 9 + 1 + (u.pm & 7); return true; }
    DI void a_ready(const pg8::Unit&) const {}
    DI void done(const pg8::Unit&) const {}
};
template <int N, int K, class Fn> DI void run_gemm(unsigned char* lds, const bf16_t* A, const bf16_t* Bt, int lat, const Fn& fn) {
    int Kr = K; if (K == 128) asm volatile("" : "+s"(Kr));
    pg8::Gemm g{A, Bt, lat ? NB * SEQ : TALL, N, Kr}; Order S; S.init(lat, N); Epi8<Fn> E{fn};
    pg8::gemm_phase<Epi8<Fn>, Order, true, true>((PG8_LAS unsigned char*)lds, g, S, E);
    __syncthreads();
}
template <int N, int K, class Epi> DI void run_gemm_epi(unsigned char* lds, const bf16_t* A, const bf16_t* Bt, int lat, const Epi& E) {
    pg8::Gemm g{A, Bt, lat ? NB * SEQ : TALL, N, K}; Order S; S.init(lat, N);
    pg8::gemm_phase<Epi, Order, true, true>((PG8_LAS unsigned char*)lds, g, S, E);
    __syncthreads();
}
namespace att {
constexpr int NW = 8, QBLK = 32, KVBLK = 64;
constexpr float SCALE = 0.10206207261596577f, THR = 8.f;
constexpr int LDQ = 768, LDKK = 768, LDV = 512, LDO = 1024;
constexpr int SHM_V = KVBLK * 64 * 2, SHM_K = KVBLK * 256, SHM_ATTN = 2 * SHM_V + 2 * SHM_K + NW * 64 * 4;
#define KSWZ(row, colB) ((row) * 256 + ((colB) ^ (((row) & 7) << 4)))
#define SBAR() __builtin_amdgcn_sched_barrier(0)
DI int crow(int r, int hi) { return (r & 3) + 8 * (r >> 2) + 4 * hi; }
DI unsigned cvtpk_(float lo, float hi) { unsigned r; asm volatile("v_cvt_pk_bf16_f32 %0, %1, %2" : "=v"(r) : "v"(lo), "v"(hi)); return r; }
DI void partialSM(f32x16& p0, f32x16& p1, float& m_reg, float& mn, float& alpha) {
  constexpr float C = SCALE * 1.4426950408889634f;
  float pmax = p0[0];
#pragma unroll
  for (int r = 1; r < 16; ++r) pmax = fmaxf(pmax, p0[r]);
#pragma unroll
  for (int r = 0; r < 16; ++r) pmax = fmaxf(pmax, p1[r]);
  { auto rr = __builtin_amdgcn_permlane32_swap(__float_as_uint(pmax), __float_as_uint(pmax), false, false);
    pmax = fmaxf(__uint_as_float(rr[0]), __uint_as_float(rr[1])); }
  if (__builtin_expect(__all(pmax - m_reg <= THR / SCALE), 1)) { mn = m_reg; alpha = 1.f; }
  else { mn = fmaxf(m_reg, pmax); alpha = __builtin_amdgcn_exp2f((m_reg - mn) * C); m_reg = mn; }
  const float mnC = -mn * C;
#pragma unroll
  for (int r = 0; r < 16; ++r) p0[r] = fmaf(p0[r], C, mnC);
#pragma unroll
  for (int r = 0; r < 16; ++r) p1[r] = fmaf(p1[r], C, mnC);
#pragma unroll
  for (int r = 0; r < 16; ++r) p0[r] = __builtin_amdgcn_exp2f(p0[r]);
}
DI void finishSM(f32x16& p0, f32x16& p1, float alpha, float& l_reg, bf16x8& pa0, bf16x8& pa1, bf16x8& pa2, bf16x8& pa3) {
#pragma unroll
  for (int r = 0; r < 16; ++r) p1[r] = __builtin_amdgcn_exp2f(p1[r]);
  float ps = 0;
#pragma unroll
  for (int r = 0; r < 16; ++r) ps += p0[r];
#pragma unroll
  for (int r = 0; r < 16; ++r) ps += p1[r];
  { auto rr = __builtin_amdgcn_permlane32_swap(__float_as_uint(ps), __float_as_uint(ps), false, false);
    ps = __uint_as_float(rr[0]) + __uint_as_float(rr[1]); }
  l_reg = l_reg * alpha + ps;
#define PK4(P, BASE, OUT) do { unsigned a0 = cvtpk_(P[BASE + 0], P[BASE + 1]), a1 = cvtpk_(P[BASE + 2], P[BASE + 3]);   \
    unsigned b0 = cvtpk_(P[BASE + 4], P[BASE + 5]), b1 = cvtpk_(P[BASE + 6], P[BASE + 7]);                              \
    auto r0 = __builtin_amdgcn_permlane32_swap(a0, b0, false, false); auto r1 = __builtin_amdgcn_permlane32_swap(a1, b1, false, false); \
    u32x4 w = {r0[0], r1[0], r0[1], r1[1]}; OUT = *reinterpret_cast<bf16x8*>(&w); } while (0)
  PK4(p0, 0, pa0); PK4(p0, 8, pa1); PK4(p1, 0, pa2); PK4(p1, 8, pa3);
#undef PK4
}
DI void qkt(f32x16& p0, f32x16& p1, const char* Ks, const bf16x8* qr, int r32, int hi) {
  p0 = f32x16{}; p1 = f32x16{};
#pragma unroll
  for (int d0 = 0; d0 < 6; ++d0) { const int cb = (d0 * 16 + hi * 8) * 2;
    bf16x8 b0 = *reinterpret_cast<const bf16x8*>(Ks + KSWZ(r32, cb));
    bf16x8 b1 = *reinterpret_cast<const bf16x8*>(Ks + KSWZ(32 + r32, cb));
    p0 = __builtin_amdgcn_mfma_f32_32x32x16_bf16(b0, qr[d0], p0, 0, 0, 0);
    p1 = __builtin_amdgcn_mfma_f32_32x32x16_bf16(b1, qr[d0], p1, 0, 0, 0); }
}
DI int v_st(int k, int c) { const int kk = (k & ~0xC) | ((k & 4) << 1) | ((k & 8) >> 1); return ((kk >> 3) * 2 + (c >> 5)) * 512 + ((kk & 7) * 32 + (c & 31)) * 2; }
DI int v_rd_base(int lane) { return ((lane & 3) << 3) | (((lane >> 2) & 3) << 6) | (((lane >> 4) & 1) << 5) | (((lane >> 5) & 1) << 8); }
constexpr int v_rd_off(int d0, int ks, int half) { return d0 * 512 + ks * 2048 + half * 1024; }
template <int OFF> DI s16x4 tr_read(int vb) {
  s16x4 r; asm volatile("ds_read_b64_tr_b16 %0, %1 offset:%2" : "=&v"(r) : "v"(vb), "i"(OFF) : "memory"); return r;
}
template <int D0> DI void pv_one(f32x16& od, int vb, bf16x8 pa0, bf16x8 pa1, bf16x8 pa2, bf16x8 pa3) {
  const s16x4 l0 = tr_read<v_rd_off(D0, 0, 0)>(vb), h0 = tr_read<v_rd_off(D0, 0, 1)>(vb), l1 = tr_read<v_rd_off(D0, 1, 0)>(vb), h1 = tr_read<v_rd_off(D0, 1, 1)>(vb);
  const s16x4 l2 = tr_read<v_rd_off(D0, 2, 0)>(vb), h2 = tr_read<v_rd_off(D0, 2, 1)>(vb), l3 = tr_read<v_rd_off(D0, 3, 0)>(vb), h3 = tr_read<v_rd_off(D0, 3, 1)>(vb);
  asm volatile("s_waitcnt lgkmcnt(0)" ::: "memory"); SBAR();
#define PK(L, H) (bf16x8){L[0], L[1], L[2], L[3], H[0], H[1], H[2], H[3]}
  od = __builtin_amdgcn_mfma_f32_32x32x16_bf16(pa0, PK(l0, h0), od, 0, 0, 0);
  od = __builtin_amdgcn_mfma_f32_32x32x16_bf16(pa1, PK(l1, h1), od, 0, 0, 0);
  od = __builtin_amdgcn_mfma_f32_32x32x16_bf16(pa2, PK(l2, h2), od, 0, 0, 0);
  od = __builtin_amdgcn_mfma_f32_32x32x16_bf16(pa3, PK(l3, h3), od, 0, 0, 0);
#undef PK
}
DI void pv_d0(f32x16* o, int vb, bf16x8 pa0, bf16x8 pa1, bf16x8 pa2, bf16x8 pa3) {
  pv_one<0>(o[0], vb, pa0, pa1, pa2, pa3); pv_one<1>(o[1], vb, pa0, pa1, pa2, pa3);
}
DI void attn_body(const bf16_t* __restrict__ Qb, const bf16_t* __restrict__ Kh, const bf16_t* __restrict__ Vh, bf16_t* __restrict__ Ob, int seq, char* lds) {
  const int tid = ltid(), wid = tid >> 6, lane = tid & 63, r32 = lane & 31, hi = lane >> 5;
  char* V_lds = lds; char* K_lds = lds + 2 * SHM_V;
  float* ws = (float*)(lds + 2 * SHM_V + 2 * SHM_K) + wid * 64; float* li_l = ws; float* al_l = ws + 32;
  float m_reg = -1e30f, l_reg = 0; f32x16 o[2] = {}; bf16x8 qr[6];
  const bf16_t* Qw = Qb + (long)(wid * QBLK + r32) * LDQ + hi * 8;
#pragma unroll
  for (int d0 = 0; d0 < 6; ++d0) qr[d0] = *reinterpret_cast<const bf16x8*>(Qw + d0 * 16);
  const int kc2 = 512 + (tid & 255);
  const int kr1 = tid / 12, kch1 = tid - kr1 * 12, kr2 = kc2 / 12, kch2 = kc2 - kr2 * 12, vr = tid >> 3, vch = tid & 7;
  const int vst = v_st(vr, vch * 8), kst1 = KSWZ(kr1, kch1 * 16), kst2 = KSWZ(kr2, kch2 * 16);
  const int vb0 = (int)(uintptr_t)V_lds + v_rd_base(lane);
  struct { bf16x8 v, k1, k2; } sr_[2];
#define SLOAD(i, k0) do { sr_[i].v = *reinterpret_cast<const bf16x8*>(&Vh[(long)((k0) + vr) * LDV + vch * 8]); \
    sr_[i].k1 = *reinterpret_cast<const bf16x8*>(&Kh[(long)((k0) + kr1) * LDKK + kch1 * 8]); sr_[i].k2 = *reinterpret_cast<const bf16x8*>(&Kh[(long)((k0) + kr2) * LDKK + kch2 * 8]); } while (0)
#define SWRITE(b, i) do { *(bf16x8*)(V_lds + (b) * SHM_V + vst) = sr_[i].v; *(bf16x8*)(K_lds + (b) * SHM_K + kst1) = sr_[i].k1; *(bf16x8*)(K_lds + (b) * SHM_K + kst2) = sr_[i].k2; } while (0)
#define RESC(a) do { if (__any((a) < 1.f)) { if (hi == 0) al_l[r32] = (a); asm volatile("s_waitcnt lgkmcnt(0)" ::: "memory"); \
    _Pragma("unroll") for (int d = 0; d < 2; ++d) _Pragma("unroll") for (int r = 0; r < 16; ++r) o[d][r] *= al_l[crow(r, hi)]; } } while (0)
  f32x16 pA0, pA1, pB0, pB1; float mnA, mnB, alA, alB; bf16x8 pa0, pa1, pa2, pa3; const int NT = seq / KVBLK;
  constexpr int SE = 0, SO = 1;
  SLOAD(SE, 0); asm volatile("s_waitcnt vmcnt(0)" ::: "memory"); SWRITE(0, SE); __syncthreads();
  qkt(pA0, pA1, K_lds, qr, r32, hi); partialSM(pA0, pA1, m_reg, mnA, alA);
  SLOAD(SO, KVBLK); if (2 < NT) SLOAD(SE, 2 * KVBLK);
  SWRITE(1, SO); __syncthreads();
  for (int j = 1; j + 1 < NT; j += 2) {
    SBAR(); qkt(pB0, pB1, K_lds + SHM_K, qr, r32, hi);
    finishSM(pA0, pA1, alA, l_reg, pa0, pa1, pa2, pa3); SBAR();
    SLOAD(SO, (j + 2) * KVBLK); SBAR();
    pv_d0(o, vb0, pa0, pa1, pa2, pa3); partialSM(pB0, pB1, m_reg, mnB, alB);
    __syncthreads(); SWRITE(0, SE);
    RESC(alB); __syncthreads();
    SBAR(); qkt(pA0, pA1, K_lds, qr, r32, hi);
    finishSM(pB0, pB1, alB, l_reg, pa0, pa1, pa2, pa3); SBAR();
    if (j + 3 < NT) SLOAD(SE, (j + 3) * KVBLK); SBAR();
    pv_d0(o, vb0 + SHM_V, pa0, pa1, pa2, pa3); partialSM(pA0, pA1, m_reg, mnA, alA);
    __syncthreads(); SWRITE(1, SO);
    RESC(alA); __syncthreads();
  }
  SBAR(); qkt(pB0, pB1, K_lds + SHM_K, qr, r32, hi);
  finishSM(pA0, pA1, alA, l_reg, pa0, pa1, pa2, pa3); SBAR();
  pv_d0(o, vb0, pa0, pa1, pa2, pa3); partialSM(pB0, pB1, m_reg, mnB, alB);
  __syncthreads(); RESC(alB);
  finishSM(pB0, pB1, alB, l_reg, pa0, pa1, pa2, pa3); SBAR();
  pv_d0(o, vb0 + SHM_V, pa0, pa1, pa2, pa3);
  if (hi == 0) li_l[r32] = l_reg; asm volatile("s_waitcnt lgkmcnt(0)" ::: "memory");
  float rli[16];
#pragma unroll
  for (int r = 0; r < 16; ++r) rli[r] = __builtin_amdgcn_rcpf(li_l[crow(r, hi)]);
  bf16_t* Ow = Ob + (long)(wid * QBLK) * LDO;
#pragma unroll
  for (int r = 0; r < 16; ++r) { const int orow = crow(r, hi);
#pragma unroll
    for (int d0 = 0; d0 < 2; ++d0) Ow[(long)orow * LDO + d0 * 32 + r32] = f2bf(o[d0][r] * rli[r]); }
#undef SLOAD
#undef SWRITE
#undef RESC
}
}

DI void phase_attn(const bf16_t* Q, const bf16_t* KA, const bf16_t* VA, bf16_t* MIX, bool last, char* lds) {
    const int c = blockIdx.x, G = gridDim.x, NU = 2048 + (last ? 0 : 256);
    for (int L = c; L < NU; L += G) {
        int bh, seq; long qrow0;
        if (L < 2048) { int qb;
            if (G == 256) { const int i = L >> 8, cc = L & 255, xcd = cc & 7, slot = cc >> 3; bh = i * 32 + xcd * 4 + (slot >> 3); qb = slot & 7; }
            else { bh = L >> 3; qb = L & 7; }
            qrow0 = (long)(bh >> 3) * TT + TC + qb * 256; seq = TT; }
        else { bh = L - 2048; qrow0 = (long)(bh >> 3) * TT; seq = TC; }
        const int b = bh >> 3, h = bh & 7;
        att::attn_body(Q + qrow0 * 768 + h * 96, KA + (long)b * TT * 768 + h * 96, VA + (long)b * TT * 512 + h * 64, MIX + qrow0 * 1024 + h * 64, seq, lds);
        __syncthreads();
    }
}

DI float rowsum16(float x) {
    x += __int_as_float(__builtin_amdgcn_update_dpp(0, __float_as_int(x), 0x128, 0xf, 0xf, false));
    x += __int_as_float(__builtin_amdgcn_update_dpp(0, __float_as_int(x), 0x124, 0xf, 0xf, false));
    x += __int_as_float(__builtin_amdgcn_update_dpp(0, __float_as_int(x), 0x122, 0xf, 0xf, false));
    x += __int_as_float(__builtin_amdgcn_update_dpp(0, __float_as_int(x), 0x121, 0xf, 0xf, false));
    return x;
}
#define RS8_STEP(R) "v_add_f32_dpp %0, %0, %0 " R " row_mask:0xf bank_mask:0xf\n\tv_add_f32_dpp %1, %1, %1 " R " row_mask:0xf bank_mask:0xf\n\t" \
                    "v_add_f32_dpp %2, %2, %2 " R " row_mask:0xf bank_mask:0xf\n\tv_add_f32_dpp %3, %3, %3 " R " row_mask:0xf bank_mask:0xf\n\t" \
                    "v_add_f32_dpp %4, %4, %4 " R " row_mask:0xf bank_mask:0xf\n\tv_add_f32_dpp %5, %5, %5 " R " row_mask:0xf bank_mask:0xf\n\t" \
                    "v_add_f32_dpp %6, %6, %6 " R " row_mask:0xf bank_mask:0xf\n\tv_add_f32_dpp %7, %7, %7 " R " row_mask:0xf bank_mask:0xf\n\t"
DI void sum8x8(float& x0, float& x1, float& x2, float& x3, float& x4, float& x5, float& x6, float& x7) {
    asm volatile("s_nop 1\n\t" RS8_STEP("quad_perm:[1,0,3,2]") RS8_STEP("quad_perm:[2,3,0,1]") RS8_STEP("row_half_mirror")
                 : "+v"(x0), "+v"(x1), "+v"(x2), "+v"(x3), "+v"(x4), "+v"(x5), "+v"(x6), "+v"(x7));
}
typedef float f32x2 __attribute__((ext_vector_type(2)));
DI float dot8(const f32x2 (&s)[4], const f32x4& x0, const f32x4& x1) {
    f32x2 t = s[0] * (f32x2){x0[0], x0[1]};
    t = __builtin_elementwise_fma(s[1], (f32x2){x0[2], x0[3]}, t);
    t = __builtin_elementwise_fma(s[2], (f32x2){x1[0], x1[1]}, t);
    t = __builtin_elementwise_fma(s[3], (f32x2){x1[2], x1[3]}, t);
    return t.x + t.y;
}
DI int scan_row(int d, int b, int n) { const int tt = d == 0 ? n : (n < TC ? TC - 1 - n : TT + TC - 1 - n); return b * TT + tt; }
typedef __bf16 bf16x2n __attribute__((ext_vector_type(2)));
DI unsigned cvtpk_n(float lo, float hi) { f32x2 v = {lo, hi}; bf16x2n b = __builtin_convertvector(v, bf16x2n); return __builtin_bit_cast(unsigned, b); }
DI bf16x8 pack_acc(const f32x16& x, int s) {
    u32x4 w; w.x = cvtpk_n(x[8 * s], x[8 * s + 1]); w.y = cvtpk_n(x[8 * s + 2], x[8 * s + 3]); w.z = cvtpk_n(x[8 * s + 4], x[8 * s + 5]); w.w = cvtpk_n(x[8 * s + 6], x[8 * s + 7]);
    return __builtin_bit_cast(bf16x8, w);
}
constexpr int SREC = 264;
struct ScanStep { bf16x8 f[4]; float bk0, bk1, v; f32x4 brp, krp; };
DI void scan_ld(ScanStep& t, const float* rec, const char* zimg, int fragoff, bool isaq, int h, int m, int vrow) {
    const char* fp = isaq ? (const char*)(rec + fragoff) + h * 16 : zimg + h * 16;
#pragma unroll
    for (int q = 0; q < 4; ++q) t.f[q] = *(const bf16x8*)(fp + q * 32);
    t.bk0 = rec[64 + h * 64 + m]; t.bk1 = rec[64 + h * 64 + 32 + m]; t.v = rec[192 + vrow]; t.brp = *(const f32x4*)(rec + 256); t.krp = *(const f32x4*)(rec + 260);
}
DI void phase_scan(const bf16_t* R, const bf16_t* Kk, const bf16_t* V, const __half* DEC, const bf16_t* AA, const float* INV, const float* kkp, const float* kap,
                   bf16_t* MIX, bf16_t* YB, char* lds) {
    const int tid = ltid(); const bool consumer = tid < 256;
    float* bufA = (float*)lds; float* ybufA = (float*)(lds + 98304); char* zimg = lds + 114688;
    if (tid < 32) ((float*)zimg)[tid] = 0.f;
    constexpr int NCH = TT / 16;
    for (int s0 = blockIdx.x * 2; s0 < 512; s0 += gridDim.x * 2) {
        const int p_ = tid & 255, pst = p_ & 15, pj0 = (p_ >> 4) * 4, pw = p_ >> 6;
        const int cw = tid >> 6, cgrp = (cw >> 1) & 1, ws_ = cw & 1, lane = tid & 63, m = lane & 31, h = lane >> 5, vrow = ws_ * 32 + m;
        const bool isaq = (m & ~5) == 0;
        const int fragoff = (m & 1) ? 32 : 0;
        f32x16 acc0, acc1, zero16;
#pragma unroll
        for (int r = 0; r < 16; ++r) { acc0[r] = 0.f; acc1[r] = 0.f; zero16[r] = 0.f; }
        const int jl_ = pj0 & 31, rem_ = jl_ & 15, imgoff = ((((pj0 >> 5) * 2 + (jl_ >> 4)) * 2 + ((rem_ >> 2) & 1)) * 16 + ((rem_ >> 3) << 2) * 2) >> 2;
        u32x2 lr[2], lk[2], lv[2], la[2], ld0[2]; float linv[2];
#define PLOAD(c) do { _Pragma("unroll") for (int gq = 0; gq < 2; ++gq) { \
            const int sid = s0 + gq, d = sid >> 8, b = (sid >> 3) & 31, hh = sid & 7, hc = hh * 64 + pj0; \
            const size_t m_ = (size_t)scan_row(d, b, (c) * 16 + pst); \
            lr[gq] = *(const u32x2*)(R + m_ * 512 + hc); lk[gq] = *(const u32x2*)(Kk + m_ * 512 + hc); lv[gq] = *(const u32x2*)(V + m_ * 512 + hc); \
            la[gq] = *(const u32x2*)(AA + m_ * 1024 + d * 512 + hc); linv[gq] = INV[m_ * 8 + hh]; ld0[gq] = *(const u32x2*)(DEC + m_ * 1024 + d * 512 + hc); } } while (0)
#define PFX(L, e) do { L = (e); \
            L += __int_as_float(__builtin_amdgcn_update_dpp(0, __float_as_int(L), 0x111, 0xf, 0xf, true)); L += __int_as_float(__builtin_amdgcn_update_dpp(0, __float_as_int(L), 0x112, 0xf, 0xf, true)); \
            L += __int_as_float(__builtin_amdgcn_update_dpp(0, __float_as_int(L), 0x114, 0xf, 0xf, true)); L += __int_as_float(__builtin_amdgcn_update_dpp(0, __float_as_int(L), 0x118, 0xf, 0xf, true)); } while (0)
#define WSUM4(x) do { x += __shfl_xor(x, 16, 64); const auto sw_ = __builtin_amdgcn_permlane32_swap(__float_as_uint(x), __float_as_uint(x), false, false); x = __uint_as_float(sw_[0]) + __uint_as_float(sw_[1]); } while (0)
#define PWRITE(bsel) do { _Pragma("unroll") for (int gq = 0; gq < 2; ++gq) { \
            const int sid = s0 + gq, hh = sid & 7, hc = hh * 64 + pj0; \
            const float l0 = h2f(ld0[gq].x & 0xffffu), l1 = h2f(ld0[gq].x >> 16), l2 = h2f(ld0[gq].y & 0xffffu), l3 = h2f(ld0[gq].y >> 16); \
            float L0, L1, L2, L3; PFX(L0, l0); PFX(L1, l1); PFX(L2, l2); PFX(L3, l3); \
            const f32x4 kk4 = *(const f32x4*)(kkp + hc), ka4 = *(const f32x4*)(kap + hc); \
            float* rec_ = bufA + gq * 12288 + (bsel) * 6144 + pst * SREC; \
            const float k0 = bflo(lk[gq].x), k1 = bfhi(lk[gq].x), k2 = bflo(lk[gq].y), k3 = bfhi(lk[gq].y), a0 = bflo(la[gq].x), a1 = bfhi(la[gq].x), a2 = bflo(la[gq].y), a3 = bfhi(la[gq].y); \
            const float q0 = k0 * kk4[0] * linv[gq], q1 = k1 * kk4[1] * linv[gq], q2 = k2 * kk4[2] * linv[gq], q3 = k3 * kk4[3] * linv[gq]; \
            const float W0 = __builtin_amdgcn_exp2f(L0), W1 = __builtin_amdgcn_exp2f(L1), W2 = __builtin_amdgcn_exp2f(L2), W3 = __builtin_amdgcn_exp2f(L3); \
            const float P0 = __builtin_amdgcn_exp2f(L0 - l0), P1 = __builtin_amdgcn_exp2f(L1 - l1), P2 = __builtin_amdgcn_exp2f(L2 - l2), P3 = __builtin_amdgcn_exp2f(L3 - l3); \
            const float I0 = __builtin_amdgcn_exp2f(-L0), I1 = __builtin_amdgcn_exp2f(-L1), I2 = __builtin_amdgcn_exp2f(-L2), I3 = __builtin_amdgcn_exp2f(-L3); \
            const float r0 = bflo(lr[gq].x), r1 = bfhi(lr[gq].x), r2 = bflo(lr[gq].y), r3 = bfhi(lr[gq].y); \
            const float b0 = q0 * a0, b1 = q1 * a1, b2 = q2 * a2, b3 = q3 * a3; \
            const float d0 = k0 * (1.f + (a0 - 1.f) * ka4[0]), d1 = k1 * (1.f + (a1 - 1.f) * ka4[1]), d2 = k2 * (1.f + (a2 - 1.f) * ka4[2]), d3 = k3 * (1.f + (a3 - 1.f) * ka4[3]); \
            { u32x2 w_; w_.x = cvtpk_n(-q0 * P0, -q1 * P1); w_.y = cvtpk_n(-q2 * P2, -q3 * P3); *(u32x2*)(rec_ + imgoff) = w_; } \
            { u32x2 w_; w_.x = cvtpk_n(r0 * W0, r1 * W1); w_.y = cvtpk_n(r2 * W2, r3 * W3); *(u32x2*)(rec_ + 32 + imgoff) = w_; } \
            *(f32x4*)(rec_ + 64 + pj0) = (f32x4){b0 * I0, b1 * I1, b2 * I2, b3 * I3}; \
            *(f32x4*)(rec_ + 128 + pj0) = (f32x4){d0 * I0, d1 * I1, d2 * I2, d3 * I3}; \
            *(f32x4*)(rec_ + 192 + pj0) = (f32x4){bflo(lv[gq].x), bfhi(lv[gq].x), bflo(lv[gq].y), bfhi(lv[gq].y)}; \
            float br_ = b0 * r0 + b1 * r1 + b2 * r2 + b3 * r3, kr_ = d0 * r0 + d1 * r1 + d2 * r2 + d3 * r3; WSUM4(br_); WSUM4(kr_); \
            if ((p_ & 48) == 0) { rec_[256 + pw] = br_; rec_[260 + pw] = kr_; } \
            if (pst == 15) *(f32x4*)(bufA + gq * 12288 + (bsel) * 6144 + 16 * SREC + pj0) = (f32x4){W0, W1, W2, W3}; } } while (0)
#define LBAR() asm volatile("s_waitcnt lgkmcnt(0)\n\ts_barrier" ::: "memory")
#define OUTPUT(c, bsel) do { _Pragma("unroll") for (int gq = 0; gq < 2; ++gq) { \
            const int sid = s0 + gq, d = sid >> 8, b = (sid >> 3) & 31, hh = sid & 7, hc = hh * 64 + pj0; \
            const f32x4 yv = *(const f32x4*)(ybufA + gq * 2048 + (bsel) * 1024 + pst * 64 + pj0); const size_t m_ = (size_t)scan_row(d, b, (c) * 16 + pst); \
            u32x2 w; w.x = cvtpk(yv[0], yv[1]); w.y = cvtpk(yv[2], yv[3]); \
            if (d == 0) *(u32x2*)(MIX + m_ * 1024 + 512 + hc) = w; else *(u32x2*)(YB + m_ * 512 + hc) = w; } } while (0)
        if (!consumer) { PLOAD(0); PWRITE(0); PLOAD(1); }
        LBAR();
        if (consumer) __builtin_amdgcn_s_setprio(3);
        for (int c = 0; c < NCH; ++c) {
            if (consumer) {
                const float* cur = bufA + cgrp * 12288 + (c & 1) * 6144; float* yb = ybufA + cgrp * 2048 + (c & 1) * 1024;
                ScanStep t; scan_ld(t, cur, zimg, fragoff, isaq, h, m, vrow);
#pragma unroll 2
                for (int st = 0; st < 16; ++st) {
                    f32x16 d0 = __builtin_amdgcn_mfma_f32_32x32x16_bf16(t.f[0], pack_acc(acc0, 0), zero16, 0, 0, 0);
                    f32x16 d1 = __builtin_amdgcn_mfma_f32_32x32x16_bf16(t.f[2], pack_acc(acc1, 0), zero16, 0, 0, 0);
                    d0 = __builtin_amdgcn_mfma_f32_32x32x16_bf16(t.f[1], pack_acc(acc0, 1), d0, 0, 0, 0);
                    d1 = __builtin_amdgcn_mfma_f32_32x32x16_bf16(t.f[3], pack_acc(acc1, 1), d1, 0, 0, 0);
                    __builtin_amdgcn_sched_barrier(0);
                    ScanStep n; scan_ld(n, cur + (st + 1) * SREC, zimg, fragoff, isaq, h, m, vrow);
                    __builtin_amdgcn_sched_barrier(0);
                    const float sa = d0[0] + d1[0], z = d0[1] + d1[1];
                    yb[st * 64 + vrow] = z + sa * ((t.brp[0] + t.brp[1]) + (t.brp[2] + t.brp[3])) + t.v * ((t.krp[0] + t.krp[1]) + (t.krp[2] + t.krp[3]));
                    const float bval = h ? t.v : sa;
                    acc0 = __builtin_amdgcn_mfma_f32_32x32x2f32(t.bk0, bval, acc0, 0, 0, 0);
                    acc1 = __builtin_amdgcn_mfma_f32_32x32x2f32(t.bk1, bval, acc1, 0, 0, 0);
                    t = n;
                }
                const float* wc = cur + 16 * SREC;
#pragma unroll
                for (int g_ = 0; g_ < 4; ++g_) { const f32x4 w0 = *(const f32x4*)(wc + 8 * g_ + 4 * h), w1 = *(const f32x4*)(wc + 32 + 8 * g_ + 4 * h);
#pragma unroll
                    for (int e = 0; e < 4; ++e) { acc0[4 * g_ + e] *= w0[e]; acc1[4 * g_ + e] *= w1[e]; } }
            } else {
                if (c + 1 < NCH) PWRITE((c + 1) & 1);
                if (c + 2 < NCH) PLOAD(c + 2);
                if (c > 0) OUTPUT(c - 1, (c - 1) & 1);
            }
            LBAR();
        }
        __builtin_amdgcn_s_setprio(0);
        if (!consumer) OUTPUT(NCH - 1, (NCH - 1) & 1);
        __syncthreads();
#undef LBAR
#undef PLOAD
#undef PWRITE
#undef PFX
#undef WSUM4
#undef OUTPUT
    }
}

DI void phase_prologue(const Args& a, unsigned char* lds) {
    const int tid = ltid(), G = gridDim.x;
    float* out = a.out; float* xc = (float*)(a.ws + WS_XC);
    if (blockIdx.x == 0) {
        float* rope = (float*)(a.ws + WS_ROPE); const int pos = tid >> 3, j = tid & 7;
        const float inv_freq = powf(10000.f, -(float)j / 8.f), ang = (float)pos * inv_freq;
        rope[tid] = cosf(ang); rope[512 + tid] = sinf(ang);
    }
    float* sv = (float*)lds; float* red = sv + 33 * 1024;
    for (int i = tid; i < 33 * 1024; i += 512) { const float v = i < 32 * 1024 ? a.in[I_C][i] : a.in[I_CCTX][i - 32 * 1024]; sv[i] = v / (1.f + __expf(-v)); }
    __syncthreads();
    const int wave = tid >> 6, lane = tid & 63;
    float* mods = (float*)(a.ws + WS_MODS);
    for (int it = blockIdx.x; it < NL * 96; it += G) {
        const int l = it / 96, n0 = (it - l * 96) * 64;
        const float* w = a.in[I_ADAW] + (size_t)l * 1024 * 6144 + n0 + lane;
        float acc[33];
#pragma unroll
        for (int r = 0; r < 33; ++r) acc[r] = 0.f;
        for (int k = wave * 128; k < wave * 128 + 128; k += 8) { float wv[8];
#pragma unroll
            for (int u = 0; u < 8; ++u) wv[u] = w[(size_t)(k + u) * 6144];
#pragma unroll
            for (int u = 0; u < 8; ++u)
#pragma unroll
                for (int r = 0; r < 33; ++r) acc[r] += sv[r * 1024 + k + u] * wv[u]; }
        for (int i = tid; i < 33 * 64; i += 512) red[i] = 0.f;
        __syncthreads();
        for (int ww = 0; ww < 8; ++ww) { if (wave == ww) {
#pragma unroll
                for (int r = 0; r < 33; ++r) red[r * 64 + lane] += acc[r]; }
            __syncthreads(); }
        for (int i = tid; i < 33 * 64; i += 512) { const int r = i >> 6, n = n0 + (i & 63); mods[((size_t)l * 33 + r) * 6144 + n] = red[i] + a.in[I_ADAB][l * 6144 + n]; }
        __syncthreads();
    }
}

DI void phase_vectors(const Args& a, unsigned char* lds) {
    const int tid = ltid(), G = gridDim.x, wave = tid >> 6, lane = tid & 63;
    const float* mods = (const float*)(a.ws + WS_MODS);
    float* gp1 = (float*)(a.ws + WS_GP1); float* gp2 = (float*)(a.ws + WS_GP2);
    for (int i = blockIdx.x * 512 + tid; i < NL * 33 * 1024; i += G * 512) { const int c = i & 1023, lr = i >> 10, l = lr / 33;
        gp1[i] = a.in[I_N1G][l * 1024 + c] * (1.f + mods[(size_t)lr * 6144 + 1024 + c]); gp2[i] = a.in[I_N2G][l * 1024 + c] * (1.f + mods[(size_t)lr * 6144 + 4 * 1024 + c]); }
    float* sv = (float*)lds; float* red = sv + 33 * 1024;
    for (int it = blockIdx.x; it < NL * 101; it += G) {
        const int l = it / 101, ci = it - l * 101, which = ci < 37 ? 0 : 1, n0 = (which ? ci - 37 : ci) * 64, n = n0 + lane;
        __syncthreads();
        for (int i = tid; i < 33 * 1024; i += 512) sv[i] = mods[((size_t)l * 33 + (i >> 10)) * 6144 + (which ? 3 * 1024 : 0) + (i & 1023)];
        for (int i = tid; i < 33 * 64; i += 512) red[i] = 0.f;
        __syncthreads();
        const float* w; int ld; float live = 1.f;
        if (which) { w = a.in[I_M1] + (size_t)l * 1024 * 4096 + n; ld = 4096; }
        else if (n < CIN) { w = a.in[I_WIN] + (size_t)l * 1024 * CIN + n; ld = CIN; }
        else if (n < CINX && l > 0) { w = a.in[I_V1] + (size_t)(l - 1) * 1024 * 32 + (n - CIN); ld = 32; }
        else { w = a.in[I_WIN]; ld = 0; live = 0.f; }
        float acc[33];
#pragma unroll
        for (int r = 0; r < 33; ++r) acc[r] = 0.f;
        for (int k = wave * 128; k < wave * 128 + 128; k += 8) { float wv[8];
#pragma unroll
            for (int u = 0; u < 8; ++u) wv[u] = w[(size_t)(k + u) * ld] * live;
#pragma unroll
            for (int u = 0; u < 8; ++u)
#pragma unroll
                for (int r = 0; r < 33; ++r) acc[r] += sv[r * 1024 + k + u] * wv[u]; }
        for (int ww = 0; ww < 8; ++ww) { if (wave == ww) {
#pragma unroll
                for (int r = 0; r < 33; ++r) red[r * 64 + lane] += acc[r]; }
            __syncthreads(); }
        float* outp = which ? (float*)(a.ws + WS_C2) + (size_t)l * 33 * DFF : (float*)(a.ws + WS_C1) + (size_t)l * 33 * NIN; const int ldo = which ? DFF : NIN;
        for (int i = tid; i < 33 * 64; i += 512) outp[(size_t)(i >> 6) * ldo + n0 + (i & 63)] = red[i];
    }
    {
        const int gw = blockIdx.x * 8 + wave, nw = G * 8; bf16_t* __restrict__ H = (bf16_t*)(a.ws + WS_H); float* __restrict__ rsa = (float*)(a.ws + WS_RSA); const float* __restrict__ gamma = a.in[I_N1G];
        for (int m = gw; m < TALL; m += nw) { const int b = m / TT, tt = m - b * TT; const bool ctx = tt < TC;
            const float* xr = ctx ? a.in[I_CTX] + (size_t)(b * TC + tt) * DM : a.in[I_X] + (size_t)(b * SEQ + tt - TC) * DM; const float* md = mods + (size_t)(ctx ? 32 : b) * 6144 + 1024;
            f32x4 v[4]; float ss = 0.f;
#pragma unroll
            for (int q = 0; q < 4; ++q) { v[q] = *(const f32x4*)(xr + q * 256 + lane * 4); ss += v[q][0] * v[q][0] + v[q][1] * v[q][1] + v[q][2] * v[q][2] + v[q][3] * v[q][3]; }
#pragma unroll
            for (int k = 1; k < 64; k <<= 1) ss = xorsum(ss, k);
            if (lane == 0) rsa[m] = ss;
#pragma unroll
            for (int q = 0; q < 4; ++q) { const int col = q * 256 + lane * 4; const f32x4 g = *(const f32x4*)(gamma + col), sc = *(const f32x4*)(md + col);
                u32x2 w; w.x = cvtpk(v[q][0] * g[0] * (1.f + sc[0]), v[q][1] * g[1] * (1.f + sc[1])); w.y = cvtpk(v[q][2] * g[2] * (1.f + sc[2]), v[q][3] * g[3] * (1.f + sc[3]));
                *(u32x2*)(H + (size_t)m * 1024 + col) = w; } }
    }
}

template <class Gt> DI void cvt_tile(bf16_t* __restrict__ dst, int ldk, int n0, int k0, const Gt& get, float*) {
    const int lane = ltid() & 63, n = n0 + lane;
#pragma unroll
    for (int ch = 0; ch < 4; ++ch) { float v[16];
#pragma unroll
        for (int kk = 0; kk < 16; ++kk) v[kk] = get(n, k0 + ch * 16 + kk);
        u32x4 w0, w1; w0.x = cvtpk(v[0], v[1]); w0.y = cvtpk(v[2], v[3]); w0.z = cvtpk(v[4], v[5]); w0.w = cvtpk(v[6], v[7]);
        w1.x = cvtpk(v[8], v[9]); w1.y = cvtpk(v[10], v[11]); w1.z = cvtpk(v[12], v[13]); w1.w = cvtpk(v[14], v[15]);
        bf16_t* p = dst + (size_t)n * ldk + k0 + ch * 16; *(u32x4*)p = w0; *(u32x4*)(p + 8) = w1; }
}
DI void convert_weights(const Args& a, int l, unsigned char* lds, int group) {
    float* tl = (float*)lds; unsigned char* ws = a.ws;
    const float* w_in = a.in[I_WIN] + (size_t)l * 1024 * CIN; const float* v1 = a.in[I_V1] + (size_t)(l > 0 ? l - 1 : 0) * 1024 * 32;
    const float* w_uq = a.in[I_WUQ] + (size_t)l * 256 * 768; const float* w_ukv = a.in[I_WUKV] + (size_t)l * 128 * 1024;
    const float* w2 = a.in[I_W2] + (size_t)l * 2 * 64 * 512; const float* a2 = a.in[I_A2] + (size_t)l * 2 * 64 * 512;
    const float* g2 = a.in[I_G2] + (size_t)l * 128 * 512; const float* v2 = a.in[I_V2] + (size_t)(l > 0 ? l - 1 : 0) * 32 * 512;
    const float* w_out = a.in[I_WOUT] + (size_t)l * 1024 * 1024; const float* m1 = a.in[I_M1] + (size_t)l * 1024 * 4096; const float* m2 = a.in[I_M2] + (size_t)l * 4096 * 1024;
    constexpr int T0 = 640, T1 = T0 + 48, T2 = T1 + 64, T3 = T2 + 128, T4 = T3 + 64, T5 = T4 + 256, T6 = T5 + 1024, T7 = T6 + 1024;
    const int tb = group == 0 ? 0 : T4, te = group == 0 ? T4 : T7;
    for (int t = tb + blockIdx.x * 8 + (ltid() >> 6); t < te; t += gridDim.x * 8) {
        if (t < T0) { const int nt = t >> 4, kt = t & 15;
            cvt_tile((bf16_t*)(ws + WT_IN), 1024, nt * 64, kt * 64, [&](int n, int k) -> float { return n < CIN ? w_in[(size_t)k * CIN + n] : ((n < CINX && l > 0) ? v1[k * 32 + (n - CIN)] : 0.f); }, tl); }
        else if (t < T1) { const int u = t - T0, nt = u >> 2, kt = u & 3;
            cvt_tile((bf16_t*)(ws + WT_UQ), 256, nt * 64, kt * 64, [&](int n, int k) -> float { return w_uq[k * 768 + n]; }, tl); }
        else if (t < T2) { const int u = t - T1, nt = u >> 2, kt = u & 3;
            if (kt < 2) cvt_tile((bf16_t*)(ws + WT_UKV), 128, nt * 64, kt * 64, [&](int n, int k) -> float { return w_ukv[k * 1024 + n]; }, tl); }
        else if (t < T3) { const int u = t - T2, nt = u >> 2, kt = u & 3;
            cvt_tile((bf16_t*)(ws + WT_L1), 256, nt * 64, kt * 64, [&](int n, int k) -> float {
                if (n < 1024) { const int d = n >> 9, c = n & 511; return (k < 128 && (k >> 6) == d) ? w2[(d * 64 + (k & 63)) * 512 + c] : 0.f; }
                const int n2 = n - 1024, d = n2 >> 9, c = n2 & 511; return (k >= 128 && ((k - 128) >> 6) == d) ? a2[(d * 64 + ((k - 128) & 63)) * 512 + c] : 0.f; }, tl); }
        else if (t < T4) { const int u = t - T3, nt = u >> 2, kt = u & 3;
            cvt_tile((bf16_t*)(ws + WT_L2), 256, nt * 64, kt * 64, [&](int n, int k) -> float {
                if (n < 512) return k < 128 ? g2[k * 512 + n] : 0.f;
                return (l > 0 && k >= 128 && k < 160) ? v2[(k - 128) * 512 + (n - 512)] : 0.f; }, tl); }
        else if (t < T5) { const int u = t - T4, nt = u >> 4, kt = u & 15;
            cvt_tile((bf16_t*)(ws + WT_OUT), 1024, nt * 64, kt * 64, [&](int n, int k) -> float { return w_out[(size_t)k * 1024 + n]; }, tl); }
        else if (t < T6) { const int u = t - T5, nt = u >> 4, kt = u & 15;
            cvt_tile((bf16_t*)(ws + WT_M1), 1024, nt * 64, kt * 64, [&](int n, int k) -> float { return m1[(size_t)k * 4096 + n]; }, tl); }
        else { const int u = t - T6, nt = u >> 6, kt = u & 63;
            cvt_tile((bf16_t*)(ws + WT_M2), 4096, nt * 64, kt * 64, [&](int n, int k) -> float { return m2[(size_t)k * 1024 + n]; }, tl); }
    }
}

DI void unpack8(const u32x4& w, float (&f)[8]) { f[0] = bflo(w.x); f[1] = bfhi(w.x); f[2] = bflo(w.y); f[3] = bfhi(w.y); f[4] = bflo(w.z); f[5] = bfhi(w.z); f[6] = bflo(w.w); f[7] = bfhi(w.w); }
DI void shift8r(const u32x4& c_, const u32x4& p_, const u32x4& n_, const float* __restrict__ mu, int col, float (&o)[8]) {
    float c[8], p[8], n[8], u[8]; unpack8(c_, c); unpack8(p_, p); unpack8(n_, n); loadf8(mu + (col - OFF_R), u);
#pragma unroll
    for (int j = 0; j < 8; ++j) o[j] = c[j] + u[j] * (0.5f * (p[j] + n[j]) - c[j]);
}
DI void phase_split(const Args& a, int l) {
    const int lane = ltid() & 63, gw = blockIdx.x * 8 + (ltid() >> 6), nw = gridDim.x * 8;
    unsigned char* ws = a.ws;
    const bf16_t* __restrict__ F = (const bf16_t*)(ws + WS_F); bf16_t* __restrict__ R = (bf16_t*)(ws + WS_R); bf16_t* __restrict__ Kb = (bf16_t*)(ws + WS_K); bf16_t* __restrict__ Vb = (bf16_t*)(ws + (l == 0 ? WS_VF : WS_V));
    bf16_t* __restrict__ A1 = (bf16_t*)(ws + WS_A1); bf16_t* __restrict__ A2 = (bf16_t*)(ws + WS_A2); bf16_t* __restrict__ CQN = (bf16_t*)(ws + WS_CQN); bf16_t* __restrict__ CKVN = (bf16_t*)(ws + WS_CKVN); bf16_t* __restrict__ KA = (bf16_t*)(ws + WS_KATT);
    float* __restrict__ INV = (float*)(ws + WS_INV); const float* __restrict__ rope = (const float*)(ws + WS_ROPE);
    const float* __restrict__ mu = a.in[I_MU] + (size_t)l * 1920; const float* __restrict__ kkp = a.in[I_KK] + l * 512; const float* __restrict__ qg = a.in[I_QNG] + l * 256; const float* __restrict__ kvg = a.in[I_KVNG] + l * 128;
    const u32x4 zero4 = {0u, 0u, 0u, 0u};
    const int lcol = lane < 48 ? OFF_WLO + lane * 8 : (lane < 52 ? OFF_HV + (lane - 48) * 8 : 0);
    const int mcol = lane < 32 ? lane * 8 : (lane < 48 ? 256 + (lane - 32) * 8 : 384 + ((lane - 48) & 3) * 8);
    const int chunk = (TALL + nw - 1) / nw, m0 = gw * chunk, m1 = (m0 + chunk < TALL) ? m0 + chunk : TALL;
    struct Raw { u32x4 r, k, v, l; };
    auto ld4 = [&](int m) -> Raw { Raw t; if (m >= 0 && m < TALL) { const bf16_t* Fq = F + (size_t)m * CINX; t.r = *(const u32x4*)(Fq + OFF_R + lane * 8); t.k = *(const u32x4*)(Fq + OFF_K + lane * 8);
            t.v = *(const u32x4*)(Fq + OFF_V + lane * 8); t.l = (lane < 52) ? *(const u32x4*)(Fq + lcol) : zero4; } else { t.r = zero4; t.k = zero4; t.v = zero4; t.l = zero4; } return t; };
    auto ldm = [&](int m) -> u32x4 { return (m < TALL) ? *(const u32x4*)(F + (size_t)m * CINX + mcol) : zero4; };
    Raw P = ld4(m0 - 1), C = ld4(m0), N = ld4(m0 + 1); u32x4 M = ldm(m0);
    for (int m = m0; m < m1; ++m) {
        const int b = m / TT, tt = m - b * TT; const bool ctx = tt < TC;
        const bool pok = !(tt == 0 || tt == TC), nok = !(tt == TC - 1 || tt == TT - 1);
        const Raw NN = ld4(m + 2); const u32x4 MN = ldm(m + 1);
        u32x4 rc = C.r, kc = C.k, vc = C.v, lc = C.l, rp = P.r, kp = P.k, vp = P.v, lp = P.l, rn = N.r, kn = N.k, vn = N.v, ln = N.l; const u32x4 mc = M;
        if (!pok) { rp = zero4; kp = zero4; vp = zero4; lp = zero4; }
        if (!nok) { rn = zero4; kn = zero4; vn = zero4; ln = zero4; }
        P = C; C = N; N = NN; M = MN;
        float x[8];
        shift8r(rc, rp, rn, mu, OFF_R + lane * 8, x); store8(R + (size_t)m * 512 + lane * 8, x);
        shift8r(kc, kp, kn, mu, OFF_K + lane * 8, x); store8(Kb + (size_t)m * 512 + lane * 8, x);
        { float kq[8], ss = 0.f; loadf8(kkp + lane * 8, kq);
#pragma unroll
          for (int j = 0; j < 8; ++j) { const float t = x[j] * kq[j]; ss += t * t; }
          ss = xorsum(ss, 1); ss = xorsum(ss, 2); ss = xorsum(ss, 4);
          if ((lane & 7) == 0) INV[(size_t)m * 8 + (lane >> 3)] = rsqrtf(fmaxf(ss, 1e-24f)); }
        shift8r(vc, vp, vn, mu, OFF_V + lane * 8, x); store8(Vb + (size_t)m * 512 + lane * 8, x);
        if (lane < 48) { shift8r(lc, lp, ln, mu, lcol, x);
            if (lane < 16) {
#pragma unroll
                for (int j = 0; j < 8; ++j) x[j] = tanhf_(x[j]); }
            else if (lane >= 32) {
#pragma unroll
                for (int j = 0; j < 8; ++j) x[j] = sigmoidf_(x[j]); }
            if (lane < 32) store8(A1 + (size_t)m * 256 + lane * 8, x); else store8(A2 + (size_t)m * 256 + (lane - 32) * 8, x); }
        else { unpack8(lc, x); store8(A2 + (size_t)m * 256 + 128 + (lane - 48) * 8, x); }
        { unpack8(mc, x); float ss = 0.f;
#pragma unroll
          for (int j = 0; j < 8; ++j) ss += x[j] * x[j];
          ss = xorsum(ss, 1); ss = xorsum(ss, 2); ss = xorsum(ss, 4); ss = xorsum(ss, 8); const float ss32 = xorsum(ss, 16);
          float px[8]; const int q = (lane - 48) & 3;
#pragma unroll
          for (int j = 0; j < 8; ++j) px[j] = __shfl_xor(x[j], 1, 64);
          if (lane < 32) { const float rstd = rsqrtf(ss32 * (1.f / 256.f) + 1e-6f); float g[8]; loadf8(qg + lane * 8, g);
#pragma unroll
              for (int j = 0; j < 8; ++j) x[j] = x[j] * rstd * g[j];
              store8(CQN + (size_t)m * 256 + lane * 8, x); }
          else if (lane < 48) { const float rstd = rsqrtf(ss * (1.f / 128.f) + 1e-6f); float g[8]; loadf8(kvg + (lane - 32) * 8, g);
#pragma unroll
              for (int j = 0; j < 8; ++j) x[j] = x[j] * rstd * g[j];
              store8(CKVN + (size_t)m * 128 + (lane - 32) * 8, x); }
          else { if (lane < 52) {
                  if (!ctx) { const int s = tt - TC, pos = (q < 2) ? (s >> 6) : (s & 63); float cs[8], sn[8]; loadf8(rope + pos * 8, cs); loadf8(rope + 512 + pos * 8, sn); const float sg = (q & 1) ? 1.f : -1.f;
#pragma unroll
                      for (int j = 0; j < 8; ++j) x[j] = x[j] * cs[j] + sg * px[j] * sn[j]; }
#pragma unroll
                  for (int hh = 0; hh < 8; ++hh) store8(KA + (size_t)m * 768 + hh * 96 + 64 + q * 8, x); }
          } }
    }
}

DI void phase_rwkv_out(const Args& a, int l, bool latent_only) {
    const int lane = ltid() & 63, gw = blockIdx.x * 8 + (ltid() >> 6), nw = gridDim.x * 8;
    unsigned char* ws = a.ws;
    const bf16_t* R = (const bf16_t*)(ws + WS_R); const bf16_t* Kb = (const bf16_t*)(ws + WS_K); const bf16_t* Vb = (const bf16_t*)(ws + (l == 0 ? WS_VF : WS_V));
    const bf16_t* AA = (const bf16_t*)(ws + WS_AA); const bf16_t* Gb = (const bf16_t*)(ws + WS_G); const bf16_t* YB = (const bf16_t*)(ws + WS_YB); bf16_t* MIX = (bf16_t*)(ws + WS_MIX);
    const int c = lane * 8; float ka[8], rk[8], lw[8], lb[8];
    loadf8(a.in[I_KA] + l * 512 + c, ka); loadf8(a.in[I_RK] + l * 512 + c, rk); loadf8(a.in[I_LNW] + l * 512 + c, lw); loadf8(a.in[I_LNB] + l * 512 + c, lb);
    for (int m = gw; m < TALL; m += nw) {
        const int tt = m % TT; if (latent_only && tt < TC) continue;
        float yf[8], yb[8], r[8], k[8], v[8], a0[8], a1[8], g[8];
        load8(MIX + (size_t)m * 1024 + 512 + c, yf); load8(YB + (size_t)m * 512 + c, yb); load8(R + (size_t)m * 512 + c, r); load8(Kb + (size_t)m * 512 + c, k); load8(Vb + (size_t)m * 512 + c, v);
        load8(AA + (size_t)m * 1024 + c, a0); load8(AA + (size_t)m * 1024 + 512 + c, a1); load8(Gb + (size_t)m * 512 + c, g);
        float s = 0.f, bon = 0.f;
#pragma unroll
        for (int j = 0; j < 8; ++j) { yf[j] += yb[j]; s += yf[j]; bon += r[j] * k[j] * (2.f + (a0[j] + a1[j] - 2.f) * ka[j]) * rk[j]; }
        s = xorsum(s, 1); s = xorsum(s, 2); s = xorsum(s, 4); bon = xorsum(bon, 1); bon = xorsum(bon, 2); bon = xorsum(bon, 4);
        const float mean = s * (1.f / 64.f); float vs = 0.f;
#pragma unroll
        for (int j = 0; j < 8; ++j) { yf[j] -= mean; vs += yf[j] * yf[j]; }
        vs = xorsum(vs, 1); vs = xorsum(vs, 2); vs = xorsum(vs, 4);
        const float rstd = rsqrtf(vs * (1.f / 64.f) + 64e-5f);
#pragma unroll
        for (int j = 0; j < 8; ++j) yf[j] = (yf[j] * rstd * lw[j] + lb[j] + bon * v[j]) * g[j];
        store8(MIX + (size_t)m * 1024 + 512 + c, yf);
    }
}

DI void phase_final(const Args& a) {
    const int lane = ltid() & 63, gw = blockIdx.x * 8 + (ltid() >> 6), nw = gridDim.x * 8; const float* gamma = a.in[I_FG];
    for (int m = gw; m < NB * SEQ; m += nw) {
        float* xr = a.out + (size_t)m * DM; f32x4 v[4]; float ss = 0.f;
#pragma unroll
        for (int i = 0; i < 4; ++i) { v[i] = *(const f32x4*)(xr + i * 256 + lane * 4); ss += v[i][0] * v[i][0] + v[i][1] * v[i][1] + v[i][2] * v[i][2] + v[i][3] * v[i][3]; }
#pragma unroll
        for (int k = 1; k < 64; k <<= 1) ss = xorsum(ss, k);
        const float rstd = rsqrtf(ss * (1.f / 1024.f) + 1e-6f);
#pragma unroll
        for (int i = 0; i < 4; ++i) { const int col = i * 256 + lane * 4; const f32x4 g = *(const f32x4*)(gamma + col); *(f32x4*)(xr + col) = v[i] * rstd * g; }
    }
}

#define LAS __attribute__((address_space(3)))
#define XB_TMO      128
#define XB_XCNT(j)  (256  + 64 * (j))
#define XB_XSUB(j)  (1280 + 64 * (j))
#define XB_XGEN(j)  (2304 + 64 * (j))
#define XB_TOP      3328
#define XB_TOPGEN   3392
#define XCD_BAR_WORDS 3456
#define XB_SPIN_CAP (1u << 18)

__device__ __forceinline__ unsigned xb_ld(unsigned* p)              { return __hip_atomic_load(p, __ATOMIC_RELAXED, __HIP_MEMORY_SCOPE_AGENT); }
__device__ __forceinline__ unsigned xb_add(unsigned* p, unsigned v) { return __hip_atomic_fetch_add(p, v, __ATOMIC_RELAXED, __HIP_MEMORY_SCOPE_AGENT); }
__device__ __forceinline__ unsigned xb_xcc_id() { return (unsigned)__builtin_amdgcn_s_getreg((3 << 11) | 20) & 0xFu; }
#define XB_SPIN(cond, bar) do { unsigned _sp = 0; while (cond) { __builtin_amdgcn_s_sleep(1); \
    if ((++_sp & 255u) == 0u) { if (xb_ld(&(bar)[XB_TMO])) break; if (_sp > XB_SPIN_CAP) { atomicAdd(&(bar)[XB_TMO], 1u); break; } } } } while (0)

struct XcdBarrier {
    unsigned* bar; unsigned x;
    volatile LAS unsigned* st;
};

__device__ __forceinline__ XcdBarrier xcd_barrier_post(unsigned* bar, volatile LAS unsigned* st) {
    XcdBarrier b; b.bar = bar; b.x = xb_xcc_id(); b.st = st;
    if (threadIdx.x == 0) (void)xb_add(&bar[XB_XCNT(b.x)], 1u);
    return b;
}
__device__ __forceinline__ void xcd_barrier_complete(unsigned* bar, unsigned x, unsigned& nloc, unsigned& nx) {
    const unsigned G = gridDim.x * gridDim.y * gridDim.z;
    unsigned sum, cnt, mine, sp = 0u;
    for (;;) {
        sum = 0u; cnt = 0u; mine = 0u;
#pragma unroll
        for (unsigned j = 0; j < 16; ++j) { const unsigned c = xb_ld(&bar[XB_XCNT(j)]); sum += c; cnt += (c > 0u) ? 1u : 0u; mine = (j == x) ? c : mine; }
        if (sum == G) break;
        __builtin_amdgcn_s_sleep(1);
        if ((++sp & 255u) == 0u) { if (xb_ld(&bar[XB_TMO])) break; if (sp > XB_SPIN_CAP) { atomicAdd(&bar[XB_TMO], 1u); break; } }
    }
    nloc = mine > 0u ? mine : 1u; nx = cnt > 0u ? cnt : 1u;
}

__device__ __forceinline__ void xcd_barrier(const XcdBarrier& b) {
    asm volatile("s_waitcnt vmcnt(0)" ::: "memory");
    __syncthreads();
    if (threadIdx.x == 0) {
        unsigned* bar = b.bar;
        __builtin_amdgcn_s_waitcnt(0);
        unsigned nloc = b.st[0], nx = b.st[1];
        if (nloc == 0u) { xcd_barrier_complete(bar, b.x, nloc, nx); b.st[0] = nloc; b.st[1] = nx; }
        const unsigned old = xb_add(&bar[XB_XSUB(b.x)], 1u);
        const unsigned gen = old / nloc;
        if (old + 1u == (gen + 1u) * nloc) {
            __builtin_amdgcn_fence(__ATOMIC_RELEASE, "agent");
            asm volatile("s_waitcnt vmcnt(0)" ::: "memory");
            const unsigned og = xb_add(&bar[XB_TOP], 1u);
            const unsigned tg = og / nx;
            if (og + 1u == (tg + 1u) * nx) xb_add(&bar[XB_TOPGEN], 1u);
            else XB_SPIN(xb_ld(&bar[XB_TOPGEN]) == tg, bar);
            __builtin_amdgcn_fence(__ATOMIC_ACQUIRE, "agent");
            xb_add(&bar[XB_XGEN(b.x)], 1u);
            asm volatile("s_waitcnt vmcnt(0)" ::: "memory");
        } else {
            XB_SPIN(xb_ld(&bar[XB_XGEN(b.x)]) == gen, bar);
            __builtin_amdgcn_fence(__ATOMIC_ACQUIRE, "agent");
            asm volatile("s_waitcnt vmcnt(0)" ::: "memory");
        }
    }
    __syncthreads();
}

__global__ void __launch_bounds__(512, 2) trunk_fwd(Args ka) {
    extern __shared__ __attribute__((aligned(16))) unsigned char lds[];
    cg::grid_group grid = cg::this_grid();
    volatile LAS unsigned* bst = (volatile LAS unsigned*)((LAS unsigned char*)lds + (LDS_BYTES - 16));
    if (threadIdx.x < 4) bst[threadIdx.x] = 0u;
    __syncthreads();
    XcdBarrier xbar = xcd_barrier_post((unsigned*)(ka.ws + WS_BAR), bst);
    const int ph_hi = ka.hi;
    {
        if (blockIdx.x == 0 && threadIdx.x == 0) {
#pragma unroll
            for (int i = 0; i < 31; ++i) ((const float**)(ka.ws + WS_TAB))[i] = ka.in[i]; }
        phase_prologue(ka, lds); convert_weights(ka, 0, lds, 0);
        grid.sync();
    }
    for (int ph = 1; ph < ph_hi; ++ph) {
        Args a; a.ws = ka.ws; a.out = ka.out; asm volatile("" : "+s"(a.ws)); asm volatile("" : "+s"(a.out));
        { const float* const* tab = (const float* const*)(a.ws + WS_TAB);
#define LD4(i) asm volatile("s_load_dwordx2 %0, %4, %5\n\ts_load_dwordx2 %1, %4, %6\n\ts_load_dwordx2 %2, %4, %7\n\ts_load_dwordx2 %3, %4, %8\n\ts_waitcnt lgkmcnt(0)" \
              : "=&s"(a.in[i]), "=&s"(a.in[i + 1]), "=&s"(a.in[i + 2]), "=&s"(a.in[i + 3]) : "s"(tab), "i"((i) * 8), "i"((i) * 8 + 8), "i"((i) * 8 + 16), "i"((i) * 8 + 24))
          LD4(0); LD4(4); LD4(8); LD4(12); LD4(16); LD4(20); LD4(24);
          asm volatile("s_load_dwordx2 %0, %3, %4\n\ts_load_dwordx2 %1, %3, %5\n\ts_load_dwordx2 %2, %3, %6\n\ts_waitcnt lgkmcnt(0)" : "=&s"(a.in[28]), "=&s"(a.in[29]), "=&s"(a.in[30]) : "s"(tab), "i"(224), "i"(232), "i"(240));
#undef LD4
        }
        a.lo = 0; a.hi = 0;
        unsigned char* ws = a.ws;
        if (ph == 1) phase_vectors(a, lds);
        else if (ph == NPH - 1) phase_final(a);
        else {
            const int l = (ph - 2) / 10, s = (ph - 2) % 10; const bool last = (l == NL - 1);
            const float* mods = (const float*)(ws + WS_MODS) + (size_t)l * 33 * 6144;
            float* rsa = (float*)(ws + WS_RSA); float* rsb = (float*)(ws + WS_RSB);
            if (s == 0) { run_gemm<NIN, 1024>(lds, (const bf16_t*)(ws + WS_H), (const bf16_t*)(ws + WT_IN), 0, FnF{(bf16_t*)(ws + WS_F), rsa, (const float*)(ws + WS_C1) + (size_t)l * 33 * NIN}); }
            else if (s == 1) { phase_split(a, l); convert_weights(a, l, lds, 1);
                for (int i = blockIdx.x * 512 + ltid(); i < TALL; i += gridDim.x * 512) { rsa[i] = 0.f; rsb[i] = 0.f; } }
            else if (s == 2) { run_gemm<768, 256>(lds, (const bf16_t*)(ws + WS_CQN), (const bf16_t*)(ws + WT_UQ), 0, FnQ{(bf16_t*)(ws + WS_Q), (const float*)(ws + WS_ROPE)});
                    run_gemm<1024, 128>(lds, (const bf16_t*)(ws + WS_CKVN), (const bf16_t*)(ws + WT_UKV), 0, FnKV{(bf16_t*)(ws + WS_KATT), (bf16_t*)(ws + WS_VATT)}); }
            else if (s == 3) { phase_attn((const bf16_t*)(ws + WS_Q), (const bf16_t*)(ws + WS_KATT), (const bf16_t*)(ws + WS_VATT), (bf16_t*)(ws + WS_MIX), last, (char*)lds); }
            else if (s == 4) { run_gemm<2048, 256>(lds, (const bf16_t*)(ws + WS_A1), (const bf16_t*)(ws + WT_L1), 0, FnL1{(__half*)(ws + WS_DEC), (bf16_t*)(ws + WS_AA), a.in[I_W0] + l * 1024, a.in[I_A0] + l * 1024});
                    run_gemm<1024, 256>(lds, (const bf16_t*)(ws + WS_A2), (const bf16_t*)(ws + WT_L2), 0,
                             FnL2{(bf16_t*)(ws + WS_G), (bf16_t*)(ws + WS_V), (const bf16_t*)(ws + WS_VF), a.in[I_V0] + (l > 0 ? l - 1 : 0) * 512, l > 0 ? 1 : 0}); }
            else if (s == 5) { phase_scan((const bf16_t*)(ws + WS_R), (const bf16_t*)(ws + WS_K), (const bf16_t*)(ws + (l == 0 ? WS_VF : WS_V)), (const __half*)(ws + WS_DEC), (const bf16_t*)(ws + WS_AA),
                               (const float*)(ws + WS_INV), a.in[I_KK] + l * 512, a.in[I_KA] + l * 512, (bf16_t*)(ws + WS_MIX), (bf16_t*)(ws + WS_YB), (char*)lds); }
            else if (s == 6) { phase_rwkv_out(a, l, last); if (!last) convert_weights(a, l + 1, lds, 0); }
            else if (s == 7) { run_gemm_epi<1024, 1024>(lds, (const bf16_t*)(ws + WS_MIX), (const bf16_t*)(ws + WT_OUT), last ? 1 : 0,
                             EpiRes{a.out, (float*)(ws + WS_XC), l == 0 ? a.in[I_X] : a.out, l == 0 ? a.in[I_CTX] : (const float*)(ws + WS_XC), mods, 2,
                                    (const float*)(ws + WS_GP2) + (size_t)l * 33 * 1024, (bf16_t*)(ws + WS_H), rsb, 1}); }
            else if (s == 8) { run_gemm<DFF, 1024>(lds, (const bf16_t*)(ws + WS_H), (const bf16_t*)(ws + WT_M1), last ? 1 : 0, FnM1{(bf16_t*)(ws + WS_HID), rsb, (const float*)(ws + WS_C2) + (size_t)l * 33 * DFF}); }
            else if (s == 9) { run_gemm_epi<1024, DFF>(lds, (const bf16_t*)(ws + WS_HID), (const bf16_t*)(ws + WT_M2), last ? 1 : 0,
                             EpiRes{a.out, (float*)(ws + WS_XC), a.out, (const float*)(ws + WS_XC), mods, 5,
                                    (const float*)(ws + WS_GP1) + (size_t)(last ? l : l + 1) * 33 * 1024, (bf16_t*)(ws + WS_H), rsa, last ? 0 : 1}); }
        }
        if (ph + 1 < ph_hi) { XcdBarrier xb = xbar; asm volatile("" : "+s"(xb.bar)); xcd_barrier(xb); }
    }
}

extern "C" void kernel_launch(void* const* d_in, const int* in_sizes, int n_in, void* d_out, int out_size, void* d_ws, size_t ws_size, hipStream_t stream) {
    static int grid = 0;
    if (grid == 0) {
        if (n_in != 31 || out_size != NB * SEQ * DM || ws_size < WS_END) { fprintf(stderr, "kernel_launch: unexpected shapes: n_in %d out %d ws %zu (need %zu)\n", n_in, out_size, ws_size, (size_t)WS_END); grid = -1; return; }
        int dev = 0, cus = 0, per_cu = 0;
        (void)hipGetDevice(&dev); (void)hipDeviceGetAttribute(&cus, hipDeviceAttributeMultiprocessorCount, dev);
        if (hipFuncSetAttribute((const void*)trunk_fwd, hipFuncAttributeMaxDynamicSharedMemorySize, LDS_BYTES) != hipSuccess) { fprintf(stderr, "kernel_launch: hipFuncSetAttribute failed\n"); grid = -1; return; }
        if (hipOccupancyMaxActiveBlocksPerMultiprocessor(&per_cu, (const void*)trunk_fwd, 512, LDS_BYTES) != hipSuccess || per_cu < 1) { fprintf(stderr, "kernel_launch: occupancy query gave %d\n", per_cu); per_cu = 1; }
        (void)hipGetLastError();
        grid = cus * 1;
    }
    if (grid < 0) return;
    if (hipMemsetAsync((char*)d_ws + WS_BAR, 0, BAR_BYTES, stream) != hipSuccess) { fprintf(stderr, "kernel_launch: hipMemsetAsync failed\n"); return; }
    Args a{};
    for (int i = 0; i < 31; ++i) a.in[i] = (const float*)d_in[i];
    a.out = (float*)d_out; a.ws = (unsigned char*)d_ws; a.lo = 0; a.hi = NPH;
    void* args[] = {&a};
    hipError_t e = hipLaunchCooperativeKernel((const void*)trunk_fwd, dim3(grid), dim3(512), args, LDS_BYTES, stream);
    if (e != hipSuccess) fprintf(stderr, "kernel_launch: cooperative launch failed: %s (grid %d)\n", hipGetErrorString(e), grid);
}
```

```cpp
#include <hip/hip_runtime.h>
#include <hip/hip_cooperative_groups.h>
#include <hip/hip_fp16.h>
#include <cstdio>
#include <cstdint>
namespace cg = cooperative_groups;
#define DI __device__ __forceinline__
DI int ltid() { int t = threadIdx.x; asm volatile("" : "+v"(t)); return t; }
namespace pg8 {
#define PG8_LAS __attribute__((address_space(3)))
typedef unsigned short bf16_t;
typedef short bf16x8 __attribute__((ext_vector_type(8)));
typedef float f32x4 __attribute__((ext_vector_type(4)));
typedef unsigned u32x4 __attribute__((ext_vector_type(4)));
constexpr int BM = 256, BK = 64, HALF = 128, HTB = HALF * BK * 2  , STAGE_BYTES = 8 * HTB, NXCD = 8, WGM = 8;

__host__ __device__ __forceinline__ int lds_byte(int r, int c) { const int st = (r >> 4) * 2 + (c >> 5), rr = r & 15, cc = c & 31, ob = rr * 64 + cc * 2; return st * 1024 + (ob ^ (((ob >> 9) & 1) << 5)); }
__host__ __device__ __forceinline__ void stage_rc(int b, int& R, int& C) { const int st = b / 1024, sb = b % 1024, swz = sb ^ (((sb >> 9) & 1) << 5); R = (st >> 1) * 16 + swz / 64; C = (st & 1) * 32 + (swz % 64) / 2; }
__host__ __device__ __forceinline__ int perm32(int rho) { const int n = rho >> 4, i = rho & 15; return 8 * (i >> 2) + 4 * n + (i & 3); }

struct Unit { int pm, pn; };
struct Gemm { const bf16_t* A; const bf16_t* Bt; int M, N, K; };

struct StaticOrder {
    int nM, nN, nwg, G, c;
    __host__ __device__ void init(int M, int N, int G_, int c_) { nM = M / BM; nN = N / BM; nwg = nM * nN; G = G_; c = c_; }
    __host__ __device__ bool next(int i, Unit& u) const {
        const long L = (long)i * G + c; if (L >= nwg) return false;
        int wgid = (int)L; { const int q = nwg / NXCD, r = nwg % NXCD, xcd = wgid % NXCD, off = wgid / NXCD; wgid = (xcd < r ? xcd * (q + 1) : r * (q + 1) + (xcd - r) * q) + off; }
        const int nig = WGM * nN, gid = wgid / nig, fm = gid * WGM, gsz = (nM - fm) < WGM ? (nM - fm) : WGM;
        u.pm = fm + ((wgid % nig) % gsz); u.pn = (wgid % nig) / gsz; return true;
    }
    __device__ __forceinline__ void a_ready(const Unit&) const {}
    __device__ __forceinline__ void done(const Unit&) const {}
};

__device__ __forceinline__ unsigned cvt_pk_bf16(float lo, float hi) { unsigned r; asm volatile("v_cvt_pk_bf16_f32 %0, %1, %2" : "=v"(r) : "v"(lo), "v"(hi)); return r; }

template <class Epi, class Sched, bool ALIGN_EPI = false, bool SP2 = false>
__device__ __forceinline__ void gemm_phase(PG8_LAS unsigned char* lds, const Gemm g, const Sched& S, const Epi& E) {
    const int tid = ltid(), wid = __builtin_amdgcn_readfirstlane(tid >> 6), lane = tid & 63, wr = wid >> 2, wc = wid & 3, fr = lane & 15, fq = lane >> 4;
    const int K = g.K, nt = K / BK;
    unsigned voffA[2], voffB[2];
#pragma unroll
    for (int i = 0; i < 2; ++i) { int R, C; stage_rc(tid * 16 + i * 8192, R, C); const int Rb = Epi::PERM ? ((R & ~31) + perm32(R & 31)) : R;
        voffA[i] = (unsigned)(R * K + C) * 2u; voffB[i] = (unsigned)(Rb * K + C) * 2u; }
    const size_t kstep = (size_t)(BK * 2);
    const size_t hstep = (size_t)HALF * K * 2;
    const size_t tstep = 2 * hstep;
    const unsigned ldsw = (unsigned)wid * 1024u;
    const int aoff = lds_byte(wr * 64 + fr, fq * 8), boff = lds_byte(wc * 32 + fr, fq * 8);
#define PG8_SA(b, h) (((b) * 2 + (h)) * HTB)
#define PG8_SB(b, h) ((4 + (b) * 2 + (h)) * HTB)
#define PG8_STAGE(bufoff, gbase, voff) do { _Pragma("unroll") for (int _i = 0; _i < 2; ++_i) \
        __builtin_amdgcn_global_load_lds((const unsigned*)((const char*)(gbase) + (voff)[_i]), (PG8_LAS unsigned*)(lds + (bufoff) + ldsw + _i * 8192), 16, 0, 0); } while (0)
#define PG8_LDA(dst, b, h) do { _Pragma("unroll") for (int m = 0; m < 4; ++m) _Pragma("unroll") for (int k = 0; k < 2; ++k) dst[m][k] = *(const PG8_LAS bf16x8*)(lds + PG8_SA(b, h) + aoff + m * 2048 + k * 1024); } while (0)
#define PG8_LDB(dst, b, h) do { _Pragma("unroll") for (int n = 0; n < 2; ++n) _Pragma("unroll") for (int k = 0; k < 2; ++k) dst[n][k] = *(const PG8_LAS bf16x8*)(lds + PG8_SB(b, h) + boff + n * 2048 + k * 1024); } while (0)
#define PG8_MMA(ai, bj, At, Bt) do { __builtin_amdgcn_s_setprio(1); _Pragma("unroll") for (int m = 0; m < 4; ++m) _Pragma("unroll") for (int n = 0; n < 2; ++n) _Pragma("unroll") for (int k = 0; k < 2; ++k) \
        acc[ai][bj][m][n] = __builtin_amdgcn_mfma_f32_16x16x32_bf16(Bt[n][k], At[m][k], acc[ai][bj][m][n], 0, 0, 0); __builtin_amdgcn_s_setprio(0); } while (0)
#define PG8_WAIT_V(n) asm volatile("s_waitcnt vmcnt(" #n ")" ::: "memory")
#define PG8_WAIT_L(n) asm volatile("s_waitcnt lgkmcnt(" #n ")" ::: "memory")
#define PG8_BAR __builtin_amdgcn_s_barrier()
#define PG8_SCHED __builtin_amdgcn_sched_barrier(0)
    Unit cur, nxt; int ui = 0;
    if (!S.next(0, cur)) return;
    f32x4 acc[2][2][4][2];
#pragma unroll
    for (int a = 0; a < 2; ++a)
#pragma unroll
        for (int b = 0; b < 2; ++b)
#pragma unroll
            for (int m = 0; m < 4; ++m)
#pragma unroll
                for (int n = 0; n < 2; ++n) acc[a][b][m][n] = (f32x4){0.f, 0.f, 0.f, 0.f};
    bf16x8 At[4][2], B0[2][2], B1[2][2];
    const char* cA = (const char*)g.A + (size_t)cur.pm * tstep; const char* cB = (const char*)g.Bt + (size_t)cur.pn * tstep;
    S.a_ready(cur);
    if constexpr (SP2) {
        PG8_STAGE(PG8_SB(0, 0), cB, voffB); PG8_STAGE(PG8_SB(0, 1), cB + hstep, voffB); PG8_STAGE(PG8_SA(0, 0), cA, voffA); PG8_STAGE(PG8_SA(0, 1), cA + hstep, voffA);
        if (wr == 1) PG8_BAR;
        PG8_WAIT_V(2); PG8_BAR;
        PG8_STAGE(PG8_SB(1, 0), cB + kstep, voffB); PG8_STAGE(PG8_SA(1, 0), cA + kstep, voffA); PG8_STAGE(PG8_SB(1, 1), cB + hstep + kstep, voffB);
        PG8_WAIT_V(6); PG8_BAR;
    } else {
        PG8_STAGE(PG8_SB(0, 0), cB, voffB); PG8_STAGE(PG8_SA(0, 0), cA, voffA); PG8_STAGE(PG8_SB(0, 1), cB + hstep, voffB); PG8_STAGE(PG8_SA(0, 1), cA + hstep, voffA);
        if (wr == 1) PG8_BAR;
        PG8_WAIT_V(4); PG8_BAR;
        PG8_STAGE(PG8_SB(1, 0), cB + kstep, voffB); PG8_STAGE(PG8_SA(1, 0), cA + kstep, voffA); PG8_STAGE(PG8_SB(1, 1), cB + hstep + kstep, voffB);
        PG8_WAIT_V(6); PG8_BAR;
    }
    for (;;) {
        const bool has_next = S.next(ui + 1, nxt);
        const char* nA = has_next ? (const char*)g.A + (size_t)nxt.pm * tstep : cA; const char* nB = has_next ? (const char*)g.Bt + (size_t)nxt.pn * tstep : cB;
#pragma nounroll
        for (int t = 0; t < nt; t += 2) {
            const bool last = (t == nt - 2);
            const char* a1 = cA + (size_t)(t + 1) * kstep;
            const char* a2 = last ? nA : cA + (size_t)(t + 2) * kstep; const char* b2 = last ? nB : cB + (size_t)(t + 2) * kstep;
            const char* a3 = a2 + kstep; const char* b3 = b2 + kstep;
            if (last && has_next) S.a_ready(nxt);
            if constexpr (SP2) {
            PG8_LDB(B0, 0, 0); PG8_LDB(B1, 0, 1); PG8_SCHED; PG8_LDA(At, 0, 0); PG8_STAGE(PG8_SA(1, 1), a1 + hstep, voffA);
            PG8_WAIT_V(8); PG8_WAIT_L(0); PG8_BAR; PG8_MMA(0, 0, At, B0); PG8_MMA(0, 1, At, B1); PG8_BAR; PG8_SCHED;
            PG8_LDA(At, 0, 1); PG8_STAGE(PG8_SB(0, 0), b2, voffB); PG8_STAGE(PG8_SB(0, 1), b2 + hstep, voffB); PG8_STAGE(PG8_SA(0, 0), a2, voffA);
            PG8_WAIT_V(8); PG8_WAIT_L(0); PG8_BAR; PG8_MMA(1, 0, At, B0); PG8_MMA(1, 1, At, B1); PG8_BAR; PG8_SCHED;
            PG8_LDB(B0, 1, 0); PG8_LDB(B1, 1, 1); PG8_SCHED; PG8_LDA(At, 1, 0); PG8_STAGE(PG8_SA(0, 1), a2 + hstep, voffA);
            PG8_WAIT_V(8); PG8_WAIT_L(0); PG8_BAR; PG8_MMA(0, 0, At, B0); PG8_MMA(0, 1, At, B1); PG8_BAR; PG8_SCHED;
            PG8_LDA(At, 1, 1); PG8_STAGE(PG8_SB(1, 0), b3, voffB); PG8_STAGE(PG8_SB(1, 1), b3 + hstep, voffB); PG8_STAGE(PG8_SA(1, 0), a3, voffA);
            PG8_WAIT_V(8); PG8_WAIT_L(0); PG8_BAR; PG8_MMA(1, 0, At, B0); PG8_MMA(1, 1, At, B1); PG8_BAR; PG8_SCHED;
            } else {
            PG8_LDB(B0, 0, 0); PG8_SCHED; PG8_LDA(At, 0, 0); PG8_STAGE(PG8_SA(1, 1), a1 + hstep, voffA);
            PG8_WAIT_L(8); PG8_BAR; PG8_WAIT_L(0); PG8_MMA(0, 0, At, B0); PG8_BAR; PG8_SCHED;
            PG8_LDB(B1, 0, 1); PG8_STAGE(PG8_SB(0, 0), b2, voffB);
            PG8_BAR; PG8_WAIT_L(0); PG8_MMA(0, 1, At, B1); PG8_BAR;
            PG8_LDA(At, 0, 1); PG8_STAGE(PG8_SA(0, 0), a2, voffA);
            PG8_BAR; PG8_WAIT_L(0); PG8_MMA(1, 0, At, B0); PG8_BAR; PG8_SCHED;
            PG8_STAGE(PG8_SB(0, 1), b2 + hstep, voffB);
            PG8_WAIT_V(6); PG8_BAR; PG8_MMA(1, 1, At, B1); PG8_BAR;
            PG8_LDB(B0, 1, 0); PG8_SCHED; PG8_LDA(At, 1, 0); PG8_STAGE(PG8_SA(0, 1), a2 + hstep, voffA);
            PG8_WAIT_L(8); PG8_BAR; PG8_WAIT_L(0); PG8_MMA(0, 0, At, B0); PG8_BAR; PG8_SCHED;
            PG8_LDB(B1, 1, 1); PG8_STAGE(PG8_SB(1, 0), b3, voffB);
            PG8_BAR; PG8_WAIT_L(0); PG8_MMA(0, 1, At, B1); PG8_BAR;
            PG8_LDA(At, 1, 1); PG8_STAGE(PG8_SA(1, 0), a3, voffA);
            PG8_BAR; PG8_WAIT_L(0); PG8_MMA(1, 0, At, B0); PG8_BAR; PG8_SCHED;
            PG8_STAGE(PG8_SB(1, 1), b3 + hstep, voffB);
            PG8_WAIT_V(6); PG8_BAR; PG8_MMA(1, 1, At, B1); PG8_BAR;
            }
        }
        if constexpr (ALIGN_EPI) { if (wr == 0) PG8_BAR; }
        if constexpr (!Epi::AFTER_DRAIN) { E(acc, cur, wr, wc, fr, fq); S.done(cur); }
        if (!has_next) break;
#pragma unroll
        for (int a = 0; a < 2; ++a)
#pragma unroll
            for (int b = 0; b < 2; ++b)
#pragma unroll
                for (int m = 0; m < 4; ++m)
#pragma unroll
                    for (int n = 0; n < 2; ++n) acc[a][b][m][n] = (f32x4){0.f, 0.f, 0.f, 0.f};
        cur = nxt; cA = nA; cB = nB; ++ui;
        if constexpr (ALIGN_EPI) { if (wr == 1) PG8_BAR; }
    }
    PG8_WAIT_V(0);
    if constexpr (!ALIGN_EPI) { if (wr == 0) PG8_BAR; }
    PG8_BAR;
    if constexpr (Epi::AFTER_DRAIN) { E.fused(acc, cur, wr, wc, fr, fq, lds, wid, lane); S.done(cur); }
#undef PG8_SA
#undef PG8_SB
#undef PG8_STAGE
#undef PG8_LDA
#undef PG8_LDB
#undef PG8_MMA
#undef PG8_WAIT_V
#undef PG8_WAIT_L
#undef PG8_BAR
#undef PG8_SCHED
}
}
typedef unsigned short bf16_t;
using bf16x8 = __attribute__((ext_vector_type(8))) short;
using s16x4  = __attribute__((ext_vector_type(4))) short;
using f32x16 = __attribute__((ext_vector_type(16))) float;
using f32x4  = __attribute__((ext_vector_type(4))) float;
using u32x4  = __attribute__((ext_vector_type(4))) unsigned;
using u32x2  = __attribute__((ext_vector_type(2))) unsigned;

constexpr int DM = 1024, NB = 32, SEQ = 2048, TC = 256, TT = 2304, TALL = NB * TT, NL = 4;
constexpr int CIN = 2336, CINX = 2368, NIN = 2560, DFF = 4096;
constexpr int OFF_R = 416, OFF_K = 928, OFF_V = 1440, OFF_WLO = 1952, OFF_HV = 2336;
constexpr int NPH = 43, LDS_BYTES = 147456;
constexpr size_t MiB = 1u << 20;
constexpr size_t WS_MODS = 0, WS_ROPE = 3 * MiB + 512 * 1024, WS_BAR = 3 * MiB + 768 * 1024, BAR_BYTES = 16384, WS_TAB = 3 * MiB + 800 * 1024, WS_XC = 4 * MiB, WS_VF = 36 * MiB, WS_WT = 108 * MiB, WS_INV = 134 * MiB, TR = 137 * MiB;
constexpr size_t WT_IN = WS_WT, WT_UQ = WS_WT + 5 * MiB, WT_UKV = WS_WT + 5 * MiB + 512 * 1024, WT_L1 = WS_WT + 6 * MiB, WT_L2 = WS_WT + 7 * MiB,
                 WT_OUT = WS_WT + 8 * MiB, WT_M1 = WS_WT + 10 * MiB, WT_M2 = WS_WT + 18 * MiB;
constexpr size_t WS_R = TR, WS_K = TR + 72 * MiB, WS_H = TR, WS_F = TR + 144 * MiB, WS_Q = TR + 144 * MiB, WS_VATT = TR + 252 * MiB, WS_MIX = TR + 324 * MiB,
                 WS_DEC = TR + 144 * MiB, WS_HID = TR + 144 * MiB, WS_A1 = TR + 477 * MiB, WS_A2 = TR + 513 * MiB, WS_YB = TR + 477 * MiB,
                 WS_CQN = TR + 549 * MiB, WS_CKVN = TR + 585 * MiB, WS_KATT = TR + 621 * MiB, WS_AA = TR + 585 * MiB, WS_G = TR + 729 * MiB,
                 WS_V = TR + 801 * MiB, WS_C1 = 1010 * MiB, WS_C2 = 1012 * MiB, WS_GP1 = 1015 * MiB, WS_GP2 = 1016 * MiB, WS_END = 1017 * MiB;
constexpr size_t WS_RSA = 136 * MiB + 256 * 1024, WS_RSB = 136 * MiB + 640 * 1024;

struct Args { const float* in[31]; float* out; unsigned char* ws; int lo, hi; };
enum { I_X = 0, I_C, I_CTX, I_CCTX, I_ADAW, I_ADAB, I_N1G, I_N2G, I_WIN, I_QNG, I_WUQ, I_KVNG, I_WUKV, I_MU, I_W0, I_W2, I_A0, I_A2, I_G2, I_KK, I_KA, I_RK,
       I_LNW, I_LNB, I_V1, I_V2, I_V0, I_WOUT, I_M1, I_M2, I_FG };

DI float bflo(unsigned w) { return __uint_as_float(w << 16); }
DI float bfhi(unsigned w) { return __uint_as_float(w & 0xffff0000u); }
DI unsigned cvtpk(float lo, float hi) { return pg8::cvt_pk_bf16(lo, hi); }
DI bf16_t f2bf(float f) { return (bf16_t)(cvtpk(f, 0.f) & 0xffffu); }
DI void load8(const bf16_t* p, float (&f)[8]) { const u32x4 w = *(const u32x4*)p; f[0] = bflo(w.x); f[1] = bfhi(w.x); f[2] = bflo(w.y); f[3] = bfhi(w.y); f[4] = bflo(w.z); f[5] = bfhi(w.z); f[6] = bflo(w.w); f[7] = bfhi(w.w); }
DI void store8(bf16_t* p, const float (&f)[8]) { u32x4 w; w.x = cvtpk(f[0], f[1]); w.y = cvtpk(f[2], f[3]); w.z = cvtpk(f[4], f[5]); w.w = cvtpk(f[6], f[7]); *(u32x4*)p = w; }
DI void loadf8(const float* p, float (&f)[8]) { const f32x4 a = *(const f32x4*)p, b = *(const f32x4*)(p + 4); f[0] = a[0]; f[1] = a[1]; f[2] = a[2]; f[3] = a[3]; f[4] = b[0]; f[5] = b[1]; f[6] = b[2]; f[7] = b[3]; }
DI float h2f(unsigned b) { return __half2float(__ushort_as_half((unsigned short)b)); }
DI float sigmoidf_(float x) { return __builtin_amdgcn_rcpf(1.f + __expf(-x)); }
DI float tanhf_(float x) { return 1.f - 2.f * __builtin_amdgcn_rcpf(1.f + __expf(2.f * x)); }
DI float xorsum(float v, int mask) { return v + __shfl_xor(v, mask, 64); }
DI float* xrow(float* out, float* xc, int m) { const int b = m / TT, tt = m - b * TT; return tt < TC ? xc + (size_t)(b * TC + tt) * DM : out + (size_t)(b * SEQ + tt - TC) * DM; }

template <class Fn> struct Epi8 {
    static constexpr bool PERM = true, AFTER_DRAIN = false; Fn f;
    DI void operator()(const pg8::f32x4 (&acc)[2][2][4][2], const pg8::Unit& u, int wr, int wc, int fr, int fq) const {
        asm volatile("" : "+v"(fr), "+v"(fq));
#pragma unroll
        for (int ai = 0; ai < 2; ++ai)
#pragma unroll
            for (int m = 0; m < 4; ++m) { const int rit = ai * 128 + wr * 64 + m * 16 + fr;
#pragma unroll
                for (int bj = 0; bj < 2; ++bj) { f(rit, u.pn * 256 + bj * 128 + wc * 32 + 8 * fq, acc[ai][bj][m][0], acc[ai][bj][m][1], u, fq); __builtin_amdgcn_sched_barrier(0); } }
    }
};
DI void st8(bf16_t* p, const pg8::f32x4& v0, const pg8::f32x4& v1) { u32x4 w; w.x = cvtpk(v0[0], v0[1]); w.y = cvtpk(v0[2], v0[3]); w.z = cvtpk(v1[0], v1[1]); w.w = cvtpk(v1[2], v1[3]); *(u32x4*)p = w; }

struct FnF { bf16_t* F; const float* rs; const float* c1;
    DI void operator()(int rit, int col0, const pg8::f32x4& v0, const pg8::f32x4& v1, const pg8::Unit& u, int) const {
        if (col0 < CINX) { const int row = u.pm * 256 + rit, b = u.pm / 9, mrow = (u.pm - b * 9 == 0) ? 32 : b;
            const float rstd = rsqrtf(rs[row] * (1.f / 1024.f) + 1e-6f); const float* c = c1 + (size_t)mrow * NIN + col0;
            const pg8::f32x4 b0 = *(const pg8::f32x4*)c, b1 = *(const pg8::f32x4*)(c + 4);
            st8(F + (size_t)row * CINX + col0, v0 * rstd + b0, v1 * rstd + b1); } } };
struct FnQ { bf16_t* Q; const float* rope;
    DI void operator()(int rit, int col0, const pg8::f32x4& v0, const pg8::f32x4& v1, const pg8::Unit& u, int fq) const {
        const int seg = u.pm % 9; const bool isrope = (seg != 0) && (((col0 >> 5) % 3) == 2);
        float x[8] = {v0[0], v0[1], v0[2], v0[3], v1[0], v1[1], v1[2], v1[3]};
        if (isrope) { const int s = (seg - 1) * 256 + rit, pos = (fq < 2) ? (s >> 6) : (s & 63); float cs[8], sn[8]; loadf8(rope + pos * 8, cs); loadf8(rope + 512 + pos * 8, sn);
            const float sg = (fq & 1) ? 1.f : -1.f;
#pragma unroll
            for (int j = 0; j < 8; ++j) { const float p = __shfl_xor(x[j], 16, 64); x[j] = x[j] * cs[j] + sg * p * sn[j]; } }
        store8(Q + (size_t)(u.pm * 256 + rit) * 768 + col0, x); } };
struct FnKV { bf16_t* KA; bf16_t* VA;
    DI void operator()(int rit, int col0, const pg8::f32x4& v0, const pg8::f32x4& v1, const pg8::Unit& u, int) const {
        const size_t row = (size_t)(u.pm * 256 + rit); const int h = col0 >> 7, c = col0 & 127;
        if (c < 64) st8(KA + row * 768 + h * 96 + c, v0, v1); else st8(VA + row * 512 + h * 64 + (c - 64), v0, v1); } };
struct FnL1 { __half* DEC; bf16_t* AA; const float* w0; const float* a0;
    DI void operator()(int rit, int col0, const pg8::f32x4& v0, const pg8::f32x4& v1, const pg8::Unit& u, int) const {
        const size_t row = (size_t)(u.pm * 256 + rit); float x[8] = {v0[0], v0[1], v0[2], v0[3], v1[0], v1[1], v1[2], v1[3]};
        if (col0 < 1024) { float b[8]; loadf8(w0 + col0, b); u32x4 w; unsigned hh[8];
#pragma unroll
            for (int j = 0; j < 8; ++j) { const float uu = 0.6065306597f * sigmoidf_(x[j] + b[j]); hh[j] = (unsigned)__half_as_ushort(__float2half(-uu * 1.4426950409f)); }
            w.x = hh[0] | (hh[1] << 16); w.y = hh[2] | (hh[3] << 16); w.z = hh[4] | (hh[5] << 16); w.w = hh[6] | (hh[7] << 16);
            *(u32x4*)(DEC + row * 1024 + col0) = w;
        } else { const int c = col0 - 1024; float b[8]; loadf8(a0 + c, b);
#pragma unroll
            for (int j = 0; j < 8; ++j) x[j] = sigmoidf_(x[j] + b[j]);
            store8(AA + row * 1024 + c, x); } } };
struct FnL2 { bf16_t* G; bf16_t* V; const bf16_t* VF; const float* v0p; int dovres;
    DI void operator()(int rit, int col0, const pg8::f32x4& v0, const pg8::f32x4& v1, const pg8::Unit& u, int) const {
        const size_t row = (size_t)(u.pm * 256 + rit);
        if (col0 < 512) st8(G + row * 512 + col0, v0, v1);
        else if (dovres) { const int c = col0 - 512; float x[8] = {v0[0], v0[1], v0[2], v0[3], v1[0], v1[1], v1[2], v1[3]}, b[8], v[8], vf[8]; loadf8(v0p + c, b); load8(V + row * 512 + c, v); load8(VF + row * 512 + c, vf);
#pragma unroll
            for (int j = 0; j < 8; ++j) v[j] = v[j] + (vf[j] - v[j]) * sigmoidf_(b[j] + x[j]);
            store8(V + row * 512 + c, v); } } };
struct FnM1 { bf16_t* HID; const float* rs; const float* c2;
    DI void operator()(int rit, int col0, const pg8::f32x4& v0, const pg8::f32x4& v1, const pg8::Unit& u, int) const {
        const int row = u.pm * 256 + rit, b = u.pm / 9, mrow = (u.pm - b * 9 == 0) ? 32 : b;
        const float rstd = rsqrtf(rs[row] * (1.f / 1024.f) + 1e-6f); const float* c = c2 + (size_t)mrow * DFF + col0;
        const pg8::f32x4 b0 = *(const pg8::f32x4*)c, b1 = *(const pg8::f32x4*)(c + 4);
        const pg8::f32x4 y0 = v0 * rstd + b0, y1 = v1 * rstd + b1;
        float x[8] = {y0[0], y0[1], y0[2], y0[3], y1[0], y1[1], y1[2], y1[3]};
#pragma unroll
        for (int j = 0; j < 8; ++j) { const float r = fmaxf(x[j], 0.f); x[j] = r * r; }
        store8(HID + (size_t)row * DFF + col0, x); } };
struct EpiRes { static constexpr bool PERM = true, AFTER_DRAIN = false;
    float* out; float* xc; const float* sx; const float* sc; const float* mods; int gidx; const float* gp; bf16_t* H; float* rs; int emit;
    DI void operator()(const pg8::f32x4 (&acc)[2][2][4][2], const pg8::Unit& u, int wr, int wc, int fr, int fq) const {
        asm volatile("" : "+v"(fr), "+v"(fq));
        const int b = u.pm / 9, seg = u.pm - b * 9, mrow = seg == 0 ? 32 : b;
        const float* gbase = mods + (size_t)mrow * 6144 + gidx * 1024; const float* gpb = gp + (size_t)mrow * 1024;
#pragma unroll
        for (int ai = 0; ai < 2; ++ai)
#pragma unroll
            for (int m = 0; m < 4; ++m) { const int rit = ai * 128 + wr * 64 + m * 16 + fr; float ss = 0.f;
                const size_t roff = (seg == 0 ? (size_t)(b * TC + rit) * DM : (size_t)(b * SEQ + (seg - 1) * 256 + rit) * DM);
#pragma unroll
                for (int bj = 0; bj < 2; ++bj) { const int col0 = u.pn * 256 + bj * 128 + wc * 32 + 8 * fq;
                    float* p = (seg == 0 ? xc : out) + roff + col0; const float* q = (seg == 0 ? sc : sx) + roff + col0;
                    const pg8::f32x4 g0 = *(const pg8::f32x4*)(gbase + col0), g1 = *(const pg8::f32x4*)(gbase + col0 + 4); pg8::f32x4 x0 = *(const pg8::f32x4*)q, x1 = *(const pg8::f32x4*)(q + 4);
                    x0 += g0 * acc[ai][bj][m][0]; x1 += g1 * acc[ai][bj][m][1]; *(pg8::f32x4*)p = x0; *(pg8::f32x4*)(p + 4) = x1;
                    if (emit) { const pg8::f32x4 p0 = *(const pg8::f32x4*)(gpb + col0), p1 = *(const pg8::f32x4*)(gpb + col0 + 4);
                        ss += x0[0] * x0[0] + x0[1] * x0[1] + x0[2] * x0[2] + x0[3] * x0[3] + x1[0] * x1[0] + x1[1] * x1[1] + x1[2] * x1[2] + x1[3] * x1[3];
                        st8(H + (size_t)(u.pm * 256 + rit) * 1024 + col0, x0 * p0, x1 * p1); }
                    __builtin_amdgcn_sched_barrier(0); }
                if (emit) { ss += __shfl_xor(ss, 16, 64); ss += __shfl_xor(ss, 32, 64); if (fq == 0) atomicAdd(rs + u.pm * 256 + rit, ss); }
            }
    }
};
struct Order { pg8::StaticOrder s; int lat;
    DI void init(int lat_, int N) { lat = lat_; s.init(lat_ ? NB * SEQ : TALL, N, (int)gridDim.x, (int)blockIdx.x); }
    DI bool next(int i, pg8::Unit& u) const { if (!s.next(i, u)) return false; if (lat) u.pm = (u.pm >> 3) * 9 + 1 + (u.pm & 7); return true; }
    DI void a_ready(const pg8::Unit&) const {}
    DI void done(const pg8::Unit&) const {}
};
template <int N, int K, class Fn> DI void run_gemm(unsigned char* lds, const bf16_t* A, const bf16_t* Bt, int lat, const Fn& fn) {
    int Kr = K; if (K == 128) asm volatile("" : "+s"(Kr));
    pg8::Gemm g{A, Bt, lat ? NB * SEQ : TALL, N, Kr}; Order S; S.init(lat, N); Epi8<Fn> E{fn};
    pg8::gemm_phase<Epi8<Fn>, Order, true, true>((PG8_LAS unsigned char*)lds, g, S, E);
    __syncthreads();
}
template <int N, int K, class Epi> DI void run_gemm_epi(unsigned char* lds, const bf16_t* A, const bf16_t* Bt, int lat, const Epi& E) {
    pg8::Gemm g{A, Bt, lat ? NB * SEQ : TALL, N, K}; Order S; S.init(lat, N);
    pg8::gemm_phase<Epi, Order, true, true>((PG8_LAS unsigned char*)lds, g, S, E);
    __syncthreads();
}
namespace att {
constexpr int NW = 8, QBLK = 32, KVBLK = 64;
constexpr float SCALE = 0.10206207261596577f, THR = 8.f;
constexpr int LDQ = 768, LDKK = 768, LDV = 512, LDO = 1024;
constexpr int SHM_V = KVBLK * 64 * 2, SHM_K = KVBLK * 256, SHM_ATTN = 2 * SHM_V + 2 * SHM_K + NW * 64 * 4;
#define KSWZ(row, colB) ((row) * 256 + ((colB) ^ (((row) & 7) << 4)))
#define SBAR() __builtin_amdgcn_sched_barrier(0)
DI int crow(int r, int hi) { return (r & 3) + 8 * (r >> 2) + 4 * hi; }
DI unsigned cvtpk_(float lo, float hi) { unsigned r; asm volatile("v_cvt_pk_bf16_f32 %0, %1, %2" : "=v"(r) : "v"(lo), "v"(hi)); return r; }
DI void partialSM(f32x16& p0, f32x16& p1, float& m_reg, float& mn, float& alpha) {
  constexpr float C = SCALE * 1.4426950408889634f;
  float pmax = p0[0];
#pragma unroll
  for (int r = 1; r < 16; ++r) pmax = fmaxf(pmax, p0[r]);
#pragma unroll
  for (int r = 0; r < 16; ++r) pmax = fmaxf(pmax, p1[r]);
  { auto rr = __builtin_amdgcn_permlane32_swap(__float_as_uint(pmax), __float_as_uint(pmax), false, false);
    pmax = fmaxf(__uint_as_float(rr[0]), __uint_as_float(rr[1])); }
  if (__builtin_expect(__all(pmax - m_reg <= THR / SCALE), 1)) { mn = m_reg; alpha = 1.f; }
  else { mn = fmaxf(m_reg, pmax); alpha = __builtin_amdgcn_exp2f((m_reg - mn) * C); m_reg = mn; }
  const float mnC = -mn * C;
#pragma unroll
  for (int r = 0; r < 16; ++r) p0[r] = fmaf(p0[r], C, mnC);
#pragma unroll
  for (int r = 0; r < 16; ++r) p1[r] = fmaf(p1[r], C, mnC);
#pragma unroll
  for (int r = 0; r < 16; ++r) p0[r] = __builtin_amdgcn_exp2f(p0[r]);
}
DI void finishSM(f32x16& p0, f32x16& p1, float alpha, float& l_reg, bf16x8& pa0, bf16x8& pa1, bf16x8& pa2, bf16x8& pa3) {
#pragma unroll
  for (int r = 0; r < 16; ++r) p1[r] = __builtin_amdgcn_exp2f(p1[r]);
  float ps = 0;
#pragma unroll
  for (int r = 0; r < 16; ++r) ps += p0[r];
#pragma unroll
  for (int r = 0; r < 16; ++r) ps += p1[r];
  { auto rr = __builtin_amdgcn_permlane32_swap(__float_as_uint(ps), __float_as_uint(ps), false, false);
    ps = __uint_as_float(rr[0]) + __uint_as_float(rr[1]); }
  l_reg = l_reg * alpha + ps;
#define PK4(P, BASE, OUT) do { unsigned a0 = cvtpk_(P[BASE + 0], P[BASE + 1]), a1 = cvtpk_(P[BASE + 2], P[BASE + 3]);   \
    unsigned b0 = cvtpk_(P[BASE + 4], P[BASE + 5]), b1 = cvtpk_(P[BASE + 6], P[BASE + 7]);                              \
    auto r0 = __builtin_amdgcn_permlane32_swap(a0, b0, false, false); auto r1 = __builtin_amdgcn_permlane32_swap(a1, b1, false, false); \
    u32x4 w = {r0[0], r1[0], r0[1], r1[1]}; OUT = *reinterpret_cast<bf16x8*>(&w); } while (0)
  PK4(p0, 0, pa0); PK4(p0, 8, pa1); PK4(p1, 0, pa2); PK4(p1, 8, pa3);
#undef PK4
}
DI void qkt(f32x16& p0, f32x16& p1, const char* Ks, const bf16x8* qr, int r32, int hi) {
  p0 = f32x16{}; p1 = f32x16{};
#pragma unroll
  for (int d0 = 0; d0 < 6; ++d0) { const int cb = (d0 * 16 + hi * 8) * 2;
    bf16x8 b0 = *reinterpret_cast<const bf16x8*>(Ks + KSWZ(r32, cb));
    bf16x8 b1 = *reinterpret_cast<const bf16x8*>(Ks + KSWZ(32 + r32, cb));
    p0 = __builtin_amdgcn_mfma_f32_32x32x16_bf16(b0, qr[d0], p0, 0, 0, 0);
    p1 = __builtin_amdgcn_mfma_f32_32x32x16_bf16(b1, qr[d0], p1, 0, 0, 0); }
}
DI int v_st(int k, int c) { const int kk = (k & ~0xC) | ((k & 4) << 1) | ((k & 8) >> 1); return ((kk >> 3) * 2 + (c >> 5)) * 512 + ((kk & 7) * 32 + (c & 31)) * 2; }
DI int v_rd_base(int lane) { return ((lane & 3) << 3) | (((lane >> 2) & 3) << 6) | (((lane >> 4) & 1) << 5) | (((lane >> 5) & 1) << 8); }
constexpr int v_rd_off(int d0, int ks, int half) { return d0 * 512 + ks * 2048 + half * 1024; }
template <int OFF> DI s16x4 tr_read(int vb) {
  s16x4 r; asm volatile("ds_read_b64_tr_b16 %0, %1 offset:%2" : "=&v"(r) : "v"(vb), "i"(OFF) : "memory"); return r;
}
template <int D0> DI void pv_one(f32x16& od, int vb, bf16x8 pa0, bf16x8 pa1, bf16x8 pa2, bf16x8 pa3) {
  const s16x4 l0 = tr_read<v_rd_off(D0, 0, 0)>(vb), h0 = tr_read<v_rd_off(D0, 0, 1)>(vb), l1 = tr_read<v_rd_off(D0, 1, 0)>(vb), h1 = tr_read<v_rd_off(D0, 1, 1)>(vb);
  const s16x4 l2 = tr_read<v_rd_off(D0, 2, 0)>(vb), h2 = tr_read<v_rd_off(D0, 2, 1)>(vb), l3 = tr_read<v_rd_off(D0, 3, 0)>(vb), h3 = tr_read<v_rd_off(D0, 3, 1)>(vb);
  asm volatile("s_waitcnt lgkmcnt(0)" ::: "memory"); SBAR();
#define PK(L, H) (bf16x8){L[0], L[1], L[2], L[3], H[0], H[1], H[2], H[3]}
  od = __builtin_amdgcn_mfma_f32_32x32x16_bf16(pa0, PK(l0, h0), od, 0, 0, 0);
  od = __builtin_amdgcn_mfma_f32_32x32x16_bf16(pa1, PK(l1, h1), od, 0, 0, 0);
  od = __builtin_amdgcn_mfma_f32_32x32x16_bf16(pa2, PK(l2, h2), od, 0, 0, 0);
  od = __builtin_amdgcn_mfma_f32_32x32x16_bf16(pa3, PK(l3, h3), od, 0, 0, 0);
#undef PK
}
DI void pv_d0(f32x16* o, int vb, bf16x8 pa0, bf16x8 pa1, bf16x8 pa2, bf16x8 pa3) {
  pv_one<0>(o[0], vb, pa0, pa1, pa2, pa3); pv_one<1>(o[1], vb, pa0, pa1, pa2, pa3);
}
DI void attn_body(const bf16_t* __restrict__ Qb, const bf16_t* __restrict__ Kh, const bf16_t* __restrict__ Vh, bf16_t* __restrict__ Ob, int seq, char* lds) {
  const int tid = ltid(), wid = tid >> 6, lane = tid & 63, r32 = lane & 31, hi = lane >> 5;
  char* V_lds = lds; char* K_lds = lds + 2 * SHM_V;
  float* ws = (float*)(lds + 2 * SHM_V + 2 * SHM_K) + wid * 64; float* li_l = ws; float* al_l = ws + 32;
  float m_reg = -1e30f, l_reg = 0; f32x16 o[2] = {}; bf16x8 qr[6];
  const bf16_t* Qw = Qb + (long)(wid * QBLK + r32) * LDQ + hi * 8;
#pragma unroll
  for (int d0 = 0; d0 < 6; ++d0) qr[d0] = *reinterpret_cast<const bf16x8*>(Qw + d0 * 16);
  const int kc2 = 512 + (tid & 255);
  const int kr1 = tid / 12, kch1 = tid - kr1 * 12, kr2 = kc2 / 12, kch2 = kc2 - kr2 * 12, vr = tid >> 3, vch = tid & 7;
  const int vst = v_st(vr, vch * 8), kst1 = KSWZ(kr1, kch1 * 16), kst2 = KSWZ(kr2, kch2 * 16);
  const int vb0 = (int)(uintptr_t)V_lds + v_rd_base(lane);
  struct { bf16x8 v, k1, k2; } sr_[2];
#define SLOAD(i, k0) do { sr_[i].v = *reinterpret_cast<const bf16x8*>(&Vh[(long)((k0) + vr) * LDV + vch * 8]); \
    sr_[i].k1 = *reinterpret_cast<const bf16x8*>(&Kh[(long)((k0) + kr1) * LDKK + kch1 * 8]); sr_[i].k2 = *reinterpret_cast<const bf16x8*>(&Kh[(long)((k0) + kr2) * LDKK + kch2 * 8]); } while (0)
#define SWRITE(b, i) do { *(bf16x8*)(V_lds + (b) * SHM_V + vst) = sr_[i].v; *(bf16x8*)(K_lds + (b) * SHM_K + kst1) = sr_[i].k1; *(bf16x8*)(K_lds + (b) * SHM_K + kst2) = sr_[i].k2; } while (0)
#define RESC(a) do { if (__any((a) < 1.f)) { if (hi == 0) al_l[r32] = (a); asm volatile("s_waitcnt lgkmcnt(0)" ::: "memory"); \
    _Pragma("unroll") for (int d = 0; d < 2; ++d) _Pragma("unroll") for (int r = 0; r < 16; ++r) o[d][r] *= al_l[crow(r, hi)]; } } while (0)
  f32x16 pA0, pA1, pB0, pB1; float mnA, mnB, alA, alB; bf16x8 pa0, pa1, pa2, pa3; const int NT = seq / KVBLK;
  constexpr int SE = 0, SO = 1;
  SLOAD(SE, 0); asm volatile("s_waitcnt vmcnt(0)" ::: "memory"); SWRITE(0, SE); __syncthreads();
  qkt(pA0, pA1, K_lds, qr, r32, hi); partialSM(pA0, pA1, m_reg, mnA, alA);
  SLOAD(SO, KVBLK); if (2 < NT) SLOAD(SE, 2 * KVBLK);
  SWRITE(1, SO); __syncthreads();
  for (int j = 1; j + 1 < NT; j += 2) {
    SBAR(); qkt(pB0, pB1, K_lds + SHM_K, qr, r32, hi);
    finishSM(pA0, pA1, alA, l_reg, pa0, pa1, pa2, pa3); SBAR();
    SLOAD(SO, (j + 2) * KVBLK); SBAR();
    pv_d0(o, vb0, pa0, pa1, pa2, pa3); partialSM(pB0, pB1, m_reg, mnB, alB);
    __syncthreads(); SWRITE(0, SE);
    RESC(alB); __syncthreads();
    SBAR(); qkt(pA0, pA1, K_lds, qr, r32, hi);
    finishSM(pB0, pB1, alB, l_reg, pa0, pa1, pa2, pa3); SBAR();
    if (j + 3 < NT) SLOAD(SE, (j + 3) * KVBLK); SBAR();
    pv_d0(o, vb0 + SHM_V, pa0, pa1, pa2, pa3); partialSM(pA0, pA1, m_reg, mnA, alA);
    __syncthreads(); SWRITE(1, SO);
    RESC(alA); __syncthreads();
  }
  SBAR(); qkt(pB0, pB1, K_lds + SHM_K, qr, r32, hi);
  finishSM(pA0, pA1, alA, l_reg, pa0, pa1, pa2, pa3); SBAR();
  pv_d0(o, vb0, pa0, pa1, pa2, pa3); partialSM(pB0, pB1, m_reg, mnB, alB);
  __syncthreads(); RESC(alB);
  finishSM(pB0, pB1, alB, l_reg, pa0, pa1, pa2, pa3); SBAR();
  pv_d0(o, vb0 + SHM_V, pa0, pa1, pa2, pa3);
  if (hi == 0) li_l[r32] = l_reg; asm volatile("s_waitcnt lgkmcnt(0)" ::: "memory");
  float rli[16];
#pragma unroll
  for (int r = 0; r < 16; ++r) rli[r] = __builtin_amdgcn_rcpf(li_l[crow(r, hi)]);
  bf16_t* Ow = Ob + (long)(wid * QBLK) * LDO;
#pragma unroll
  for (int r = 0; r < 16; ++r) { const int orow = crow(r, hi);
#pragma unroll
    for (int d0 = 0; d0 < 2; ++d0) Ow[(long)orow * LDO + d0 * 32 + r32] = f2bf(o[d0][r] * rli[r]); }
#undef SLOAD
#undef SWRITE
#undef RESC
}
}

DI void phase_attn(const bf16_t* Q, const bf16_t* KA, const bf16_t* VA, bf16_t* MIX, bool last, char* lds) {
    const int c = blockIdx.x, G = gridDim.x, NU = 2048 + (last ? 0 : 256);
    for (int L = c; L < NU; L += G) {
        int bh, seq; long qrow0;
        if (L < 2048) { int qb;
            if (G == 256) { const int i = L >> 8, cc = L & 255, xcd = cc & 7, slot = cc >> 3; bh = i * 32 + xcd * 4 + (slot >> 3); qb = slot & 7; }
            else { bh = L >> 3; qb = L & 7; }
            qrow0 = (long)(bh >> 3) * TT + TC + qb * 256; seq = TT; }
        else { bh = L - 2048; qrow0 = (long)(bh >> 3) * TT; seq = TC; }
        const int b = bh >> 3, h = bh & 7;
        att::attn_body(Q + qrow0 * 768 + h * 96, KA + (long)b * TT * 768 + h * 96, VA + (long)b * TT * 512 + h * 64, MIX + qrow0 * 1024 + h * 64, seq, lds);
        __syncthreads();
    }
}

DI float rowsum16(float x) {
    x += __int_as_float(__builtin_amdgcn_update_dpp(0, __float_as_int(x), 0x128, 0xf, 0xf, false));
    x += __int_as_float(__builtin_amdgcn_update_dpp(0, __float_as_int(x), 0x124, 0xf, 0xf, false));
    x += __int_as_float(__builtin_amdgcn_update_dpp(0, __float_as_int(x), 0x122, 0xf, 0xf, false));
    x += __int_as_float(__builtin_amdgcn_update_dpp(0, __float_as_int(x), 0x121, 0xf, 0xf, false));
    return x;
}
#define RS8_STEP(R) "v_add_f32_dpp %0, %0, %0 " R " row_mask:0xf bank_mask:0xf\n\tv_add_f32_dpp %1, %1, %1 " R " row_mask:0xf bank_mask:0xf\n\t" \
                    "v_add_f32_dpp %2, %2, %2 " R " row_mask:0xf bank_mask:0xf\n\tv_add_f32_dpp %3, %3, %3 " R " row_mask:0xf bank_mask:0xf\n\t" \
                    "v_add_f32_dpp %4, %4, %4 " R " row_mask:0xf bank_mask:0xf\n\tv_add_f32_dpp %5, %5, %5 " R " row_mask:0xf bank_mask:0xf\n\t" \
                    "v_add_f32_dpp %6, %6, %6 " R " row_mask:0xf bank_mask:0xf\n\tv_add_f32_dpp %7, %7, %7 " R " row_mask:0xf bank_mask:0xf\n\t"
DI void sum8x8(float& x0, float& x1, float& x2, float& x3, float& x4, float& x5, float& x6, float& x7) {
    asm volatile("s_nop 1\n\t" RS8_STEP("quad_perm:[1,0,3,2]") RS8_STEP("quad_perm:[2,3,0,1]") RS8_STEP("row_half_mirror")
                 : "+v"(x0), "+v"(x1), "+v"(x2), "+v"(x3), "+v"(x4), "+v"(x5), "+v"(x6), "+v"(x7));
}
typedef float f32x2 __attribute__((ext_vector_type(2)));
DI float dot8(const f32x2 (&s)[4], const f32x4& x0, const f32x4& x1) {
    f32x2 t = s[0] * (f32x2){x0[0], x0[1]};
    t = __builtin_elementwise_fma(s[1], (f32x2){x0[2], x0[3]}, t);
    t = __builtin_elementwise_fma(s[2], (f32x2){x1[0], x1[1]}, t);
    t = __builtin_elementwise_fma(s[3], (f32x2){x1[2], x1[3]}, t);
    return t.x + t.y;
}
DI int scan_row(int d, int b, int n) { const int tt = d == 0 ? n : (n < TC ? TC - 1 - n : TT + TC - 1 - n); return b * TT + tt; }
typedef __bf16 bf16x2n __attribute__((ext_vector_type(2)));
DI unsigned cvtpk_n(float lo, float hi) { f32x2 v = {lo, hi}; bf16x2n b = __builtin_convertvector(v, bf16x2n); return __builtin_bit_cast(unsigned, b); }
DI bf16x8 pack_acc(const f32x16& x, int s) {
    u32x4 w; w.x = cvtpk_n(x[8 * s], x[8 * s + 1]); w.y = cvtpk_n(x[8 * s + 2], x[8 * s + 3]); w.z = cvtpk_n(x[8 * s + 4], x[8 * s + 5]); w.w = cvtpk_n(x[8 * s + 6], x[8 * s + 7]);
    return __builtin_bit_cast(bf16x8, w);
}
constexpr int SREC = 264;
struct ScanStep { bf16x8 f[4]; float b0, k0, b1, k1, v; f32x4 brp, krp; };
DI void scan_ld(ScanStep& t, const float* rec, const char* zimg, int fragoff, bool isaq, int h, int m, int vrow) {
    const char* fp = isaq ? (const char*)(rec + fragoff) + h * 16 : zimg + h * 16;
#pragma unroll
    for (int q = 0; q < 4; ++q) t.f[q] = *(const bf16x8*)(fp + q * 32);
    t.b0 = rec[64 + m]; t.k0 = rec[128 + m]; t.b1 = rec[96 + m]; t.k1 = rec[160 + m]; t.v = rec[192 + vrow]; t.brp = *(const f32x4*)(rec + 256); t.krp = *(const f32x4*)(rec + 260);
}
DI void phase_scan(const bf16_t* R, const bf16_t* Kk, const bf16_t* V, const __half* DEC, const bf16_t* AA, const float* INV, const float* kkp, const float* kap,
                   bf16_t* MIX, bf16_t* YB, char* lds) {
    const int tid = ltid(); const bool consumer = tid < 256;
    float* bufA = (float*)lds; float* ybufA = (float*)(lds + 98304); char* zimg = lds + 114688;
    if (tid < 32) ((float*)zimg)[tid] = 0.f;
    constexpr int NCH = TT / 16;
    for (int s0 = blockIdx.x * 2; s0 < 512; s0 += gridDim.x * 2) {
        const int p_ = tid & 255, pst = p_ & 15, pj0 = (p_ >> 4) * 4, pw = p_ >> 6;
        const int cw = tid >> 6, cgrp = (cw >> 1) & 1, ws_ = cw & 1, lane = tid & 63, m = lane & 31, h = lane >> 5, vrow = ws_ * 32 + m;
        const bool isaq = (m & ~5) == 0;
        const int fragoff = (m & 1) ? 32 : 0;
        f32x16 acc0, acc1, zero16;
#pragma unroll
        for (int r = 0; r < 16; ++r) { acc0[r] = 0.f; acc1[r] = 0.f; zero16[r] = 0.f; }
        const int jl_ = pj0 & 31, rem_ = jl_ & 15, imgoff = ((((pj0 >> 5) * 2 + (jl_ >> 4)) * 2 + ((rem_ >> 2) & 1)) * 16 + ((rem_ >> 3) << 2) * 2) >> 2;
        u32x2 lr[2], lk[2], lv[2], la[2], ld0[2]; float linv[2];
#define PLOAD(c) do { _Pragma("unroll") for (int gq = 0; gq < 2; ++gq) { \
            const int sid = s0 + gq, d = sid >> 8, b = (sid >> 3) & 31, hh = sid & 7, hc = hh * 64 + pj0; \
            const size_t m_ = (size_t)scan_row(d, b, (c) * 16 + pst); \
            lr[gq] = *(const u32x2*)(R + m_ * 512 + hc); lk[gq] = *(const u32x2*)(Kk + m_ * 512 + hc); lv[gq] = *(const u32x2*)(V + m_ * 512 + hc); \
            la[gq] = *(const u32x2*)(AA + m_ * 1024 + d * 512 + hc); linv[gq] = INV[m_ * 8 + hh]; ld0[gq] = *(const u32x2*)(DEC + m_ * 1024 + d * 512 + hc); } } while (0)
#define PFX(L, e) do { L = (e); \
            L += __int_as_float(__builtin_amdgcn_update_dpp(0, __float_as_int(L), 0x111, 0xf, 0xf, true)); L += __int_as_float(__builtin_amdgcn_update_dpp(0, __float_as_int(L), 0x112, 0xf, 0xf, true)); \
            L += __int_as_float(__builtin_amdgcn_update_dpp(0, __float_as_int(L), 0x114, 0xf, 0xf, true)); L += __int_as_float(__builtin_amdgcn_update_dpp(0, __float_as_int(L), 0x118, 0xf, 0xf, true)); } while (0)
#define WSUM4(x) do { x += __shfl_xor(x, 16, 64); const auto sw_ = __builtin_amdgcn_permlane32_swap(__float_as_uint(x), __float_as_uint(x), false, false); x = __uint_as_float(sw_[0]) + __uint_as_float(sw_[1]); } while (0)
#define PWRITE(bsel) do { _Pragma("unroll") for (int gq = 0; gq < 2; ++gq) { \
            const int sid = s0 + gq, hh = sid & 7, hc = hh * 64 + pj0; \
            const float l0 = h2f(ld0[gq].x & 0xffffu), l1 = h2f(ld0[gq].x >> 16), l2 = h2f(ld0[gq].y & 0xffffu), l3 = h2f(ld0[gq].y >> 16); \
            float L0, L1, L2, L3; PFX(L0, l0); PFX(L1, l1); PFX(L2, l2); PFX(L3, l3); \
            const f32x4 kk4 = *(const f32x4*)(kkp + hc), ka4 = *(const f32x4*)(kap + hc); \
            float* rec_ = bufA + gq * 12288 + (bsel) * 6144 + pst * SREC; \
            const float k0 = bflo(lk[gq].x), k1 = bfhi(lk[gq].x), k2 = bflo(lk[gq].y), k3 = bfhi(lk[gq].y), a0 = bflo(la[gq].x), a1 = bfhi(la[gq].x), a2 = bflo(la[gq].y), a3 = bfhi(la[gq].y); \
            const float q0 = k0 * kk4[0] * linv[gq], q1 = k1 * kk4[1] * linv[gq], q2 = k2 * kk4[2] * linv[gq], q3 = k3 * kk4[3] * linv[gq]; \
            const float W0 = __builtin_amdgcn_exp2f(L0), W1 = __builtin_amdgcn_exp2f(L1), W2 = __builtin_amdgcn_exp2f(L2), W3 = __builtin_amdgcn_exp2f(L3); \
            const float P0 = __builtin_amdgcn_exp2f(L0 - l0), P1 = __builtin_amdgcn_exp2f(L1 - l1), P2 = __builtin_amdgcn_exp2f(L2 - l2), P3 = __builtin_amdgcn_exp2f(L3 - l3); \
            const float I0 = __builtin_amdgcn_exp2f(-L0), I1 = __builtin_amdgcn_exp2f(-L1), I2 = __builtin_amdgcn_exp2f(-L2), I3 = __builtin_amdgcn_exp2f(-L3); \
            const float r0 = bflo(lr[gq].x), r1 = bfhi(lr[gq].x), r2 = bflo(lr[gq].y), r3 = bfhi(lr[gq].y); \
            const float b0 = q0 * a0, b1 = q1 * a1, b2 = q2 * a2, b3 = q3 * a3; \
            const float d0 = k0 * (1.f + (a0 - 1.f) * ka4[0]), d1 = k1 * (1.f + (a1 - 1.f) * ka4[1]), d2 = k2 * (1.f + (a2 - 1.f) * ka4[2]), d3 = k3 * (1.f + (a3 - 1.f) * ka4[3]); \
            { u32x2 w_; w_.x = cvtpk_n(-q0 * P0, -q1 * P1); w_.y = cvtpk_n(-q2 * P2, -q3 * P3); *(u32x2*)(rec_ + imgoff) = w_; } \
            { u32x2 w_; w_.x = cvtpk_n(r0 * W0, r1 * W1); w_.y = cvtpk_n(r2 * W2, r3 * W3); *(u32x2*)(rec_ + 32 + imgoff) = w_; } \
            *(f32x4*)(rec_ + 64 + pj0) = (f32x4){b0 * I0, b1 * I1, b2 * I2, b3 * I3}; \
            *(f32x4*)(rec_ + 128 + pj0) = (f32x4){d0 * I0, d1 * I1, d2 * I2, d3 * I3}; \
            *(f32x4*)(rec_ + 192 + pj0) = (f32x4){bflo(lv[gq].x), bfhi(lv[gq].x), bflo(lv[gq].y), bfhi(lv[gq].y)}; \
            float br_ = b0 * r0 + b1 * r1 + b2 * r2 + b3 * r3, kr_ = d0 * r0 + d1 * r1 + d2 * r2 + d3 * r3; WSUM4(br_); WSUM4(kr_); \
            if ((p_ & 48) == 0) { rec_[256 + pw] = br_; rec_[260 + pw] = kr_; } \
            if (pst == 15) *(f32x4*)(bufA + gq * 12288 + (bsel) * 6144 + 16 * SREC + pj0) = (f32x4){W0, W1, W2, W3}; } } while (0)
#define LBAR() asm volatile("s_waitcnt lgkmcnt(0)\n\ts_barrier" ::: "memory")
#define OUTPUT(c, bsel) do { _Pragma("unroll") for (int gq = 0; gq < 2; ++gq) { \
            const int sid = s0 + gq, d = sid >> 8, b = (sid >> 3) & 31, hh = sid & 7, hc = hh * 64 + pj0; \
            const f32x4 yv = *(const f32x4*)(ybufA + gq * 2048 + (bsel) * 1024 + pst * 64 + pj0); const size_t m_ = (size_t)scan_row(d, b, (c) * 16 + pst); \
            u32x2 w; w.x = cvtpk(yv[0], yv[1]); w.y = cvtpk(yv[2], yv[3]); \
            if (d == 0) *(u32x2*)(MIX + m_ * 1024 + 512 + hc) = w; else *(u32x2*)(YB + m_ * 512 + hc) = w; } } while (0)
        if (!consumer) { PLOAD(0); PWRITE(0); PLOAD(1); }
        LBAR();
        if (consumer) __builtin_amdgcn_s_setprio(3);
        for (int c = 0; c < NCH; ++c) {
            if (consumer) {
                const float* cur = bufA + cgrp * 12288 + (c & 1) * 6144; float* yb = ybufA + cgrp * 2048 + (c & 1) * 1024;
                ScanStep t; scan_ld(t, cur, zimg, fragoff, isaq, h, m, vrow);
#pragma unroll 2
                for (int st = 0; st < 16; ++st) {
                    f32x16 d0 = __builtin_amdgcn_mfma_f32_32x32x16_bf16(t.f[0], pack_acc(acc0, 0), zero16, 0, 0, 0);
                    f32x16 d1 = __builtin_amdgcn_mfma_f32_32x32x16_bf16(t.f[2], pack_acc(acc1, 0), zero16, 0, 0, 0);
                    d0 = __builtin_amdgcn_mfma_f32_32x32x16_bf16(t.f[1], pack_acc(acc0, 1), d0, 0, 0, 0);
                    d1 = __builtin_amdgcn_mfma_f32_32x32x16_bf16(t.f[3], pack_acc(acc1, 1), d1, 0, 0, 0);
                    __builtin_amdgcn_sched_barrier(0);
                    ScanStep n; scan_ld(n, cur + (st + 1) * SREC, zimg, fragoff, isaq, h, m, vrow);
                    __builtin_amdgcn_sched_barrier(0);
                    const float sa = d0[0] + d1[0], z = d0[1] + d1[1];
                    yb[st * 64 + vrow] = z + sa * ((t.brp[0] + t.brp[1]) + (t.brp[2] + t.brp[3])) + t.v * ((t.krp[0] + t.krp[1]) + (t.krp[2] + t.krp[3]));
                    const unsigned hz = h ? 0u : 0xffffffffu;
                    const u32x4 ua0 = {cvtpk_n(t.b0, t.k0) & hz, 0u, 0u, 0u}, ua1 = {cvtpk_n(t.b1, t.k1) & hz, 0u, 0u, 0u}, ub = {cvtpk_n(sa, t.v) & hz, 0u, 0u, 0u};
                    acc0 = __builtin_amdgcn_mfma_f32_32x32x16_bf16(__builtin_bit_cast(bf16x8, ua0), __builtin_bit_cast(bf16x8, ub), acc0, 0, 0, 0);
                    acc1 = __builtin_amdgcn_mfma_f32_32x32x16_bf16(__builtin_bit_cast(bf16x8, ua1), __builtin_bit_cast(bf16x8, ub), acc1, 0, 0, 0);
                    t = n;
                }
                const float* wc = cur + 16 * SREC;
#pragma unroll
                for (int g_ = 0; g_ < 4; ++g_) { const f32x4 w0 = *(const f32x4*)(wc + 8 * g_ + 4 * h), w1 = *(const f32x4*)(wc + 32 + 8 * g_ + 4 * h);
#pragma unroll
                    for (int e = 0; e < 4; ++e) { acc0[4 * g_ + e] *= w0[e]; acc1[4 * g_ + e] *= w1[e]; } }
            } else {
                if (c + 1 < NCH) PWRITE((c + 1) & 1);
                if (c + 2 < NCH) PLOAD(c + 2);
                if (c > 0) OUTPUT(c - 1, (c - 1) & 1);
            }
            LBAR();
        }
        __builtin_amdgcn_s_setprio(0);
        if (!consumer) OUTPUT(NCH - 1, (NCH - 1) & 1);
        __syncthreads();
#undef LBAR
#undef PLOAD
#undef PWRITE
#undef PFX
#undef WSUM4
#undef OUTPUT
    }
}

DI void phase_prologue(const Args& a, unsigned char* lds) {
    const int tid = ltid(), G = gridDim.x;
    float* out = a.out; float* xc = (float*)(a.ws + WS_XC);
    if (blockIdx.x == 0) {
        float* rope = (float*)(a.ws + WS_ROPE); const int pos = tid >> 3, j = tid & 7;
        const float inv_freq = powf(10000.f, -(float)j / 8.f), ang = (float)pos * inv_freq;
        rope[tid] = cosf(ang); rope[512 + tid] = sinf(ang);
    }
    float* sv = (float*)lds; float* red = sv + 33 * 1024;
    for (int i = tid; i < 33 * 1024; i += 512) { const float v = i < 32 * 1024 ? a.in[I_C][i] : a.in[I_CCTX][i - 32 * 1024]; sv[i] = v / (1.f + __expf(-v)); }
    __syncthreads();
    const int wave = tid >> 6, lane = tid & 63;
    float* mods = (float*)(a.ws + WS_MODS);
    for (int it = blockIdx.x; it < NL * 96; it += G) {
        const int l = it / 96, n0 = (it - l * 96) * 64;
        const float* w = a.in[I_ADAW] + (size_t)l * 1024 * 6144 + n0 + lane;
        float acc[33];
#pragma unroll
        for (int r = 0; r < 33; ++r) acc[r] = 0.f;
        for (int k = wave * 128; k < wave * 128 + 128; k += 8) { float wv[8];
#pragma unroll
            for (int u = 0; u < 8; ++u) wv[u] = w[(size_t)(k + u) * 6144];
#pragma unroll
            for (int u = 0; u < 8; ++u)
#pragma unroll
                for (int r = 0; r < 33; ++r) acc[r] += sv[r * 1024 + k + u] * wv[u]; }
        for (int i = tid; i < 33 * 64; i += 512) red[i] = 0.f;
        __syncthreads();
        for (int ww = 0; ww < 8; ++ww) { if (wave == ww) {
#pragma unroll
                for (int r = 0; r < 33; ++r) red[r * 64 + lane] += acc[r]; }
            __syncthreads(); }
        for (int i = tid; i < 33 * 64; i += 512) { const int r = i >> 6, n = n0 + (i & 63); mods[((size_t)l * 33 + r) * 6144 + n] = red[i] + a.in[I_ADAB][l * 6144 + n]; }
        __syncthreads();
    }
}

DI void phase_vectors(const Args& a, unsigned char* lds) {
    const int tid = ltid(), G = gridDim.x, wave = tid >> 6, lane = tid & 63;
    const float* mods = (const float*)(a.ws + WS_MODS);
    float* gp1 = (float*)(a.ws + WS_GP1); float* gp2 = (float*)(a.ws + WS_GP2);
    for (int i = blockIdx.x * 512 + tid; i < NL * 33 * 1024; i += G * 512) { const int c = i & 1023, lr = i >> 10, l = lr / 33;
        gp1[i] = a.in[I_N1G][l * 1024 + c] * (1.f + mods[(size_t)lr * 6144 + 1024 + c]); gp2[i] = a.in[I_N2G][l * 1024 + c] * (1.f + mods[(size_t)lr * 6144 + 4 * 1024 + c]); }
    float* sv = (float*)lds; float* red = sv + 33 * 1024;
    for (int it = blockIdx.x; it < NL * 101; it += G) {
        const int l = it / 101, ci = it - l * 101, which = ci < 37 ? 0 : 1, n0 = (which ? ci - 37 : ci) * 64, n = n0 + lane;
        __syncthreads();
        for (int i = tid; i < 33 * 1024; i += 512) sv[i] = mods[((size_t)l * 33 + (i >> 10)) * 6144 + (which ? 3 * 1024 : 0) + (i & 1023)];
        for (int i = tid; i < 33 * 64; i += 512) red[i] = 0.f;
        __syncthreads();
        const float* w; int ld; float live = 1.f;
        if (which) { w = a.in[I_M1] + (size_t)l * 1024 * 4096 + n; ld = 4096; }
        else if (n < CIN) { w = a.in[I_WIN] + (size_t)l * 1024 * CIN + n; ld = CIN; }
        else if (n < CINX && l > 0) { w = a.in[I_V1] + (size_t)(l - 1) * 1024 * 32 + (n - CIN); ld = 32; }
        else { w = a.in[I_WIN]; ld = 0; live = 0.f; }
        float acc[33];
#pragma unroll
        for (int r = 0; r < 33; ++r) acc[r] = 0.f;
        for (int k = wave * 128; k < wave * 128 + 128; k += 8) { float wv[8];
#pragma unroll
            for (int u = 0; u < 8; ++u) wv[u] = w[(size_t)(k + u) * ld] * live;
#pragma unroll
            for (int u = 0; u < 8; ++u)
#pragma unroll
                for (int r = 0; r < 33; ++r) acc[r] += sv[r * 1024 + k + u] * wv[u]; }
        for (int ww = 0; ww < 8; ++ww) { if (wave == ww) {
#pragma unroll
                for (int r = 0; r < 33; ++r) red[r * 64 + lane] += acc[r]; }
            __syncthreads(); }
        float* outp = which ? (float*)(a.ws + WS_C2) + (size_t)l * 33 * DFF : (float*)(a.ws + WS_C1) + (size_t)l * 33 * NIN; const int ldo = which ? DFF : NIN;
        for (int i = tid; i < 33 * 64; i += 512) outp[(size_t)(i >> 6) * ldo + n0 + (i & 63)] = red[i];
    }
    {
        const int gw = blockIdx.x * 8 + wave, nw = G * 8; bf16_t* __restrict__ H = (bf16_t*)(a.ws + WS_H); float* __restrict__ rsa = (float*)(a.ws + WS_RSA); const float* __restrict__ gamma = a.in[I_N1G];
        for (int m = gw; m < TALL; m += nw) { const int b = m / TT, tt = m - b * TT; const bool ctx = tt < TC;
            const float* xr = ctx ? a.in[I_CTX] + (size_t)(b * TC + tt) * DM : a.in[I_X] + (size_t)(b * SEQ + tt - TC) * DM; const float* md = mods + (size_t)(ctx ? 32 : b) * 6144 + 1024;
            f32x4 v[4]; float ss = 0.f;
#pragma unroll
            for (int q = 0; q < 4; ++q) { v[q] = *(const f32x4*)(xr + q * 256 + lane * 4); ss += v[q][0] * v[q][0] + v[q][1] * v[q][1] + v[q][2] * v[q][2] + v[q][3] * v[q][3]; }
#pragma unroll
            for (int k = 1; k < 64; k <<= 1) ss = xorsum(ss, k);
            if (lane == 0) rsa[m] = ss;
#pragma unroll
            for (int q = 0; q < 4; ++q) { const int col = q * 256 + lane * 4; const f32x4 g = *(const f32x4*)(gamma + col), sc = *(const f32x4*)(md + col);
                u32x2 w; w.x = cvtpk(v[q][0] * g[0] * (1.f + sc[0]), v[q][1] * g[1] * (1.f + sc[1])); w.y = cvtpk(v[q][2] * g[2] * (1.f + sc[2]), v[q][3] * g[3] * (1.f + sc[3]));
                *(u32x2*)(H + (size_t)m * 1024 + col) = w; } }
    }
}

template <class Gt> DI void cvt_tile(bf16_t* __restrict__ dst, int ldk, int n0, int k0, const Gt& get, float*) {
    const int lane = ltid() & 63, n = n0 + lane;
#pragma unroll
    for (int ch = 0; ch < 4; ++ch) { float v[16];
#pragma unroll
        for (int kk = 0; kk < 16; ++kk) v[kk] = get(n, k0 + ch * 16 + kk);
        u32x4 w0, w1; w0.x = cvtpk(v[0], v[1]); w0.y = cvtpk(v[2], v[3]); w0.z = cvtpk(v[4], v[5]); w0.w = cvtpk(v[6], v[7]);
        w1.x = cvtpk(v[8], v[9]); w1.y = cvtpk(v[10], v[11]); w1.z = cvtpk(v[12], v[13]); w1.w = cvtpk(v[14], v[15]);
        bf16_t* p = dst + (size_t)n * ldk + k0 + ch * 16; *(u32x4*)p = w0; *(u32x4*)(p + 8) = w1; }
}
DI void convert_weights(const Args& a, int l, unsigned char* lds, int group) {
    float* tl = (float*)lds; unsigned char* ws = a.ws;
    const float* w_in = a.in[I_WIN] + (size_t)l * 1024 * CIN; const float* v1 = a.in[I_V1] + (size_t)(l > 0 ? l - 1 : 0) * 1024 * 32;
    const float* w_uq = a.in[I_WUQ] + (size_t)l * 256 * 768; const float* w_ukv = a.in[I_WUKV] + (size_t)l * 128 * 1024;
    const float* w2 = a.in[I_W2] + (size_t)l * 2 * 64 * 512; const float* a2 = a.in[I_A2] + (size_t)l * 2 * 64 * 512;
    const float* g2 = a.in[I_G2] + (size_t)l * 128 * 512; const float* v2 = a.in[I_V2] + (size_t)(l > 0 ? l - 1 : 0) * 32 * 512;
    const float* w_out = a.in[I_WOUT] + (size_t)l * 1024 * 1024; const float* m1 = a.in[I_M1] + (size_t)l * 1024 * 4096; const float* m2 = a.in[I_M2] + (size_t)l * 4096 * 1024;
    constexpr int T0 = 640, T1 = T0 + 48, T2 = T1 + 64, T3 = T2 + 128, T4 = T3 + 64, T5 = T4 + 256, T6 = T5 + 1024, T7 = T6 + 1024;
    const int tb = group == 0 ? 0 : T4, te = group == 0 ? T4 : T7;
    for (int t = tb + blockIdx.x * 8 + (ltid() >> 6); t < te; t += gridDim.x * 8) {
        if (t < T0) { const int nt = t >> 4, kt = t & 15;
            cvt_tile((bf16_t*)(ws + WT_IN), 1024, nt * 64, kt * 64, [&](int n, int k) -> float { return n < CIN ? w_in[(size_t)k * CIN + n] : ((n < CINX && l > 0) ? v1[k * 32 + (n - CIN)] : 0.f); }, tl); }
        else if (t < T1) { const int u = t - T0, nt = u >> 2, kt = u & 3;
            cvt_tile((bf16_t*)(ws + WT_UQ), 256, nt * 64, kt * 64, [&](int n, int k) -> float { return w_uq[k * 768 + n]; }, tl); }
        else if (t < T2) { const int u = t - T1, nt = u >> 2, kt = u & 3;
            if (kt < 2) cvt_tile((bf16_t*)(ws + WT_UKV), 128, nt * 64, kt * 64, [&](int n, int k) -> float { return w_ukv[k * 1024 + n]; }, tl); }
        else if (t < T3) { const int u = t - T2, nt = u >> 2, kt = u & 3;
            cvt_tile((bf16_t*)(ws + WT_L1), 256, nt * 64, kt * 64, [&](int n, int k) -> float {
                if (n < 1024) { const int d = n >> 9, c = n & 511; return (k < 128 && (k >> 6) == d) ? w2[(d * 64 + (k & 63)) * 512 + c] : 0.f; }
                const int n2 = n - 1024, d = n2 >> 9, c = n2 & 511; return (k >= 128 && ((k - 128) >> 6) == d) ? a2[(d * 64 + ((k - 128) & 63)) * 512 + c] : 0.f; }, tl); }
        else if (t < T4) { const int u = t - T3, nt = u >> 2, kt = u & 3;
            cvt_tile((bf16_t*)(ws + WT_L2), 256, nt * 64, kt * 64, [&](int n, int k) -> float {
                if (n < 512) return k < 128 ? g2[k * 512 + n] : 0.f;
                return (l > 0 && k >= 128 && k < 160) ? v2[(k - 128) * 512 + (n - 512)] : 0.f; }, tl); }
        else if (t < T5) { const int u = t - T4, nt = u >> 4, kt = u & 15;
            cvt_tile((bf16_t*)(ws + WT_OUT), 1024, nt * 64, kt * 64, [&](int n, int k) -> float { return w_out[(size_t)k * 1024 + n]; }, tl); }
        else if (t < T6) { const int u = t - T5, nt = u >> 4, kt = u & 15;
            cvt_tile((bf16_t*)(ws + WT_M1), 1024, nt * 64, kt * 64, [&](int n, int k) -> float { return m1[(size_t)k * 4096 + n]; }, tl); }
        else { const int u = t - T6, nt = u >> 6, kt = u & 63;
            cvt_tile((bf16_t*)(ws + WT_M2), 4096, nt * 64, kt * 64, [&](int n, int k) -> float { return m2[(size_t)k * 1024 + n]; }, tl); }
    }
}

DI void unpack8(const u32x4& w, float (&f)[8]) { f[0] = bflo(w.x); f[1] = bfhi(w.x); f[2] = bflo(w.y); f[3] = bfhi(w.y); f[4] = bflo(w.z); f[5] = bfhi(w.z); f[6] = bflo(w.w); f[7] = bfhi(w.w); }
DI void shift8r(const u32x4& c_, const u32x4& p_, const u32x4& n_, const float* __restrict__ mu, int col, float (&o)[8]) {
    float c[8], p[8], n[8], u[8]; unpack8(c_, c); unpack8(p_, p); unpack8(n_, n); loadf8(mu + (col - OFF_R), u);
#pragma unroll
    for (int j = 0; j < 8; ++j) o[j] = c[j] + u[j] * (0.5f * (p[j] + n[j]) - c[j]);
}
DI void phase_split(const Args& a, int l) {
    const int lane = ltid() & 63, gw = blockIdx.x * 8 + (ltid() >> 6), nw = gridDim.x * 8;
    unsigned char* ws = a.ws;
    const bf16_t* __restrict__ F = (const bf16_t*)(ws + WS_F); bf16_t* __restrict__ R = (bf16_t*)(ws + WS_R); bf16_t* __restrict__ Kb = (bf16_t*)(ws + WS_K); bf16_t* __restrict__ Vb = (bf16_t*)(ws + (l == 0 ? WS_VF : WS_V));
    bf16_t* __restrict__ A1 = (bf16_t*)(ws + WS_A1); bf16_t* __restrict__ A2 = (bf16_t*)(ws + WS_A2); bf16_t* __restrict__ CQN = (bf16_t*)(ws + WS_CQN); bf16_t* __restrict__ CKVN = (bf16_t*)(ws + WS_CKVN); bf16_t* __restrict__ KA = (bf16_t*)(ws + WS_KATT);
    float* __restrict__ INV = (float*)(ws + WS_INV); const float* __restrict__ rope = (const float*)(ws + WS_ROPE);
    const float* __restrict__ mu = a.in[I_MU] + (size_t)l * 1920; const float* __restrict__ kkp = a.in[I_KK] + l * 512; const float* __restrict__ qg = a.in[I_QNG] + l * 256; const float* __restrict__ kvg = a.in[I_KVNG] + l * 128;
    const u32x4 zero4 = {0u, 0u, 0u, 0u};
    const int lcol = lane < 48 ? OFF_WLO + lane * 8 : (lane < 52 ? OFF_HV + (lane - 48) * 8 : 0);
    const int mcol = lane < 32 ? lane * 8 : (lane < 48 ? 256 + (lane - 32) * 8 : 384 + ((lane - 48) & 3) * 8);
    const int chunk = (TALL + nw - 1) / nw, m0 = gw * chunk, m1 = (m0 + chunk < TALL) ? m0 + chunk : TALL;
    struct Raw { u32x4 r, k, v, l; };
    auto ld4 = [&](int m) -> Raw { Raw t; if (m >= 0 && m < TALL) { const bf16_t* Fq = F + (size_t)m * CINX; t.r = *(const u32x4*)(Fq + OFF_R + lane * 8); t.k = *(const u32x4*)(Fq + OFF_K + lane * 8);
            t.v = *(const u32x4*)(Fq + OFF_V + lane * 8); t.l = (lane < 52) ? *(const u32x4*)(Fq + lcol) : zero4; } else { t.r = zero4; t.k = zero4; t.v = zero4; t.l = zero4; } return t; };
    auto ldm = [&](int m) -> u32x4 { return (m < TALL) ? *(const u32x4*)(F + (size_t)m * CINX + mcol) : zero4; };
    Raw P = ld4(m0 - 1), C = ld4(m0), N = ld4(m0 + 1); u32x4 M = ldm(m0);
    for (int m = m0; m < m1; ++m) {
        const int b = m / TT, tt = m - b * TT; const bool ctx = tt < TC;
        const bool pok = !(tt == 0 || tt == TC), nok = !(tt == TC - 1 || tt == TT - 1);
        const Raw NN = ld4(m + 2); const u32x4 MN = ldm(m + 1);
        u32x4 rc = C.r, kc = C.k, vc = C.v, lc = C.l, rp = P.r, kp = P.k, vp = P.v, lp = P.l, rn = N.r, kn = N.k, vn = N.v, ln = N.l; const u32x4 mc = M;
        if (!pok) { rp = zero4; kp = zero4; vp = zero4; lp = zero4; }
        if (!nok) { rn = zero4; kn = zero4; vn = zero4; ln = zero4; }
        P = C; C = N; N = NN; M = MN;
        float x[8];
        shift8r(rc, rp, rn, mu, OFF_R + lane * 8, x); store8(R + (size_t)m * 512 + lane * 8, x);
        shift8r(kc, kp, kn, mu, OFF_K + lane * 8, x); store8(Kb + (size_t)m * 512 + lane * 8, x);
        { float kq[8], ss = 0.f; loadf8(kkp + lane * 8, kq);
#pragma unroll
          for (int j = 0; j < 8; ++j) { const float t = x[j] * kq[j]; ss += t * t; }
          ss = xorsum(ss, 1); ss = xorsum(ss, 2); ss = xorsum(ss, 4);
          if ((lane & 7) == 0) INV[(size_t)m * 8 + (lane >> 3)] = rsqrtf(fmaxf(ss, 1e-24f)); }
        shift8r(vc, vp, vn, mu, OFF_V + lane * 8, x); store8(Vb + (size_t)m * 512 + lane * 8, x);
        if (lane < 48) { shift8r(lc, lp, ln, mu, lcol, x);
            if (lane < 16) {
#pragma unroll
                for (int j = 0; j < 8; ++j) x[j] = tanhf_(x[j]); }
            else if (lane >= 32) {
#pragma unroll
                for (int j = 0; j < 8; ++j) x[j] = sigmoidf_(x[j]); }
            if (lane < 32) store8(A1 + (size_t)m * 256 + lane * 8, x); else store8(A2 + (size_t)m * 256 + (lane - 32) * 8, x); }
        else { unpack8(lc, x); store8(A2 + (size_t)m * 256 + 128 + (lane - 48) * 8, x); }
        { unpack8(mc, x); float ss = 0.f;
#pragma unroll
          for (int j = 0; j < 8; ++j) ss += x[j] * x[j];
          ss = xorsum(ss, 1); ss = xorsum(ss, 2); ss = xorsum(ss, 4); ss = xorsum(ss, 8); const float ss32 = xorsum(ss, 16);
          float px[8]; const int q = (lane - 48) & 3;
#pragma unroll
          for (int j = 0; j < 8; ++j) px[j] = __shfl_xor(x[j], 1, 64);
          if (lane < 32) { const float rstd = rsqrtf(ss32 * (1.f / 256.f) + 1e-6f); float g[8]; loadf8(qg + lane * 8, g);
#pragma unroll
              for (int j = 0; j < 8; ++j) x[j] = x[j] * rstd * g[j];
              store8(CQN + (size_t)m * 256 + lane * 8, x); }
          else if (lane < 48) { const float rstd = rsqrtf(ss * (1.f / 128.f) + 1e-6f); float g[8]; loadf8(kvg + (lane - 32) * 8, g);
#pragma unroll
              for (int j = 0; j < 8; ++j) x[j] = x[j] * rstd * g[j];
              store8(CKVN + (size_t)m * 128 + (lane - 32) * 8, x); }
          else { if (lane < 52) {
                  if (!ctx) { const int s = tt - TC, pos = (q < 2) ? (s >> 6) : (s & 63); float cs[8], sn[8]; loadf8(rope + pos * 8, cs); loadf8(rope + 512 + pos * 8, sn); const float sg = (q & 1) ? 1.f : -1.f;
#pragma unroll
                      for (int j = 0; j < 8; ++j) x[j] = x[j] * cs[j] + sg * px[j] * sn[j]; }
#pragma unroll
                  for (int hh = 0; hh < 8; ++hh) store8(KA + (size_t)m * 768 + hh * 96 + 64 + q * 8, x); }
          } }
    }
}

DI void phase_rwkv_out(const Args& a, int l, bool latent_only) {
    const int lane = ltid() & 63, gw = blockIdx.x * 8 + (ltid() >> 6), nw = gridDim.x * 8;
    unsigned char* ws = a.ws;
    const bf16_t* R = (const bf16_t*)(ws + WS_R); const bf16_t* Kb = (const bf16_t*)(ws + WS_K); const bf16_t* Vb = (const bf16_t*)(ws + (l == 0 ? WS_VF : WS_V));
    const bf16_t* AA = (const bf16_t*)(ws + WS_AA); const bf16_t* Gb = (const bf16_t*)(ws + WS_G); const bf16_t* YB = (const bf16_t*)(ws + WS_YB); bf16_t* MIX = (bf16_t*)(ws + WS_MIX);
    const int c = lane * 8; float ka[8], rk[8], lw[8], lb[8];
    loadf8(a.in[I_KA] + l * 512 + c, ka); loadf8(a.in[I_RK] + l * 512 + c, rk); loadf8(a.in[I_LNW] + l * 512 + c, lw); loadf8(a.in[I_LNB] + l * 512 + c, lb);
    for (int m = gw; m < TALL; m += nw) {
        const int tt = m % TT; if (latent_only && tt < TC) continue;
        float yf[8], yb[8], r[8], k[8], v[8], a0[8], a1[8], g[8];
        load8(MIX + (size_t)m * 1024 + 512 + c, yf); load8(YB + (size_t)m * 512 + c, yb); load8(R + (size_t)m * 512 + c, r); load8(Kb + (size_t)m * 512 + c, k); load8(Vb + (size_t)m * 512 + c, v);
        load8(AA + (size_t)m * 1024 + c, a0); load8(AA + (size_t)m * 1024 + 512 + c, a1); load8(Gb + (size_t)m * 512 + c, g);
        float s = 0.f, bon = 0.f;
#pragma unroll
        for (int j = 0; j < 8; ++j) { yf[j] += yb[j]; s += yf[j]; bon += r[j] * k[j] * (2.f + (a0[j] + a1[j] - 2.f) * ka[j]) * rk[j]; }
        s = xorsum(s, 1); s = xorsum(s, 2); s = xorsum(s, 4); bon = xorsum(bon, 1); bon = xorsum(bon, 2); bon = xorsum(bon, 4);
        const float mean = s * (1.f / 64.f); float vs = 0.f;
#pragma unroll
        for (int j = 0; j < 8; ++j) { yf[j] -= mean; vs += yf[j] * yf[j]; }
        vs = xorsum(vs, 1); vs = xorsum(vs, 2); vs = xorsum(vs, 4);
        const float rstd = rsqrtf(vs * (1.f / 64.f) + 64e-5f);
#pragma unroll
        for (int j = 0; j < 8; ++j) yf[j] = (yf[j] * rstd * lw[j] + lb[j] + bon * v[j]) * g[j];
        store8(MIX + (size_t)m * 1024 + 512 + c, yf);
    }
}

DI void phase_final(const Args& a) {
    const int lane = ltid() & 63, gw = blockIdx.x * 8 + (ltid() >> 6), nw = gridDim.x * 8; const float* gamma = a.in[I_FG];
    for (int m = gw; m < NB * SEQ; m += nw) {
        float* xr = a.out + (size_t)m * DM; f32x4 v[4]; float ss = 0.f;
#pragma unroll
        for (int i = 0; i < 4; ++i) { v[i] = *(const f32x4*)(xr + i * 256 + lane * 4); ss += v[i][0] * v[i][0] + v[i][1] * v[i][1] + v[i][2] * v[i][2] + v[i][3] * v[i][3]; }
#pragma unroll
        for (int k = 1; k < 64; k <<= 1) ss = xorsum(ss, k);
        const float rstd = rsqrtf(ss * (1.f / 1024.f) + 1e-6f);
#pragma unroll
        for (int i = 0; i < 4; ++i) { const int col = i * 256 + lane * 4; const f32x4 g = *(const f32x4*)(gamma + col); *(f32x4*)(xr + col) = v[i] * rstd * g; }
    }
}

#define LAS __attribute__((address_space(3)))
#define XB_TMO      128
#define XB_XCNT(j)  (256  + 64 * (j))
#define XB_XSUB(j)  (1280 + 64 * (j))
#define XB_XGEN(j)  (2304 + 64 * (j))
#define XB_TOP      3328
#define XB_TOPGEN   3392
#define XCD_BAR_WORDS 3456
#define XB_SPIN_CAP (1u << 18)

__device__ __forceinline__ unsigned xb_ld(unsigned* p)              { return __hip_atomic_load(p, __ATOMIC_RELAXED, __HIP_MEMORY_SCOPE_AGENT); }
__device__ __forceinline__ unsigned xb_add(unsigned* p, unsigned v) { return __hip_atomic_fetch_add(p, v, __ATOMIC_RELAXED, __HIP_MEMORY_SCOPE_AGENT); }
__device__ __forceinline__ unsigned xb_xcc_id() { return (unsigned)__builtin_amdgcn_s_getreg((3 << 11) | 20) & 0xFu; }
#define XB_SPIN(cond, bar) do { unsigned _sp = 0; while (cond) { __builtin_amdgcn_s_sleep(1); \
    if ((++_sp & 255u) == 0u) { if (xb_ld(&(bar)[XB_TMO])) break; if (_sp > XB_SPIN_CAP) { atomicAdd(&(bar)[XB_TMO], 1u); break; } } } } while (0)

struct XcdBarrier {
    unsigned* bar; unsigned x;
    volatile LAS unsigned* st;
};

__device__ __forceinline__ XcdBarrier xcd_barrier_post(unsigned* bar, volatile LAS unsigned* st) {
    XcdBarrier b; b.bar = bar; b.x = xb_xcc_id(); b.st = st;
    if (threadIdx.x == 0) (void)xb_add(&bar[XB_XCNT(b.x)], 1u);
    return b;
}
__device__ __forceinline__ void xcd_barrier_complete(unsigned* bar, unsigned x, unsigned& nloc, unsigned& nx) {
    const unsigned G = gridDim.x * gridDim.y * gridDim.z;
    unsigned sum, cnt, mine, sp = 0u;
    for (;;) {
        sum = 0u; cnt = 0u; mine = 0u;
#pragma unroll
        for (unsigned j = 0; j < 16; ++j) { const unsigned c = xb_ld(&bar[XB_XCNT(j)]); sum += c; cnt += (c > 0u) ? 1u : 0u; mine = (j == x) ? c : mine; }
        if (sum == G) break;
        __builtin_amdgcn_s_sleep(1);
        if ((++sp & 255u) == 0u) { if (xb_ld(&bar[XB_TMO])) break; if (sp > XB_SPIN_CAP) { atomicAdd(&bar[XB_TMO], 1u); break; } }
    }
    nloc = mine > 0u ? mine : 1u; nx = cnt > 0u ? cnt : 1u;
}

__device__ __forceinline__ void xcd_barrier(const XcdBarrier& b) {
    asm volatile("s_waitcnt vmcnt(0)" ::: "memory");
    __syncthreads();
    if (threadIdx.x == 0) {
        unsigned* bar = b.bar;
        __builtin_amdgcn_s_waitcnt(0);
        unsigned nloc = b.st[0], nx = b.st[1];
        if (nloc == 0u) { xcd_barrier_complete(bar, b.x, nloc, nx); b.st[0] = nloc; b.st[1] = nx; }
        const unsigned old = xb_add(&bar[XB_XSUB(b.x)], 1u);
        const unsigned gen = old / nloc;
        if (old + 1u == (gen + 1u) * nloc) {
            __builtin_amdgcn_fence(__ATOMIC_RELEASE, "agent");
            asm volatile("s_waitcnt vmcnt(0)" ::: "memory");
            const unsigned og = xb_add(&bar[XB_TOP], 1u);
            const unsigned tg = og / nx;
            if (og + 1u == (tg + 1u) * nx) xb_add(&bar[XB_TOPGEN], 1u);
            else XB_SPIN(xb_ld(&bar[XB_TOPGEN]) == tg, bar);
            __builtin_amdgcn_fence(__ATOMIC_ACQUIRE, "agent");
            xb_add(&bar[XB_XGEN(b.x)], 1u);
            asm volatile("s_waitcnt vmcnt(0)" ::: "memory");
        } else {
            XB_SPIN(xb_ld(&bar[XB_XGEN(b.x)]) == gen, bar);
            __builtin_amdgcn_fence(__ATOMIC_ACQUIRE, "agent");
            asm volatile("s_waitcnt vmcnt(0)" ::: "memory");
        }
    }
    __syncthreads();
}

__global__ void __launch_bounds__(512, 2) trunk_fwd(Args ka) {
    extern __shared__ __attribute__((aligned(16))) unsigned char lds[];
    cg::grid_group grid = cg::this_grid();
    volatile LAS unsigned* bst = (volatile LAS unsigned*)((LAS unsigned char*)lds + (LDS_BYTES - 16));
    if (threadIdx.x < 4) bst[threadIdx.x] = 0u;
    __syncthreads();
    XcdBarrier xbar = xcd_barrier_post((unsigned*)(ka.ws + WS_BAR), bst);
    const int ph_hi = ka.hi;
    {
        if (blockIdx.x == 0 && threadIdx.x == 0) {
#pragma unroll
            for (int i = 0; i < 31; ++i) ((const float**)(ka.ws + WS_TAB))[i] = ka.in[i]; }
        phase_prologue(ka, lds); convert_weights(ka, 0, lds, 0);
        grid.sync();
    }
    for (int ph = 1; ph < ph_hi; ++ph) {
        Args a; a.ws = ka.ws; a.out = ka.out; asm volatile("" : "+s"(a.ws)); asm volatile("" : "+s"(a.out));
        { const float* const* tab = (const float* const*)(a.ws + WS_TAB);
#define LD4(i) asm volatile("s_load_dwordx2 %0, %4, %5\n\ts_load_dwordx2 %1, %4, %6\n\ts_load_dwordx2 %2, %4, %7\n\ts_load_dwordx2 %3, %4, %8\n\ts_waitcnt lgkmcnt(0)" \
              : "=&s"(a.in[i]), "=&s"(a.in[i + 1]), "=&s"(a.in[i + 2]), "=&s"(a.in[i + 3]) : "s"(tab), "i"((i) * 8), "i"((i) * 8 + 8), "i"((i) * 8 + 16), "i"((i) * 8 + 24))
          LD4(0); LD4(4); LD4(8); LD4(12); LD4(16); LD4(20); LD4(24);
          asm volatile("s_load_dwordx2 %0, %3, %4\n\ts_load_dwordx2 %1, %3, %5\n\ts_load_dwordx2 %2, %3, %6\n\ts_waitcnt lgkmcnt(0)" : "=&s"(a.in[28]), "=&s"(a.in[29]), "=&s"(a.in[30]) : "s"(tab), "i"(224), "i"(232), "i"(240));
#undef LD4
        }
        a.lo = 0; a.hi = 0;
        unsigned char* ws = a.ws;
        if (ph == 1) phase_vectors(a, lds);
        else if (ph == NPH - 1) phase_final(a);
        else {
            const int l = (ph - 2) / 10, s = (ph - 2) % 10; const bool last = (l == NL - 1);
            const float* mods = (const float*)(ws + WS_MODS) + (size_t)l * 33 * 6144;
            float* rsa = (float*)(ws + WS_RSA); float* rsb = (float*)(ws + WS_RSB);
            if (s == 0) { run_gemm<NIN, 1024>(lds, (const bf16_t*)(ws + WS_H), (const bf16_t*)(ws + WT_IN), 0, FnF{(bf16_t*)(ws + WS_F), rsa, (const float*)(ws + WS_C1) + (size_t)l * 33 * NIN}); }
            else if (s == 1) { phase_split(a, l); convert_weights(a, l, lds, 1);
                for (int i = blockIdx.x * 512 + ltid(); i < TALL; i += gridDim.x * 512) { rsa[i] = 0.f; rsb[i] = 0.f; } }
            else if (s == 2) { run_gemm<768, 256>(lds, (const bf16_t*)(ws + WS_CQN), (const bf16_t*)(ws + WT_UQ), 0, FnQ{(bf16_t*)(ws + WS_Q), (const float*)(ws + WS_ROPE)});
                    run_gemm<1024, 128>(lds, (const bf16_t*)(ws + WS_CKVN), (const bf16_t*)(ws + WT_UKV), 0, FnKV{(bf16_t*)(ws + WS_KATT), (bf16_t*)(ws + WS_VATT)}); }
            else if (s == 3) { phase_attn((const bf16_t*)(ws + WS_Q), (const bf16_t*)(ws + WS_KATT), (const bf16_t*)(ws + WS_VATT), (bf16_t*)(ws + WS_MIX), last, (char*)lds); }
            else if (s == 4) { run_gemm<2048, 256>(lds, (const bf16_t*)(ws + WS_A1), (const bf16_t*)(ws + WT_L1), 0, FnL1{(__half*)(ws + WS_DEC), (bf16_t*)(ws + WS_AA), a.in[I_W0] + l * 1024, a.in[I_A0] + l * 1024});
                    run_gemm<1024, 256>(lds, (const bf16_t*)(ws + WS_A2), (const bf16_t*)(ws + WT_L2), 0,
                             FnL2{(bf16_t*)(ws + WS_G), (bf16_t*)(ws + WS_V), (const bf16_t*)(ws + WS_VF), a.in[I_V0] + (l > 0 ? l - 1 : 0) * 512, l > 0 ? 1 : 0}); }
            else if (s == 5) { phase_scan((const bf16_t*)(ws + WS_R), (const bf16_t*)(ws + WS_K), (const bf16_t*)(ws + (l == 0 ? WS_VF : WS_V)), (const __half*)(ws + WS_DEC), (const bf16_t*)(ws + WS_AA),
                               (const float*)(ws + WS_INV), a.in[I_KK] + l * 512, a.in[I_KA] + l * 512, (bf16_t*)(ws + WS_MIX), (bf16_t*)(ws + WS_YB), (char*)lds); }
            else if (s == 6) { phase_rwkv_out(a, l, last); if (!last) convert_weights(a, l + 1, lds, 0); }
            else if (s == 7) { run_gemm_epi<1024, 1024>(lds, (const bf16_t*)(ws + WS_MIX), (const bf16_t*)(ws + WT_OUT), last ? 1 : 0,
                             EpiRes{a.out, (float*)(ws + WS_XC), l == 0 ? a.in[I_X] : a.out, l == 0 ? a.in[I_CTX] : (const float*)(ws + WS_XC), mods, 2,
                                    (const float*)(ws + WS_GP2) + (size_t)l * 33 * 1024, (bf16_t*)(ws + WS_H), rsb, 1}); }
            else if (s == 8) { run_gemm<DFF, 1024>(lds, (const bf16_t*)(ws + WS_H), (const bf16_t*)(ws + WT_M1), last ? 1 : 0, FnM1{(bf16_t*)(ws + WS_HID), rsb, (const float*)(ws + WS_C2) + (size_t)l * 33 * DFF}); }
            else if (s == 9) { run_gemm_epi<1024, DFF>(lds, (const bf16_t*)(ws + WS_HID), (const bf16_t*)(ws + WT_M2), last ? 1 : 0,
                             EpiRes{a.out, (float*)(ws + WS_XC), a.out, (const float*)(ws + WS_XC), mods, 5,
                                    (const float*)(ws + WS_GP1) + (size_t)(last ? l : l + 1) * 33 * 1024, (bf16_t*)(ws + WS_H), rsa, last ? 0 : 1}); }
        }
        if (ph + 1 < ph_hi) { XcdBarrier xb = xbar; asm volatile("" : "+s"(xb.bar)); xcd_barrier(xb); }
    }
}

extern "C" void kernel_launch(void* const* d_in, const int* in_sizes, int n_in, void* d_out, int out_size, void* d_ws, size_t ws_size, hipStream_t stream) {
    static int grid = 0;
    if (grid == 0) {
        if (n_in != 31 || out_size != NB * SEQ * DM || ws_size < WS_END) { fprintf(stderr, "kernel_launch: unexpected shapes: n_in %d out %d ws %zu (need %zu)\n", n_in, out_size, ws_size, (size_t)WS_END); grid = -1; return; }
        int dev = 0, cus = 0, per_cu = 0;
        (void)hipGetDevice(&dev); (void)hipDeviceGetAttribute(&cus, hipDeviceAttributeMultiprocessorCount, dev);
        if (hipFuncSetAttribute((const void*)trunk_fwd, hipFuncAttributeMaxDynamicSharedMemorySize, LDS_BYTES) != hipSuccess) { fprintf(stderr, "kernel_launch: hipFuncSetAttribute failed\n"); grid = -1; return; }
        if (hipOccupancyMaxActiveBlocksPerMultiprocessor(&per_cu, (const void*)trunk_fwd, 512, LDS_BYTES) != hipSuccess || per_cu < 1) { fprintf(stderr, "kernel_launch: occupancy query gave %d\n", per_cu); per_cu = 1; }
        (void)hipGetLastError();
        grid = cus * 1;
    }
    if (grid < 0) return;
    if (hipMemsetAsync((char*)d_ws + WS_BAR, 0, BAR_BYTES, stream) != hipSuccess) { fprintf(stderr, "kernel_launch: hipMemsetAsync failed\n"); return; }
    Args a{};
    for (int i = 0; i < 31; ++i) a.in[i] = (const float*)d_in[i];
    a.out = (float*)d_out; a.ws = (unsigned char*)d_ws; a.lo = 0; a.hi = NPH;
    void* args[] = {&a};
    hipError_t e = hipLaunchCooperativeKernel((const void*)trunk_fwd, dim3(grid), dim3(512), args, LDS_BYTES, stream);
    if (e != hipSuccess) fprintf(stderr, "kernel_launch: cooperative launch failed: %s (grid %d)\n", hipGetErrorString(e), grid);
}
```

```cpp
#include <hip/hip_runtime.h>
#include <hip/hip_cooperative_groups.h>
#include <hip/hip_fp16.h>
#include <cstdio>
#include <cstdint>
namespace cg = cooperative_groups;
#define DI __device__ __forceinline__
DI int ltid() { int t = threadIdx.x; asm volatile("" : "+v"(t)); return t; }
namespace pg8 {
#define PG8_LAS __attribute__((address_space(3)))
typedef unsigned short bf16_t;
typedef short bf16x8 __attribute__((ext_vector_type(8)));
typedef float f32x4 __attribute__((ext_vector_type(4)));
typedef unsigned u32x4 __attribute__((ext_vector_type(4)));
constexpr int BM = 256, BK = 64, HALF = 128, HTB = HALF * BK * 2  , STAGE_BYTES = 8 * HTB, NXCD = 8, WGM = 8;

__host__ __device__ __forceinline__ int lds_byte(int r, int c) { const int st = (r >> 4) * 2 + (c >> 5), rr = r & 15, cc = c & 31, ob = rr * 64 + cc * 2; return st * 1024 + (ob ^ (((ob >> 9) & 1) << 5)); }
__host__ __device__ __forceinline__ void stage_rc(int b, int& R, int& C) { const int st = b / 1024, sb = b % 1024, swz = sb ^ (((sb >> 9) & 1) << 5); R = (st >> 1) * 16 + swz / 64; C = (st & 1) * 32 + (swz % 64) / 2; }
__host__ __device__ __forceinline__ int perm32(int rho) { const int n = rho >> 4, i = rho & 15; return 8 * (i >> 2) + 4 * n + (i & 3); }

struct Unit { int pm, pn; };
struct Gemm { const bf16_t* A; const bf16_t* Bt; int M, N, K; };

struct StaticOrder {
    int nM, nN, nwg, G, c;
    __host__ __device__ void init(int M, int N, int G_, int c_) { nM = M / BM; nN = N / BM; nwg = nM * nN; G = G_; c = c_; }
    __host__ __device__ bool next(int i, Unit& u) const {
        const long L = (long)i * G + c; if (L >= nwg) return false;
        int wgid = (int)L; { const int q = nwg / NXCD, r = nwg % NXCD, xcd = wgid % NXCD, off = wgid / NXCD; wgid = (xcd < r ? xcd * (q + 1) : r * (q + 1) + (xcd - r) * q) + off; }
        const int nig = WGM * nN, gid = wgid / nig, fm = gid * WGM, gsz = (nM - fm) < WGM ? (nM - fm) : WGM;
        u.pm = fm + ((wgid % nig) % gsz); u.pn = (wgid % nig) / gsz; return true;
    }
    __device__ __forceinline__ void a_ready(const Unit&) const {}
    __device__ __forceinline__ void done(const Unit&) const {}
};

__device__ __forceinline__ unsigned cvt_pk_bf16(float lo, float hi) { unsigned r; asm volatile("v_cvt_pk_bf16_f32 %0, %1, %2" : "=v"(r) : "v"(lo), "v"(hi)); return r; }

template <class Epi, class Sched, bool ALIGN_EPI = false, bool SP2 = false>
__device__ __forceinline__ void gemm_phase(PG8_LAS unsigned char* lds, const Gemm g, const Sched& S, const Epi& E) {
    const int tid = ltid(), wid = __builtin_amdgcn_readfirstlane(tid >> 6), lane = tid & 63, wr = wid >> 2, wc = wid & 3, fr = lane & 15, fq = lane >> 4;
    const int K = g.K, nt = K / BK;
    unsigned voffA[2], voffB[2];
#pragma unroll
    for (int i = 0; i < 2; ++i) { int R, C; stage_rc(tid * 16 + i * 8192, R, C); const int Rb = Epi::PERM ? ((R & ~31) + perm32(R & 31)) : R;
        voffA[i] = (unsigned)(R * K + C) * 2u; voffB[i] = (unsigned)(Rb * K + C) * 2u; }
    const size_t kstep = (size_t)(BK * 2);
    const size_t hstep = (size_t)HALF * K * 2;
    const size_t tstep = 2 * hstep;
    const unsigned ldsw = (unsigned)wid * 1024u;
    const int aoff = lds_byte(wr * 64 + fr, fq * 8), boff = lds_byte(wc * 32 + fr, fq * 8);
#define PG8_SA(b, h) (((b) * 2 + (h)) * HTB)
#define PG8_SB(b, h) ((4 + (b) * 2 + (h)) * HTB)
#define PG8_STAGE(bufoff, gbase, voff) do { _Pragma("unroll") for (int _i = 0; _i < 2; ++_i) \
        __builtin_amdgcn_global_load_lds((const unsigned*)((const char*)(gbase) + (voff)[_i]), (PG8_LAS unsigned*)(lds + (bufoff) + ldsw + _i * 8192), 16, 0, 0); } while (0)
#define PG8_LDA(dst, b, h) do { _Pragma("unroll") for (int m = 0; m < 4; ++m) _Pragma("unroll") for (int k = 0; k < 2; ++k) dst[m][k] = *(const PG8_LAS bf16x8*)(lds + PG8_SA(b, h) + aoff + m * 2048 + k * 1024); } while (0)
#define PG8_LDB(dst, b, h) do { _Pragma("unroll") for (int n = 0; n < 2; ++n) _Pragma("unroll") for (int k = 0; k < 2; ++k) dst[n][k] = *(const PG8_LAS bf16x8*)(lds + PG8_SB(b, h) + boff + n * 2048 + k * 1024); } while (0)
#define PG8_MMA(ai, bj, At, Bt) do { __builtin_amdgcn_s_setprio(1); _Pragma("unroll") for (int m = 0; m < 4; ++m) _Pragma("unroll") for (int n = 0; n < 2; ++n) _Pragma("unroll") for (int k = 0; k < 2; ++k) \
        acc[ai][bj][m][n] = __builtin_amdgcn_mfma_f32_16x16x32_bf16(Bt[n][k], At[m][k], acc[ai][bj][m][n], 0, 0, 0); __builtin_amdgcn_s_setprio(0); } while (0)
#define PG8_WAIT_V(n) asm volatile("s_waitcnt vmcnt(" #n ")" ::: "memory")
#define PG8_WAIT_L(n) asm volatile("s_waitcnt lgkmcnt(" #n ")" ::: "memory")
#define PG8_BAR __builtin_amdgcn_s_barrier()
#define PG8_SCHED __builtin_amdgcn_sched_barrier(0)
    Unit cur, nxt; int ui = 0;
    if (!S.next(0, cur)) return;
    f32x4 acc[2][2][4][2];
#pragma unroll
    for (int a = 0; a < 2; ++a)
#pragma unroll
        for (int b = 0; b < 2; ++b)
#pragma unroll
            for (int m = 0; m < 4; ++m)
#pragma unroll
                for (int n = 0; n < 2; ++n) acc[a][b][m][n] = (f32x4){0.f, 0.f, 0.f, 0.f};
    bf16x8 At[4][2], B0[2][2], B1[2][2];
    const char* cA = (const char*)g.A + (size_t)cur.pm * tstep; const char* cB = (const char*)g.Bt + (size_t)cur.pn * tstep;
    S.a_ready(cur);
    if constexpr (SP2) {
        PG8_STAGE(PG8_SB(0, 0), cB, voffB); PG8_STAGE(PG8_SB(0, 1), cB + hstep, voffB); PG8_STAGE(PG8_SA(0, 0), cA, voffA); PG8_STAGE(PG8_SA(0, 1), cA + hstep, voffA);
        if (wr == 1) PG8_BAR;
        PG8_WAIT_V(2); PG8_BAR;
        PG8_STAGE(PG8_SB(1, 0), cB + kstep, voffB); PG8_STAGE(PG8_SA(1, 0), cA + kstep, voffA); PG8_STAGE(PG8_SB(1, 1), cB + hstep + kstep, voffB);
        PG8_WAIT_V(6); PG8_BAR;
    } else {
        PG8_STAGE(PG8_SB(0, 0), cB, voffB); PG8_STAGE(PG8_SA(0, 0), cA, voffA); PG8_STAGE(PG8_SB(0, 1), cB + hstep, voffB); PG8_STAGE(PG8_SA(0, 1), cA + hstep, voffA);
        if (wr == 1) PG8_BAR;
        PG8_WAIT_V(4); PG8_BAR;
        PG8_STAGE(PG8_SB(1, 0), cB + kstep, voffB); PG8_STAGE(PG8_SA(1, 0), cA + kstep, voffA); PG8_STAGE(PG8_SB(1, 1), cB + hstep + kstep, voffB);
        PG8_WAIT_V(6); PG8_BAR;
    }
    for (;;) {
        const bool has_next = S.next(ui + 1, nxt);
        const char* nA = has_next ? (const char*)g.A + (size_t)nxt.pm * tstep : cA; const char* nB = has_next ? (const char*)g.Bt + (size_t)nxt.pn * tstep : cB;
#pragma nounroll
        for (int t = 0; t < nt; t += 2) {
            const bool last = (t == nt - 2);
            const char* a1 = cA + (size_t)(t + 1) * kstep;
            const char* a2 = last ? nA : cA + (size_t)(t + 2) * kstep; const char* b2 = last ? nB : cB + (size_t)(t + 2) * kstep;
            const char* a3 = a2 + kstep; const char* b3 = b2 + kstep;
            if (last && has_next) S.a_ready(nxt);
            if constexpr (SP2) {
            PG8_LDB(B0, 0, 0); PG8_LDB(B1, 0, 1); PG8_SCHED; PG8_LDA(At, 0, 0); PG8_STAGE(PG8_SA(1, 1), a1 + hstep, voffA);
            PG8_WAIT_V(8); PG8_WAIT_L(0); PG8_BAR; PG8_MMA(0, 0, At, B0); PG8_MMA(0, 1, At, B1); PG8_BAR; PG8_SCHED;
            PG8_LDA(At, 0, 1); PG8_STAGE(PG8_SB(0, 0), b2, voffB); PG8_STAGE(PG8_SB(0, 1), b2 + hstep, voffB); PG8_STAGE(PG8_SA(0, 0), a2, voffA);
            PG8_WAIT_V(8); PG8_WAIT_L(0); PG8_BAR; PG8_MMA(1, 0, At, B0); PG8_MMA(1, 1, At, B1); PG8_BAR; PG8_SCHED;
            PG8_LDB(B0, 1, 0); PG8_LDB(B1, 1, 1); PG8_SCHED; PG8_LDA(At, 1, 0); PG8_STAGE(PG8_SA(0, 1), a2 + hstep, voffA);
            PG8_WAIT_V(8); PG8_WAIT_L(0); PG8_BAR; PG8_MMA(0, 0, At, B0); PG8_MMA(0, 1, At, B1); PG8_BAR; PG8_SCHED;
            PG8_LDA(At, 1, 1); PG8_STAGE(PG8_SB(1, 0), b3, voffB); PG8_STAGE(PG8_SB(1, 1), b3 + hstep, voffB); PG8_STAGE(PG8_SA(1, 0), a3, voffA);
            PG8_WAIT_V(8); PG8_WAIT_L(0); PG8_BAR; PG8_MMA(1, 0, At, B0); PG8_MMA(1, 1, At, B1); PG8_BAR; PG8_SCHED;
            } else {
            PG8_LDB(B0, 0, 0); PG8_SCHED; PG8_LDA(At, 0, 0); PG8_STAGE(PG8_SA(1, 1), a1 + hstep, voffA);
            PG8_WAIT_L(8); PG8_BAR; PG8_WAIT_L(0); PG8_MMA(0, 0, At, B0); PG8_BAR; PG8_SCHED;
            PG8_LDB(B1, 0, 1); PG8_STAGE(PG8_SB(0, 0), b2, voffB);
            PG8_BAR; PG8_WAIT_L(0); PG8_MMA(0, 1, At, B1); PG8_BAR;
            PG8_LDA(At, 0, 1); PG8_STAGE(PG8_SA(0, 0), a2, voffA);
            PG8_BAR; PG8_WAIT_L(0); PG8_MMA(1, 0, At, B0); PG8_BAR; PG8_SCHED;
            PG8_STAGE(PG8_SB(0, 1), b2 + hstep, voffB);
            PG8_WAIT_V(6); PG8_BAR; PG8_MMA(1, 1, At, B1); PG8_BAR;
            PG8_LDB(B0, 1, 0); PG8_SCHED; PG8_LDA(At, 1, 0); PG8_STAGE(PG8_SA(0, 1), a2 + hstep, voffA);
            PG8_WAIT_L(8); PG8_BAR; PG8_WAIT_L(0); PG8_MMA(0, 0, At, B0); PG8_BAR; PG8_SCHED;
            PG8_LDB(B1, 1, 1); PG8_STAGE(PG8_SB(1, 0), b3, voffB);
            PG8_BAR; PG8_WAIT_L(0); PG8_MMA(0, 1, At, B1); PG8_BAR;
            PG8_LDA(At, 1, 1); PG8_STAGE(PG8_SA(1, 0), a3, voffA);
            PG8_BAR; PG8_WAIT_L(0); PG8_MMA(1, 0, At, B0); PG8_BAR; PG8_SCHED;
            PG8_STAGE(PG8_SB(1, 1), b3 + hstep, voffB);
            PG8_WAIT_V(6); PG8_BAR; PG8_MMA(1, 1, At, B1); PG8_BAR;
            }
        }
        if constexpr (ALIGN_EPI) { if (wr == 0) PG8_BAR; }
        if constexpr (!Epi::AFTER_DRAIN) { E(acc, cur, wr, wc, fr, fq); S.done(cur); }
        if (!has_next) break;
#pragma unroll
        for (int a = 0; a < 2; ++a)
#pragma unroll
            for (int b = 0; b < 2; ++b)
#pragma unroll
                for (int m = 0; m < 4; ++m)
#pragma unroll
                    for (int n = 0; n < 2; ++n) acc[a][b][m][n] = (f32x4){0.f, 0.f, 0.f, 0.f};
        cur = nxt; cA = nA; cB = nB; ++ui;
        if constexpr (ALIGN_EPI) { if (wr == 1) PG8_BAR; }
    }
    PG8_WAIT_V(0);
    if constexpr (!ALIGN_EPI) { if (wr == 0) PG8_BAR; }
    PG8_BAR;
    if constexpr (Epi::AFTER_DRAIN) { E.fused(acc, cur, wr, wc, fr, fq, lds, wid, lane); S.done(cur); }
#undef PG8_SA
#undef PG8_SB
#undef PG8_STAGE
#undef PG8_LDA
#undef PG8_LDB
#undef PG8_MMA
#undef PG8_WAIT_V
#undef PG8_WAIT_L
#undef PG8_BAR
#undef PG8_SCHED
}
}
typedef unsigned short bf16_t;
using bf16x8 = __attribute__((ext_vector_type(8))) short;
using s16x4  = __attribute__((ext_vector_type(4))) short;
using f32x16 = __attribute__((ext_vector_type(16))) float;
using f32x4  = __attribute__((ext_vector_type(4))) float;
using u32x4  = __attribute__((ext_vector_type(4))) unsigned;
using u32x2  = __attribute__((ext_vector_type(2))) unsigned;

constexpr int DM = 1024, NB = 32, SEQ = 2048, TC = 256, TT = 2304, TALL = NB * TT, NL = 4;
constexpr int CIN = 2336, CINX = 2368, NIN = 2560, DFF = 4096;
constexpr int OFF_R = 416, OFF_K = 928, OFF_V = 1440, OFF_WLO = 1952, OFF_HV = 2336;
constexpr int NPH = 43, LDS_BYTES = 147456;
constexpr size_t MiB = 1u << 20;
constexpr size_t WS_MODS = 0, WS_ROPE = 3 * MiB + 512 * 1024, WS_BAR = 3 * MiB + 768 * 1024, BAR_BYTES = 16384, WS_TAB = 3 * MiB + 800 * 1024, WS_XC = 4 * MiB, WS_VF = 36 * MiB, WS_WT = 108 * MiB, WS_INV = 134 * MiB, TR = 137 * MiB;
constexpr size_t WT_IN = WS_WT, WT_UQ = WS_WT + 5 * MiB, WT_UKV = WS_WT + 5 * MiB + 512 * 1024, WT_L1 = WS_WT + 6 * MiB, WT_L2 = WS_WT + 7 * MiB,
                 WT_OUT = WS_WT + 8 * MiB, WT_M1 = WS_WT + 10 * MiB, WT_M2 = WS_WT + 18 * MiB;
constexpr size_t WS_R = TR, WS_K = TR + 72 * MiB, WS_H = TR, WS_F = TR + 144 * MiB, WS_Q = TR + 144 * MiB, WS_VATT = TR + 252 * MiB, WS_MIX = TR + 324 * MiB,
                 WS_DEC = TR + 144 * MiB, WS_HID = TR + 144 * MiB, WS_A1 = TR + 477 * MiB, WS_A2 = TR + 513 * MiB, WS_YB = TR + 477 * MiB,
                 WS_CQN = TR + 549 * MiB, WS_CKVN = TR + 585 * MiB, WS_KATT = TR + 621 * MiB, WS_AA = TR + 585 * MiB, WS_G = TR + 729 * MiB,
                 WS_V = TR + 801 * MiB, WS_C1 = 1010 * MiB, WS_C2 = 1012 * MiB, WS_GP1 = 1015 * MiB, WS_GP2 = 1016 * MiB, WS_END = 1017 * MiB;
constexpr size_t WS_RSA = 136 * MiB + 256 * 1024, WS_RSB = 136 * MiB + 640 * 1024;

struct Args { const float* in[31]; float* out; unsigned char* ws; int lo, hi; };
enum { I_X = 0, I_C, I_CTX, I_CCTX, I_ADAW, I_ADAB, I_N1G, I_N2G, I_WIN, I_QNG, I_WUQ, I_KVNG, I_WUKV, I_MU, I_W0, I_W2, I_A0, I_A2, I_G2, I_KK, I_KA, I_RK,
       I_LNW, I_LNB, I_V1, I_V2, I_V0, I_WOUT, I_M1, I_M2, I_FG };

DI float bflo(unsigned w) { return __uint_as_float(w << 16); }
DI float bfhi(unsigned w) { return __uint_as_float(w & 0xffff0000u); }
DI unsigned cvtpk(float lo, float hi) { return pg8::cvt_pk_bf16(lo, hi); }
DI bf16_t f2bf(float f) { return (bf16_t)(cvtpk(f, 0.f) & 0xffffu); }
DI void load8(const bf16_t* p, float (&f)[8]) { const u32x4 w = *(const u32x4*)p; f[0] = bflo(w.x); f[1] = bfhi(w.x); f[2] = bflo(w.y); f[3] = bfhi(w.y); f[4] = bflo(w.z); f[5] = bfhi(w.z); f[6] = bflo(w.w); f[7] = bfhi(w.w); }
DI void store8(bf16_t* p, const float (&f)[8]) { u32x4 w; w.x = cvtpk(f[0], f[1]); w.y = cvtpk(f[2], f[3]); w.z = cvtpk(f[4], f[5]); w.w = cvtpk(f[6], f[7]); *(u32x4*)p = w; }
DI void loadf8(const float* p, float (&f)[8]) { const f32x4 a = *(const f32x4*)p, b = *(const f32x4*)(p + 4); f[0] = a[0]; f[1] = a[1]; f[2] = a[2]; f[3] = a[3]; f[4] = b[0]; f[5] = b[1]; f[6] = b[2]; f[7] = b[3]; }
DI float h2f(unsigned b) { return __half2float(__ushort_as_half((unsigned short)b)); }
DI float sigmoidf_(float x) { return __builtin_amdgcn_rcpf(1.f + __expf(-x)); }
DI float tanhf_(float x) { return 1.f - 2.f * __builtin_amdgcn_rcpf(1.f + __expf(2.f * x)); }
DI float xorsum(float v, int mask) { return v + __shfl_xor(v, mask, 64); }
DI float* xrow(float* out, float* xc, int m) { const int b = m / TT, tt = m - b * TT; return tt < TC ? xc + (size_t)(b * TC + tt) * DM : out + (size_t)(b * SEQ + tt - TC) * DM; }

template <class Fn> struct Epi8 {
    static constexpr bool PERM = true, AFTER_DRAIN = false; Fn f;
    DI void operator()(const pg8::f32x4 (&acc)[2][2][4][2], const pg8::Unit& u, int wr, int wc, int fr, int fq) const {
        asm volatile("" : "+v"(fr), "+v"(fq));
#pragma unroll
        for (int ai = 0; ai < 2; ++ai)
#pragma unroll
            for (int m = 0; m < 4; ++m) { const int rit = ai * 128 + wr * 64 + m * 16 + fr;
#pragma unroll
                for (int bj = 0; bj < 2; ++bj) { f(rit, u.pn * 256 + bj * 128 + wc * 32 + 8 * fq, acc[ai][bj][m][0], acc[ai][bj][m][1], u, fq); __builtin_amdgcn_sched_barrier(0); } }
    }
};
DI void st8(bf16_t* p, const pg8::f32x4& v0, const pg8::f32x4& v1) { u32x4 w; w.x = cvtpk(v0[0], v0[1]); w.y = cvtpk(v0[2], v0[3]); w.z = cvtpk(v1[0], v1[1]); w.w = cvtpk(v1[2], v1[3]); *(u32x4*)p = w; }

struct FnF { bf16_t* F; const float* rs; const float* c1;
    DI void operator()(int rit, int col0, const pg8::f32x4& v0, const pg8::f32x4& v1, const pg8::Unit& u, int) const {
        if (col0 < CINX) { const int row = u.pm * 256 + rit, b = u.pm / 9, mrow = (u.pm - b * 9 == 0) ? 32 : b;
            const float rstd = rsqrtf(rs[row] * (1.f / 1024.f) + 1e-6f); const float* c = c1 + (size_t)mrow * NIN + col0;
            const pg8::f32x4 b0 = *(const pg8::f32x4*)c, b1 = *(const pg8::f32x4*)(c + 4);
            st8(F + (size_t)row * CINX + col0, v0 * rstd + b0, v1 * rstd + b1); } } };
struct FnQ { bf16_t* Q; const float* rope;
    DI void operator()(int rit, int col0, const pg8::f32x4& v0, const pg8::f32x4& v1, const pg8::Unit& u, int fq) const {
        const int seg = u.pm % 9; const bool isrope = (seg != 0) && (((col0 >> 5) % 3) == 2);
        float x[8] = {v0[0], v0[1], v0[2], v0[3], v1[0], v1[1], v1[2], v1[3]};
        if (isrope) { const int s = (seg - 1) * 256 + rit, pos = (fq < 2) ? (s >> 6) : (s & 63); float cs[8], sn[8]; loadf8(rope + pos * 8, cs); loadf8(rope + 512 + pos * 8, sn);
            const float sg = (fq & 1) ? 1.f : -1.f;
#pragma unroll
            for (int j = 0; j < 8; ++j) { const float p = __shfl_xor(x[j], 16, 64); x[j] = x[j] * cs[j] + sg * p * sn[j]; } }
        store8(Q + (size_t)(u.pm * 256 + rit) * 768 + col0, x); } };
struct FnKV { bf16_t* KA; bf16_t* VA;
    DI void operator()(int rit, int col0, const pg8::f32x4& v0, const pg8::f32x4& v1, const pg8::Unit& u, int) const {
        const size_t row = (size_t)(u.pm * 256 + rit); const int h = col0 >> 7, c = col0 & 127;
        if (c < 64) st8(KA + row * 768 + h * 96 + c, v0, v1); else st8(VA + row * 512 + h * 64 + (c - 64), v0, v1); } };
struct FnL1 { __half* DEC; bf16_t* AA; const float* w0; const float* a0;
    DI void operator()(int rit, int col0, const pg8::f32x4& v0, const pg8::f32x4& v1, const pg8::Unit& u, int) const {
        const size_t row = (size_t)(u.pm * 256 + rit); float x[8] = {v0[0], v0[1], v0[2], v0[3], v1[0], v1[1], v1[2], v1[3]};
        if (col0 < 1024) { float b[8]; loadf8(w0 + col0, b); u32x4 w; unsigned hh[8];
#pragma unroll
            for (int j = 0; j < 8; ++j) { const float uu = 0.6065306597f * sigmoidf_(x[j] + b[j]); hh[j] = (unsigned)__half_as_ushort(__float2half(-uu * 1.4426950409f)); }
            w.x = hh[0] | (hh[1] << 16); w.y = hh[2] | (hh[3] << 16); w.z = hh[4] | (hh[5] << 16); w.w = hh[6] | (hh[7] << 16);
            *(u32x4*)(DEC + row * 1024 + col0) = w;
        } else { const int c = col0 - 1024; float b[8]; loadf8(a0 + c, b);
#pragma unroll
            for (int j = 0; j < 8; ++j) x[j] = sigmoidf_(x[j] + b[j]);
            store8(AA + row * 1024 + c, x); } } };
struct FnL2 { bf16_t* G; bf16_t* V; const bf16_t* VF; const float* v0p; int dovres;
    DI void operator()(int rit, int col0, const pg8::f32x4& v0, const pg8::f32x4& v1, const pg8::Unit& u, int) const {
        const size_t row = (size_t)(u.pm * 256 + rit);
        if (col0 < 512) st8(G + row * 512 + col0, v0, v1);
        else if (dovres) { const int c = col0 - 512; float x[8] = {v0[0], v0[1], v0[2], v0[3], v1[0], v1[1], v1[2], v1[3]}, b[8], v[8], vf[8]; loadf8(v0p + c, b); load8(V + row * 512 + c, v); load8(VF + row * 512 + c, vf);
#pragma unroll
            for (int j = 0; j < 8; ++j) v[j] = v[j] + (vf[j] - v[j]) * sigmoidf_(b[j] + x[j]);
            store8(V + row * 512 + c, v); } } };
struct FnM1 { bf16_t* HID; const float* rs; const float* c2;
    DI void operator()(int rit, int col0, const pg8::f32x4& v0, const pg8::f32x4& v1, const pg8::Unit& u, int) const {
        const int row = u.pm * 256 + rit, b = u.pm / 9, mrow = (u.pm - b * 9 == 0) ? 32 : b;
        const float rstd = rsqrtf(rs[row] * (1.f / 1024.f) + 1e-6f); const float* c = c2 + (size_t)mrow * DFF + col0;
        const pg8::f32x4 b0 = *(const pg8::f32x4*)c, b1 = *(const pg8::f32x4*)(c + 4);
        const pg8::f32x4 y0 = v0 * rstd + b0, y1 = v1 * rstd + b1;
        float x[8] = {y0[0], y0[1], y0[2], y0[3], y1[0], y1[1], y1[2], y1[3]};
#pragma unroll
        for (int j = 0; j < 8; ++j) { const float r = fmaxf(x[j], 0.f); x[j] = r * r; }
        store8(HID + (size_t)row * DFF + col0, x); } };
struct EpiRes { static constexpr bool PERM = true, AFTER_DRAIN = false;
    float* out; float* xc; const float* sx; const float* sc; const float* mods; int gidx; const float* gp; bf16_t* H; float* rs; int emit;
    DI void operator()(const pg8::f32x4 (&acc)[2][2][4][2], const pg8::Unit& u, int wr, int wc, int fr, int fq) const {
        asm volatile("" : "+v"(fr), "+v"(fq));
        const int b = u.pm / 9, seg = u.pm - b * 9, mrow = seg == 0 ? 32 : b;
        const float* gbase = mods + (size_t)mrow * 6144 + gidx * 1024; const float* gpb = gp + (size_t)mrow * 1024;
#pragma unroll
        for (int ai = 0; ai < 2; ++ai)
#pragma unroll
            for (int m = 0; m < 4; ++m) { const int rit = ai * 128 + wr * 64 + m * 16 + fr; float ss = 0.f;
                const size_t roff = (seg == 0 ? (size_t)(b * TC + rit) * DM : (size_t)(b * SEQ + (seg - 1) * 256 + rit) * DM);
#pragma unroll
                for (int bj = 0; bj < 2; ++bj) { const int col0 = u.pn * 256 + bj * 128 + wc * 32 + 8 * fq;
                    float* p = (seg == 0 ? xc : out) + roff + col0; const float* q = (seg == 0 ? sc : sx) + roff + col0;
                    const pg8::f32x4 g0 = *(const pg8::f32x4*)(gbase + col0), g1 = *(const pg8::f32x4*)(gbase + col0 + 4); pg8::f32x4 x0 = *(const pg8::f32x4*)q, x1 = *(const pg8::f32x4*)(q + 4);
                    x0 += g0 * acc[ai][bj][m][0]; x1 += g1 * acc[ai][bj][m][1]; *(pg8::f32x4*)p = x0; *(pg8::f32x4*)(p + 4) = x1;
                    if (emit) { const pg8::f32x4 p0 = *(const pg8::f32x4*)(gpb + col0), p1 = *(const pg8::f32x4*)(gpb + col0 + 4);
                        ss += x0[0] * x0[0] + x0[1] * x0[1] + x0[2] * x0[2] + x0[3] * x0[3] + x1[0] * x1[0] + x1[1] * x1[1] + x1[2] * x1[2] + x1[3] * x1[3];
                        st8(H + (size_t)(u.pm * 256 + rit) * 1024 + col0, x0 * p0, x1 * p1); }
                    __builtin_amdgcn_sched_barrier(0); }
                if (emit) { ss += __shfl_xor(ss, 16, 64); ss += __shfl_xor(ss, 32, 64); if (fq == 0) atomicAdd(rs + u.pm * 256 + rit, ss); }
            }
    }
};
struct Order { pg8::StaticOrder s; int lat;
    DI void init(int lat_, int N) { lat = lat_; s.init(lat_ ? NB * SEQ : TALL, N, (int)gridDim.x, (int)blockIdx.x); }
    DI bool next(int i, pg8::Unit& u) const { if (!s.next(i, u)) return false; if (lat) u.pm = (u.pm >> 3) * 9 + 1 + (u.pm & 7); return true; }
    DI void a_ready(const pg8::Unit&) const {}
    DI void done(const pg8::Unit&) const {}
};
template <int N, int K, class Fn> DI void run_gemm(unsigned char* lds, const bf16_t* A, const bf16_t* Bt, int lat, const Fn& fn) {
    int Kr = K; if (K == 128) asm volatile("" : "+s"(Kr));
    pg8::Gemm g{A, Bt, lat ? NB * SEQ : TALL, N, Kr}; Order S; S.init(lat, N); Epi8<Fn> E{fn};
    pg8::gemm_phase<Epi8<Fn>, Order, true, true>((PG8_LAS unsigned char*)lds, g, S, E);
    __syncthreads();
}
template <int N, int K, class Epi> DI void run_gemm_epi(unsigned char* lds, const bf16_t* A, const bf16_t* Bt, int lat, const Epi& E) {
    pg8::Gemm g{A, Bt, lat ? NB * SEQ : TALL, N, K}; Order S; S.init(lat, N);
    pg8::gemm_phase<Epi, Order, true, true>((PG8_LAS unsigned char*)lds, g, S, E);
    __syncthreads();
}
namespace att {
constexpr int NW = 8, QBLK = 32, KVBLK = 64;
constexpr float SCALE = 0.10206207261596577f, THR = 8.f;
constexpr int LDQ = 768, LDKK = 768, LDV = 512, LDO = 1024;
constexpr int SHM_V = KVBLK * 64 * 2, SHM_K = KVBLK * 256, SHM_ATTN = 2 * SHM_V + 2 * SHM_K + NW * 64 * 4;
#define KSWZ(row, colB) ((row) * 256 + ((colB) ^ (((row) & 7) << 4)))
#define SBAR() __builtin_amdgcn_sched_barrier(0)
DI int crow(int r, int hi) { return (r & 3) + 8 * (r >> 2) + 4 * hi; }
DI unsigned cvtpk_(float lo, float hi) { unsigned r; asm volatile("v_cvt_pk_bf16_f32 %0, %1, %2" : "=v"(r) : "v"(lo), "v"(hi)); return r; }
DI void partialSM(f32x16& p0, f32x16& p1, float& m_reg, float& mn, float& alpha) {
  constexpr float C = SCALE * 1.4426950408889634f;
  float pmax = p0[0];
#pragma unroll
  for (int r = 1; r < 16; ++r) pmax = fmaxf(pmax, p0[r]);
#pragma unroll
  for (int r = 0; r < 16; ++r) pmax = fmaxf(pmax, p1[r]);
  { auto rr = __builtin_amdgcn_permlane32_swap(__float_as_uint(pmax), __float_as_uint(pmax), false, false);
    pmax = fmaxf(__uint_as_float(rr[0]), __uint_as_float(rr[1])); }
  if (__builtin_expect(__all(pmax - m_reg <= THR / SCALE), 1)) { mn = m_reg; alpha = 1.f; }
  else { mn = fmaxf(m_reg, pmax); alpha = __builtin_amdgcn_exp2f((m_reg - mn) * C); m_reg = mn; }
  const float mnC = -mn * C;
#pragma unroll
  for (int r = 0; r < 16; ++r) p0[r] = fmaf(p0[r], C, mnC);
#pragma unroll
  for (int r = 0; r < 16; ++r) p1[r] = fmaf(p1[r], C, mnC);
#pragma unroll
  for (int r = 0; r < 16; ++r) p0[r] = __builtin_amdgcn_exp2f(p0[r]);
}
DI void finishSM(f32x16& p0, f32x16& p1, float alpha, float& l_reg, bf16x8& pa0, bf16x8& pa1, bf16x8& pa2, bf16x8& pa3) {
#pragma unroll
  for (int r = 0; r < 16; ++r) p1[r] = __builtin_amdgcn_exp2f(p1[r]);
  float ps = 0;
#pragma unroll
  for (int r = 0; r < 16; ++r) ps += p0[r];
#pragma unroll
  for (int r = 0; r < 16; ++r) ps += p1[r];
  { auto rr = __builtin_amdgcn_permlane32_swap(__float_as_uint(ps), __float_as_uint(ps), false, false);
    ps = __uint_as_float(rr[0]) + __uint_as_float(rr[1]); }
  l_reg = l_reg * alpha + ps;
#define PK4(P, BASE, OUT) do { unsigned a0 = cvtpk_(P[BASE + 0], P[BASE + 1]), a1 = cvtpk_(P[BASE + 2], P[BASE + 3]);   \
    unsigned b0 = cvtpk_(P[BASE + 4], P[BASE + 5]), b1 = cvtpk_(P[BASE + 6], P[BASE + 7]);                              \
    auto r0 = __builtin_amdgcn_permlane32_swap(a0, b0, false, false); auto r1 = __builtin_amdgcn_permlane32_swap(a1, b1, false, false); \
    u32x4 w = {r0[0], r1[0], r0[1], r1[1]}; OUT = *reinterpret_cast<bf16x8*>(&w); } while (0)
  PK4(p0, 0, pa0); PK4(p0, 8, pa1); PK4(p1, 0, pa2); PK4(p1, 8, pa3);
#undef PK4
}
DI void qkt(f32x16& p0, f32x16& p1, const char* Ks, const bf16x8* qr, int r32, int hi) {
  p0 = f32x16{}; p1 = f32x16{};
#pragma unroll
  for (int d0 = 0; d0 < 6; ++d0) { const int cb = (d0 * 16 + hi * 8) * 2;
    bf16x8 b0 = *reinterpret_cast<const bf16x8*>(Ks + KSWZ(r32, cb));
    bf16x8 b1 = *reinterpret_cast<const bf16x8*>(Ks + KSWZ(32 + r32, cb));
    p0 = __builtin_amdgcn_mfma_f32_32x32x16_bf16(b0, qr[d0], p0, 0, 0, 0);
    p1 = __builtin_amdgcn_mfma_f32_32x32x16_bf16(b1, qr[d0], p1, 0, 0, 0); }
}
DI int v_st(int k, int c) { const int kk = (k & ~0xC) | ((k & 4) << 1) | ((k & 8) >> 1); return ((kk >> 3) * 2 + (c >> 5)) * 512 + ((kk & 7) * 32 + (c & 31)) * 2; }
DI int v_rd_base(int lane) { return ((lane & 3) << 3) | (((lane >> 2) & 3) << 6) | (((lane >> 4) & 1) << 5) | (((lane >> 5) & 1) << 8); }
constexpr int v_rd_off(int d0, int ks, int half) { return d0 * 512 + ks * 2048 + half * 1024; }
template <int OFF> DI s16x4 tr_read(int vb) {
  s16x4 r; asm volatile("ds_read_b64_tr_b16 %0, %1 offset:%2" : "=&v"(r) : "v"(vb), "i"(OFF) : "memory"); return r;
}
template <int D0> DI void pv_one(f32x16& od, int vb, bf16x8 pa0, bf16x8 pa1, bf16x8 pa2, bf16x8 pa3) {
  const s16x4 l0 = tr_read<v_rd_off(D0, 0, 0)>(vb), h0 = tr_read<v_rd_off(D0, 0, 1)>(vb), l1 = tr_read<v_rd_off(D0, 1, 0)>(vb), h1 = tr_read<v_rd_off(D0, 1, 1)>(vb);
  const s16x4 l2 = tr_read<v_rd_off(D0, 2, 0)>(vb), h2 = tr_read<v_rd_off(D0, 2, 1)>(vb), l3 = tr_read<v_rd_off(D0, 3, 0)>(vb), h3 = tr_read<v_rd_off(D0, 3, 1)>(vb);
  asm volatile("s_waitcnt lgkmcnt(0)" ::: "memory"); SBAR();
#define PK(L, H) (bf16x8){L[0], L[1], L[2], L[3], H[0], H[1], H[2], H[3]}
  od = __builtin_amdgcn_mfma_f32_32x32x16_bf16(pa0, PK(l0, h0), od, 0, 0, 0);
  od = __builtin_amdgcn_mfma_f32_32x32x16_bf16(pa1, PK(l1, h1), od, 0, 0, 0);
  od = __builtin_amdgcn_mfma_f32_32x32x16_bf16(pa2, PK(l2, h2), od, 0, 0, 0);
  od = __builtin_amdgcn_mfma_f32_32x32x16_bf16(pa3, PK(l3, h3), od, 0, 0, 0);
#undef PK
}
DI void pv_d0(f32x16* o, int vb, bf16x8 pa0, bf16x8 pa1, bf16x8 pa2, bf16x8 pa3) {
  pv_one<0>(o[0], vb, pa0, pa1, pa2, pa3); pv_one<1>(o[1], vb, pa0, pa1, pa2, pa3);
}
DI void attn_body(const bf16_t* __restrict__ Qb, const bf16_t* __restrict__ Kh, const bf16_t* __restrict__ Vh, bf16_t* __restrict__ Ob, int seq, char* lds) {
  const int tid = ltid(), wid = tid >> 6, lane = tid & 63, r32 = lane & 31, hi = lane >> 5;
  char* V_lds = lds; char* K_lds = lds + 2 * SHM_V;
  float* ws = (float*)(lds + 2 * SHM_V + 2 * SHM_K) + wid * 64; float* li_l = ws; float* al_l = ws + 32;
  float m_reg = -1e30f, l_reg = 0; f32x16 o[2] = {}; bf16x8 qr[6];
  const bf16_t* Qw = Qb + (long)(wid * QBLK + r32) * LDQ + hi * 8;
#pragma unroll
  for (int d0 = 0; d0 < 6; ++d0) qr[d0] = *reinterpret_cast<const bf16x8*>(Qw + d0 * 16);
  const int kc2 = 512 + (tid & 255);
  const int kr1 = tid / 12, kch1 = tid - kr1 * 12, kr2 = kc2 / 12, kch2 = kc2 - kr2 * 12, vr = tid >> 3, vch = tid & 7;
  const int vst = v_st(vr, vch * 8), kst1 = KSWZ(kr1, kch1 * 16), kst2 = KSWZ(kr2, kch2 * 16);
  const int vb0 = (int)(uintptr_t)V_lds + v_rd_base(lane);
  struct { bf16x8 v, k1, k2; } sr_[2];
#define SLOAD(i, k0) do { sr_[i].v = *reinterpret_cast<const bf16x8*>(&Vh[(long)((k0) + vr) * LDV + vch * 8]); \
    sr_[i].k1 = *reinterpret_cast<const bf16x8*>(&Kh[(long)((k0) + kr1) * LDKK + kch1 * 8]); sr_[i].k2 = *reinterpret_cast<const bf16x8*>(&Kh[(long)((k0) + kr2) * LDKK + kch2 * 8]); } while (0)
#define SWRITE(b, i) do { *(bf16x8*)(V_lds + (b) * SHM_V + vst) = sr_[i].v; *(bf16x8*)(K_lds + (b) * SHM_K + kst1) = sr_[i].k1; *(bf16x8*)(K_lds + (b) * SHM_K + kst2) = sr_[i].k2; } while (0)
#define RESC(a) do { if (__any((a) < 1.f)) { if (hi == 0) al_l[r32] = (a); asm volatile("s_waitcnt lgkmcnt(0)" ::: "memory"); \
    _Pragma("unroll") for (int d = 0; d < 2; ++d) _Pragma("unroll") for (int r = 0; r < 16; ++r) o[d][r] *= al_l[crow(r, hi)]; } } while (0)
  f32x16 pA0, pA1, pB0, pB1; float mnA, mnB, alA, alB; bf16x8 pa0, pa1, pa2, pa3; const int NT = seq / KVBLK;
  constexpr int SE = 0, SO = 1;
  SLOAD(SE, 0); asm volatile("s_waitcnt vmcnt(0)" ::: "memory"); SWRITE(0, SE); __syncthreads();
  qkt(pA0, pA1, K_lds, qr, r32, hi); partialSM(pA0, pA1, m_reg, mnA, alA);
  SLOAD(SO, KVBLK); if (2 < NT) SLOAD(SE, 2 * KVBLK);
  SWRITE(1, SO); __syncthreads();
  for (int j = 1; j + 1 < NT; j += 2) {
    SBAR(); qkt(pB0, pB1, K_lds + SHM_K, qr, r32, hi);
    finishSM(pA0, pA1, alA, l_reg, pa0, pa1, pa2, pa3); SBAR();
    SLOAD(SO, (j + 2) * KVBLK); SBAR();
    pv_d0(o, vb0, pa0, pa1, pa2, pa3); partialSM(pB0, pB1, m_reg, mnB, alB);
    __syncthreads(); SWRITE(0, SE);
    RESC(alB); __syncthreads();
    SBAR(); qkt(pA0, pA1, K_lds, qr, r32, hi);
    finishSM(pB0, pB1, alB, l_reg, pa0, pa1, pa2, pa3); SBAR();
    if (j + 3 < NT) SLOAD(SE, (j + 3) * KVBLK); SBAR();
    pv_d0(o, vb0 + SHM_V, pa0, pa1, pa2, pa3); partialSM(pA0, pA1, m_reg, mnA, alA);
    __syncthreads(); SWRITE(1, SO);
    RESC(alA); __syncthreads();
  }
  SBAR(); qkt(pB0, pB1, K_lds + SHM_K, qr, r32, hi);
  finishSM(pA0, pA1, alA, l_reg, pa0, pa1, pa2, pa3); SBAR();
  pv_d0(o, vb0, pa0, pa1, pa2, pa3); partialSM(pB0, pB1, m_reg, mnB, alB);
  __syncthreads(); RESC(alB);
  finishSM(pB0, pB1, alB, l_reg, pa0, pa1, pa2, pa3); SBAR();
  pv_d0(o, vb0 + SHM_V, pa0, pa1, pa2, pa3);
  if (hi == 0) li_l[r32] = l_reg; asm volatile("s_waitcnt lgkmcnt(0)" ::: "memory");
  float rli[16];
#pragma unroll
  for (int r = 0; r < 16; ++r) rli[r] = __builtin_amdgcn_rcpf(li_l[crow(r, hi)]);
  bf16_t* Ow = Ob + (long)(wid * QBLK) * LDO;
#pragma unroll
  for (int r = 0; r < 16; ++r) { const int orow = crow(r, hi);
#pragma unroll
    for (int d0 = 0; d0 < 2; ++d0) Ow[(long)orow * LDO + d0 * 32 + r32] = f2bf(o[d0][r] * rli[r]); }
#undef SLOAD
#undef SWRITE
#undef RESC
}
}

DI void phase_attn(const bf16_t* Q, const bf16_t* KA, const bf16_t* VA, bf16_t* MIX, bool last, char* lds) {
    const int c = blockIdx.x, G = gridDim.x, NU = 2048 + (last ? 0 : 256);
    for (int L = c; L < NU; L += G) {
        int bh, seq; long qrow0;
        if (L < 2048) { int qb;
            if (G == 256) { const int i = L >> 8, cc = L & 255, xcd = cc & 7, slot = cc >> 3; bh = i * 32 + xcd * 4 + (slot >> 3); qb = slot & 7; }
            else { bh = L >> 3; qb = L & 7; }
            qrow0 = (long)(bh >> 3) * TT + TC + qb * 256; seq = TT; }
        else { bh = L - 2048; qrow0 = (long)(bh >> 3) * TT; seq = TC; }
        const int b = bh >> 3, h = bh & 7;
        att::attn_body(Q + qrow0 * 768 + h * 96, KA + (long)b * TT * 768 + h * 96, VA + (long)b * TT * 512 + h * 64, MIX + qrow0 * 1024 + h * 64, seq, lds);
        __syncthreads();
    }
}

DI float rowsum16(float x) {
    x += __int_as_float(__builtin_amdgcn_update_dpp(0, __float_as_int(x), 0x128, 0xf, 0xf, false));
    x += __int_as_float(__builtin_amdgcn_update_dpp(0, __float_as_int(x), 0x124, 0xf, 0xf, false));
    x += __int_as_float(__builtin_amdgcn_update_dpp(0, __float_as_int(x), 0x122, 0xf, 0xf, false));
    x += __int_as_float(__builtin_amdgcn_update_dpp(0, __float_as_int(x), 0x121, 0xf, 0xf, false));
    return x;
}
#define RS8_STEP(R) "v_add_f32_dpp %0, %0, %0 " R " row_mask:0xf bank_mask:0xf\n\tv_add_f32_dpp %1, %1, %1 " R " row_mask:0xf bank_mask:0xf\n\t" \
                    "v_add_f32_dpp %2, %2, %2 " R " row_mask:0xf bank_mask:0xf\n\tv_add_f32_dpp %3, %3, %3 " R " row_mask:0xf bank_mask:0xf\n\t" \
                    "v_add_f32_dpp %4, %4, %4 " R " row_mask:0xf bank_mask:0xf\n\tv_add_f32_dpp %5, %5, %5 " R " row_mask:0xf bank_mask:0xf\n\t" \
                    "v_add_f32_dpp %6, %6, %6 " R " row_mask:0xf bank_mask:0xf\n\tv_add_f32_dpp %7, %7, %7 " R " row_mask:0xf bank_mask:0xf\n\t"
DI void sum8x8(float& x0, float& x1, float& x2, float& x3, float& x4, float& x5, float& x6, float& x7) {
    asm volatile("s_nop 1\n\t" RS8_STEP("quad_perm:[1,0,3,2]") RS8_STEP("quad_perm:[2,3,0,1]") RS8_STEP("row_half_mirror")
                 : "+v"(x0), "+v"(x1), "+v"(x2), "+v"(x3), "+v"(x4), "+v"(x5), "+v"(x6), "+v"(x7));
}
typedef float f32x2 __attribute__((ext_vector_type(2)));
DI float dot8(const f32x2 (&s)[4], const f32x4& x0, const f32x4& x1) {
    f32x2 t = s[0] * (f32x2){x0[0], x0[1]};
    t = __builtin_elementwise_fma(s[1], (f32x2){x0[2], x0[3]}, t);
    t = __builtin_elementwise_fma(s[2], (f32x2){x1[0], x1[1]}, t);
    t = __builtin_elementwise_fma(s[3], (f32x2){x1[2], x1[3]}, t);
    return t.x + t.y;
}
DI int scan_row(int d, int b, int n) { const int tt = d == 0 ? n : (n < TC ? TC - 1 - n : TT + TC - 1 - n); return b * TT + tt; }
typedef __bf16 bf16x2n __attribute__((ext_vector_type(2)));
DI unsigned cvtpk_n(float lo, float hi) { f32x2 v = {lo, hi}; bf16x2n b = __builtin_convertvector(v, bf16x2n); return __builtin_bit_cast(unsigned, b); }
DI bf16x8 pack_acc(const f32x16& x, int s) {
    u32x4 w; w.x = cvtpk_n(x[8 * s], x[8 * s + 1]); w.y = cvtpk_n(x[8 * s + 2], x[8 * s + 3]); w.z = cvtpk_n(x[8 * s + 4], x[8 * s + 5]); w.w = cvtpk_n(x[8 * s + 6], x[8 * s + 7]);
    return __builtin_bit_cast(bf16x8, w);
}
constexpr int SREC = 264;
struct ScanStep { bf16x8 f[4]; float b0, k0, b1, k1, v; f32x4 brp, krp; };
DI void scan_ld(ScanStep& t, const float* rec, const char* zimg, int fragoff, bool isaq, int h, int m, int vrow) {
    const char* fp = isaq ? (const char*)(rec + fragoff) + h * 16 : zimg + h * 16;
#pragma unroll
    for (int q = 0; q < 4; ++q) t.f[q] = *(const bf16x8*)(fp + q * 32);
    t.b0 = rec[64 + m]; t.k0 = rec[128 + m]; t.b1 = rec[96 + m]; t.k1 = rec[160 + m]; t.v = rec[192 + vrow]; t.brp = *(const f32x4*)(rec + 256); t.krp = *(const f32x4*)(rec + 260);
}
DI void phase_scan(const bf16_t* R, const bf16_t* Kk, const bf16_t* V, const __half* DEC, const bf16_t* AA, const float* INV, const float* kkp, const float* kap,
                   bf16_t* MIX, bf16_t* YB, char* lds) {
    const int tid = ltid(); const bool consumer = tid < 256;
    float* bufA = (float*)lds; float* ybufA = (float*)(lds + 98304); char* zimg = lds + 114688;
    if (tid < 32) ((float*)zimg)[tid] = 0.f;
    constexpr int NCH = TT / 16;
    for (int s0 = blockIdx.x * 2; s0 < 512; s0 += gridDim.x * 2) {
        const int p_ = tid & 255, pst = p_ & 15, pj0 = (p_ >> 4) * 4, pw = p_ >> 6;
        const int cw = tid >> 6, cgrp = (cw >> 1) & 1, ws_ = cw & 1, lane = tid & 63, m = lane & 31, h = lane >> 5, vrow = ws_ * 32 + m;
        const bool isaq = (m & ~5) == 0;
        const int fragoff = (m & 1) ? 32 : 0;
        f32x16 acc0, acc1, zero16;
#pragma unroll
        for (int r = 0; r < 16; ++r) { acc0[r] = 0.f; acc1[r] = 0.f; zero16[r] = 0.f; }
        const int jl_ = pj0 & 31, rem_ = jl_ & 15, imgoff = ((((pj0 >> 5) * 2 + (jl_ >> 4)) * 2 + ((rem_ >> 2) & 1)) * 16 + ((rem_ >> 3) << 2) * 2) >> 2;
        u32x2 lr[2], lk[2], lv[2], la[2], ld0[2]; float linv[2];
#define PLOAD(c) do { _Pragma("unroll") for (int gq = 0; gq < 2; ++gq) { \
            const int sid = s0 + gq, d = sid >> 8, b = (sid >> 3) & 31, hh = sid & 7, hc = hh * 64 + pj0; \
            const size_t m_ = (size_t)scan_row(d, b, (c) * 16 + pst); \
            lr[gq] = *(const u32x2*)(R + m_ * 512 + hc); lk[gq] = *(const u32x2*)(Kk + m_ * 512 + hc); lv[gq] = *(const u32x2*)(V + m_ * 512 + hc); \
            la[gq] = *(const u32x2*)(AA + m_ * 1024 + d * 512 + hc); linv[gq] = INV[m_ * 8 + hh]; ld0[gq] = *(const u32x2*)(DEC + m_ * 1024 + d * 512 + hc); } } while (0)
#define PFX(L, e) do { L = (e); \
            L += __int_as_float(__builtin_amdgcn_update_dpp(0, __float_as_int(L), 0x111, 0xf, 0xf, true)); L += __int_as_float(__builtin_amdgcn_update_dpp(0, __float_as_int(L), 0x112, 0xf, 0xf, true)); \
            L += __int_as_float(__builtin_amdgcn_update_dpp(0, __float_as_int(L), 0x114, 0xf, 0xf, true)); L += __int_as_float(__builtin_amdgcn_update_dpp(0, __float_as_int(L), 0x118, 0xf, 0xf, true)); } while (0)
#define WSUM4(x) do { x += __shfl_xor(x, 16, 64); const auto sw_ = __builtin_amdgcn_permlane32_swap(__float_as_uint(x), __float_as_uint(x), false, false); x = __uint_as_float(sw_[0]) + __uint_as_float(sw_[1]); } while (0)
#define PWRITE(bsel) do { _Pragma("unroll") for (int gq = 0; gq < 2; ++gq) { \
            const int sid = s0 + gq, hh = sid & 7, hc = hh * 64 + pj0; \
            const float l0 = h2f(ld0[gq].x & 0xffffu), l1 = h2f(ld0[gq].x >> 16), l2 = h2f(ld0[gq].y & 0xffffu), l3 = h2f(ld0[gq].y >> 16); \
            float L0, L1, L2, L3; PFX(L0, l0); PFX(L1, l1); PFX(L2, l2); PFX(L3, l3); \
            const f32x4 kk4 = *(const f32x4*)(kkp + hc), ka4 = *(const f32x4*)(kap + hc); \
            float* rec_ = bufA + gq * 12288 + (bsel) * 6144 + pst * SREC; \
            const float k0 = bflo(lk[gq].x), k1 = bfhi(lk[gq].x), k2 = bflo(lk[gq].y), k3 = bfhi(lk[gq].y), a0 = bflo(la[gq].x), a1 = bfhi(la[gq].x), a2 = bflo(la[gq].y), a3 = bfhi(la[gq].y); \
            const float q0 = k0 * kk4[0] * linv[gq], q1 = k1 * kk4[1] * linv[gq], q2 = k2 * kk4[2] * linv[gq], q3 = k3 * kk4[3] * linv[gq]; \
            const float W0 = __builtin_amdgcn_exp2f(L0), W1 = __builtin_amdgcn_exp2f(L1), W2 = __builtin_amdgcn_exp2f(L2), W3 = __builtin_amdgcn_exp2f(L3); \
            const float P0 = __builtin_amdgcn_exp2f(L0 - l0), P1 = __builtin_amdgcn_exp2f(L1 - l1), P2 = __builtin_amdgcn_exp2f(L2 - l2), P3 = __builtin_amdgcn_exp2f(L3 - l3); \
            const float I0 = __builtin_amdgcn_exp2f(-L0), I1 = __builtin_amdgcn_exp2f(-L1), I2 = __builtin_amdgcn_exp2f(-L2), I3 = __builtin_amdgcn_exp2f(-L3); \
            const float r0 = bflo(lr[gq].x), r1 = bfhi(lr[gq].x), r2 = bflo(lr[gq].y), r3 = bfhi(lr[gq].y); \
            const float b0 = q0 * a0, b1 = q1 * a1, b2 = q2 * a2, b3 = q3 * a3; \
            const float d0 = k0 * (1.f + (a0 - 1.f) * ka4[0]), d1 = k1 * (1.f + (a1 - 1.f) * ka4[1]), d2 = k2 * (1.f + (a2 - 1.f) * ka4[2]), d3 = k3 * (1.f + (a3 - 1.f) * ka4[3]); \
            { u32x2 w_; w_.x = cvtpk_n(-q0 * P0, -q1 * P1); w_.y = cvtpk_n(-q2 * P2, -q3 * P3); *(u32x2*)(rec_ + imgoff) = w_; } \
            { u32x2 w_; w_.x = cvtpk_n(r0 * W0, r1 * W1); w_.y = cvtpk_n(r2 * W2, r3 * W3); *(u32x2*)(rec_ + 32 + imgoff) = w_; } \
            *(f32x4*)(rec_ + 64 + pj0) = (f32x4){b0 * I0, b1 * I1, b2 * I2, b3 * I3}; \
            *(f32x4*)(rec_ + 128 + pj0) = (f32x4){d0 * I0, d1 * I1, d2 * I2, d3 * I3}; \
            *(f32x4*)(rec_ + 192 + pj0) = (f32x4){bflo(lv[gq].x), bfhi(lv[gq].x), bflo(lv[gq].y), bfhi(lv[gq].y)}; \
            float br_ = b0 * r0 + b1 * r1 + b2 * r2 + b3 * r3, kr_ = d0 * r0 + d1 * r1 + d2 * r2 + d3 * r3; WSUM4(br_); WSUM4(kr_); \
            if ((p_ & 48) == 0) { rec_[256 + pw] = br_; rec_[260 + pw] = kr_; } \
            if (pst == 15) *(f32x4*)(bufA + gq * 12288 + (bsel) * 6144 + 16 * SREC + pj0) = (f32x4){W0, W1, W2, W3}; } } while (0)
#define LBAR() asm volatile("s_waitcnt lgkmcnt(0)\n\ts_barrier" ::: "memory")
#define OUTPUT(c, bsel) do { _Pragma("unroll") for (int gq = 0; gq < 2; ++gq) { \
            const int sid = s0 + gq, d = sid >> 8, b = (sid >> 3) & 31, hh = sid & 7, hc = hh * 64 + pj0; \
            const f32x4 yv = *(const f32x4*)(ybufA + gq * 2048 + (bsel) * 1024 + pst * 64 + pj0); const size_t m_ = (size_t)scan_row(d, b, (c) * 16 + pst); \
            u32x2 w; w.x = cvtpk(yv[0], yv[1]); w.y = cvtpk(yv[2], yv[3]); \
            if (d == 0) *(u32x2*)(MIX + m_ * 1024 + 512 + hc) = w; else *(u32x2*)(YB + m_ * 512 + hc) = w; } } while (0)
        if (!consumer) { PLOAD(0); PWRITE(0); PLOAD(1); }
        LBAR();
        if (consumer) __builtin_amdgcn_s_setprio(3);
        for (int c = 0; c < NCH; ++c) {
            if (consumer) {
                const float* cur = bufA + cgrp * 12288 + (c & 1) * 6144; float* yb = ybufA + cgrp * 2048 + (c & 1) * 1024;
                ScanStep t; scan_ld(t, cur, zimg, fragoff, isaq, h, m, vrow);
#pragma unroll 2
                for (int st = 0; st < 16; ++st) {
                    f32x16 d0 = __builtin_amdgcn_mfma_f32_32x32x16_bf16(t.f[0], pack_acc(acc0, 0), zero16, 0, 0, 0);
                    d0 = __builtin_amdgcn_mfma_f32_32x32x16_bf16(t.f[1], pack_acc(acc0, 1), d0, 0, 0, 0);
                    d0 = __builtin_amdgcn_mfma_f32_32x32x16_bf16(t.f[2], pack_acc(acc1, 0), d0, 0, 0, 0);
                    d0 = __builtin_amdgcn_mfma_f32_32x32x16_bf16(t.f[3], pack_acc(acc1, 1), d0, 0, 0, 0);
                    __builtin_amdgcn_sched_barrier(0);
                    ScanStep n; scan_ld(n, cur + (st + 1) * SREC, zimg, fragoff, isaq, h, m, vrow);
                    __builtin_amdgcn_sched_barrier(0);
                    const float sa = d0[0], z = d0[1];
                    yb[st * 64 + vrow] = z + sa * ((t.brp[0] + t.brp[1]) + (t.brp[2] + t.brp[3])) + t.v * ((t.krp[0] + t.krp[1]) + (t.krp[2] + t.krp[3]));
                    const unsigned hz = h ? 0u : 0xffffffffu;
                    const u32x4 ua0 = {cvtpk_n(t.b0, t.k0) & hz, 0u, 0u, 0u}, ua1 = {cvtpk_n(t.b1, t.k1) & hz, 0u, 0u, 0u}, ub = {cvtpk_n(sa, t.v) & hz, 0u, 0u, 0u};
                    acc0 = __builtin_amdgcn_mfma_f32_32x32x16_bf16(__builtin_bit_cast(bf16x8, ua0), __builtin_bit_cast(bf16x8, ub), acc0, 0, 0, 0);
                    acc1 = __builtin_amdgcn_mfma_f32_32x32x16_bf16(__builtin_bit_cast(bf16x8, ua1), __builtin_bit_cast(bf16x8, ub), acc1, 0, 0, 0);
                    t = n;
                }
                const float* wc = cur + 16 * SREC;
#pragma unroll
                for (int g_ = 0; g_ < 4; ++g_) { const f32x4 w0 = *(const f32x4*)(wc + 8 * g_ + 4 * h), w1 = *(const f32x4*)(wc + 32 + 8 * g_ + 4 * h);
#pragma unroll
                    for (int e = 0; e < 4; ++e) { acc0[4 * g_ + e] *= w0[e]; acc1[4 * g_ + e] *= w1[e]; } }
            } else {
                if (c + 1 < NCH) PWRITE((c + 1) & 1);
                if (c + 2 < NCH) PLOAD(c + 2);
                if (c > 0) OUTPUT(c - 1, (c - 1) & 1);
            }
            LBAR();
        }
        __builtin_amdgcn_s_setprio(0);
        if (!consumer) OUTPUT(NCH - 1, (NCH - 1) & 1);
        __syncthreads();
#undef LBAR
#undef PLOAD
#undef PWRITE
#undef PFX
#undef WSUM4
#undef OUTPUT
    }
}

DI void phase_prologue(const Args& a, unsigned char* lds) {
    const int tid = ltid(), G = gridDim.x;
    float* out = a.out; float* xc = (float*)(a.ws + WS_XC);
    if (blockIdx.x == 0) {
        float* rope = (float*)(a.ws + WS_ROPE); const int pos = tid >> 3, j = tid & 7;
        const float inv_freq = powf(10000.f, -(float)j / 8.f), ang = (float)pos * inv_freq;
        rope[tid] = cosf(ang); rope[512 + tid] = sinf(ang);
    }
    float* sv = (float*)lds; float* red = sv + 33 * 1024;
    for (int i = tid; i < 33 * 1024; i += 512) { const float v = i < 32 * 1024 ? a.in[I_C][i] : a.in[I_CCTX][i - 32 * 1024]; sv[i] = v / (1.f + __expf(-v)); }
    __syncthreads();
    const int wave = tid >> 6, lane = tid & 63;
    float* mods = (float*)(a.ws + WS_MODS);
    for (int it = blockIdx.x; it < NL * 96; it += G) {
        const int l = it / 96, n0 = (it - l * 96) * 64;
        const float* w = a.in[I_ADAW] + (size_t)l * 1024 * 6144 + n0 + lane;
        float acc[33];
#pragma unroll
        for (int r = 0; r < 33; ++r) acc[r] = 0.f;
        for (int k = wave * 128; k < wave * 128 + 128; k += 8) { float wv[8];
#pragma unroll
            for (int u = 0; u < 8; ++u) wv[u] = w[(size_t)(k + u) * 6144];
#pragma unroll
            for (int u = 0; u < 8; ++u)
#pragma unroll
                for (int r = 0; r < 33; ++r) acc[r] += sv[r * 1024 + k + u] * wv[u]; }
        for (int i = tid; i < 33 * 64; i += 512) red[i] = 0.f;
        __syncthreads();
        for (int ww = 0; ww < 8; ++ww) { if (wave == ww) {
#pragma unroll
                for (int r = 0; r < 33; ++r) red[r * 64 + lane] += acc[r]; }
            __syncthreads(); }
        for (int i = tid; i < 33 * 64; i += 512) { const int r = i >> 6, n = n0 + (i & 63); mods[((size_t)l * 33 + r) * 6144 + n] = red[i] + a.in[I_ADAB][l * 6144 + n]; }
        __syncthreads();
    }
}

DI void phase_vectors(const Args& a, unsigned char* lds) {
    const int tid = ltid(), G = gridDim.x, wave = tid >> 6, lane = tid & 63;
    const float* mods = (const float*)(a.ws + WS_MODS);
    float* gp1 = (float*)(a.ws + WS_GP1); float* gp2 = (float*)(a.ws + WS_GP2);
    for (int i = blockIdx.x * 512 + tid; i < NL * 33 * 1024; i += G * 512) { const int c = i & 1023, lr = i >> 10, l = lr / 33;
        gp1[i] = a.in[I_N1G][l * 1024 + c] * (1.f + mods[(size_t)lr * 6144 + 1024 + c]); gp2[i] = a.in[I_N2G][l * 1024 + c] * (1.f + mods[(size_t)lr * 6144 + 4 * 1024 + c]); }
    float* sv = (float*)lds; float* red = sv + 33 * 1024;
    for (int it = blockIdx.x; it < NL * 101; it += G) {
        const int l = it / 101, ci = it - l * 101, which = ci < 37 ? 0 : 1, n0 = (which ? ci - 37 : ci) * 64, n = n0 + lane;
        __syncthreads();
        for (int i = tid; i < 33 * 1024; i += 512) sv[i] = mods[((size_t)l * 33 + (i >> 10)) * 6144 + (which ? 3 * 1024 : 0) + (i & 1023)];
        for (int i = tid; i < 33 * 64; i += 512) red[i] = 0.f;
        __syncthreads();
        const float* w; int ld; float live = 1.f;
        if (which) { w = a.in[I_M1] + (size_t)l * 1024 * 4096 + n; ld = 4096; }
        else if (n < CIN) { w = a.in[I_WIN] + (size_t)l * 1024 * CIN + n; ld = CIN; }
        else if (n < CINX && l > 0) { w = a.in[I_V1] + (size_t)(l - 1) * 1024 * 32 + (n - CIN); ld = 32; }
        else { w = a.in[I_WIN]; ld = 0; live = 0.f; }
        float acc[33];
#pragma unroll
        for (int r = 0; r < 33; ++r) acc[r] = 0.f;
        for (int k = wave * 128; k < wave * 128 + 128; k += 8) { float wv[8];
#pragma unroll
            for (int u = 0; u < 8; ++u) wv[u] = w[(size_t)(k + u) * ld] * live;
#pragma unroll
            for (int u = 0; u < 8; ++u)
#pragma unroll
                for (int r = 0; r < 33; ++r) acc[r] += sv[r * 1024 + k + u] * wv[u]; }
        for (int ww = 0; ww < 8; ++ww) { if (wave == ww) {
#pragma unroll
                for (int r = 0; r < 33; ++r) red[r * 64 + lane] += acc[r]; }
            __syncthreads(); }
        float* outp = which ? (float*)(a.ws + WS_C2) + (size_t)l * 33 * DFF : (float*)(a.ws + WS_C1) + (size_t)l * 33 * NIN; const int ldo = which ? DFF : NIN;
        for (int i = tid; i < 33 * 64; i += 512) outp[(size_t)(i >> 6) * ldo + n0 + (i & 63)] = red[i];
    }
    {
        const int gw = blockIdx.x * 8 + wave, nw = G * 8; bf16_t* __restrict__ H = (bf16_t*)(a.ws + WS_H); float* __restrict__ rsa = (float*)(a.ws + WS_RSA); const float* __restrict__ gamma = a.in[I_N1G];
        for (int m = gw; m < TALL; m += nw) { const int b = m / TT, tt = m - b * TT; const bool ctx = tt < TC;
            const float* xr = ctx ? a.in[I_CTX] + (size_t)(b * TC + tt) * DM : a.in[I_X] + (size_t)(b * SEQ + tt - TC) * DM; const float* md = mods + (size_t)(ctx ? 32 : b) * 6144 + 1024;
            f32x4 v[4]; float ss = 0.f;
#pragma unroll
            for (int q = 0; q < 4; ++q) { v[q] = *(const f32x4*)(xr + q * 256 + lane * 4); ss += v[q][0] * v[q][0] + v[q][1] * v[q][1] + v[q][2] * v[q][2] + v[q][3] * v[q][3]; }
#pragma unroll
            for (int k = 1; k < 64; k <<= 1) ss = xorsum(ss, k);
            if (lane == 0) rsa[m] = ss;
#pragma unroll
            for (int q = 0; q < 4; ++q) { const int col = q * 256 + lane * 4; const f32x4 g = *(const f32x4*)(gamma + col), sc = *(const f32x4*)(md + col);
                u32x2 w; w.x = cvtpk(v[q][0] * g[0] * (1.f + sc[0]), v[q][1] * g[1] * (1.f + sc[1])); w.y = cvtpk(v[q][2] * g[2] * (1.f + sc[2]), v[q][3] * g[3] * (1.f + sc[3]));
                *(u32x2*)(H + (size_t)m * 1024 + col) = w; } }
    }
}

template <class Gt> DI void cvt_tile(bf16_t* __restrict__ dst, int ldk, int n0, int k0, const Gt& get, float*) {
    const int lane = ltid() & 63, n = n0 + lane;
#pragma unroll
    for (int ch = 0; ch < 4; ++ch) { float v[16];
#pragma unroll
        for (int kk = 0; kk < 16; ++kk) v[kk] = get(n, k0 + ch * 16 + kk);
        u32x4 w0, w1; w0.x = cvtpk(v[0], v[1]); w0.y = cvtpk(v[2], v[3]); w0.z = cvtpk(v[4], v[5]); w0.w = cvtpk(v[6], v[7]);
        w1.x = cvtpk(v[8], v[9]); w1.y = cvtpk(v[10], v[11]); w1.z = cvtpk(v[12], v[13]); w1.w = cvtpk(v[14], v[15]);
        bf16_t* p = dst + (size_t)n * ldk + k0 + ch * 16; *(u32x4*)p = w0; *(u32x4*)(p + 8) = w1; }
}
DI void convert_weights(const Args& a, int l, unsigned char* lds, int group) {
    float* tl = (float*)lds; unsigned char* ws = a.ws;
    const float* w_in = a.in[I_WIN] + (size_t)l * 1024 * CIN; const float* v1 = a.in[I_V1] + (size_t)(l > 0 ? l - 1 : 0) * 1024 * 32;
    const float* w_uq = a.in[I_WUQ] + (size_t)l * 256 * 768; const float* w_ukv = a.in[I_WUKV] + (size_t)l * 128 * 1024;
    const float* w2 = a.in[I_W2] + (size_t)l * 2 * 64 * 512; const float* a2 = a.in[I_A2] + (size_t)l * 2 * 64 * 512;
    const float* g2 = a.in[I_G2] + (size_t)l * 128 * 512; const float* v2 = a.in[I_V2] + (size_t)(l > 0 ? l - 1 : 0) * 32 * 512;
    const float* w_out = a.in[I_WOUT] + (size_t)l * 1024 * 1024; const float* m1 = a.in[I_M1] + (size_t)l * 1024 * 4096; const float* m2 = a.in[I_M2] + (size_t)l * 4096 * 1024;
    constexpr int T0 = 640, T1 = T0 + 48, T2 = T1 + 64, T3 = T2 + 128, T4 = T3 + 64, T5 = T4 + 256, T6 = T5 + 1024, T7 = T6 + 1024;
    const int tb = group == 0 ? 0 : T4, te = group == 0 ? T4 : T7;
    for (int t = tb + blockIdx.x * 8 + (ltid() >> 6); t < te; t += gridDim.x * 8) {
        if (t < T0) { const int nt = t >> 4, kt = t & 15;
            cvt_tile((bf16_t*)(ws + WT_IN), 1024, nt * 64, kt * 64, [&](int n, int k) -> float { return n < CIN ? w_in[(size_t)k * CIN + n] : ((n < CINX && l > 0) ? v1[k * 32 + (n - CIN)] : 0.f); }, tl); }
        else if (t < T1) { const int u = t - T0, nt = u >> 2, kt = u & 3;
            cvt_tile((bf16_t*)(ws + WT_UQ), 256, nt * 64, kt * 64, [&](int n, int k) -> float { return w_uq[k * 768 + n]; }, tl); }
        else if (t < T2) { const int u = t - T1, nt = u >> 2, kt = u & 3;
            if (kt < 2) cvt_tile((bf16_t*)(ws + WT_UKV), 128, nt * 64, kt * 64, [&](int n, int k) -> float { return w_ukv[k * 1024 + n]; }, tl); }
        else if (t < T3) { const int u = t - T2, nt = u >> 2, kt = u & 3;
            cvt_tile((bf16_t*)(ws + WT_L1), 256, nt * 64, kt * 64, [&](int n, int k) -> float {
                if (n < 1024) { const int d = n >> 9, c = n & 511; return (k < 128 && (k >> 6) == d) ? w2[(d * 64 + (k & 63)) * 512 + c] : 0.f; }
                const int n2 = n - 1024, d = n2 >> 9, c = n2 & 511; return (k >= 128 && ((k - 128) >> 6) == d) ? a2[(d * 64 + ((k - 128) & 63)) * 512 + c] : 0.f; }, tl); }
        else if (t < T4) { const int u = t - T3, nt = u >> 2, kt = u & 3;
            cvt_tile((bf16_t*)(ws + WT_L2), 256, nt * 64, kt * 64, [&](int n, int k) -> float {
                if (n < 512) return k < 128 ? g2[k * 512 + n] : 0.f;
                return (l > 0 && k >= 128 && k < 160) ? v2[(k - 128) * 512 + (n - 512)] : 0.f; }, tl); }
        else if (t < T5) { const int u = t - T4, nt = u >> 4, kt = u & 15;
            cvt_tile((bf16_t*)(ws + WT_OUT), 1024, nt * 64, kt * 64, [&](int n, int k) -> float { return w_out[(size_t)k * 1024 + n]; }, tl); }
        else if (t < T6) { const int u = t - T5, nt = u >> 4, kt = u & 15;
            cvt_tile((bf16_t*)(ws + WT_M1), 1024, nt * 64, kt * 64, [&](int n, int k) -> float { return m1[(size_t)k * 4096 + n]; }, tl); }
        else { const int u = t - T6, nt = u >> 6, kt = u & 63;
            cvt_tile((bf16_t*)(ws + WT_M2), 4096, nt * 64, kt * 64, [&](int n, int k) -> float { return m2[(size_t)k * 1024 + n]; }, tl); }
    }
}

DI void unpack8(const u32x4& w, float (&f)[8]) { f[0] = bflo(w.x); f[1] = bfhi(w.x); f[2] = bflo(w.y); f[3] = bfhi(w.y); f[4] = bflo(w.z); f[5] = bfhi(w.z); f[6] = bflo(w.w); f[7] = bfhi(w.w); }
DI void shift8r(const u32x4& c_, const u32x4& p_, const u32x4& n_, const float* __restrict__ mu, int col, float (&o)[8]) {
    float c[8], p[8], n[8], u[8]; unpack8(c_, c); unpack8(p_, p); unpack8(n_, n); loadf8(mu + (col - OFF_R), u);
#pragma unroll
    for (int j = 0; j < 8; ++j) o[j] = c[j] + u[j] * (0.5f * (p[j] + n[j]) - c[j]);
}
DI void phase_split(const Args& a, int l) {
    const int lane = ltid() & 63, gw = blockIdx.x * 8 + (ltid() >> 6), nw = gridDim.x * 8;
    unsigned char* ws = a.ws;
    const bf16_t* __restrict__ F = (const bf16_t*)(ws + WS_F); bf16_t* __restrict__ R = (bf16_t*)(ws + WS_R); bf16_t* __restrict__ Kb = (bf16_t*)(ws + WS_K); bf16_t* __restrict__ Vb = (bf16_t*)(ws + (l == 0 ? WS_VF : WS_V));
    bf16_t* __restrict__ A1 = (bf16_t*)(ws + WS_A1); bf16_t* __restrict__ A2 = (bf16_t*)(ws + WS_A2); bf16_t* __restrict__ CQN = (bf16_t*)(ws + WS_CQN); bf16_t* __restrict__ CKVN = (bf16_t*)(ws + WS_CKVN); bf16_t* __restrict__ KA = (bf16_t*)(ws + WS_KATT);
    float* __restrict__ INV = (float*)(ws + WS_INV); const float* __restrict__ rope = (const float*)(ws + WS_ROPE);
    const float* __restrict__ mu = a.in[I_MU] + (size_t)l * 1920; const float* __restrict__ kkp = a.in[I_KK] + l * 512; const float* __restrict__ qg = a.in[I_QNG] + l * 256; const float* __restrict__ kvg = a.in[I_KVNG] + l * 128;
    const u32x4 zero4 = {0u, 0u, 0u, 0u};
    const int lcol = lane < 48 ? OFF_WLO + lane * 8 : (lane < 52 ? OFF_HV + (lane - 48) * 8 : 0);
    const int mcol = lane < 32 ? lane * 8 : (lane < 48 ? 256 + (lane - 32) * 8 : 384 + ((lane - 48) & 3) * 8);
    const int chunk = (TALL + nw - 1) / nw, m0 = gw * chunk, m1 = (m0 + chunk < TALL) ? m0 + chunk : TALL;
    struct Raw { u32x4 r, k, v, l; };
    auto ld4 = [&](int m) -> Raw { Raw t; if (m >= 0 && m < TALL) { const bf16_t* Fq = F + (size_t)m * CINX; t.r = *(const u32x4*)(Fq + OFF_R + lane * 8); t.k = *(const u32x4*)(Fq + OFF_K + lane * 8);
            t.v = *(const u32x4*)(Fq + OFF_V + lane * 8); t.l = (lane < 52) ? *(const u32x4*)(Fq + lcol) : zero4; } else { t.r = zero4; t.k = zero4; t.v = zero4; t.l = zero4; } return t; };
    auto ldm = [&](int m) -> u32x4 { return (m < TALL) ? *(const u32x4*)(F + (size_t)m * CINX + mcol) : zero4; };
    Raw P = ld4(m0 - 1), C = ld4(m0), N = ld4(m0 + 1); u32x4 M = ldm(m0);
    for (int m = m0; m < m1; ++m) {
        const int b = m / TT, tt = m - b * TT; const bool ctx = tt < TC;
        const bool pok = !(tt == 0 || tt == TC), nok = !(tt == TC - 1 || tt == TT - 1);
        const Raw NN = ld4(m + 2); const u32x4 MN = ldm(m + 1);
        u32x4 rc = C.r, kc = C.k, vc = C.v, lc = C.l, rp = P.r, kp = P.k, vp = P.v, lp = P.l, rn = N.r, kn = N.k, vn = N.v, ln = N.l; const u32x4 mc = M;
        if (!pok) { rp = zero4; kp = zero4; vp = zero4; lp = zero4; }
        if (!nok) { rn = zero4; kn = zero4; vn = zero4; ln = zero4; }
        P = C; C = N; N = NN; M = MN;
        float x[8];
        shift8r(rc, rp, rn, mu, OFF_R + lane * 8, x); store8(R + (size_t)m * 512 + lane * 8, x);
        shift8r(kc, kp, kn, mu, OFF_K + lane * 8, x); store8(Kb + (size_t)m * 512 + lane * 8, x);
        { float kq[8], ss = 0.f; loadf8(kkp + lane * 8, kq);
#pragma unroll
          for (int j = 0; j < 8; ++j) { const float t = x[j] * kq[j]; ss += t * t; }
          ss = xorsum(ss, 1); ss = xorsum(ss, 2); ss = xorsum(ss, 4);
          if ((lane & 7) == 0) INV[(size_t)m * 8 + (lane >> 3)] = rsqrtf(fmaxf(ss, 1e-24f)); }
        shift8r(vc, vp, vn, mu, OFF_V + lane * 8, x); store8(Vb + (size_t)m * 512 + lane * 8, x);
        if (lane < 48) { shift8r(lc, lp, ln, mu, lcol, x);
            if (lane < 16) {
#pragma unroll
                for (int j = 0; j < 8; ++j) x[j] = tanhf_(x[j]); }
            else if (lane >= 32) {
#pragma unroll
                for (int j = 0; j < 8; ++j) x[j] = sigmoidf_(x[j]); }
            if (lane < 32) store8(A1 + (size_t)m * 256 + lane * 8, x); else store8(A2 + (size_t)m * 256 + (lane - 32) * 8, x); }
        else { unpack8(lc, x); store8(A2 + (size_t)m * 256 + 128 + (lane - 48) * 8, x); }
        { unpack8(mc, x); float ss = 0.f;
#pragma unroll
          for (int j = 0; j < 8; ++j) ss += x[j] * x[j];
          ss = xorsum(ss, 1); ss = xorsum(ss, 2); ss = xorsum(ss, 4); ss = xorsum(ss, 8); const float ss32 = xorsum(ss, 16);
          float px[8]; const int q = (lane - 48) & 3;
#pragma unroll
          for (int j = 0; j < 8; ++j) px[j] = __shfl_xor(x[j], 1, 64);
          if (lane < 32) { const float rstd = rsqrtf(ss32 * (1.f / 256.f) + 1e-6f); float g[8]; loadf8(qg + lane * 8, g);
#pragma unroll
              for (int j = 0; j < 8; ++j) x[j] = x[j] * rstd * g[j];
              store8(CQN + (size_t)m * 256 + lane * 8, x); }
          else if (lane < 48) { const float rstd = rsqrtf(ss * (1.f / 128.f) + 1e-6f); float g[8]; loadf8(kvg + (lane - 32) * 8, g);
#pragma unroll
              for (int j = 0; j < 8; ++j) x[j] = x[j] * rstd * g[j];
              store8(CKVN + (size_t)m * 128 + (lane - 32) * 8, x); }
          else { if (lane < 52) {
                  if (!ctx) { const int s = tt - TC, pos = (q < 2) ? (s >> 6) : (s & 63); float cs[8], sn[8]; loadf8(rope + pos * 8, cs); loadf8(rope + 512 + pos * 8, sn); const float sg = (q & 1) ? 1.f : -1.f;
#pragma unroll
                      for (int j = 0; j < 8; ++j) x[j] = x[j] * cs[j] + sg * px[j] * sn[j]; }
#pragma unroll
                  for (int hh = 0; hh < 8; ++hh) store8(KA + (size_t)m * 768 + hh * 96 + 64 + q * 8, x); }
          } }
    }
}

DI void phase_rwkv_out(const Args& a, int l, bool latent_only) {
    const int lane = ltid() & 63, gw = blockIdx.x * 8 + (ltid() >> 6), nw = gridDim.x * 8;
    unsigned char* ws = a.ws;
    const bf16_t* R = (const bf16_t*)(ws + WS_R); const bf16_t* Kb = (const bf16_t*)(ws + WS_K); const bf16_t* Vb = (const bf16_t*)(ws + (l == 0 ? WS_VF : WS_V));
    const bf16_t* AA = (const bf16_t*)(ws + WS_AA); const bf16_t* Gb = (const bf16_t*)(ws + WS_G); const bf16_t* YB = (const bf16_t*)(ws + WS_YB); bf16_t* MIX = (bf16_t*)(ws + WS_MIX);
    const int c = lane * 8; float ka[8], rk[8], lw[8], lb[8];
    loadf8(a.in[I_KA] + l * 512 + c, ka); loadf8(a.in[I_RK] + l * 512 + c, rk); loadf8(a.in[I_LNW] + l * 512 + c, lw); loadf8(a.in[I_LNB] + l * 512 + c, lb);
    for (int m = gw; m < TALL; m += nw) {
        const int tt = m % TT; if (latent_only && tt < TC) continue;
        float yf[8], yb[8], r[8], k[8], v[8], a0[8], a1[8], g[8];
        load8(MIX + (size_t)m * 1024 + 512 + c, yf); load8(YB + (size_t)m * 512 + c, yb); load8(R + (size_t)m * 512 + c, r); load8(Kb + (size_t)m * 512 + c, k); load8(Vb + (size_t)m * 512 + c, v);
        load8(AA + (size_t)m * 1024 + c, a0); load8(AA + (size_t)m * 1024 + 512 + c, a1); load8(Gb + (size_t)m * 512 + c, g);
        float s = 0.f, bon = 0.f;
#pragma unroll
        for (int j = 0; j < 8; ++j) { yf[j] += yb[j]; s += yf[j]; bon += r[j] * k[j] * (2.f + (a0[j] + a1[j] - 2.f) * ka[j]) * rk[j]; }
        s = xorsum(s, 1); s = xorsum(s, 2); s = xorsum(s, 4); bon = xorsum(bon, 1); bon = xorsum(bon, 2); bon = xorsum(bon, 4);
        const float mean = s * (1.f / 64.f); float vs = 0.f;
#pragma unroll
        for (int j = 0; j < 8; ++j) { yf[j] -= mean; vs += yf[j] * yf[j]; }
        vs = xorsum(vs, 1); vs = xorsum(vs, 2); vs = xorsum(vs, 4);
        const float rstd = rsqrtf(vs * (1.f / 64.f) + 64e-5f);
#pragma unroll
        for (int j = 0; j < 8; ++j) yf[j] = (yf[j] * rstd * lw[j] + lb[j] + bon * v[j]) * g[j];
        store8(MIX + (size_t)m * 1024 + 512 + c, yf);
    }
}

DI void phase_final(const Args& a) {
    const int lane = ltid() & 63, gw = blockIdx.x * 8 + (ltid() >> 6), nw = gridDim.x * 8; const float* gamma = a.in[I_FG];
    for (int m = gw; m < NB * SEQ; m += nw) {
        float* xr = a.out + (size_t)m * DM; f32x4 v[4]; float ss = 0.f;
#pragma unroll
        for (int i = 0; i < 4; ++i) { v[i] = *(const f32x4*)(xr + i * 256 + lane * 4); ss += v[i][0] * v[i][0] + v[i][1] * v[i][1] + v[i][2] * v[i][2] + v[i][3] * v[i][3]; }
#pragma unroll
        for (int k = 1; k < 64; k <<= 1) ss = xorsum(ss, k);
        const float rstd = rsqrtf(ss * (1.f / 1024.f) + 1e-6f);
#pragma unroll
        for (int i = 0; i < 4; ++i) { const int col = i * 256 + lane * 4; const f32x4 g = *(const f32x4*)(gamma + col); *(f32x4*)(xr + col) = v[i] * rstd * g; }
    }
}

#define LAS __attribute__((address_space(3)))
#define XB_TMO      128
#define XB_XCNT(j)  (256  + 64 * (j))
#define XB_XSUB(j)  (1280 + 64 * (j))
#define XB_XGEN(j)  (2304 + 64 * (j))
#define XB_TOP      3328
#define XB_TOPGEN   3392
#define XCD_BAR_WORDS 3456
#define XB_SPIN_CAP (1u << 18)

__device__ __forceinline__ unsigned xb_ld(unsigned* p)              { return __hip_atomic_load(p, __ATOMIC_RELAXED, __HIP_MEMORY_SCOPE_AGENT); }
__device__ __forceinline__ unsigned xb_add(unsigned* p, unsigned v) { return __hip_atomic_fetch_add(p, v, __ATOMIC_RELAXED, __HIP_MEMORY_SCOPE_AGENT); }
__device__ __forceinline__ unsigned xb_xcc_id() { return (unsigned)__builtin_amdgcn_s_getreg((3 << 11) | 20) & 0xFu; }
#define XB_SPIN(cond, bar) do { unsigned _sp = 0; while (cond) { __builtin_amdgcn_s_sleep(1); \
    if ((++_sp & 255u) == 0u) { if (xb_ld(&(bar)[XB_TMO])) break; if (_sp > XB_SPIN_CAP) { atomicAdd(&(bar)[XB_TMO], 1u); break; } } } } while (0)

struct XcdBarrier {
    unsigned* bar; unsigned x;
    volatile LAS unsigned* st;
};

__device__ __forceinline__ XcdBarrier xcd_barrier_post(unsigned* bar, volatile LAS unsigned* st) {
    XcdBarrier b; b.bar = bar; b.x = xb_xcc_id(); b.st = st;
    if (threadIdx.x == 0) (void)xb_add(&bar[XB_XCNT(b.x)], 1u);
    return b;
}
__device__ __forceinline__ void xcd_barrier_complete(unsigned* bar, unsigned x, unsigned& nloc, unsigned& nx) {
    const unsigned G = gridDim.x * gridDim.y * gridDim.z;
    unsigned sum, cnt, mine, sp = 0u;
    for (;;) {
        sum = 0u; cnt = 0u; mine = 0u;
#pragma unroll
        for (unsigned j = 0; j < 16; ++j) { const unsigned c = xb_ld(&bar[XB_XCNT(j)]); sum += c; cnt += (c > 0u) ? 1u : 0u; mine = (j == x) ? c : mine; }
        if (sum == G) break;
        __builtin_amdgcn_s_sleep(1);
        if ((++sp & 255u) == 0u) { if (xb_ld(&bar[XB_TMO])) break; if (sp > XB_SPIN_CAP) { atomicAdd(&bar[XB_TMO], 1u); break; } }
    }
    nloc = mine > 0u ? mine : 1u; nx = cnt > 0u ? cnt : 1u;
}

__device__ __forceinline__ void xcd_barrier(const XcdBarrier& b) {
    asm volatile("s_waitcnt vmcnt(0)" ::: "memory");
    __syncthreads();
    if (threadIdx.x == 0) {
        unsigned* bar = b.bar;
        __builtin_amdgcn_s_waitcnt(0);
        unsigned nloc = b.st[0], nx = b.st[1];
        if (nloc == 0u) { xcd_barrier_complete(bar, b.x, nloc, nx); b.st[0] = nloc; b.st[1] = nx; }
        const unsigned old = xb_add(&bar[XB_XSUB(b.x)], 1u);
        const unsigned gen = old / nloc;
        if (old + 1u == (gen + 1u) * nloc) {
            __builtin_amdgcn_fence(__ATOMIC_RELEASE, "agent");
            asm volatile("s_waitcnt vmcnt(0)" ::: "memory");
            const unsigned og = xb_add(&bar[XB_TOP], 1u);
            const unsigned tg = og / nx;
            if (og + 1u == (tg + 1u) * nx) xb_add(&bar[XB_TOPGEN], 1u);
            else XB_SPIN(xb_ld(&bar[XB_TOPGEN]) == tg, bar);
            __builtin_amdgcn_fence(__ATOMIC_ACQUIRE, "agent");
            xb_add(&bar[XB_XGEN(b.x)], 1u);
            asm volatile("s_waitcnt vmcnt(0)" ::: "memory");
        } else {
            XB_SPIN(xb_ld(&bar[XB_XGEN(b.x)]) == gen, bar);
            __builtin_amdgcn_fence(__ATOMIC_ACQUIRE, "agent");
            asm volatile("s_waitcnt vmcnt(0)" ::: "memory");
        }
    }
    __syncthreads();
}

__global__ void __launch_bounds__(512, 2) trunk_fwd(Args ka) {
    extern __shared__ __attribute__((aligned(16))) unsigned char lds[];
    cg::grid_group grid = cg::this_grid();
    volatile LAS unsigned* bst = (volatile LAS unsigned*)((LAS unsigned char*)lds + (LDS_BYTES - 16));
    if (threadIdx.x < 4) bst[threadIdx.x] = 0u;
    __syncthreads();
    XcdBarrier xbar = xcd_barrier_post((unsigned*)(ka.ws + WS_BAR), bst);
    const int ph_hi = ka.hi;
    {
        if (blockIdx.x == 0 && threadIdx.x == 0) {
#pragma unroll
            for (int i = 0; i < 31; ++i) ((const float**)(ka.ws + WS_TAB))[i] = ka.in[i]; }
        phase_prologue(ka, lds); convert_weights(ka, 0, lds, 0);
        grid.sync();
    }
    for (int ph = 1; ph < ph_hi; ++ph) {
        Args a; a.ws = ka.ws; a.out = ka.out; asm volatile("" : "+s"(a.ws)); asm volatile("" : "+s"(a.out));
        { const float* const* tab = (const float* const*)(a.ws + WS_TAB);
#define LD4(i) asm volatile("s_load_dwordx2 %0, %4, %5\n\ts_load_dwordx2 %1, %4, %6\n\ts_load_dwordx2 %2, %4, %7\n\ts_load_dwordx2 %3, %4, %8\n\ts_waitcnt lgkmcnt(0)" \
              : "=&s"(a.in[i]), "=&s"(a.in[i + 1]), "=&s"(a.in[i + 2]), "=&s"(a.in[i + 3]) : "s"(tab), "i"((i) * 8), "i"((i) * 8 + 8), "i"((i) * 8 + 16), "i"((i) * 8 + 24))
          LD4(0); LD4(4); LD4(8); LD4(12); LD4(16); LD4(20); LD4(24);
          asm volatile("s_load_dwordx2 %0, %3, %4\n\ts_load_dwordx2 %1, %3, %5\n\ts_load_dwordx2 %2, %3, %6\n\ts_waitcnt lgkmcnt(0)" : "=&s"(a.in[28]), "=&s"(a.in[29]), "=&s"(a.in[30]) : "s"(tab), "i"(224), "i"(232), "i"(240));
#undef LD4
        }
        a.lo = 0; a.hi = 0;
        unsigned char* ws = a.ws;
        if (ph == 1) phase_vectors(a, lds);
        else if (ph == NPH - 1) phase_final(a);
        else {
            const int l = (ph - 2) / 10, s = (ph - 2) % 10; const bool last = (l == NL - 1);
            const float* mods = (const float*)(ws + WS_MODS) + (size_t)l * 33 * 6144;
            float* rsa = (float*)(ws + WS_RSA); float* rsb = (float*)(ws + WS_RSB);
            if (s == 0) { run_gemm<NIN, 1024>(lds, (const bf16_t*)(ws + WS_H), (const bf16_t*)(ws + WT_IN), 0, FnF{(bf16_t*)(ws + WS_F), rsa, (const float*)(ws + WS_C1) + (size_t)l * 33 * NIN}); }
            else if (s == 1) { phase_split(a, l); convert_weights(a, l, lds, 1);
                for (int i = blockIdx.x * 512 + ltid(); i < TALL; i += gridDim.x * 512) { rsa[i] = 0.f; rsb[i] = 0.f; } }
            else if (s == 2) { run_gemm<768, 256>(lds, (const bf16_t*)(ws + WS_CQN), (const bf16_t*)(ws + WT_UQ), 0, FnQ{(bf16_t*)(ws + WS_Q), (const float*)(ws + WS_ROPE)});
                    run_gemm<1024, 128>(lds, (const bf16_t*)(ws + WS_CKVN), (const bf16_t*)(ws + WT_UKV), 0, FnKV{(bf16_t*)(ws + WS_KATT), (bf16_t*)(ws + WS_VATT)}); }
            else if (s == 3) { phase_attn((const bf16_t*)(ws + WS_Q), (const bf16_t*)(ws + WS_KATT), (const bf16_t*)(ws + WS_VATT), (bf16_t*)(ws + WS_MIX), last, (char*)lds); }
            else if (s == 4) { run_gemm<2048, 256>(lds, (const bf16_t*)(ws + WS_A1), (const bf16_t*)(ws + WT_L1), 0, FnL1{(__half*)(ws + WS_DEC), (bf16_t*)(ws + WS_AA), a.in[I_W0] + l * 1024, a.in[I_A0] + l * 1024});
                    run_gemm<1024, 256>(lds, (const bf16_t*)(ws + WS_A2), (const bf16_t*)(ws + WT_L2), 0,
                             FnL2{(bf16_t*)(ws + WS_G), (bf16_t*)(ws + WS_V), (const bf16_t*)(ws + WS_VF), a.in[I_V0] + (l > 0 ? l - 1 : 0) * 512, l > 0 ? 1 : 0}); }
            else if (s == 5) { phase_scan((const bf16_t*)(ws + WS_R), (const bf16_t*)(ws + WS_K), (const bf16_t*)(ws + (l == 0 ? WS_VF : WS_V)), (const __half*)(ws + WS_DEC), (const bf16_t*)(ws + WS_AA),
                               (const float*)(ws + WS_INV), a.in[I_KK] + l * 512, a.in[I_KA] + l * 512, (bf16_t*)(ws + WS_MIX), (bf16_t*)(ws + WS_YB), (char*)lds); }
            else if (s == 6) { phase_rwkv_out(a, l, last); if (!last) convert_weights(a, l + 1, lds, 0); }
            else if (s == 7) { run_gemm_epi<1024, 1024>(lds, (const bf16_t*)(ws + WS_MIX), (const bf16_t*)(ws + WT_OUT), last ? 1 : 0,
                             EpiRes{a.out, (float*)(ws + WS_XC), l == 0 ? a.in[I_X] : a.out, l == 0 ? a.in[I_CTX] : (const float*)(ws + WS_XC), mods, 2,
                                    (const float*)(ws + WS_GP2) + (size_t)l * 33 * 1024, (bf16_t*)(ws + WS_H), rsb, 1}); }
            else if (s == 8) { run_gemm<DFF, 1024>(lds, (const bf16_t*)(ws + WS_H), (const bf16_t*)(ws + WT_M1), last ? 1 : 0, FnM1{(bf16_t*)(ws + WS_HID), rsb, (const float*)(ws + WS_C2) + (size_t)l * 33 * DFF}); }
            else if (s == 9) { run_gemm_epi<1024, DFF>(lds, (const bf16_t*)(ws + WS_HID), (const bf16_t*)(ws + WT_M2), last ? 1 : 0,
                             EpiRes{a.out, (float*)(ws + WS_XC), a.out, (const float*)(ws + WS_XC), mods, 5,
                                    (const float*)(ws + WS_GP1) + (size_t)(last ? l : l + 1) * 33 * 1024, (bf16_t*)(ws + WS_H), rsa, last ? 0 : 1}); }
        }
        if (ph + 1 < ph_hi) { XcdBarrier xb = xbar; asm volatile("" : "+s"(xb.bar)); xcd_barrier(xb); }
    }
}

extern "C" void kernel_launch(void* const* d_in, const int* in_sizes, int n_in, void* d_out, int out_size, void* d_ws, size_t ws_size, hipStream_t stream) {
    static int grid = 0;
    if (grid == 0) {
        if (n_in != 31 || out_size != NB * SEQ * DM || ws_size < WS_END) { fprintf(stderr, "kernel_launch: unexpected shapes: n_in %d out %d ws %zu (need %zu)\n", n_in, out_size, ws_size, (size_t)WS_END); grid = -1; return; }
        int dev = 0, cus = 0, per_cu = 0;
        (void)hipGetDevice(&dev); (void)hipDeviceGetAttribute(&cus, hipDeviceAttributeMultiprocessorCount, dev);
        if (hipFuncSetAttribute((const void*)trunk_fwd, hipFuncAttributeMaxDynamicSharedMemorySize, LDS_BYTES) != hipSuccess) { fprintf(stderr, "kernel_launch: hipFuncSetAttribute failed\n"); grid = -1; return; }
        if (hipOccupancyMaxActiveBlocksPerMultiprocessor(&per_cu, (const void*)trunk_fwd, 512, LDS_BYTES) != hipSuccess || per_cu < 1) { fprintf(stderr, "kernel_launch: occupancy query gave %d\n", per_cu); per_cu = 1; }
        (void)hipGetLastError();
        grid = cus * 1;
    }
    if (grid < 0) return;
    if (hipMemsetAsync((char*)d_ws + WS_BAR, 0, BAR_BYTES, stream) != hipSuccess) { fprintf(stderr, "kernel_launch: hipMemsetAsync failed\n"); return; }
    Args a{};
    for (int i = 0; i < 31; ++i) a.in[i] = (const float*)d_in[i];
    a.out = (float*)d_out; a.ws = (unsigned char*)d_ws; a.lo = 0; a.hi = NPH;
    void* args[] = {&a};
    hipError_t e = hipLaunchCooperativeKernel((const void*)trunk_fwd, dim3(grid), dim3(512), args, LDS_BYTES, stream);
    if (e != hipSuccess) fprintf(stderr, "kernel_launch: cooperative launch failed: %s (grid %d)\n", hipGetErrorString(e), grid);
}
```
